# Optimizing an MI355X kernel written in HIP

```python
import jax, jax.numpy as jnp
from jax import lax
import numpy as np

D_MODEL = 1024
BATCH = 8
SEQ = 2048
DEPTH = 2

CTX_LEN = 256
GRID_W = 64
ROPE_BASE = 10000.0
Q_BLOCK = 128
EPS = 1e-6

D_MIX = D_MODEL
SSD_WIDTH = D_MIX // 2
SSD_HEAD_DIM = 64
SSD_HEADS = SSD_WIDTH // SSD_HEAD_DIM
SSD_GROUPS = 2
SSD_STATE = 128
SSD_CHUNK = 128
CONV_K = 5
XBC_DIM = SSD_WIDTH + 2 * SSD_GROUPS * SSD_STATE
GQA_WIDTH = D_MIX // 4
GQA_HEAD_DIM = 64
GQA_HEADS = GQA_WIDTH // GQA_HEAD_DIM
GQA_KV_HEADS = GQA_HEADS // 2
DIFF_WIDTH = D_MIX // 4
DIFF_V_DIM = 64
DIFF_HEADS = DIFF_WIDTH // DIFF_V_DIM
DIFF_QK_DIM = DIFF_V_DIM // 2

IN_SPLITS = (
    ("xbc", XBC_DIM), ("z", SSD_WIDTH), ("dt", 2 * SSD_HEADS),
    ("gq", GQA_HEADS * GQA_HEAD_DIM), ("gk", GQA_KV_HEADS * GQA_HEAD_DIM),
    ("gv", GQA_KV_HEADS * GQA_HEAD_DIM), ("gg", GQA_WIDTH),
    ("dq", 2 * DIFF_HEADS * DIFF_QK_DIM), ("dk", 2 * DIFF_HEADS * DIFF_QK_DIM),
    ("dv", DIFF_HEADS * DIFF_V_DIM), ("dg", DIFF_WIDTH),
)
IN_COLS = sum(s for _, s in IN_SPLITS)

kernel_name = "hybrid_ssd_gqa_diffattn_dit_block"


def rmsnorm(x, g):
    xf = x.astype(jnp.float32)
    y = xf * lax.rsqrt(jnp.mean(xf * xf, axis=-1, keepdims=True) + EPS)
    return y.astype(x.dtype) * g


def split_proj(p):
    idx = [int(i) for i in np.cumsum([s for _, s in IN_SPLITS])[:-1]]
    parts = jnp.split(p, idx, axis=-1)
    return {name: part for (name, _), part in zip(IN_SPLITS, parts)}


def axial_angles(row_idx, col_idx, dim):
    quarter = dim // 4
    inv = ROPE_BASE ** (-jnp.arange(quarter, dtype=jnp.float32) / quarter)
    ang_r = row_idx.astype(jnp.float32)[:, None] * inv
    ang_c = col_idx.astype(jnp.float32)[:, None] * inv
    return jnp.concatenate([ang_r, ang_c], axis=-1)


def apply_rope(x, ang):
    half = x.shape[-1] // 2
    xf = x.astype(jnp.float32)
    x1, x2 = xf[..., :half], xf[..., half:]
    cos = jnp.cos(ang)[None, :, None, :]
    sin = jnp.sin(ang)[None, :, None, :]
    out = jnp.concatenate([x1 * cos - x2 * sin, x2 * cos + x1 * sin], axis=-1)
    return out.astype(x.dtype)


def attention(q, k, v):
    b, t, hq, d = q.shape
    g = k.shape[2]
    r = hq // g
    dv = v.shape[-1]
    nb = t // Q_BLOCK
    qb = jnp.moveaxis(q.reshape(b, nb, Q_BLOCK, g, r, d), 1, 0)
    scale = d ** -0.5

    def block(qblk):
        s = jnp.einsum('bqgrd,bsgd->bgrqs', qblk, k).astype(jnp.float32) * scale
        p = jax.nn.softmax(s, axis=-1).astype(v.dtype)
        return jnp.einsum('bgrqs,bsgd->bqgrd', p, v)

    out = lax.map(block, qb)
    return jnp.moveaxis(out, 0, 1).reshape(b, t, hq, dv)


def segsum_exp(cs):
    t = cs.shape[-1]
    diff = cs[..., :, None] - cs[..., None, :]
    mask = jnp.tril(jnp.ones((t, t), dtype=bool))
    return jnp.exp(jnp.where(mask, diff, -jnp.inf))


def ssd_scan(x, dt, a, bm, cm, init_state):
    b, l, h, p = x.shape
    nc = l // SSD_CHUNK
    f = lambda t: t.reshape((b, nc, SSD_CHUNK) + t.shape[2:])
    xd = f(x * dt[..., None])
    a_cum = jnp.cumsum(f(dt * a), axis=2)
    bc, cc = f(bm), f(cm)
    lmat = segsum_exp(jnp.moveaxis(a_cum, -1, 2))
    y_diag = jnp.einsum('bcqhn,bcshn,bchqs,bcshp->bcqhp', cc, bc, lmat, xd)
    decay_states = jnp.exp(a_cum[:, :, -1:, :] - a_cum)
    states = jnp.einsum('bcshn,bcsh,bcshp->bchpn', bc, decay_states, xd)
    chunk_cum = jnp.concatenate(
        [jnp.zeros((b, 1, h), a_cum.dtype), jnp.cumsum(a_cum[:, :, -1, :], axis=1)], axis=1)
    decay_chunk = segsum_exp(jnp.moveaxis(chunk_cum, 1, 2))
    all_states = jnp.concatenate([init_state[:, None].astype(states.dtype), states], axis=1)
    new_states = jnp.einsum('bhzy,byhpn->bzhpn', decay_chunk, all_states)
    states_in, final_state = new_states[:, :-1], new_states[:, -1]
    y_off = jnp.einsum('bcqhn,bchpn,bcqh->bcqhp', cc, states_in, jnp.exp(a_cum))
    return (y_diag + y_off).reshape(b, l, h, p), final_state


def dwconv(u, w, bias):
    out = lax.conv_general_dilated(
        u, w[:, None, :], window_strides=(1,), padding=[(CONV_K // 2, CONV_K // 2)],
        dimension_numbers=('NWC', 'WIO', 'NWC'), feature_group_count=u.shape[-1])
    return out + bias


def ssd_branch(p_l, p_c, conv_w, conv_b, a_log_f, a_log_b, dtb_f, dtb_b, d_skip, norm_g):
    a_f = -jnp.exp(a_log_f.astype(jnp.float32))
    a_b = -jnp.exp(a_log_b.astype(jnp.float32))
    rep = SSD_HEADS // SSD_GROUPS

    def prep(p):
        u = jax.nn.silu(dwconv(p["xbc"], conv_w, conv_b))
        bb, ll = u.shape[:2]
        xs, bs, cs = jnp.split(u, [SSD_WIDTH, SSD_WIDTH + SSD_GROUPS * SSD_STATE], axis=-1)
        xs = xs.reshape(bb, ll, SSD_HEADS, SSD_HEAD_DIM)
        bs = jnp.repeat(bs.reshape(bb, ll, SSD_GROUPS, SSD_STATE), rep, axis=2)
        cs = jnp.repeat(cs.reshape(bb, ll, SSD_GROUPS, SSD_STATE), rep, axis=2)
        dt_raw = p["dt"].astype(jnp.float32)
        dt_f = jax.nn.softplus(dt_raw[..., :SSD_HEADS] + dtb_f.astype(jnp.float32))
        dt_b = jax.nn.softplus(dt_raw[..., SSD_HEADS:] + dtb_b.astype(jnp.float32))
        return xs, bs, cs, dt_f, dt_b

    flip = lambda t: jnp.flip(t, axis=1)
    xc, bc, cc, dcf, dcb = prep(p_c)
    xl, bl, cl, dlf, dlb = prep(p_l)
    zeros = jnp.zeros((xc.shape[0], SSD_HEADS, SSD_HEAD_DIM, SSD_STATE), jnp.float32)
    y_cf, s_f = ssd_scan(xc, dcf, a_f, bc, cc, zeros)
    y_cb, s_b = ssd_scan(flip(xc), flip(dcb), a_b, flip(bc), flip(cc), zeros)
    y_lf, _ = ssd_scan(xl, dlf, a_f, bl, cl, s_f)
    y_lb, _ = ssd_scan(flip(xl), flip(dlb), a_b, flip(bl), flip(cl), s_b)

    def finish(yf, yb_rev, xs, z):
        y = yf + flip(yb_rev) + xs * d_skip[:, None]
        y = y.reshape(y.shape[0], y.shape[1], SSD_WIDTH)
        return rmsnorm(y * jax.nn.silu(z.astype(y.dtype)), norm_g).astype(z.dtype)

    return finish(y_lf, y_lb, xl, p_l["z"]), finish(y_cf, y_cb, xc, p_c["z"])


def gqa_branch(p_l, p_c, ang, q_g, k_g, ctx_out):
    def qkv(p):
        bb, ll = p["gq"].shape[:2]
        q = rmsnorm(p["gq"].reshape(bb, ll, GQA_HEADS, GQA_HEAD_DIM), q_g)
        k = rmsnorm(p["gk"].reshape(bb, ll, GQA_KV_HEADS, GQA_HEAD_DIM), k_g)
        v = p["gv"].reshape(bb, ll, GQA_KV_HEADS, GQA_HEAD_DIM)
        return q, k, v

    def gate(o, p):
        return o.reshape(o.shape[0], o.shape[1], GQA_WIDTH) * jax.nn.silu(p["gg"])

    q_l, k_l, v_l = qkv(p_l)
    q_c, k_c, v_c = qkv(p_c)
    q_l, k_l = apply_rope(q_l, ang), apply_rope(k_l, ang)
    k_all = jnp.concatenate([k_c, k_l], axis=1)
    v_all = jnp.concatenate([v_c, v_l], axis=1)
    y_l = gate(attention(q_l, k_all, v_all), p_l)
    y_c = gate(attention(q_c, k_c, v_c), p_c) if ctx_out else None
    return y_l, y_c


def diff_branch(p_l, p_c, ang, lam_params, norm_g, lam_init, ctx_out):
    lp = lam_params.astype(jnp.float32)
    lam = jnp.exp(jnp.sum(lp[0] * lp[1])) - jnp.exp(jnp.sum(lp[2] * lp[3])) + lam_init

    def qkv(p):
        bb, ll = p["dq"].shape[:2]
        q = p["dq"].reshape(bb, ll, 2 * DIFF_HEADS, DIFF_QK_DIM)
        k = p["dk"].reshape(bb, ll, 2 * DIFF_HEADS, DIFF_QK_DIM)
        v = p["dv"].reshape(bb, ll, DIFF_HEADS, DIFF_V_DIM)
        return q, k, v

    def diff_attend(q, k, v, p):
        o = attention(q[:, :, 0::2], k[:, :, 0::2], v) - lam * attention(q[:, :, 1::2], k[:, :, 1::2], v)
        o = (rmsnorm(o, norm_g) * (1.0 - lam_init)).astype(v.dtype)
        return o.reshape(o.shape[0], o.shape[1], DIFF_WIDTH) * jax.nn.silu(p["dg"])

    q_l, k_l, v_l = qkv(p_l)
    q_c, k_c, v_c = qkv(p_c)
    q_l, k_l = apply_rope(q_l, ang), apply_rope(k_l, ang)
    k_all = jnp.concatenate([k_c, k_l], axis=1)
    v_all = jnp.concatenate([v_c, v_l], axis=1)
    y_l = diff_attend(q_l, k_all, v_all, p_l)
    y_c = diff_attend(q_c, k_c, v_c, p_c) if ctx_out else None
    return y_l, y_c


def setup_inputs(seed: int = 0) -> dict:
    key = jax.random.key(seed)
    ks = jax.random.split(key, 24)
    nrm = jax.random.normal

    def dt_bias(k):
        dt = jnp.exp(jax.random.uniform(k, (DEPTH, SSD_HEADS), minval=float(np.log(1e-3)), maxval=float(np.log(1e-1))))
        return dt + jnp.log(-jnp.expm1(-dt))

    return {
        "x": nrm(ks[0], (BATCH, SEQ, D_MODEL), jnp.float32),
        "c": nrm(ks[1], (BATCH, D_MODEL), jnp.float32),
        "ctx": nrm(ks[2], (BATCH, CTX_LEN, D_MODEL), jnp.float32),
        "c_ctx": nrm(ks[3], (D_MODEL,), jnp.float32),
        "w_mod": nrm(ks[4], (DEPTH, D_MODEL, 3 * D_MODEL), jnp.float32) * (0.5 * D_MODEL ** -0.5),
        "b_mod": 0.01 * nrm(ks[5], (DEPTH, 3 * D_MODEL), jnp.float32),
        "g_pre": 1.0 + 0.02 * nrm(ks[6], (DEPTH, D_MODEL), jnp.float32),
        "g_post": 1.0 + 0.02 * nrm(ks[7], (DEPTH, D_MODEL), jnp.float32),
        "w_in": nrm(ks[8], (DEPTH, D_MODEL, IN_COLS), jnp.float32) * D_MODEL ** -0.5,
        "conv_w": nrm(ks[9], (DEPTH, CONV_K, XBC_DIM), jnp.float32) * CONV_K ** -0.5,
        "conv_b": 0.01 * nrm(ks[10], (DEPTH, XBC_DIM), jnp.float32),
        "a_log_fwd": jnp.log(jax.random.uniform(ks[11], (DEPTH, SSD_HEADS), minval=1.0, maxval=16.0)),
        "a_log_bwd": jnp.log(jax.random.uniform(ks[12], (DEPTH, SSD_HEADS), minval=1.0, maxval=16.0)),
        "dt_bias_fwd": dt_bias(ks[13]),
        "dt_bias_bwd": dt_bias(ks[14]),
        "d_skip": 1.0 + 0.1 * nrm(ks[15], (DEPTH, SSD_HEADS), jnp.float32),
        "ssd_norm_g": 1.0 + 0.02 * nrm(ks[16], (DEPTH, SSD_WIDTH), jnp.float32),
        "q_norm_g": 1.0 + 0.02 * nrm(ks[17], (DEPTH, GQA_HEAD_DIM), jnp.float32),
        "k_norm_g": 1.0 + 0.02 * nrm(ks[18], (DEPTH, GQA_HEAD_DIM), jnp.float32),
        "diff_lambda": 0.1 * nrm(ks[19], (DEPTH, 4, DIFF_QK_DIM), jnp.float32),
        "diff_norm_g": 1.0 + 0.02 * nrm(ks[20], (DEPTH, DIFF_V_DIM), jnp.float32),
        "w_out": nrm(ks[21], (DEPTH, D_MIX, D_MODEL), jnp.float32) * D_MIX ** -0.5,
    }


def reference(x, c, ctx, c_ctx, w_mod, b_mod, g_pre, g_post, w_in, conv_w, conv_b,
              a_log_fwd, a_log_bwd, dt_bias_fwd, dt_bias_bwd, d_skip, ssd_norm_g,
              q_norm_g, k_norm_g, diff_lambda, diff_norm_g, w_out):
    n_lat = x.shape[1]
    ROWS = n_lat // GRID_W
    row_idx = jnp.repeat(jnp.arange(ROWS), GRID_W)
    col_idx = jnp.arange(ROWS * GRID_W) % GRID_W
    ang_g = axial_angles(row_idx, col_idx, GQA_HEAD_DIM)
    ang_d = axial_angles(row_idx, col_idx, DIFF_QK_DIM)

    h, hc = x, ctx
    s_lat = jax.nn.silu(c)
    s_ctx = jax.nn.silu(c_ctx)
    for l in range(DEPTH):
        ctx_out = l < DEPTH - 1
        lam_init = 0.8 - 0.6 * float(np.exp(-0.3 * l))
        mod_l = s_lat @ w_mod[l] + b_mod[l]
        mod_c = s_ctx @ w_mod[l] + b_mod[l]
        sh_l, sc_l, gt_l = jnp.split(mod_l[:, None, :], 3, axis=-1)
        sh_c, sc_c, gt_c = jnp.split(mod_c, 3)
        u_l = rmsnorm(h, g_pre[l]) * (1 + sc_l) + sh_l
        u_c = rmsnorm(hc, g_pre[l]) * (1 + sc_c) + sh_c
        p_l = split_proj(u_l @ w_in[l])
        p_c = split_proj(u_c @ w_in[l])

        y_s_l, y_s_c = ssd_branch(p_l, p_c, conv_w[l], conv_b[l], a_log_fwd[l], a_log_bwd[l],
                                  dt_bias_fwd[l], dt_bias_bwd[l], d_skip[l], ssd_norm_g[l])
        y_g_l, y_g_c = gqa_branch(p_l, p_c, ang_g, q_norm_g[l], k_norm_g[l], ctx_out)
        y_d_l, y_d_c = diff_branch(p_l, p_c, ang_d, diff_lambda[l], diff_norm_g[l], lam_init, ctx_out)

        o_l = jnp.concatenate([y_s_l, y_g_l, y_d_l], axis=-1) @ w_out[l]
        h = h + gt_l * rmsnorm(o_l, g_post[l])
        if ctx_out:
            o_c = jnp.concatenate([y_s_c, y_g_c, y_d_c], axis=-1) @ w_out[l]
            hc = hc + gt_c * rmsnorm(o_c, g_post[l])
    return h
```

```cpp
#include <hip/hip_runtime.h>
#include <hip/hip_cooperative_groups.h>
#include <cstdio>
namespace cg = cooperative_groups;

#define DI __device__ __forceinline__
#define NT 512
static __device__ __forceinline__ int fresh_tid() { int t = threadIdx.x; asm volatile("" : "+v"(t)); return t; }
typedef unsigned short u16;
typedef __attribute__((ext_vector_type(8))) short bf16x8;
typedef __attribute__((ext_vector_type(4))) short s16x4;
typedef __attribute__((ext_vector_type(16))) float f32x16;
typedef __attribute__((ext_vector_type(4))) float f32x4;
typedef __attribute__((ext_vector_type(2))) __bf16 bf2v;
typedef __attribute__((ext_vector_type(2))) float f2v;

#define MFMA32(a, b, c) __builtin_amdgcn_mfma_f32_32x32x16_bf16((a), (b), (c), 0, 0, 0)
#define MFMA16(a, b, c) __builtin_amdgcn_mfma_f32_16x16x32_bf16((a), (b), (c), 0, 0, 0)

constexpr int LDS_BYTES = 140 * 1024;
constexpr int TT = 2304;
constexpr int RR = 18432;
constexpr int NPAD = 3456;
constexpr float EPS = 1e-6f;
constexpr float LOG2E = 1.4426950408889634f;

constexpr size_t SZ_WIN = (size_t)2 * NPAD * 1024 * 2;
constexpr size_t SZ_WOUT = (size_t)2 * 1024 * 1024 * 2;
constexpr size_t SZ_MOD = (size_t)2 * 9 * 3072 * 4;
constexpr size_t SZ_ROPE = 16384;
constexpr size_t SZ_R1024 = (size_t)RR * 1024 * 2;
constexpr size_t SZ_R512 = (size_t)RR * 512 * 2;
constexpr size_t SZ_R256 = (size_t)RR * 256 * 2;
constexpr size_t OFF_WIN = 0;
constexpr size_t OFF_WOUT = OFF_WIN + SZ_WIN;
constexpr size_t OFF_MOD = OFF_WOUT + SZ_WOUT;
constexpr size_t OFF_ROPE = OFF_MOD + SZ_MOD;
constexpr size_t OFF_U = OFF_ROPE + SZ_ROPE;
constexpr size_t OFF_XBC = OFF_U + SZ_R1024;
constexpr size_t OFF_Z = OFF_XBC + SZ_R1024;
constexpr size_t OFF_DT = OFF_Z + SZ_R512;
constexpr size_t SZ_DT = (size_t)RR * 16 * 4;
constexpr size_t OFF_Q = OFF_DT + SZ_DT;
constexpr size_t SZ_Q = (size_t)8 * 4 * TT * 64 * 2;
constexpr size_t OFF_K = OFF_Q + SZ_Q;
constexpr size_t SZ_K = (size_t)8 * 2 * TT * 64 * 2;
constexpr size_t OFF_VT = OFF_K + SZ_K;
constexpr size_t OFF_DQ = OFF_VT + SZ_K;
constexpr size_t SZ_DQ = (size_t)8 * 8 * TT * 32 * 2;
constexpr size_t OFF_DK = OFF_DQ + SZ_DQ;
constexpr size_t OFF_DVT = OFF_DK + SZ_DQ;
constexpr size_t SZ_DVT = (size_t)8 * 4 * 64 * TT * 2;
constexpr size_t OFF_GG = OFF_DVT + SZ_DVT;
constexpr size_t OFF_DG = OFF_GG + SZ_R256;
constexpr size_t OFF_CC = OFF_DG + SZ_R256;
constexpr size_t OFF_CUMF = OFF_CC + SZ_R256;
constexpr size_t SZ_CUM = (size_t)RR * 8 * 4;
constexpr size_t OFF_CUMB = OFF_CUMF + SZ_CUM;
constexpr size_t OFF_SLOC = OFF_CUMB + SZ_CUM;
constexpr size_t SZ_ST = (size_t)2 * 8 * 18 * 8 * 8192 * 2;
constexpr size_t OFF_OPART = OFF_SLOC + SZ_ST;
constexpr size_t WS_END = OFF_OPART + SZ_DT;
static_assert(SZ_ST <= (OFF_GG - OFF_Q), "Stin must fit in the q/k/v region");
static_assert(WS_END <= (size_t)256 * 1024 * 1024, "workspace");

struct Params {
  const float* in[22];
  float* out;
  unsigned char* ws;
};

struct WS {
  u16 *WinT, *WoutT, *U, *Ycat, *XBC, *Obuf, *Z, *Q, *K, *Vt, *DQ, *DK, *DVt, *GG, *DG, *Cc, *Sloc, *Stin;
  float *mod, *DT, *cumF, *cumB, *Opart;
  float2 *ropeG, *ropeD;
};

DI unsigned pk(float a, float b) { f2v v = {a, b}; return __builtin_bit_cast(unsigned, __builtin_convertvector(v, bf2v)); }
DI u16 f2bf(float a) { return (u16)(pk(a, 0.f) & 0xffffu); }
DI float bf2f(u16 b) { return __uint_as_float(((unsigned)b) << 16); }
DI float bflo(unsigned u) { return __uint_as_float(u << 16); }
DI float bfhi(unsigned u) { return __uint_as_float(u & 0xffff0000u); }
DI float silu(float x) { return x / (1.f + __expf(-x)); }
DI float softplus(float x) { return fmaxf(x, 0.f) + log1pf(__expf(-fabsf(x))); }
DI float fexp2(float x) { return __builtin_amdgcn_exp2f(x); }

DI void store64(u16* dst, const float (&v)[64]) {
#pragma unroll
  for (int i = 0; i < 8; ++i) {
    uint4 u;
    u.x = pk(v[8 * i], v[8 * i + 1]); u.y = pk(v[8 * i + 2], v[8 * i + 3]);
    u.z = pk(v[8 * i + 4], v[8 * i + 5]); u.w = pk(v[8 * i + 6], v[8 * i + 7]);
    ((uint4*)dst)[i] = u;
  }
}

constexpr int G_LDK = 72;
constexpr int G_CST = 132;
DI void gemm_tile_to_lds(const u16* __restrict__ A, const u16* __restrict__ Bt, int m0, int n0, unsigned char* lds) {
  constexpr int K = 1024;
  u16* As = (u16*)lds;
  u16* Bs = (u16*)(lds + 2 * 256 * G_LDK * 2);
  const int tid = fresh_tid(), lane = tid & 63, w = tid >> 6;
  const int r = lane & 31, h = lane >> 5;
  const int wm = w >> 1, wn = w & 1;
  const int arow = tid >> 3, akc = tid & 7;
  const u16* ag = A + (size_t)(m0 + arow) * K + akc * 8;
  const u16* bg = Bt + (size_t)(n0 + arow) * K + akc * 8;
  f32x16 acc[2][2];
#pragma unroll
  for (int i = 0; i < 2; ++i)
#pragma unroll
    for (int j = 0; j < 2; ++j)
#pragma unroll
      for (int e = 0; e < 16; ++e) acc[i][j][e] = 0.f;
  uint4 ra[4], rb[2];
#pragma unroll
  for (int i = 0; i < 4; ++i) ra[i] = *(const uint4*)(ag + (size_t)64 * i * K);
#pragma unroll
  for (int i = 0; i < 2; ++i) rb[i] = *(const uint4*)(bg + (size_t)64 * i * K);
#pragma unroll
  for (int i = 0; i < 4; ++i) *(uint4*)&As[(arow + 64 * i) * G_LDK + akc * 8] = ra[i];
#pragma unroll
  for (int i = 0; i < 2; ++i) *(uint4*)&Bs[(arow + 64 * i) * G_LDK + akc * 8] = rb[i];
  __syncthreads();
  for (int kt = 0; kt < 16; ++kt) {
    const int cur = kt & 1;
    if (kt + 1 < 16) {
      const int k0 = (kt + 1) * 64;
#pragma unroll
      for (int i = 0; i < 4; ++i) ra[i] = *(const uint4*)(ag + (size_t)64 * i * K + k0);
#pragma unroll
      for (int i = 0; i < 2; ++i) rb[i] = *(const uint4*)(bg + (size_t)64 * i * K + k0);
    }
    const u16* as = As + cur * 256 * G_LDK + (64 * wm + r) * G_LDK + 8 * h;
    const u16* bs = Bs + cur * 128 * G_LDK + (64 * wn + r) * G_LDK + 8 * h;
#pragma unroll
    for (int ks = 0; ks < 4; ++ks) {
      bf16x8 a0 = *(const bf16x8*)(as + 16 * ks);
      bf16x8 a1 = *(const bf16x8*)(as + 32 * G_LDK + 16 * ks);
      bf16x8 b0 = *(const bf16x8*)(bs + 16 * ks);
      bf16x8 b1 = *(const bf16x8*)(bs + 32 * G_LDK + 16 * ks);
      acc[0][0] = MFMA32(a0, b0, acc[0][0]);
      acc[0][1] = MFMA32(a0, b1, acc[0][1]);
      acc[1][0] = MFMA32(a1, b0, acc[1][0]);
      acc[1][1] = MFMA32(a1, b1, acc[1][1]);
    }
    if (kt + 1 < 16) {
      const int nx = cur ^ 1;
#pragma unroll
      for (int i = 0; i < 4; ++i) *(uint4*)&As[nx * 256 * G_LDK + (arow + 64 * i) * G_LDK + akc * 8] = ra[i];
#pragma unroll
      for (int i = 0; i < 2; ++i) *(uint4*)&Bs[nx * 128 * G_LDK + (arow + 64 * i) * G_LDK + akc * 8] = rb[i];
    }
    __syncthreads();
  }
  float* Cst = (float*)lds;
#pragma unroll
  for (int i = 0; i < 2; ++i)
#pragma unroll
    for (int j = 0; j < 2; ++j)
#pragma unroll
      for (int e = 0; e < 16; ++e) {
        const int row = 64 * wm + 32 * i + (e & 3) + 8 * (e >> 2) + 4 * h;
        Cst[row * G_CST + 64 * wn + 32 * j + r] = acc[i][j][e];
      }
  __syncthreads();
}

DI void load_row64(const unsigned char* lds, float (&v)[64]) {
  const int tid = fresh_tid();
  const float* src = (const float*)lds + (tid >> 1) * G_CST + (tid & 1) * 64;
#pragma unroll
  for (int i = 0; i < 16; ++i) {
    float4 f = ((const float4*)src)[i];
    v[4 * i] = f.x; v[4 * i + 1] = f.y; v[4 * i + 2] = f.z; v[4 * i + 3] = f.w;
  }
}

DI void inproj_epi(const Params& P, const WS& W, int l, int R, int nt, int half, float (&v)[64]) {
  const int b = R / TT;
  const int t = R - b * TT;
  if (nt < 8) {
    store64(W.XBC + (size_t)R * 1024 + nt * 128 + half * 64, v);
  } else if (nt < 12) {
    store64(W.Z + (size_t)R * 512 + (nt - 8) * 128 + half * 64, v);
  } else if (nt < 15) {
    const bool isq = nt < 14;
    const float* g = (isq ? P.in[17] : P.in[18]) + l * 64;
    float ss = 0.f;
#pragma unroll
    for (int j = 0; j < 64; ++j) ss += v[j] * v[j];
    const float rn = rsqrtf(ss * (1.f / 64.f) + EPS);
#pragma unroll
    for (int j = 0; j < 64; ++j) { if ((j & 15) == 0) __builtin_amdgcn_sched_barrier(0); v[j] = v[j] * rn * g[j]; }
    if (t >= 256) {
      const int pos = t - 256, ri = pos >> 6, ci = pos & 63;
#pragma unroll
      for (int i = 0; i < 32; ++i) {
        if ((i & 7) == 0) __builtin_amdgcn_sched_barrier(0);
        const float2 cs = (i < 16) ? W.ropeG[ri * 16 + i] : W.ropeG[ci * 16 + (i - 16)];
        const float x1 = v[i], x2 = v[i + 32];
        v[i] = x1 * cs.x - x2 * cs.y;
        v[i + 32] = x2 * cs.x + x1 * cs.y;
      }
    }
    if (isq) {
      const float sc = 0.125f * LOG2E;
#pragma unroll
      for (int j = 0; j < 64; ++j) v[j] *= sc;
      const int head = (nt - 12) * 2 + half;
      store64(W.Q + ((size_t)(b * 4 + head) * TT + t) * 64, v);
    } else {
      store64(W.K + ((size_t)(b * 2 + half) * TT + t) * 64, v);
    }
  } else if (nt == 15) {
    u16* dst = W.Vt + ((size_t)(b * 2 + half) * 64) * TT + t;
#pragma unroll
    for (int j = 0; j < 64; ++j) { if ((j & 7) == 0) __builtin_amdgcn_sched_barrier(0); dst[(size_t)j * TT] = f2bf(v[j]); }
  } else if (nt < 18) {
#pragma unroll
    for (int j = 0; j < 64; ++j) v[j] = silu(v[j]);
    store64(W.GG + (size_t)R * 256 + (nt - 16) * 128 + half * 64, v);
  } else if (nt < 22) {
    const bool isq = nt < 20;
    const int mbase = (nt - (isq ? 18 : 20)) * 4 + half * 2;
    if (t >= 256) {
      const int pos = t - 256, ri = pos >> 6, ci = pos & 63;
#pragma unroll
      for (int mm = 0; mm < 2; ++mm)
#pragma unroll
        for (int i = 0; i < 16; ++i) {
          if ((i & 7) == 0) __builtin_amdgcn_sched_barrier(0);
          const float2 cs = (i < 8) ? W.ropeD[ri * 8 + i] : W.ropeD[ci * 8 + (i - 8)];
          const float x1 = v[32 * mm + i], x2 = v[32 * mm + i + 16];
          v[32 * mm + i] = x1 * cs.x - x2 * cs.y;
          v[32 * mm + i + 16] = x2 * cs.x + x1 * cs.y;
        }
    }
    if (isq) {
      const float sc = 0.17677669529663687f * LOG2E;
#pragma unroll
      for (int j = 0; j < 64; ++j) v[j] *= sc;
    }
    u16* base = isq ? W.DQ : W.DK;
#pragma unroll
    for (int mm = 0; mm < 2; ++mm) {
      u16* dst = base + ((size_t)(b * 8 + mbase + mm) * TT + t) * 32;
#pragma unroll
      for (int i = 0; i < 4; ++i) {
        uint4 u;
        u.x = pk(v[32 * mm + 8 * i], v[32 * mm + 8 * i + 1]); u.y = pk(v[32 * mm + 8 * i + 2], v[32 * mm + 8 * i + 3]);
        u.z = pk(v[32 * mm + 8 * i + 4], v[32 * mm + 8 * i + 5]); u.w = pk(v[32 * mm + 8 * i + 6], v[32 * mm + 8 * i + 7]);
        ((uint4*)dst)[i] = u;
      }
    }
  } else if (nt < 24) {
    const int head = (nt - 22) * 2 + half;
    u16* dst = W.DVt + ((size_t)(b * 4 + head) * 64) * TT + t;
#pragma unroll
    for (int j = 0; j < 64; ++j) { if ((j & 7) == 0) __builtin_amdgcn_sched_barrier(0); dst[(size_t)j * TT] = f2bf(v[j]); }
  } else if (nt < 26) {
#pragma unroll
    for (int j = 0; j < 64; ++j) v[j] = silu(v[j]);
    store64(W.DG + (size_t)R * 256 + (nt - 24) * 128 + half * 64, v);
  } else {
    if (half == 0) {
      const float* bf = P.in[13] + l * 8;
      const float* bb = P.in[14] + l * 8;
#pragma unroll
      for (int j = 0; j < 16; ++j) {
        const float x = v[j] + (j < 8 ? bf[j] : bb[j - 8]);
        W.DT[(size_t)R * 16 + j] = softplus(x);
      }
    }
  }
}

template <int D>
DI void attn_core(const u16* __restrict__ Qh, const u16* __restrict__ Kh, const u16* __restrict__ Vth, int q0, int nkeys,
                  unsigned char* lds, f32x16 (&O)[2], float& lout) {
  constexpr int KP = D + 8;
  constexpr int KS = D / 16;
  u16* Ks = (u16*)lds;
  u16* Vs = (u16*)(lds + 2 * 64 * 72 * 2);
  const int tid = fresh_tid(), lane = tid & 63, w = tid >> 6;
  const int r = lane & 31, h = lane >> 5;
  bf16x8 qf[KS];
  {
    const u16* qp = Qh + (size_t)(q0 + 32 * w + r) * D + 8 * h;
#pragma unroll
    for (int ks = 0; ks < KS; ++ks) qf[ks] = *(const bf16x8*)(qp + 16 * ks);
  }
#pragma unroll
  for (int e = 0; e < 16; ++e) { O[0][e] = 0.f; O[1][e] = 0.f; }
  float m = -1e30f, lsum = 0.f;
  const int krow = (D == 64) ? (tid >> 3) : (tid >> 2);
  const int kc = (D == 64) ? (tid & 7) : (tid & 3);
  const bool kact = (D == 64) ? true : (tid < 256);
  const int vrow = tid >> 3, vc = tid & 7;
  const u16* kg = Kh + (size_t)krow * D + kc * 8;
  const u16* vg = Vth + (size_t)vrow * TT + vc * 8;
  uint4 rk = make_uint4(0, 0, 0, 0), rv;
  if (kact) rk = *(const uint4*)kg;
  rv = *(const uint4*)vg;
  if (kact) *(uint4*)&Ks[krow * KP + kc * 8] = rk;
  *(uint4*)&Vs[vrow * 72 + vc * 8] = rv;
  __syncthreads();
  const int nk = nkeys >> 6;
  for (int kt = 0; kt < nk; ++kt) {
    const int cur = kt & 1;
    if (kt + 1 < nk) {
      if (kact) rk = *(const uint4*)(kg + (size_t)(kt + 1) * 64 * D);
      rv = *(const uint4*)(vg + (kt + 1) * 64);
    }
    f32x16 S[2];
#pragma unroll
    for (int e = 0; e < 16; ++e) { S[0][e] = 0.f; S[1][e] = 0.f; }
    const u16* ks_ = Ks + cur * 64 * KP + r * KP + 8 * h;
#pragma unroll
    for (int ks = 0; ks < KS; ++ks) {
      bf16x8 a0 = *(const bf16x8*)(ks_ + 16 * ks);
      bf16x8 a1 = *(const bf16x8*)(ks_ + 32 * KP + 16 * ks);
      S[0] = MFMA32(a0, qf[ks], S[0]);
      S[1] = MFMA32(a1, qf[ks], S[1]);
    }
    __builtin_amdgcn_sched_barrier(0);
    float mx = S[0][0];
#pragma unroll
    for (int e = 1; e < 16; ++e) mx = fmaxf(mx, S[0][e]);
#pragma unroll
    for (int e = 0; e < 16; ++e) mx = fmaxf(mx, S[1][e]);
    mx = fmaxf(mx, __shfl_xor(mx, 32));
    const float mnew = fmaxf(m, mx);
    const float alpha = fexp2(m - mnew);
    m = mnew;
    float rs = 0.f;
#pragma unroll
    for (int e = 0; e < 16; ++e) { S[0][e] = fexp2(S[0][e] - mnew); rs += S[0][e]; }
#pragma unroll
    for (int e = 0; e < 16; ++e) { S[1][e] = fexp2(S[1][e] - mnew); rs += S[1][e]; }
    lsum = lsum * alpha + rs;
#pragma unroll
    for (int e = 0; e < 16; ++e) { O[0][e] *= alpha; O[1][e] *= alpha; }
    const u16* vs_ = Vs + cur * 64 * 72 + r * 72 + 4 * h;
    __builtin_amdgcn_sched_barrier(0);
#pragma unroll
    for (int t2 = 0; t2 < 2; ++t2)
#pragma unroll
      for (int s = 0; s < 2; ++s) {
        __builtin_amdgcn_sched_barrier(0);
        uint4 pu;
        pu.x = pk(S[t2][8 * s], S[t2][8 * s + 1]); pu.y = pk(S[t2][8 * s + 2], S[t2][8 * s + 3]);
        pu.z = pk(S[t2][8 * s + 4], S[t2][8 * s + 5]); pu.w = pk(S[t2][8 * s + 6], S[t2][8 * s + 7]);
        const bf16x8 pb = __builtin_bit_cast(bf16x8, pu);
#pragma unroll
        for (int dt = 0; dt < 2; ++dt) {
          const u16* vp = vs_ + dt * 32 * 72 + 32 * t2 + 16 * s;
          s16x4 lo = *(const s16x4*)vp;
          s16x4 hi = *(const s16x4*)(vp + 8);
          const bf16x8 a = __builtin_shufflevector(lo, hi, 0, 1, 2, 3, 4, 5, 6, 7);
          O[dt] = MFMA32(a, pb, O[dt]);
        }
      }
    if (kt + 1 < nk) {
      const int nx = cur ^ 1;
      if (kact) *(uint4*)&Ks[nx * 64 * KP + krow * KP + kc * 8] = rk;
      *(uint4*)&Vs[nx * 64 * 72 + vrow * 72 + vc * 8] = rv;
    }
    __syncthreads();
  }
  lout = lsum + __shfl_xor(lsum, 32);
}

DI void gqa_unit(const WS& W, int b, int head, int qb, unsigned char* lds) {
  const int tid = fresh_tid(), lane = tid & 63, w = tid >> 6, r = lane & 31, h = lane >> 5;
  const int q0 = qb * 256;
  const int nkeys = (qb == 0) ? 256 : TT;
  f32x16 O[2];
  float l;
  attn_core<64>(W.Q + (size_t)(b * 4 + head) * TT * 64, W.K + (size_t)(b * 2 + (head >> 1)) * TT * 64,
                W.Vt + (size_t)(b * 2 + (head >> 1)) * 64 * TT, q0, nkeys, lds, O, l);
  const float il = 1.f / l;
  const size_t Rr = (size_t)b * TT + q0 + 32 * w + r;
#pragma unroll
  for (int dt = 0; dt < 2; ++dt)
#pragma unroll
    for (int i4 = 0; i4 < 4; ++i4) {
      const int dv = 32 * dt + 8 * i4 + 4 * h;
      const uint2 g = *(const uint2*)(W.GG + Rr * 256 + head * 64 + dv);
      uint2 o;
      o.x = pk(O[dt][4 * i4] * il * bflo(g.x), O[dt][4 * i4 + 1] * il * bfhi(g.x));
      o.y = pk(O[dt][4 * i4 + 2] * il * bflo(g.y), O[dt][4 * i4 + 3] * il * bfhi(g.y));
      *(uint2*)(W.Ycat + Rr * 1024 + 512 + head * 64 + dv) = o;
    }
}

DI void diff_unit(const Params& P, const WS& W, int l, int b, int hh, int qb, unsigned char* lds) {
  const int tid = fresh_tid(), lane = tid & 63, w = tid >> 6, r = lane & 31, h = lane >> 5;
  const int q0 = qb * 256;
  const int nkeys = (qb == 0) ? 256 : TT;
  const float lam_init = (l == 0) ? 0.2f : 0.35550906759f;
  float lam;
  {
    const float* lp = P.in[19] + l * 128;
    float s1 = (lane < 32) ? lp[lane] * lp[32 + lane] : 0.f;
    float s2 = (lane < 32) ? lp[64 + lane] * lp[96 + lane] : 0.f;
#pragma unroll
    for (int d = 32; d >= 1; d >>= 1) { s1 += __shfl_xor(s1, d); s2 += __shfl_xor(s2, d); }
    lam = __expf(s1) - __expf(s2) + lam_init;
  }
  f32x16 O1[2], O2[2];
  float l1, l2;
  const u16* vt = W.DVt + (size_t)(b * 4 + hh) * 64 * TT;
  attn_core<32>(W.DQ + (size_t)(b * 8 + 2 * hh) * TT * 32, W.DK + (size_t)(b * 8 + 2 * hh) * TT * 32, vt, q0, nkeys, lds, O1, l1);
  attn_core<32>(W.DQ + (size_t)(b * 8 + 2 * hh + 1) * TT * 32, W.DK + (size_t)(b * 8 + 2 * hh + 1) * TT * 32, vt, q0, nkeys, lds, O2, l2);
  const float i1 = 1.f / l1, i2 = lam / l2;
  float ss = 0.f;
#pragma unroll
  for (int dt = 0; dt < 2; ++dt)
#pragma unroll
    for (int e = 0; e < 16; ++e) {
      const float o = O1[dt][e] * i1 - O2[dt][e] * i2;
      O1[dt][e] = o;
      ss += o * o;
    }
  ss += __shfl_xor(ss, 32);
  const float rn = rsqrtf(ss * (1.f / 64.f) + EPS) * (1.f - lam_init);
  const float* ng = P.in[20] + l * 64;
  const size_t Rr = (size_t)b * TT + q0 + 32 * w + r;
#pragma unroll
  for (int dt = 0; dt < 2; ++dt)
#pragma unroll
    for (int i4 = 0; i4 < 4; ++i4) {
      const int dv = 32 * dt + 8 * i4 + 4 * h;
      const uint2 g = *(const uint2*)(W.DG + Rr * 256 + hh * 64 + dv);
      const float4 n4 = *(const float4*)(ng + dv);
      uint2 o;
      o.x = pk(O1[dt][4 * i4] * rn * n4.x * bflo(g.x), O1[dt][4 * i4 + 1] * rn * n4.y * bfhi(g.x));
      o.y = pk(O1[dt][4 * i4 + 2] * rn * n4.z * bflo(g.y), O1[dt][4 * i4 + 3] * rn * n4.w * bfhi(g.y));
      *(uint2*)(W.Ycat + Rr * 1024 + 768 + hh * 64 + dv) = o;
    }
}

constexpr int S_LD = 136;
DI void ssd_local_unit(const Params& P, const WS& W, int l, int b, int c, int g, unsigned char* lds) {
  const int tid = fresh_tid(), lane = tid & 63, w = tid >> 6;
  u16* BsT = (u16*)lds;
  u16* Bs = (u16*)(lds + 34816);
  u16* Cs = (u16*)(lds + 69632);
  u16* xT = (u16*)(lds + 34816);
  u16* xsF = (u16*)(lds + 52224);
  u16* xsB = (u16*)(lds + 69632);
  float* cumF = (float*)(lds + 104448);
  float* cumB = cumF + 512;
  float* dtF = cumB + 512;
  float* dtB = dtF + 512;
  const size_t Rc0 = (size_t)b * TT + c * 128;
  const int seg_lo = (c < 2) ? 0 : 256;
  const int seg_hi = (c < 2) ? 256 : TT;
  const float* conv_w = P.in[9] + (size_t)l * 5 * 1024;
  const float* conv_b = P.in[10] + (size_t)l * 1024;
  {
    const int hh = w & 3, dir = w >> 2, hg = g * 4 + hh;
    const float a = -__expf((dir ? P.in[12] : P.in[11])[l * 8 + hg]);
    const float d0 = W.DT[(Rc0 + 2 * lane) * 16 + dir * 8 + hg];
    const float d1 = W.DT[(Rc0 + 2 * lane + 1) * 16 + dir * 8 + hg];
    const float a0 = d0 * a, a1 = d1 * a;
    float v = a0 + a1;
    float c0, c1;
    if (dir == 0) {
#pragma unroll
      for (int d = 1; d < 64; d <<= 1) { const float t = __shfl_up(v, d); if (lane >= d) v += t; }
      c0 = v - a1; c1 = v;
    } else {
#pragma unroll
      for (int d = 1; d < 64; d <<= 1) { const float t = __shfl_down(v, d); if (lane + d < 64) v += t; }
      c0 = v; c1 = v - a0;
    }
    float* lc = cumF + dir * 512 + hh * 128 + 2 * lane;
    lc[0] = c0; lc[1] = c1;
    lc[1024] = d0; lc[1025] = d1;
    float* gc = W.cumF + (size_t)dir * ((size_t)RR * 8) + (Rc0 + 2 * lane) * 8 + hg;
    gc[0] = c0; gc[8] = c1;
  }
  {
    const int ch = tid & 255, th = tid >> 8;
    const bool isB = ch < 128;
    const int col = isB ? (512 + g * 128 + ch) : (768 + g * 128 + (ch - 128));
    const float w0 = conv_w[col], w1 = conv_w[1024 + col], w2 = conv_w[2048 + col], w3 = conv_w[3072 + col], w4 = conv_w[4096 + col];
    const float bias = conv_b[col];
    const u16* src = W.XBC + (size_t)b * TT * 1024 + col;
    const int tb = c * 128 + th * 64;
    auto ld = [&](int t) -> float { return (t >= seg_lo && t < seg_hi) ? bf2f(src[(size_t)t * 1024]) : 0.f; };
    float x0 = ld(tb - 2), x1 = ld(tb - 1), x2 = ld(tb), x3 = ld(tb + 1);
    for (int o8 = 0; o8 < 8; ++o8) {
      float y[8];
#pragma unroll
      for (int k = 0; k < 8; ++k) {
        const float x4 = ld(tb + o8 * 8 + k + 2);
        y[k] = silu(bias + w0 * x0 + w1 * x1 + w2 * x2 + w3 * x3 + w4 * x4);
        x0 = x1; x1 = x2; x2 = x3; x3 = x4;
      }
      const int s0 = th * 64 + o8 * 8;
      if (isB) {
#pragma unroll
        for (int k = 0; k < 8; ++k) Bs[(s0 + k) * S_LD + ch] = f2bf(y[k]);
        uint4 u;
        u.x = pk(y[0], y[1]); u.y = pk(y[2], y[3]); u.z = pk(y[4], y[5]); u.w = pk(y[6], y[7]);
        *(uint4*)&BsT[ch * S_LD + s0] = u;
      } else {
        const int cc = ch - 128;
#pragma unroll
        for (int k = 0; k < 8; ++k) {
          const u16 q = f2bf(y[k]);
          Cs[(s0 + k) * S_LD + cc] = q;
          W.Cc[(Rc0 + s0 + k) * 256 + g * 128 + cc] = q;
        }
      }
    }
  }
  __syncthreads();
  const int c16 = lane & 15, q = lane >> 4;
  f32x4 G[8];
#pragma unroll
  for (int st = 0; st < 8; ++st) G[st] = (f32x4){0.f, 0.f, 0.f, 0.f};
#pragma unroll
  for (int ks = 0; ks < 4; ++ks) {
    const bf16x8 bfrag = *(const bf16x8*)&Cs[(16 * w + c16) * S_LD + 32 * ks + 8 * q];
#pragma unroll
    for (int st = 0; st < 8; ++st) {
      const bf16x8 afrag = *(const bf16x8*)&Bs[(16 * st + c16) * S_LD + 32 * ks + 8 * q];
      G[st] = MFMA16(afrag, bfrag, G[st]);
    }
  }
  __syncthreads();
  for (int hh = 0; hh < 4; ++hh) {
    const int hg = g * 4 + hh;
    {
      const int p = tid & 63, e8 = tid >> 6;
      const int col = hg * 64 + p;
      const float w0 = conv_w[col], w1 = conv_w[1024 + col], w2 = conv_w[2048 + col], w3 = conv_w[3072 + col], w4 = conv_w[4096 + col];
      const float bias = conv_b[col];
      const u16* src = W.XBC + (size_t)b * TT * 1024 + col;
      const int tb = c * 128 + e8 * 16;
      auto ld = [&](int t) -> float { return (t >= seg_lo && t < seg_hi) ? bf2f(src[(size_t)t * 1024]) : 0.f; };
      float x0 = ld(tb - 2), x1 = ld(tb - 1), x2 = ld(tb), x3 = ld(tb + 1);
      const float cF_end = cumF[hh * 128 + 127], cB_end = cumB[hh * 128];
#pragma unroll
      for (int o8 = 0; o8 < 2; ++o8) {
        float y[8], yf[8], yb[8];
#pragma unroll
        for (int k = 0; k < 8; ++k) {
          const float x4 = ld(tb + o8 * 8 + k + 2);
          y[k] = silu(bias + w0 * x0 + w1 * x1 + w2 * x2 + w3 * x3 + w4 * x4);
          x0 = x1; x1 = x2; x2 = x3; x3 = x4;
          const int s = e8 * 16 + o8 * 8 + k;
          yf[k] = y[k] * dtF[hh * 128 + s] * __expf(cF_end - cumF[hh * 128 + s]);
          yb[k] = y[k] * dtB[hh * 128 + s] * __expf(cB_end - cumB[hh * 128 + s]);
        }
        const int s0 = e8 * 16 + o8 * 8;
        uint4 u;
        u.x = pk(y[0], y[1]); u.y = pk(y[2], y[3]); u.z = pk(y[4], y[5]); u.w = pk(y[6], y[7]);
        *(uint4*)&xT[p * S_LD + s0] = u;
        u.x = pk(yf[0], yf[1]); u.y = pk(yf[2], yf[3]); u.z = pk(yf[4], yf[5]); u.w = pk(yf[6], yf[7]);
        *(uint4*)&xsF[p * S_LD + s0] = u;
        u.x = pk(yb[0], yb[1]); u.y = pk(yb[2], yb[3]); u.z = pk(yb[4], yb[5]); u.w = pk(yb[6], yb[7]);
        *(uint4*)&xsB[p * S_LD + s0] = u;
      }
    }
    __syncthreads();
    {
      const int t = 16 * w + c16;
      const float cF_t = cumF[hh * 128 + t], cB_t = cumB[hh * 128 + t];
      const float Dh = P.in[15][l * 8 + hg];
      f32x4 Y[4];
#pragma unroll
      for (int pt = 0; pt < 4; ++pt) Y[pt] = (f32x4){0.f, 0.f, 0.f, 0.f};
#pragma unroll
      for (int m = 0; m < 4; ++m) {
        __builtin_amdgcn_sched_barrier(0);
        float mv[8];
#pragma unroll
        for (int j = 0; j < 8; ++j) {
          const int st = 2 * m + (j >> 2), i = j & 3;
          const int s = 16 * st + 4 * q + i;
          const float ef = (s <= t) ? __expf(cF_t - cumF[hh * 128 + s]) * dtF[hh * 128 + s] : 0.f;
          const float eb = (s >= t) ? __expf(cB_t - cumB[hh * 128 + s]) * dtB[hh * 128 + s] : 0.f;
          mv[j] = G[st][i] * (ef + eb) + ((s == t) ? Dh : 0.f);
        }
        uint4 mu;
        mu.x = pk(mv[0], mv[1]); mu.y = pk(mv[2], mv[3]); mu.z = pk(mv[4], mv[5]); mu.w = pk(mv[6], mv[7]);
        const bf16x8 Mf = __builtin_bit_cast(bf16x8, mu);
#pragma unroll
        for (int pt = 0; pt < 4; ++pt) {
          const u16* xp = xT + (16 * pt + c16) * S_LD + 32 * m + 4 * q;
          s16x4 lo = *(const s16x4*)xp;
          s16x4 hi = *(const s16x4*)(xp + 16);
          const bf16x8 af = __builtin_shufflevector(lo, hi, 0, 1, 2, 3, 4, 5, 6, 7);
          Y[pt] = MFMA16(af, Mf, Y[pt]);
        }
      }
#pragma unroll
      for (int pt = 0; pt < 4; ++pt) {
        uint2 o;
        o.x = pk(Y[pt][0], Y[pt][1]); o.y = pk(Y[pt][2], Y[pt][3]);
        *(uint2*)(W.Ycat + (Rc0 + t) * 1024 + hg * 64 + 16 * pt + 4 * q) = o;
      }
    }
#pragma unroll
    for (int dir = 0; dir < 2; ++dir) {
      const u16* xs = dir ? xsB : xsF;
      f32x4 acc[4];
#pragma unroll
      for (int pt = 0; pt < 4; ++pt) acc[pt] = (f32x4){0.f, 0.f, 0.f, 0.f};
#pragma unroll
      for (int ks = 0; ks < 4; ++ks) {
        const bf16x8 af = *(const bf16x8*)&BsT[(16 * w + c16) * S_LD + 32 * ks + 8 * q];
#pragma unroll
        for (int pt = 0; pt < 4; ++pt) {
          const bf16x8 bfr = *(const bf16x8*)&xs[(16 * pt + c16) * S_LD + 32 * ks + 8 * q];
          acc[pt] = MFMA16(af, bfr, acc[pt]);
        }
      }
      u16* dst = W.Sloc + ((((size_t)dir * 8 + b) * 18 + c) * 8 + hg) * 8192;
#pragma unroll
      for (int pt = 0; pt < 4; ++pt) {
        uint2 o;
        o.x = pk(acc[pt][0], acc[pt][1]); o.y = pk(acc[pt][2], acc[pt][3]);
        *(uint2*)(dst + (16 * pt + c16) * 128 + 16 * w + 4 * q) = o;
      }
    }
    __syncthreads();
  }
}

DI void ws_init(WS& W, unsigned char* ws) {
        W.WinT = (u16*)(ws + OFF_WIN); W.WoutT = (u16*)(ws + OFF_WOUT); W.mod = (float*)(ws + OFF_MOD);
    W.ropeG = (float2*)(ws + OFF_ROPE); W.ropeD = (float2*)(ws + OFF_ROPE + 8192);
    W.U = (u16*)(ws + OFF_U); W.Ycat = (u16*)(ws + OFF_U); W.XBC = (u16*)(ws + OFF_XBC); W.Obuf = (u16*)(ws + OFF_XBC);
    W.Z = (u16*)(ws + OFF_Z); W.DT = (float*)(ws + OFF_DT);
    W.Q = (u16*)(ws + OFF_Q); W.K = (u16*)(ws + OFF_K); W.Vt = (u16*)(ws + OFF_VT);
    W.DQ = (u16*)(ws + OFF_DQ); W.DK = (u16*)(ws + OFF_DK); W.DVt = (u16*)(ws + OFF_DVT); W.Stin = (u16*)(ws + OFF_Q);
    W.GG = (u16*)(ws + OFF_GG); W.DG = (u16*)(ws + OFF_DG); W.Cc = (u16*)(ws + OFF_CC);
    W.cumF = (float*)(ws + OFF_CUMF); W.cumB = (float*)(ws + OFF_CUMB); W.Sloc = (u16*)(ws + OFF_SLOC);
    W.Opart = (float*)(ws + OFF_OPART);
}

typedef const Params __attribute__((address_space(4)))* KArgP;
DI Params load_params(KArgP kp) {
  asm volatile("" : "+s"(kp));
  Params P;
#pragma unroll
  for (int i = 0; i < 22; ++i) P.in[i] = kp->in[i];
  P.out = kp->out; P.ws = kp->ws;
  return P;
}

DI void ph0_prologue(KArgP kp, unsigned char* lds) {
  const Params P = load_params(kp); WS W; ws_init(W, P.ws);
  const int tid = fresh_tid(), lane = tid & 63, w = tid >> 6;
  const int nb = gridDim.x, bid = blockIdx.x;
  (void)lane; (void)w; (void)tid;
  {
    float* S = (float*)(lds + 65536);
    for (int i = tid; i < 9 * 1024; i += NT) {
      const float x = (i < 8192) ? P.in[1][i] : P.in[3][i - 8192];
      S[i] = silu(x);
    }
    __syncthreads();
    constexpr int U_WIN = 2 * 54 * 16, U_WOUT = 2 * 16 * 16, U_MOD = 384;
    for (int u = bid; u < U_WIN + U_WOUT + U_MOD + 1; u += nb) {
      if (u < U_WIN + U_WOUT) {
        const float* src; u16* dst; int ldn, n0, k0; bool inproj;
        if (u < U_WIN) {
          const int l = u / (54 * 16), rem = u % (54 * 16);
          n0 = (rem >> 4) * 64; k0 = (rem & 15) * 64; ldn = 3344; inproj = true;
          src = P.in[8] + (size_t)l * 1024 * 3344; dst = W.WinT + (size_t)l * NPAD * 1024;
        } else {
          const int v = u - U_WIN; const int l = v >> 8, rem = v & 255;
          n0 = (rem >> 4) * 64; k0 = (rem & 15) * 64; ldn = 1024; inproj = false;
          src = P.in[21] + (size_t)l * 1024 * 1024; dst = W.WoutT + (size_t)l * 1024 * 1024;
        }
        float* tile = (float*)lds;
        {
          const int n = tid & 63, kq = tid >> 6;
          const int nd = n0 + n;
          int ns = nd;
          if (inproj) { ns = (nd < 1536) ? nd : (nd < 3328 ? nd + 16 : (nd < 3344 ? nd - 3328 + 1536 : -1)); }
#pragma unroll
          for (int i = 0; i < 8; ++i) {
            const int k = kq * 8 + i;
            tile[k * 65 + n] = (ns >= 0) ? src[(size_t)(k0 + k) * ldn + ns] : 0.f;
          }
        }
        __syncthreads();
        {
          const int n = tid >> 3, kc = tid & 7;
          float f[8];
#pragma unroll
          for (int i = 0; i < 8; ++i) f[i] = tile[(kc * 8 + i) * 65 + n];
          uint4 o;
          o.x = pk(f[0], f[1]); o.y = pk(f[2], f[3]); o.z = pk(f[4], f[5]); o.w = pk(f[6], f[7]);
          *(uint4*)(dst + (size_t)(n0 + n) * 1024 + k0 + kc * 8) = o;
        }
        __syncthreads();
      } else if (u < U_WIN + U_WOUT + U_MOD) {
        const int v = u - U_WIN - U_WOUT;
        const int l = v / 192, n0 = (v % 192) * 16;
        const int c16 = tid & 15, kg = tid >> 4;
        const float* wm = P.in[4] + (size_t)l * 1024 * 3072 + n0 + c16;
        float acc[9];
#pragma unroll
        for (int rr = 0; rr < 9; ++rr) acc[rr] = 0.f;
#pragma unroll 8
        for (int kk = 0; kk < 32; ++kk) {
          const int k = kg * 32 + kk;
          const float wv = wm[(size_t)k * 3072];
#pragma unroll
          for (int rr = 0; rr < 9; ++rr) acc[rr] += S[rr * 1024 + k] * wv;
        }
        float* red = (float*)lds;
#pragma unroll
        for (int rr = 0; rr < 9; ++rr) red[(kg * 16 + c16) * 9 + rr] = acc[rr];
        __syncthreads();
        if (tid < 144) {
          const int cc = tid / 9, rr = tid % 9;
          float s = 0.f;
          for (int k2 = 0; k2 < 32; ++k2) s += red[(k2 * 16 + cc) * 9 + rr];
          W.mod[((size_t)l * 9 + rr) * 3072 + n0 + cc] = s + P.in[5][l * 3072 + n0 + cc];
        }
        __syncthreads();
      } else {
        for (int i = tid; i < 64 * 16; i += NT) {
          const int idx = i >> 4, k = i & 15;
          const float inv = powf(10000.f, -(float)k / 16.f);
          float sn, cs; sincosf((float)idx * inv, &sn, &cs);
          W.ropeG[i] = make_float2(cs, sn);
        }
        for (int i = tid; i < 64 * 8; i += NT) {
          const int idx = i >> 3, k = i & 7;
          const float inv = powf(10000.f, -(float)k / 8.f);
          float sn, cs; sincosf((float)idx * inv, &sn, &cs);
          W.ropeD[i] = make_float2(cs, sn);
        }
      }
    }
  }
}

DI void ph1_prep(KArgP kp) {
  const Params P = load_params(kp); WS W; ws_init(W, P.ws);
  const int tid = fresh_tid(), lane = tid & 63, w = tid >> 6;
  const int nb = gridDim.x, bid = blockIdx.x;
  (void)lane; (void)w; (void)tid;
  for (int R = bid * 8 + w; R < RR; R += nb * 8) {
    const int b = R / TT, t = R - b * TT;
    const float* src = (t < 256) ? (P.in[2] + ((size_t)b * 256 + t) * 1024) : (P.in[0] + ((size_t)b * 2048 + (t - 256)) * 1024);
    const float* md = W.mod + (size_t)((t < 256) ? 8 : b) * 3072;
    const float* gp = P.in[6];
    float4 x[4];
    float ss = 0.f;
#pragma unroll
    for (int i = 0; i < 4; ++i) {
      x[i] = *(const float4*)(src + i * 256 + lane * 4);
      ss += x[i].x * x[i].x + x[i].y * x[i].y + x[i].z * x[i].z + x[i].w * x[i].w;
    }
#pragma unroll
    for (int d = 32; d >= 1; d >>= 1) ss += __shfl_xor(ss, d);
    const float rn = rsqrtf(ss * (1.f / 1024.f) + EPS);
#pragma unroll
    for (int i = 0; i < 4; ++i) {
      const int k = i * 256 + lane * 4;
      const float4 g4 = *(const float4*)(gp + k);
      const float4 sh = *(const float4*)(md + k);
      const float4 sc = *(const float4*)(md + 1024 + k);
      uint2 o;
      o.x = pk(x[i].x * rn * g4.x * (1.f + sc.x) + sh.x, x[i].y * rn * g4.y * (1.f + sc.y) + sh.y);
      o.y = pk(x[i].z * rn * g4.z * (1.f + sc.z) + sh.z, x[i].w * rn * g4.w * (1.f + sc.w) + sh.w);
      *(uint2*)(W.U + (size_t)R * 1024 + k) = o;
    }
  }
}

DI void ph2_inproj(KArgP kp, int l, unsigned char* lds) {
  const Params P = load_params(kp); WS W; ws_init(W, P.ws);
  const int tid = fresh_tid(), lane = tid & 63, w = tid >> 6;
  const int nb = gridDim.x, bid = blockIdx.x;
  (void)lane; (void)w; (void)tid;
    for (int tile = bid; tile < 72 * 27; tile += nb) {
      const int mt = tile / 27, nt = tile - mt * 27;
      gemm_tile_to_lds(W.U, W.WinT + (size_t)l * NPAD * 1024, mt * 256, nt * 128, lds);
      float v[64];
      load_row64(lds, v);
      inproj_epi(P, W, l, mt * 256 + (tid >> 1), nt, tid & 1, v);
      __syncthreads();
    }
}

DI void ph3_mix(KArgP kp, int l, unsigned char* lds) {
  const Params P = load_params(kp); WS W; ws_init(W, P.ws);
  const int tid = fresh_tid(), lane = tid & 63, w = tid >> 6;
  const int nb = gridDim.x, bid = blockIdx.x;
  (void)lane; (void)w; (void)tid;
    {
      const int n_units = 256 + 256 + 288 + (l == 0 ? 64 : 0);
      for (int u = bid; u < n_units; u += nb) {
        if (u < 256) {
          const int b = u >> 5, hh = (u >> 3) & 3, qb = 1 + (u & 7);
          diff_unit(P, W, l, b, hh, qb, lds);
        } else if (u < 512) {
          const int v = u - 256;
          const int b = v >> 5, hd = (v >> 3) & 3, qb = 1 + (v & 7);
          gqa_unit(W, b, hd, qb, lds);
        } else if (u < 800) {
          const int v = u - 512;
          const int b = v / 36, rem = v % 36;
          ssd_local_unit(P, W, l, b, rem >> 1, rem & 1, lds);
        } else if (u < 832) {
          const int v = u - 800;
          diff_unit(P, W, l, v >> 2, v & 3, 0, lds);
        } else {
          const int v = u - 832;
          gqa_unit(W, v >> 2, v & 3, 0, lds);
        }
        __syncthreads();
      }
    }
}

DI void ph4a_states(KArgP kp) {
  const Params P = load_params(kp); WS W; ws_init(W, P.ws);
  const int tid = fresh_tid(), lane = tid & 63, w = tid >> 6;
  const int nb = gridDim.x, bid = blockIdx.x;
  (void)lane; (void)w; (void)tid;
    for (int gid = bid * NT + tid; gid < 2 * 8 * 8 * 2048; gid += nb * NT) {
      const int e4 = gid & 2047, hg = (gid >> 11) & 7, b = (gid >> 14) & 7, dir = gid >> 17;
      float s0 = 0.f, s1 = 0.f, s2 = 0.f, s3 = 0.f;
      for (int step = 0; step < 18; ++step) {
        const int c = dir ? (step == 0 ? 1 : (step == 1 ? 0 : 19 - step)) : step;
        const size_t idx = ((((size_t)dir * 8 + b) * 18 + c) * 8 + hg) * 8192 + (size_t)e4 * 4;
        uint2 o;
        o.x = pk(s0, s1); o.y = pk(s2, s3);
        *(uint2*)(W.Stin + idx) = o;
        const float tot = W.cumF[(size_t)dir * ((size_t)RR * 8) + ((size_t)b * TT + c * 128 + (dir ? 0 : 127)) * 8 + hg];
        const float dec = __expf(tot);
        const uint2 sv = *(const uint2*)(W.Sloc + idx);
        s0 = s0 * dec + bflo(sv.x); s1 = s1 * dec + bfhi(sv.x);
        s2 = s2 * dec + bflo(sv.y); s3 = s3 * dec + bfhi(sv.y);
      }
    }
}

DI void ph4b_yoff(KArgP kp, int l, unsigned char* lds) {
  const Params P = load_params(kp); WS W; ws_init(W, P.ws);
  const int tid = fresh_tid(), lane = tid & 63, w = tid >> 6;
  const int nb = gridDim.x, bid = blockIdx.x;
  (void)lane; (void)w; (void)tid;
    for (int u = bid; u < 8 * 18 * 4; u += nb) {
      const int b = u / 72, rem = u % 72, c = rem >> 2, tb = rem & 3;
      const int r = lane & 31, h2 = lane >> 5;
      const int hg = w, g = w >> 2;
      const size_t Rr = (size_t)b * TT + c * 128 + 32 * tb + r;
      f32x16 acc[2][2];
#pragma unroll
      for (int d = 0; d < 2; ++d)
#pragma unroll
        for (int pt = 0; pt < 2; ++pt)
#pragma unroll
          for (int e = 0; e < 16; ++e) acc[d][pt][e] = 0.f;
      const u16* cp = W.Cc + Rr * 256 + g * 128 + 8 * h2;
      const u16* sf = W.Stin + ((((size_t)0 * 8 + b) * 18 + c) * 8 + hg) * 8192 + (size_t)r * 128 + 8 * h2;
      const u16* sb = W.Stin + ((((size_t)1 * 8 + b) * 18 + c) * 8 + hg) * 8192 + (size_t)r * 128 + 8 * h2;
#pragma unroll 2
      for (int ks = 0; ks < 8; ++ks) {
        const bf16x8 bfr = *(const bf16x8*)(cp + 16 * ks);
        const bf16x8 f0 = *(const bf16x8*)(sf + 16 * ks);
        const bf16x8 f1 = *(const bf16x8*)(sf + 32 * 128 + 16 * ks);
        const bf16x8 b0 = *(const bf16x8*)(sb + 16 * ks);
        const bf16x8 b1 = *(const bf16x8*)(sb + 32 * 128 + 16 * ks);
        acc[0][0] = MFMA32(f0, bfr, acc[0][0]);
        acc[0][1] = MFMA32(f1, bfr, acc[0][1]);
        acc[1][0] = MFMA32(b0, bfr, acc[1][0]);
        acc[1][1] = MFMA32(b1, bfr, acc[1][1]);
      }
      const float eF = __expf(W.cumF[Rr * 8 + hg]), eB = __expf(W.cumB[Rr * 8 + hg]);
      float ss = 0.f;
#pragma unroll
      for (int pt = 0; pt < 2; ++pt)
#pragma unroll
        for (int i4 = 0; i4 < 4; ++i4) {
          const int p = 32 * pt + 8 * i4 + 4 * h2;
          const uint2 yd = *(const uint2*)(W.Ycat + Rr * 1024 + hg * 64 + p);
          const uint2 zz = *(const uint2*)(W.Z + Rr * 512 + hg * 64 + p);
          float y0 = bflo(yd.x) + eF * acc[0][pt][4 * i4] + eB * acc[1][pt][4 * i4];
          float y1 = bfhi(yd.x) + eF * acc[0][pt][4 * i4 + 1] + eB * acc[1][pt][4 * i4 + 1];
          float y2 = bflo(yd.y) + eF * acc[0][pt][4 * i4 + 2] + eB * acc[1][pt][4 * i4 + 2];
          float y3 = bfhi(yd.y) + eF * acc[0][pt][4 * i4 + 3] + eB * acc[1][pt][4 * i4 + 3];
          y0 *= silu(bflo(zz.x)); y1 *= silu(bfhi(zz.x)); y2 *= silu(bflo(zz.y)); y3 *= silu(bfhi(zz.y));
          acc[0][pt][4 * i4] = y0; acc[0][pt][4 * i4 + 1] = y1; acc[0][pt][4 * i4 + 2] = y2; acc[0][pt][4 * i4 + 3] = y3;
          ss += y0 * y0 + y1 * y1 + y2 * y2 + y3 * y3;
        }
      ss += __shfl_xor(ss, 32);
      float* red = (float*)lds;
      if (h2 == 0) red[w * 32 + r] = ss;
      __syncthreads();
      float tot = 0.f;
#pragma unroll
      for (int k = 0; k < 8; ++k) tot += red[k * 32 + r];
      const float rn = rsqrtf(tot * (1.f / 512.f) + EPS);
      const float* ng = P.in[16] + l * 512 + hg * 64;
#pragma unroll
      for (int pt = 0; pt < 2; ++pt)
#pragma unroll
        for (int i4 = 0; i4 < 4; ++i4) {
          const int p = 32 * pt + 8 * i4 + 4 * h2;
          const float4 n4 = *(const float4*)(ng + p);
          uint2 o;
          o.x = pk(acc[0][pt][4 * i4] * rn * n4.x, acc[0][pt][4 * i4 + 1] * rn * n4.y);
          o.y = pk(acc[0][pt][4 * i4 + 2] * rn * n4.z, acc[0][pt][4 * i4 + 3] * rn * n4.w);
          *(uint2*)(W.Ycat + Rr * 1024 + hg * 64 + p) = o;
        }
      __syncthreads();
    }
}

DI void ph5_outproj(KArgP kp, int l, unsigned char* lds) {
  const Params P = load_params(kp); WS W; ws_init(W, P.ws);
  const int tid = fresh_tid(), lane = tid & 63, w = tid >> 6;
  const int nb = gridDim.x, bid = blockIdx.x;
  (void)lane; (void)w; (void)tid;
    {
      const int n_tiles = (l == 0) ? 72 * 8 : 64 * 8;
      for (int tile = bid; tile < n_tiles; tile += nb) {
        int mt = tile >> 3;
        const int nt = tile & 7;
        if (l != 0) mt = (mt >> 3) * 9 + 1 + (mt & 7);
        gemm_tile_to_lds(W.Ycat, W.WoutT + (size_t)l * 1024 * 1024, mt * 256, nt * 128, lds);
        float v[64];
        load_row64(lds, v);
        const size_t R = (size_t)mt * 256 + (tid >> 1);
        float ss = 0.f;
#pragma unroll
        for (int j = 0; j < 64; ++j) ss += v[j] * v[j];
        W.Opart[R * 16 + nt * 2 + (tid & 1)] = ss;
        store64(W.Obuf + R * 1024 + nt * 128 + (tid & 1) * 64, v);
        __syncthreads();
      }
    }
}

DI void ph6_post(KArgP kp, int l) {
  const Params P = load_params(kp); WS W; ws_init(W, P.ws);
  const int tid = fresh_tid(), lane = tid & 63, w = tid >> 6;
  const int nb = gridDim.x, bid = blockIdx.x;
  (void)lane; (void)w; (void)tid;
    for (int R = bid * 8 + w; R < RR; R += nb * 8) {
      const int b = R / TT, t = R - b * TT;
      const bool isctx = t < 256;
      if (l == 1 && isctx) continue;
      const float* md = W.mod + ((size_t)l * 9 + (isctx ? 8 : b)) * 3072;
      const float* hsrc;
      if (isctx) hsrc = P.in[2] + ((size_t)b * 256 + t) * 1024;
      else hsrc = (l == 0 ? P.in[0] : (const float*)P.out) + ((size_t)b * 2048 + (t - 256)) * 1024;
      float pss = (lane < 16) ? W.Opart[(size_t)R * 16 + lane] : 0.f;
#pragma unroll
      for (int d = 8; d >= 1; d >>= 1) pss += __shfl_xor(pss, d);
      pss = __shfl(pss, 0);
      const float rn = rsqrtf(pss * (1.f / 1024.f) + EPS);
      const float* gpost = P.in[7] + l * 1024;
      float4 hn[4];
      float ss = 0.f;
#pragma unroll
      for (int i = 0; i < 4; ++i) {
        const int k = i * 256 + lane * 4;
        const float4 hv = *(const float4*)(hsrc + k);
        const uint2 ov = *(const uint2*)(W.Obuf + (size_t)R * 1024 + k);
        const float4 g4 = *(const float4*)(gpost + k);
        const float4 gt = *(const float4*)(md + 2048 + k);
        hn[i].x = hv.x + gt.x * (bflo(ov.x) * rn * g4.x);
        hn[i].y = hv.y + gt.y * (bfhi(ov.x) * rn * g4.y);
        hn[i].z = hv.z + gt.z * (bflo(ov.y) * rn * g4.z);
        hn[i].w = hv.w + gt.w * (bfhi(ov.y) * rn * g4.w);
        ss += hn[i].x * hn[i].x + hn[i].y * hn[i].y + hn[i].z * hn[i].z + hn[i].w * hn[i].w;
      }
      if (!isctx) {
        float* dst = P.out + ((size_t)b * 2048 + (t - 256)) * 1024;
#pragma unroll
        for (int i = 0; i < 4; ++i) *(float4*)(dst + i * 256 + lane * 4) = hn[i];
      }
      if (l == 0) {
#pragma unroll
        for (int d = 32; d >= 1; d >>= 1) ss += __shfl_xor(ss, d);
        const float r2 = rsqrtf(ss * (1.f / 1024.f) + EPS);
        const float* md1 = W.mod + ((size_t)9 + (isctx ? 8 : b)) * 3072;
        const float* gp = P.in[6] + 1024;
#pragma unroll
        for (int i = 0; i < 4; ++i) {
          const int k = i * 256 + lane * 4;
          const float4 g4 = *(const float4*)(gp + k);
          const float4 sh = *(const float4*)(md1 + k);
          const float4 sc = *(const float4*)(md1 + 1024 + k);
          uint2 o;
          o.x = pk(hn[i].x * r2 * g4.x * (1.f + sc.x) + sh.x, hn[i].y * r2 * g4.y * (1.f + sc.y) + sh.y);
          o.y = pk(hn[i].z * r2 * g4.z * (1.f + sc.z) + sh.z, hn[i].w * r2 * g4.w * (1.f + sc.w) + sh.w);
          *(uint2*)(W.U + (size_t)R * 1024 + k) = o;
        }
      }
    }
}

__global__ void __launch_bounds__(NT) fwd_mega(Params Parg) {
  extern __shared__ __attribute__((aligned(16))) unsigned char lds[];
  cg::grid_group grid = cg::this_grid();
  KArgP kp = (KArgP)__builtin_amdgcn_kernarg_segment_ptr();

  ph0_prologue(kp, lds);
  grid.sync();

  ph1_prep(kp);
  grid.sync();

  for (int l = 0; l < 2; ++l) {
    ph2_inproj(kp, l, lds);
    grid.sync();

    ph3_mix(kp, l, lds);
    grid.sync();

    ph4a_states(kp);
    grid.sync();

    ph4b_yoff(kp, l, lds);
    grid.sync();

    ph5_outproj(kp, l, lds);
    grid.sync();

    ph6_post(kp, l);
    if (l == 0) grid.sync();
  }
}

extern "C" void kernel_launch(void* const* d_in, const int* in_sizes, int n_in,
                              void* d_out, int out_size, void* d_ws, size_t ws_size,
                              hipStream_t stream) {
  static int grid_blocks = 0;
  if (!grid_blocks) {
    int dev = 0, cus = 0, per_cu = 0;
    (void)hipGetDevice(&dev);
    (void)hipDeviceGetAttribute(&cus, hipDeviceAttributeMultiprocessorCount, dev);
    (void)hipFuncSetAttribute((const void*)fwd_mega, hipFuncAttributeMaxDynamicSharedMemorySize, LDS_BYTES);
    (void)hipOccupancyMaxActiveBlocksPerMultiprocessor(&per_cu, (const void*)fwd_mega, NT, LDS_BYTES);
    if (per_cu < 1) per_cu = 1;
    grid_blocks = cus * per_cu;
    if (ws_size < WS_END) fprintf(stderr, "workspace too small: %zu < %zu\n", ws_size, (size_t)WS_END);
  }
  Params p{};
  for (int i = 0; i < 22; ++i) p.in[i] = (const float*)d_in[i];
  p.out = (float*)d_out;
  p.ws = (unsigned char*)d_ws;
  void* args[] = {&p};
  hipError_t e = hipLaunchCooperativeKernel((const void*)fwd_mega, dim3(grid_blocks), dim3(NT), args, LDS_BYTES, stream);
  if (e != hipSuccess) fprintf(stderr, "cooperative launch failed: %s (grid %d)\n", hipGetErrorString(e), grid_blocks);
}
```

```cpp
#include <hip/hip_runtime.h>
#include <hip/hip_cooperative_groups.h>
#include <cstdio>
namespace cg = cooperative_groups;

#define DI __device__ __forceinline__
#define NT 512
static __device__ __forceinline__ int fresh_tid() { int t = threadIdx.x; asm volatile("" : "+v"(t)); return t; }
typedef unsigned short u16;
typedef __attribute__((ext_vector_type(8))) short bf16x8;
typedef __attribute__((ext_vector_type(4))) short s16x4;
typedef __attribute__((ext_vector_type(16))) float f32x16;
typedef __attribute__((ext_vector_type(4))) float f32x4;
typedef __attribute__((ext_vector_type(2))) __bf16 bf2v;
typedef __attribute__((ext_vector_type(2))) float f2v;
typedef unsigned __attribute__((ext_vector_type(4))) u32x4;

#define MFMA32(a, b, c) __builtin_amdgcn_mfma_f32_32x32x16_bf16((a), (b), (c), 0, 0, 0)
#define MFMA16(a, b, c) __builtin_amdgcn_mfma_f32_16x16x32_bf16((a), (b), (c), 0, 0, 0)

constexpr int LDS_BYTES = 140 * 1024;
constexpr int TT = 2304;
constexpr int RR = 18432;
constexpr int NPAD = 3456;
constexpr float EPS = 1e-6f;
constexpr float LOG2E = 1.4426950408889634f;

constexpr size_t SZ_WIN = (size_t)2 * NPAD * 1024 * 2;
constexpr size_t SZ_WOUT = (size_t)2 * 1024 * 1024 * 2;
constexpr size_t SZ_MOD = (size_t)2 * 9 * 3072 * 4;
constexpr size_t SZ_ROPE = 16384;
constexpr size_t SZ_R1024 = (size_t)RR * 1024 * 2;
constexpr size_t SZ_R512 = (size_t)RR * 512 * 2;
constexpr size_t SZ_R256 = (size_t)RR * 256 * 2;
constexpr size_t OFF_WIN = 0;
constexpr size_t OFF_WOUT = OFF_WIN + SZ_WIN;
constexpr size_t OFF_MOD = OFF_WOUT + SZ_WOUT;
constexpr size_t OFF_ROPE = OFF_MOD + SZ_MOD;
constexpr size_t OFF_U = OFF_ROPE + SZ_ROPE;
constexpr size_t OFF_XBC = OFF_U + SZ_R1024;
constexpr size_t OFF_Z = OFF_XBC + SZ_R1024;
constexpr size_t OFF_DT = OFF_Z + SZ_R512;
constexpr size_t SZ_DT = (size_t)RR * 16 * 4;
constexpr size_t OFF_Q = OFF_DT + SZ_DT;
constexpr size_t SZ_Q = (size_t)8 * 4 * TT * 64 * 2;
constexpr size_t OFF_K = OFF_Q + SZ_Q;
constexpr size_t SZ_K = (size_t)8 * 2 * TT * 64 * 2;
constexpr size_t OFF_VT = OFF_K + SZ_K;
constexpr size_t OFF_DQ = OFF_VT + SZ_K;
constexpr size_t SZ_DQ = (size_t)8 * 8 * TT * 32 * 2;
constexpr size_t OFF_DK = OFF_DQ + SZ_DQ;
constexpr size_t OFF_DVT = OFF_DK + SZ_DQ;
constexpr size_t SZ_DVT = (size_t)8 * 4 * 64 * TT * 2;
constexpr size_t OFF_GG = OFF_DVT + SZ_DVT;
constexpr size_t OFF_DG = OFF_GG + SZ_R256;
constexpr size_t OFF_CC = OFF_DG + SZ_R256;
constexpr size_t OFF_CUMF = OFF_CC + SZ_R256;
constexpr size_t SZ_CUM = (size_t)RR * 8 * 4;
constexpr size_t OFF_CUMB = OFF_CUMF + SZ_CUM;
constexpr size_t OFF_SLOC = OFF_CUMB + SZ_CUM;
constexpr size_t SZ_ST = (size_t)2 * 8 * 18 * 8 * 8192 * 2;
constexpr size_t OFF_OPART = OFF_SLOC + SZ_ST;
constexpr size_t OFF_BAR = OFF_OPART + SZ_DT;
constexpr size_t WS_END = OFF_BAR + 4096;
static_assert(SZ_ST <= (OFF_GG - OFF_Q), "Stin must fit in the q/k/v region");
static_assert(WS_END <= (size_t)256 * 1024 * 1024, "workspace");

struct Params {
  const float* in[22];
  float* out;
  unsigned char* ws;
};

struct WS {
  u16 *WinT, *WoutT, *U, *Ycat, *XBC, *Obuf, *Z, *Q, *K, *Vt, *DQ, *DK, *DVt, *GG, *DG, *Cc, *Sloc, *Stin;
  float *mod, *DT, *cumF, *cumB, *Opart;
  float2 *ropeG, *ropeD;
};

DI unsigned pk(float a, float b) { f2v v = {a, b}; return __builtin_bit_cast(unsigned, __builtin_convertvector(v, bf2v)); }
DI u16 f2bf(float a) { return (u16)(pk(a, 0.f) & 0xffffu); }
DI float bf2f(u16 b) { return __uint_as_float(((unsigned)b) << 16); }
DI float bflo(unsigned u) { return __uint_as_float(u << 16); }
DI float bfhi(unsigned u) { return __uint_as_float(u & 0xffff0000u); }
DI float silu(float x) { return x / (1.f + __expf(-x)); }
DI float softplus(float x) { return fmaxf(x, 0.f) + log1pf(__expf(-fabsf(x))); }
DI float fexp2(float x) { return __builtin_amdgcn_exp2f(x); }

DI void store64(u16* dst, const float (&v)[64]) {
#pragma unroll
  for (int i = 0; i < 8; ++i) {
    uint4 u;
    u.x = pk(v[8 * i], v[8 * i + 1]); u.y = pk(v[8 * i + 2], v[8 * i + 3]);
    u.z = pk(v[8 * i + 4], v[8 * i + 5]); u.w = pk(v[8 * i + 6], v[8 * i + 7]);
    ((uint4*)dst)[i] = u;
  }
}

struct GRegs { u32x4 a0, a1, a2, a3, b0, b1; };
DI void g_load(GRegs& R, const u16* ag, const u16* bg, int k0) {
  constexpr size_t K = 1024;
  R.a0 = *(const u32x4*)(ag + k0);
  R.a1 = *(const u32x4*)(ag + 64 * K + k0);
  R.a2 = *(const u32x4*)(ag + 128 * K + k0);
  R.a3 = *(const u32x4*)(ag + 192 * K + k0);
  R.b0 = *(const u32x4*)(bg + k0);
  R.b1 = *(const u32x4*)(bg + 64 * K + k0);
}
DI void g_store(const GRegs& R, u16* as, u16* bs) {
  *(u32x4*)(as) = R.a0;
  *(u32x4*)(as + 64 * 72) = R.a1;
  *(u32x4*)(as + 128 * 72) = R.a2;
  *(u32x4*)(as + 192 * 72) = R.a3;
  *(u32x4*)(bs) = R.b0;
  *(u32x4*)(bs + 64 * 72) = R.b1;
}
DI void g_compute(const u16* as, const u16* bs, f32x16 (&acc)[2][2]) {
#pragma unroll
  for (int ks = 0; ks < 4; ++ks) {
    bf16x8 a0 = *(const bf16x8*)(as + 16 * ks);
    bf16x8 a1 = *(const bf16x8*)(as + 32 * 72 + 16 * ks);
    bf16x8 b0 = *(const bf16x8*)(bs + 16 * ks);
    bf16x8 b1 = *(const bf16x8*)(bs + 32 * 72 + 16 * ks);
    acc[0][0] = MFMA32(a0, b0, acc[0][0]);
    acc[0][1] = MFMA32(a0, b1, acc[0][1]);
    acc[1][0] = MFMA32(a1, b0, acc[1][0]);
    acc[1][1] = MFMA32(a1, b1, acc[1][1]);
  }
}
constexpr int G_LDK = 72;
constexpr int G_CST = 132;
DI void gemm_tile_to_lds(const u16* __restrict__ A, const u16* __restrict__ Bt, int m0, int n0, unsigned char* lds) {
  constexpr int K = 1024;
  u16* As = (u16*)lds;
  u16* Bs = (u16*)(lds + 2 * 256 * G_LDK * 2);
  const int tid = fresh_tid(), lane = tid & 63, w = tid >> 6;
  const int r = lane & 31, h = lane >> 5;
  const int wm = w >> 1, wn = w & 1;
  const int arow = tid >> 3, akc = tid & 7;
  const u16* ag = A + (size_t)(m0 + arow) * K + akc * 8;
  const u16* bg = Bt + (size_t)(n0 + arow) * K + akc * 8;
  f32x16 acc[2][2];
#pragma unroll
  for (int i = 0; i < 2; ++i)
#pragma unroll
    for (int j = 0; j < 2; ++j)
#pragma unroll
      for (int e = 0; e < 16; ++e) acc[i][j][e] = 0.f;
  GRegs R0, R1;
  g_load(R0, ag, bg, 0);
  g_load(R1, ag, bg, 64);
  g_store(R0, As + arow * G_LDK + akc * 8, Bs + arow * G_LDK + akc * 8);
  __syncthreads();
  const u16* as0 = As + (64 * wm + r) * G_LDK + 8 * h;
  const u16* bs0 = Bs + (64 * wn + r) * G_LDK + 8 * h;
  for (int kt2 = 0; kt2 < 16; kt2 += 2) {
    if (kt2 + 2 < 16) g_load(R0, ag, bg, (kt2 + 2) * 64);
    g_compute(as0, bs0, acc);
    g_store(R1, As + 256 * G_LDK + arow * G_LDK + akc * 8, Bs + 128 * G_LDK + arow * G_LDK + akc * 8);
    __syncthreads();
    if (kt2 + 3 < 16) g_load(R1, ag, bg, (kt2 + 3) * 64);
    g_compute(as0 + 256 * G_LDK, bs0 + 128 * G_LDK, acc);
    if (kt2 + 2 < 16) g_store(R0, As + arow * G_LDK + akc * 8, Bs + arow * G_LDK + akc * 8);
    __syncthreads();
  }
  float* Cst = (float*)lds;
#pragma unroll
  for (int i = 0; i < 2; ++i)
#pragma unroll
    for (int j = 0; j < 2; ++j)
#pragma unroll
      for (int e = 0; e < 16; ++e) {
        const int row = 64 * wm + 32 * i + (e & 3) + 8 * (e >> 2) + 4 * h;
        Cst[row * G_CST + 64 * wn + 32 * j + r] = acc[i][j][e];
      }
  __syncthreads();
}

DI void load_row64(const unsigned char* lds, float (&v)[64]) {
  const int tid = fresh_tid();
  const float* src = (const float*)lds + (tid >> 1) * G_CST + (tid & 1) * 64;
#pragma unroll
  for (int i = 0; i < 16; ++i) {
    float4 f = ((const float4*)src)[i];
    v[4 * i] = f.x; v[4 * i + 1] = f.y; v[4 * i + 2] = f.z; v[4 * i + 3] = f.w;
  }
}

DI void inproj_epi(const Params& P, const WS& W, int l, int R, int nt, int half, float (&v)[64]) {
  const int b = R / TT;
  const int t = R - b * TT;
  if (nt < 8) {
    store64(W.XBC + (size_t)R * 1024 + nt * 128 + half * 64, v);
  } else if (nt < 12) {
    store64(W.Z + (size_t)R * 512 + (nt - 8) * 128 + half * 64, v);
  } else if (nt < 15) {
    const bool isq = nt < 14;
    const float* g = (isq ? P.in[17] : P.in[18]) + l * 64;
    float ss = 0.f;
#pragma unroll
    for (int j = 0; j < 64; ++j) ss += v[j] * v[j];
    const float rn = rsqrtf(ss * (1.f / 64.f) + EPS);
#pragma unroll
    for (int j = 0; j < 64; ++j) { if ((j & 15) == 0) __builtin_amdgcn_sched_barrier(0); v[j] = v[j] * rn * g[j]; }
    if (t >= 256) {
      const int pos = t - 256, ri = pos >> 6, ci = pos & 63;
#pragma unroll
      for (int i = 0; i < 32; ++i) {
        if ((i & 7) == 0) __builtin_amdgcn_sched_barrier(0);
        const float2 cs = (i < 16) ? W.ropeG[ri * 16 + i] : W.ropeG[ci * 16 + (i - 16)];
        const float x1 = v[i], x2 = v[i + 32];
        v[i] = x1 * cs.x - x2 * cs.y;
        v[i + 32] = x2 * cs.x + x1 * cs.y;
      }
    }
    if (isq) {
      const float sc = 0.125f * LOG2E;
#pragma unroll
      for (int j = 0; j < 64; ++j) v[j] *= sc;
      const int head = (nt - 12) * 2 + half;
      store64(W.Q + ((size_t)(b * 4 + head) * TT + t) * 64, v);
    } else {
      store64(W.K + ((size_t)(b * 2 + half) * TT + t) * 64, v);
    }
  } else if (nt == 15) {
    u16* dst = W.Vt + ((size_t)(b * 2 + half) * 64) * TT + t;
#pragma unroll
    for (int j = 0; j < 64; ++j) { if ((j & 7) == 0) __builtin_amdgcn_sched_barrier(0); dst[(size_t)j * TT] = f2bf(v[j]); }
  } else if (nt < 18) {
#pragma unroll
    for (int j = 0; j < 64; ++j) v[j] = silu(v[j]);
    store64(W.GG + (size_t)R * 256 + (nt - 16) * 128 + half * 64, v);
  } else if (nt < 22) {
    const bool isq = nt < 20;
    const int mbase = (nt - (isq ? 18 : 20)) * 4 + half * 2;
    if (t >= 256) {
      const int pos = t - 256, ri = pos >> 6, ci = pos & 63;
#pragma unroll
      for (int mm = 0; mm < 2; ++mm)
#pragma unroll
        for (int i = 0; i < 16; ++i) {
          if ((i & 7) == 0) __builtin_amdgcn_sched_barrier(0);
          const float2 cs = (i < 8) ? W.ropeD[ri * 8 + i] : W.ropeD[ci * 8 + (i - 8)];
          const float x1 = v[32 * mm + i], x2 = v[32 * mm + i + 16];
          v[32 * mm + i] = x1 * cs.x - x2 * cs.y;
          v[32 * mm + i + 16] = x2 * cs.x + x1 * cs.y;
        }
    }
    if (isq) {
      const float sc = 0.17677669529663687f * LOG2E;
#pragma unroll
      for (int j = 0; j < 64; ++j) v[j] *= sc;
    }
    u16* base = isq ? W.DQ : W.DK;
#pragma unroll
    for (int mm = 0; mm < 2; ++mm) {
      u16* dst = base + ((size_t)(b * 8 + mbase + mm) * TT + t) * 32;
#pragma unroll
      for (int i = 0; i < 4; ++i) {
        uint4 u;
        u.x = pk(v[32 * mm + 8 * i], v[32 * mm + 8 * i + 1]); u.y = pk(v[32 * mm + 8 * i + 2], v[32 * mm + 8 * i + 3]);
        u.z = pk(v[32 * mm + 8 * i + 4], v[32 * mm + 8 * i + 5]); u.w = pk(v[32 * mm + 8 * i + 6], v[32 * mm + 8 * i + 7]);
        ((uint4*)dst)[i] = u;
      }
    }
  } else if (nt < 24) {
    const int head = (nt - 22) * 2 + half;
    u16* dst = W.DVt + ((size_t)(b * 4 + head) * 64) * TT + t;
#pragma unroll
    for (int j = 0; j < 64; ++j) { if ((j & 7) == 0) __builtin_amdgcn_sched_barrier(0); dst[(size_t)j * TT] = f2bf(v[j]); }
  } else if (nt < 26) {
#pragma unroll
    for (int j = 0; j < 64; ++j) v[j] = silu(v[j]);
    store64(W.DG + (size_t)R * 256 + (nt - 24) * 128 + half * 64, v);
  } else if (nt == 26) {
    if (half == 0) {
      const float* bf = P.in[13] + l * 8;
      const float* bb = P.in[14] + l * 8;
#pragma unroll
      for (int j = 0; j < 16; ++j) {
        const float x = v[j] + (j < 8 ? bf[j] : bb[j - 8]);
        W.DT[(size_t)R * 16 + j] = softplus(x);
      }
    }
  }
}

template <int D>
DI void attn_core(const u16* __restrict__ Qh, const u16* __restrict__ Kh, const u16* __restrict__ Vth, int q0, int nkeys,
                  unsigned char* lds, f32x16 (&O)[2], float& lout) {
  constexpr int KP = D + 8;
  constexpr int KS = D / 16;
  u16* Ks = (u16*)lds;
  u16* Vs = (u16*)(lds + 2 * 64 * 72 * 2);
  const int tid = fresh_tid(), lane = tid & 63, w = tid >> 6;
  const int r = lane & 31, h = lane >> 5;
  bf16x8 qf[KS];
  {
    const u16* qp = Qh + (size_t)(q0 + 32 * w + r) * D + 8 * h;
#pragma unroll
    for (int ks = 0; ks < KS; ++ks) qf[ks] = *(const bf16x8*)(qp + 16 * ks);
  }
#pragma unroll
  for (int e = 0; e < 16; ++e) { O[0][e] = 0.f; O[1][e] = 0.f; }
  float m = -1e30f, lsum = 0.f;
  const int krow = (D == 64) ? (tid >> 3) : (tid >> 2);
  const int kc = (D == 64) ? (tid & 7) : (tid & 3);
  const bool kact = (D == 64) ? true : (tid < 256);
  const int vrow = tid >> 3, vc = tid & 7;
  const u16* kg = Kh + (size_t)krow * D + kc * 8;
  const u16* vg = Vth + (size_t)vrow * TT + vc * 8;
  u32x4 rk0 = (u32x4){0u, 0u, 0u, 0u}, rk1 = rk0, rv0, rv1;
  const int nk = nkeys >> 6;
  if (kact) rk0 = *(const u32x4*)kg;
  rv0 = *(const u32x4*)vg;
  if (kact) rk1 = *(const u32x4*)(kg + (size_t)64 * D);
  rv1 = *(const u32x4*)(vg + 64);
  if (kact) *(u32x4*)&Ks[krow * KP + kc * 8] = rk0;
  *(u32x4*)&Vs[vrow * 72 + vc * 8] = rv0;
  __syncthreads();
  for (int kt2 = 0; kt2 < nk; kt2 += 2) {
#pragma unroll
  for (int ph = 0; ph < 2; ++ph) {
    const int kt = kt2 + ph;
    const int cur = ph;
    if (kt + 2 < nk) {
      if (ph == 0) {
        if (kact) rk0 = *(const u32x4*)(kg + (size_t)(kt + 2) * 64 * D);
        rv0 = *(const u32x4*)(vg + (kt + 2) * 64);
      } else {
        if (kact) rk1 = *(const u32x4*)(kg + (size_t)(kt + 2) * 64 * D);
        rv1 = *(const u32x4*)(vg + (kt + 2) * 64);
      }
    }
    f32x16 S[2];
#pragma unroll
    for (int e = 0; e < 16; ++e) { S[0][e] = 0.f; S[1][e] = 0.f; }
    const u16* ks_ = Ks + cur * 64 * KP + r * KP + 8 * h;
#pragma unroll
    for (int ks = 0; ks < KS; ++ks) {
      bf16x8 a0 = *(const bf16x8*)(ks_ + 16 * ks);
      bf16x8 a1 = *(const bf16x8*)(ks_ + 32 * KP + 16 * ks);
      S[0] = MFMA32(a0, qf[ks], S[0]);
      S[1] = MFMA32(a1, qf[ks], S[1]);
    }
    __builtin_amdgcn_sched_barrier(0);
    float mx = S[0][0];
#pragma unroll
    for (int e = 1; e < 16; ++e) mx = fmaxf(mx, S[0][e]);
#pragma unroll
    for (int e = 0; e < 16; ++e) mx = fmaxf(mx, S[1][e]);
    mx = fmaxf(mx, __shfl_xor(mx, 32));
    const float mnew = fmaxf(m, mx);
    const float alpha = fexp2(m - mnew);
    m = mnew;
    float rs = 0.f;
#pragma unroll
    for (int e = 0; e < 16; ++e) { S[0][e] = fexp2(S[0][e] - mnew); rs += S[0][e]; }
#pragma unroll
    for (int e = 0; e < 16; ++e) { S[1][e] = fexp2(S[1][e] - mnew); rs += S[1][e]; }
    lsum = lsum * alpha + rs;
#pragma unroll
    for (int e = 0; e < 16; ++e) { O[0][e] *= alpha; O[1][e] *= alpha; }
    const u16* vs_ = Vs + cur * 64 * 72 + r * 72 + 4 * h;
    __builtin_amdgcn_sched_barrier(0);
#pragma unroll
    for (int t2 = 0; t2 < 2; ++t2)
#pragma unroll
      for (int s = 0; s < 2; ++s) {
        __builtin_amdgcn_sched_barrier(0);
        uint4 pu;
        pu.x = pk(S[t2][8 * s], S[t2][8 * s + 1]); pu.y = pk(S[t2][8 * s + 2], S[t2][8 * s + 3]);
        pu.z = pk(S[t2][8 * s + 4], S[t2][8 * s + 5]); pu.w = pk(S[t2][8 * s + 6], S[t2][8 * s + 7]);
        const bf16x8 pb = __builtin_bit_cast(bf16x8, pu);
#pragma unroll
        for (int dt = 0; dt < 2; ++dt) {
          const u16* vp = vs_ + dt * 32 * 72 + 32 * t2 + 16 * s;
          s16x4 lo = *(const s16x4*)vp;
          s16x4 hi = *(const s16x4*)(vp + 8);
          const bf16x8 a = __builtin_shufflevector(lo, hi, 0, 1, 2, 3, 4, 5, 6, 7);
          O[dt] = MFMA32(a, pb, O[dt]);
        }
      }
    if (kt + 1 < nk) {
      const int nx = cur ^ 1;
      if (kact) *(u32x4*)&Ks[nx * 64 * KP + krow * KP + kc * 8] = (ph == 0) ? rk1 : rk0;
      *(u32x4*)&Vs[nx * 64 * 72 + vrow * 72 + vc * 8] = (ph == 0) ? rv1 : rv0;
    }
    __syncthreads();
  }
  }
  lout = lsum + __shfl_xor(lsum, 32);
}

DI void gqa_unit(const WS& W, int b, int head, int qb, unsigned char* lds) {
  const int tid = fresh_tid(), lane = tid & 63, w = tid >> 6, r = lane & 31, h = lane >> 5;
  const int q0 = qb * 256;
  const int nkeys = (qb == 0) ? 256 : TT;
  f32x16 O[2];
  float l;
  attn_core<64>(W.Q + (size_t)(b * 4 + head) * TT * 64, W.K + (size_t)(b * 2 + (head >> 1)) * TT * 64,
                W.Vt + (size_t)(b * 2 + (head >> 1)) * 64 * TT, q0, nkeys, lds, O, l);
  const float il = 1.f / l;
  const size_t Rr = (size_t)b * TT + q0 + 32 * w + r;
#pragma unroll
  for (int dt = 0; dt < 2; ++dt)
#pragma unroll
    for (int i4 = 0; i4 < 4; ++i4) {
      const int dv = 32 * dt + 8 * i4 + 4 * h;
      const uint2 g = *(const uint2*)(W.GG + Rr * 256 + head * 64 + dv);
      uint2 o;
      o.x = pk(O[dt][4 * i4] * il * bflo(g.x), O[dt][4 * i4 + 1] * il * bfhi(g.x));
      o.y = pk(O[dt][4 * i4 + 2] * il * bflo(g.y), O[dt][4 * i4 + 3] * il * bfhi(g.y));
      *(uint2*)(W.Ycat + Rr * 1024 + 512 + head * 64 + dv) = o;
    }
}

DI void diff_unit(const Params& P, const WS& W, int l, int b, int hh, int qb, unsigned char* lds) {
  const int tid = fresh_tid(), lane = tid & 63, w = tid >> 6, r = lane & 31, h = lane >> 5;
  const int q0 = qb * 256;
  const int nkeys = (qb == 0) ? 256 : TT;
  const float lam_init = (l == 0) ? 0.2f : 0.35550906759f;
  float lam;
  {
    const float* lp = P.in[19] + l * 128;
    float s1 = (lane < 32) ? lp[lane] * lp[32 + lane] : 0.f;
    float s2 = (lane < 32) ? lp[64 + lane] * lp[96 + lane] : 0.f;
#pragma unroll
    for (int d = 32; d >= 1; d >>= 1) { s1 += __shfl_xor(s1, d); s2 += __shfl_xor(s2, d); }
    lam = __expf(s1) - __expf(s2) + lam_init;
  }
  f32x16 O1[2], O2[2];
  float l1, l2;
  const u16* vt = W.DVt + (size_t)(b * 4 + hh) * 64 * TT;
  attn_core<32>(W.DQ + (size_t)(b * 8 + 2 * hh) * TT * 32, W.DK + (size_t)(b * 8 + 2 * hh) * TT * 32, vt, q0, nkeys, lds, O1, l1);
  attn_core<32>(W.DQ + (size_t)(b * 8 + 2 * hh + 1) * TT * 32, W.DK + (size_t)(b * 8 + 2 * hh + 1) * TT * 32, vt, q0, nkeys, lds, O2, l2);
  const float i1 = 1.f / l1, i2 = lam / l2;
  float ss = 0.f;
#pragma unroll
  for (int dt = 0; dt < 2; ++dt)
#pragma unroll
    for (int e = 0; e < 16; ++e) {
      const float o = O1[dt][e] * i1 - O2[dt][e] * i2;
      O1[dt][e] = o;
      ss += o * o;
    }
  ss += __shfl_xor(ss, 32);
  const float rn = rsqrtf(ss * (1.f / 64.f) + EPS) * (1.f - lam_init);
  const float* ng = P.in[20] + l * 64;
  const size_t Rr = (size_t)b * TT + q0 + 32 * w + r;
#pragma unroll
  for (int dt = 0; dt < 2; ++dt)
#pragma unroll
    for (int i4 = 0; i4 < 4; ++i4) {
      const int dv = 32 * dt + 8 * i4 + 4 * h;
      const uint2 g = *(const uint2*)(W.DG + Rr * 256 + hh * 64 + dv);
      const float4 n4 = *(const float4*)(ng + dv);
      uint2 o;
      o.x = pk(O1[dt][4 * i4] * rn * n4.x * bflo(g.x), O1[dt][4 * i4 + 1] * rn * n4.y * bfhi(g.x));
      o.y = pk(O1[dt][4 * i4 + 2] * rn * n4.z * bflo(g.y), O1[dt][4 * i4 + 3] * rn * n4.w * bfhi(g.y));
      *(uint2*)(W.Ycat + Rr * 1024 + 768 + hh * 64 + dv) = o;
    }
}

constexpr int S_LD = 136;
DI void ssd_local_unit(const Params& P, const WS& W, int l, int b, int c, int g, unsigned char* lds) {
  const int tid = fresh_tid(), lane = tid & 63, w = tid >> 6;
  u16* BsT = (u16*)lds;
  u16* Bs = (u16*)(lds + 34816);
  u16* Cs = (u16*)(lds + 69632);
  u16* xT = (u16*)(lds + 34816);
  u16* xsF = (u16*)(lds + 52224);
  u16* xsB = (u16*)(lds + 69632);
  float* cumF = (float*)(lds + 104448);
  float* cumB = cumF + 512;
  float* dtF = cumB + 512;
  float* dtB = dtF + 512;
  const size_t Rc0 = (size_t)b * TT + c * 128;
  const int seg_lo = (c < 2) ? 0 : 256;
  const int seg_hi = (c < 2) ? 256 : TT;
  const float* conv_w = P.in[9] + (size_t)l * 5 * 1024;
  const float* conv_b = P.in[10] + (size_t)l * 1024;
  {
    const int hh = w & 3, dir = w >> 2, hg = g * 4 + hh;
    const float a = -__expf((dir ? P.in[12] : P.in[11])[l * 8 + hg]);
    const float d0 = W.DT[(Rc0 + 2 * lane) * 16 + dir * 8 + hg];
    const float d1 = W.DT[(Rc0 + 2 * lane + 1) * 16 + dir * 8 + hg];
    const float a0 = d0 * a, a1 = d1 * a;
    float v = a0 + a1;
    float c0, c1;
    if (dir == 0) {
#pragma unroll
      for (int d = 1; d < 64; d <<= 1) { const float t = __shfl_up(v, d); if (lane >= d) v += t; }
      c0 = v - a1; c1 = v;
    } else {
#pragma unroll
      for (int d = 1; d < 64; d <<= 1) { const float t = __shfl_down(v, d); if (lane + d < 64) v += t; }
      c0 = v; c1 = v - a0;
    }
    float* lc = cumF + dir * 512 + hh * 128 + 2 * lane;
    lc[0] = c0; lc[1] = c1;
    lc[1024] = d0; lc[1025] = d1;
    float* gc = W.cumF + (size_t)dir * ((size_t)RR * 8) + (Rc0 + 2 * lane) * 8 + hg;
    gc[0] = c0; gc[8] = c1;
  }
  {
    const int ch = tid & 255, th = tid >> 8;
    const bool isB = ch < 128;
    const int col = isB ? (512 + g * 128 + ch) : (768 + g * 128 + (ch - 128));
    const float w0 = conv_w[col], w1 = conv_w[1024 + col], w2 = conv_w[2048 + col], w3 = conv_w[3072 + col], w4 = conv_w[4096 + col];
    const float bias = conv_b[col];
    const u16* src = W.XBC + (size_t)b * TT * 1024 + col;
    const int tb = c * 128 + th * 64;
    auto ld = [&](int t) -> float { return (t >= seg_lo && t < seg_hi) ? bf2f(src[(size_t)t * 1024]) : 0.f; };
    float x0 = ld(tb - 2), x1 = ld(tb - 1), x2 = ld(tb), x3 = ld(tb + 1);
    for (int o8 = 0; o8 < 8; ++o8) {
      float y[8];
#pragma unroll
      for (int k = 0; k < 8; ++k) {
        const float x4 = ld(tb + o8 * 8 + k + 2);
        y[k] = silu(bias + w0 * x0 + w1 * x1 + w2 * x2 + w3 * x3 + w4 * x4);
        x0 = x1; x1 = x2; x2 = x3; x3 = x4;
      }
      const int s0 = th * 64 + o8 * 8;
      if (isB) {
#pragma unroll
        for (int k = 0; k < 8; ++k) Bs[(s0 + k) * S_LD + ch] = f2bf(y[k]);
        uint4 u;
        u.x = pk(y[0], y[1]); u.y = pk(y[2], y[3]); u.z = pk(y[4], y[5]); u.w = pk(y[6], y[7]);
        *(uint4*)&BsT[ch * S_LD + s0] = u;
      } else {
        const int cc = ch - 128;
#pragma unroll
        for (int k = 0; k < 8; ++k) {
          const u16 q = f2bf(y[k]);
          Cs[(s0 + k) * S_LD + cc] = q;
          W.Cc[(Rc0 + s0 + k) * 256 + g * 128 + cc] = q;
        }
      }
    }
  }
  __syncthreads();
  const int c16 = lane & 15, q = lane >> 4;
  f32x4 G[8];
#pragma unroll
  for (int st = 0; st < 8; ++st) G[st] = (f32x4){0.f, 0.f, 0.f, 0.f};
#pragma unroll
  for (int ks = 0; ks < 4; ++ks) {
    const bf16x8 bfrag = *(const bf16x8*)&Cs[(16 * w + c16) * S_LD + 32 * ks + 8 * q];
#pragma unroll
    for (int st = 0; st < 8; ++st) {
      const bf16x8 afrag = *(const bf16x8*)&Bs[(16 * st + c16) * S_LD + 32 * ks + 8 * q];
      G[st] = MFMA16(afrag, bfrag, G[st]);
    }
  }
  __syncthreads();
  for (int hh = 0; hh < 4; ++hh) {
    const int hg = g * 4 + hh;
    {
      const int p = tid & 63, e8 = tid >> 6;
      const int col = hg * 64 + p;
      const float w0 = conv_w[col], w1 = conv_w[1024 + col], w2 = conv_w[2048 + col], w3 = conv_w[3072 + col], w4 = conv_w[4096 + col];
      const float bias = conv_b[col];
      const u16* src = W.XBC + (size_t)b * TT * 1024 + col;
      const int tb = c * 128 + e8 * 16;
      auto ld = [&](int t) -> float { return (t >= seg_lo && t < seg_hi) ? bf2f(src[(size_t)t * 1024]) : 0.f; };
      float x0 = ld(tb - 2), x1 = ld(tb - 1), x2 = ld(tb), x3 = ld(tb + 1);
      const float cF_end = cumF[hh * 128 + 127], cB_end = cumB[hh * 128];
#pragma unroll
      for (int o8 = 0; o8 < 2; ++o8) {
        float y[8], yf[8], yb[8];
#pragma unroll
        for (int k = 0; k < 8; ++k) {
          const float x4 = ld(tb + o8 * 8 + k + 2);
          y[k] = silu(bias + w0 * x0 + w1 * x1 + w2 * x2 + w3 * x3 + w4 * x4);
          x0 = x1; x1 = x2; x2 = x3; x3 = x4;
          const int s = e8 * 16 + o8 * 8 + k;
          yf[k] = y[k] * dtF[hh * 128 + s] * __expf(cF_end - cumF[hh * 128 + s]);
          yb[k] = y[k] * dtB[hh * 128 + s] * __expf(cB_end - cumB[hh * 128 + s]);
        }
        const int s0 = e8 * 16 + o8 * 8;
        uint4 u;
        u.x = pk(y[0], y[1]); u.y = pk(y[2], y[3]); u.z = pk(y[4], y[5]); u.w = pk(y[6], y[7]);
        *(uint4*)&xT[p * S_LD + s0] = u;
        u.x = pk(yf[0], yf[1]); u.y = pk(yf[2], yf[3]); u.z = pk(yf[4], yf[5]); u.w = pk(yf[6], yf[7]);
        *(uint4*)&xsF[p * S_LD + s0] = u;
        u.x = pk(yb[0], yb[1]); u.y = pk(yb[2], yb[3]); u.z = pk(yb[4], yb[5]); u.w = pk(yb[6], yb[7]);
        *(uint4*)&xsB[p * S_LD + s0] = u;
      }
    }
    __syncthreads();
    {
      const int t = 16 * w + c16;
      const float cF_t = cumF[hh * 128 + t], cB_t = cumB[hh * 128 + t];
      const float Dh = P.in[15][l * 8 + hg];
      f32x4 Y[4];
#pragma unroll
      for (int pt = 0; pt < 4; ++pt) Y[pt] = (f32x4){0.f, 0.f, 0.f, 0.f};
#pragma unroll
      for (int m = 0; m < 4; ++m) {
        __builtin_amdgcn_sched_barrier(0);
        float mv[8];
#pragma unroll
        for (int j = 0; j < 8; ++j) {
          const int st = 2 * m + (j >> 2), i = j & 3;
          const int s = 16 * st + 4 * q + i;
          const float ef = (s <= t) ? __expf(cF_t - cumF[hh * 128 + s]) * dtF[hh * 128 + s] : 0.f;
          const float eb = (s >= t) ? __expf(cB_t - cumB[hh * 128 + s]) * dtB[hh * 128 + s] : 0.f;
          mv[j] = G[st][i] * (ef + eb) + ((s == t) ? Dh : 0.f);
        }
        uint4 mu;
        mu.x = pk(mv[0], mv[1]); mu.y = pk(mv[2], mv[3]); mu.z = pk(mv[4], mv[5]); mu.w = pk(mv[6], mv[7]);
        const bf16x8 Mf = __builtin_bit_cast(bf16x8, mu);
#pragma unroll
        for (int pt = 0; pt < 4; ++pt) {
          const u16* xp = xT + (16 * pt + c16) * S_LD + 32 * m + 4 * q;
          s16x4 lo = *(const s16x4*)xp;
          s16x4 hi = *(const s16x4*)(xp + 16);
          const bf16x8 af = __builtin_shufflevector(lo, hi, 0, 1, 2, 3, 4, 5, 6, 7);
          Y[pt] = MFMA16(af, Mf, Y[pt]);
        }
      }
#pragma unroll
      for (int pt = 0; pt < 4; ++pt) {
        uint2 o;
        o.x = pk(Y[pt][0], Y[pt][1]); o.y = pk(Y[pt][2], Y[pt][3]);
        *(uint2*)(W.Ycat + (Rc0 + t) * 1024 + hg * 64 + 16 * pt + 4 * q) = o;
      }
    }
#pragma unroll
    for (int dir = 0; dir < 2; ++dir) {
      const u16* xs = dir ? xsB : xsF;
      f32x4 acc[4];
#pragma unroll
      for (int pt = 0; pt < 4; ++pt) acc[pt] = (f32x4){0.f, 0.f, 0.f, 0.f};
#pragma unroll
      for (int ks = 0; ks < 4; ++ks) {
        const bf16x8 af = *(const bf16x8*)&BsT[(16 * w + c16) * S_LD + 32 * ks + 8 * q];
#pragma unroll
        for (int pt = 0; pt < 4; ++pt) {
          const bf16x8 bfr = *(const bf16x8*)&xs[(16 * pt + c16) * S_LD + 32 * ks + 8 * q];
          acc[pt] = MFMA16(af, bfr, acc[pt]);
        }
      }
      u16* dst = W.Sloc + ((((size_t)dir * 8 + b) * 18 + c) * 8 + hg) * 8192;
#pragma unroll
      for (int pt = 0; pt < 4; ++pt) {
        uint2 o;
        o.x = pk(acc[pt][0], acc[pt][1]); o.y = pk(acc[pt][2], acc[pt][3]);
        *(uint2*)(dst + (16 * pt + c16) * 128 + 16 * w + 4 * q) = o;
      }
    }
    __syncthreads();
  }
}

DI void ws_init(WS& W, unsigned char* ws) {
        W.WinT = (u16*)(ws + OFF_WIN); W.WoutT = (u16*)(ws + OFF_WOUT); W.mod = (float*)(ws + OFF_MOD);
    W.ropeG = (float2*)(ws + OFF_ROPE); W.ropeD = (float2*)(ws + OFF_ROPE + 8192);
    W.U = (u16*)(ws + OFF_U); W.Ycat = (u16*)(ws + OFF_U); W.XBC = (u16*)(ws + OFF_XBC); W.Obuf = (u16*)(ws + OFF_XBC);
    W.Z = (u16*)(ws + OFF_Z); W.DT = (float*)(ws + OFF_DT);
    W.Q = (u16*)(ws + OFF_Q); W.K = (u16*)(ws + OFF_K); W.Vt = (u16*)(ws + OFF_VT);
    W.DQ = (u16*)(ws + OFF_DQ); W.DK = (u16*)(ws + OFF_DK); W.DVt = (u16*)(ws + OFF_DVT); W.Stin = (u16*)(ws + OFF_Q);
    W.GG = (u16*)(ws + OFF_GG); W.DG = (u16*)(ws + OFF_DG); W.Cc = (u16*)(ws + OFF_CC);
    W.cumF = (float*)(ws + OFF_CUMF); W.cumB = (float*)(ws + OFF_CUMB); W.Sloc = (u16*)(ws + OFF_SLOC);
    W.Opart = (float*)(ws + OFF_OPART);
}

#define XCD_LOOP(UPX, xcd, idx) \
  const bool sw_ = (nb & 7) == 0; \
  for (int t_ = sw_ ? (bid >> 3) : bid; t_ < (sw_ ? (UPX) : 8 * (UPX)); t_ += (sw_ ? (nb >> 3) : nb)) { \
    const int xcd = sw_ ? (bid & 7) : t_ / (UPX); const int idx = sw_ ? t_ : t_ % (UPX);
#define XCD_END }

typedef const Params __attribute__((address_space(4)))* KArgP;
DI Params load_params(KArgP kp) {
  asm volatile("" : "+s"(kp));
  Params P;
#pragma unroll
  for (int i = 0; i < 22; ++i) P.in[i] = kp->in[i];
  P.out = kp->out; P.ws = kp->ws;
  return P;
}

DI void ph0_prologue(KArgP kp, unsigned char* lds) {
  const Params P = load_params(kp); WS W; ws_init(W, P.ws);
  const int tid = fresh_tid(), lane = tid & 63, w = tid >> 6;
  const int nb = gridDim.x, bid = blockIdx.x;
  (void)lane; (void)w; (void)tid;
  {
    float* S = (float*)(lds + 65536);
    for (int i = tid; i < 9 * 1024; i += NT) {
      const float x = (i < 8192) ? P.in[1][i] : P.in[3][i - 8192];
      S[i] = silu(x);
    }
    __syncthreads();
    constexpr int U_WIN = 2 * 54 * 16, U_WOUT = 2 * 16 * 16, U_MOD = 384;
    for (int u = bid; u < U_WIN + U_WOUT + U_MOD + 1; u += nb) {
      if (u < U_WIN + U_WOUT) {
        const float* src; u16* dst; int ldn, n0, k0; bool inproj;
        if (u < U_WIN) {
          const int l = u / (54 * 16), rem = u % (54 * 16);
          n0 = (rem >> 4) * 64; k0 = (rem & 15) * 64; ldn = 3344; inproj = true;
          src = P.in[8] + (size_t)l * 1024 * 3344; dst = W.WinT + (size_t)l * NPAD * 1024;
        } else {
          const int v = u - U_WIN; const int l = v >> 8, rem = v & 255;
          n0 = (rem >> 4) * 64; k0 = (rem & 15) * 64; ldn = 1024; inproj = false;
          src = P.in[21] + (size_t)l * 1024 * 1024; dst = W.WoutT + (size_t)l * 1024 * 1024;
        }
        float* tile = (float*)lds;
        {
          const int n = tid & 63, kq = tid >> 6;
          const int nd = n0 + n;
          int ns = nd;
          if (inproj) { ns = (nd < 1536) ? nd : (nd < 3328 ? nd + 16 : (nd < 3344 ? nd - 3328 + 1536 : -1)); }
#pragma unroll
          for (int i = 0; i < 8; ++i) {
            const int k = kq * 8 + i;
            tile[k * 65 + n] = (ns >= 0) ? src[(size_t)(k0 + k) * ldn + ns] : 0.f;
          }
        }
        __syncthreads();
        {
          const int n = tid >> 3, kc = tid & 7;
          float f[8];
#pragma unroll
          for (int i = 0; i < 8; ++i) f[i] = tile[(kc * 8 + i) * 65 + n];
          uint4 o;
          o.x = pk(f[0], f[1]); o.y = pk(f[2], f[3]); o.z = pk(f[4], f[5]); o.w = pk(f[6], f[7]);
          *(uint4*)(dst + (size_t)(n0 + n) * 1024 + k0 + kc * 8) = o;
        }
        __syncthreads();
      } else if (u < U_WIN + U_WOUT + U_MOD) {
        const int v = u - U_WIN - U_WOUT;
        const int l = v / 192, n0 = (v % 192) * 16;
        const int c16 = tid & 15, kg = tid >> 4;
        const float* wm = P.in[4] + (size_t)l * 1024 * 3072 + n0 + c16;
        float acc[9];
#pragma unroll
        for (int rr = 0; rr < 9; ++rr) acc[rr] = 0.f;
#pragma unroll 8
        for (int kk = 0; kk < 32; ++kk) {
          const int k = kg * 32 + kk;
          const float wv = wm[(size_t)k * 3072];
#pragma unroll
          for (int rr = 0; rr < 9; ++rr) acc[rr] += S[rr * 1024 + k] * wv;
        }
        float* red = (float*)lds;
#pragma unroll
        for (int rr = 0; rr < 9; ++rr) red[(kg * 16 + c16) * 9 + rr] = acc[rr];
        __syncthreads();
        if (tid < 144) {
          const int cc = tid / 9, rr = tid % 9;
          float s = 0.f;
          for (int k2 = 0; k2 < 32; ++k2) s += red[(k2 * 16 + cc) * 9 + rr];
          W.mod[((size_t)l * 9 + rr) * 3072 + n0 + cc] = s + P.in[5][l * 3072 + n0 + cc];
        }
        __syncthreads();
      } else {
        for (int i = tid; i < 64 * 16; i += NT) {
          const int idx = i >> 4, k = i & 15;
          const float inv = powf(10000.f, -(float)k / 16.f);
          float sn, cs; sincosf((float)idx * inv, &sn, &cs);
          W.ropeG[i] = make_float2(cs, sn);
        }
        for (int i = tid; i < 64 * 8; i += NT) {
          const int idx = i >> 3, k = i & 7;
          const float inv = powf(10000.f, -(float)k / 8.f);
          float sn, cs; sincosf((float)idx * inv, &sn, &cs);
          W.ropeD[i] = make_float2(cs, sn);
        }
      }
    }
  }
}

DI void ph1_prep(KArgP kp) {
  const Params P = load_params(kp); WS W; ws_init(W, P.ws);
  const int tid = fresh_tid(), lane = tid & 63, w = tid >> 6;
  const int nb = gridDim.x, bid = blockIdx.x;
  (void)lane; (void)w; (void)tid;
  XCD_LOOP(288, xcd, idx)
    const int R = xcd * TT + idx * 8 + w;
    const int b = xcd, t = idx * 8 + w;
    const float* src = (t < 256) ? (P.in[2] + ((size_t)b * 256 + t) * 1024) : (P.in[0] + ((size_t)b * 2048 + (t - 256)) * 1024);
    const float* md = W.mod + (size_t)((t < 256) ? 8 : b) * 3072;
    const float* gp = P.in[6];
    float4 x[4];
    float ss = 0.f;
#pragma unroll
    for (int i = 0; i < 4; ++i) {
      x[i] = *(const float4*)(src + i * 256 + lane * 4);
      ss += x[i].x * x[i].x + x[i].y * x[i].y + x[i].z * x[i].z + x[i].w * x[i].w;
    }
#pragma unroll
    for (int d = 32; d >= 1; d >>= 1) ss += __shfl_xor(ss, d);
    const float rn = rsqrtf(ss * (1.f / 1024.f) + EPS);
#pragma unroll
    for (int i = 0; i < 4; ++i) {
      const int k = i * 256 + lane * 4;
      const float4 g4 = *(const float4*)(gp + k);
      const float4 sh = *(const float4*)(md + k);
      const float4 sc = *(const float4*)(md + 1024 + k);
      uint2 o;
      o.x = pk(x[i].x * rn * g4.x * (1.f + sc.x) + sh.x, x[i].y * rn * g4.y * (1.f + sc.y) + sh.y);
      o.y = pk(x[i].z * rn * g4.z * (1.f + sc.z) + sh.z, x[i].w * rn * g4.w * (1.f + sc.w) + sh.w);
      *(uint2*)(W.U + (size_t)R * 1024 + k) = o;
    }
  XCD_END
}

DI void ph2_inproj(KArgP kp, int l, unsigned char* lds) {
  const Params P = load_params(kp); WS W; ws_init(W, P.ws);
  const int tid = fresh_tid();
  const int nb = gridDim.x, bid = blockIdx.x;
  XCD_LOOP(243, xcd, idx)
    const int nt = idx / 9, mt = xcd * 9 + idx % 9;
    gemm_tile_to_lds(W.U, W.WinT + (size_t)l * NPAD * 1024, mt * 256, nt * 128, lds);
    float v[64];
    load_row64(lds, v);
    inproj_epi(P, W, l, mt * 256 + (tid >> 1), nt, tid & 1, v);
    __syncthreads();
  XCD_END
}

DI void ph3_mix(KArgP kp, int l, unsigned char* lds) {
  const Params P = load_params(kp); WS W; ws_init(W, P.ws);
  const int nb = gridDim.x, bid = blockIdx.x;
  const int upx = (l == 0) ? 108 : 100;
  XCD_LOOP(upx, xcd, idx)
    const int b = xcd;
    if (idx < 32) {
      diff_unit(P, W, l, b, idx >> 3, 1 + (idx & 7), lds);
    } else if (idx < 64) {
      gqa_unit(W, b, (idx - 32) >> 3, 1 + (idx & 7), lds);
    } else if (idx < 100) {
      const int v = idx - 64;
      ssd_local_unit(P, W, l, b, v >> 1, v & 1, lds);
    } else if (idx < 104) {
      diff_unit(P, W, l, b, idx - 100, 0, lds);
    } else {
      gqa_unit(W, b, idx - 104, 0, lds);
    }
    __syncthreads();
  XCD_END
}

DI void ph4a_states(KArgP kp) {
  const Params P = load_params(kp); WS W; ws_init(W, P.ws);
  const int tid = fresh_tid(), lane = tid & 63, w = tid >> 6;
  const int nb = gridDim.x, bid = blockIdx.x;
  (void)lane; (void)w; (void)tid;
    XCD_LOOP(64, xcd, idx)
      const int gid = idx * NT + tid;
      const int e4 = gid & 2047, hg = (gid >> 11) & 7, b = xcd, dir = gid >> 14;
      float s0 = 0.f, s1 = 0.f, s2 = 0.f, s3 = 0.f;
      for (int step = 0; step < 18; ++step) {
        const int c = dir ? (step == 0 ? 1 : (step == 1 ? 0 : 19 - step)) : step;
        const size_t idx = ((((size_t)dir * 8 + b) * 18 + c) * 8 + hg) * 8192 + (size_t)e4 * 4;
        uint2 o;
        o.x = pk(s0, s1); o.y = pk(s2, s3);
        *(uint2*)(W.Stin + idx) = o;
        const float tot = W.cumF[(size_t)dir * ((size_t)RR * 8) + ((size_t)b * TT + c * 128 + (dir ? 0 : 127)) * 8 + hg];
        const float dec = __expf(tot);
        const uint2 sv = *(const uint2*)(W.Sloc + idx);
        s0 = s0 * dec + bflo(sv.x); s1 = s1 * dec + bfhi(sv.x);
        s2 = s2 * dec + bflo(sv.y); s3 = s3 * dec + bfhi(sv.y);
      }
    XCD_END
}

DI void ph4b_yoff(KArgP kp, int l, unsigned char* lds) {
  const Params P = load_params(kp); WS W; ws_init(W, P.ws);
  const int tid = fresh_tid(), lane = tid & 63, w = tid >> 6;
  const int nb = gridDim.x, bid = blockIdx.x;
  (void)lane; (void)w; (void)tid;
    XCD_LOOP(72, xcd, idx)
      const int b = xcd, c = idx >> 2, tb = idx & 3;
      const int r = lane & 31, h2 = lane >> 5;
      const int hg = w, g = w >> 2;
      const size_t Rr = (size_t)b * TT + c * 128 + 32 * tb + r;
      f32x16 acc[2][2];
#pragma unroll
      for (int d = 0; d < 2; ++d)
#pragma unroll
        for (int pt = 0; pt < 2; ++pt)
#pragma unroll
          for (int e = 0; e < 16; ++e) acc[d][pt][e] = 0.f;
      const u16* cp = W.Cc + Rr * 256 + g * 128 + 8 * h2;
      const u16* sf = W.Stin + ((((size_t)0 * 8 + b) * 18 + c) * 8 + hg) * 8192 + (size_t)r * 128 + 8 * h2;
      const u16* sb = W.Stin + ((((size_t)1 * 8 + b) * 18 + c) * 8 + hg) * 8192 + (size_t)r * 128 + 8 * h2;
#pragma unroll 2
      for (int ks = 0; ks < 8; ++ks) {
        const bf16x8 bfr = *(const bf16x8*)(cp + 16 * ks);
        const bf16x8 f0 = *(const bf16x8*)(sf + 16 * ks);
        const bf16x8 f1 = *(const bf16x8*)(sf + 32 * 128 + 16 * ks);
        const bf16x8 b0 = *(const bf16x8*)(sb + 16 * ks);
        const bf16x8 b1 = *(const bf16x8*)(sb + 32 * 128 + 16 * ks);
        acc[0][0] = MFMA32(f0, bfr, acc[0][0]);
        acc[0][1] = MFMA32(f1, bfr, acc[0][1]);
        acc[1][0] = MFMA32(b0, bfr, acc[1][0]);
        acc[1][1] = MFMA32(b1, bfr, acc[1][1]);
      }
      const float eF = __expf(W.cumF[Rr * 8 + hg]), eB = __expf(W.cumB[Rr * 8 + hg]);
      float ss = 0.f;
#pragma unroll
      for (int pt = 0; pt < 2; ++pt)
#pragma unroll
        for (int i4 = 0; i4 < 4; ++i4) {
          const int p = 32 * pt + 8 * i4 + 4 * h2;
          const uint2 yd = *(const uint2*)(W.Ycat + Rr * 1024 + hg * 64 + p);
          const uint2 zz = *(const uint2*)(W.Z + Rr * 512 + hg * 64 + p);
          float y0 = bflo(yd.x) + eF * acc[0][pt][4 * i4] + eB * acc[1][pt][4 * i4];
          float y1 = bfhi(yd.x) + eF * acc[0][pt][4 * i4 + 1] + eB * acc[1][pt][4 * i4 + 1];
          float y2 = bflo(yd.y) + eF * acc[0][pt][4 * i4 + 2] + eB * acc[1][pt][4 * i4 + 2];
          float y3 = bfhi(yd.y) + eF * acc[0][pt][4 * i4 + 3] + eB * acc[1][pt][4 * i4 + 3];
          y0 *= silu(bflo(zz.x)); y1 *= silu(bfhi(zz.x)); y2 *= silu(bflo(zz.y)); y3 *= silu(bfhi(zz.y));
          acc[0][pt][4 * i4] = y0; acc[0][pt][4 * i4 + 1] = y1; acc[0][pt][4 * i4 + 2] = y2; acc[0][pt][4 * i4 + 3] = y3;
          ss += y0 * y0 + y1 * y1 + y2 * y2 + y3 * y3;
        }
      ss += __shfl_xor(ss, 32);
      float* red = (float*)lds;
      if (h2 == 0) red[w * 32 + r] = ss;
      __syncthreads();
      float tot = 0.f;
#pragma unroll
      for (int k = 0; k < 8; ++k) tot += red[k * 32 + r];
      const float rn = rsqrtf(tot * (1.f / 512.f) + EPS);
      const float* ng = P.in[16] + l * 512 + hg * 64;
#pragma unroll
      for (int pt = 0; pt < 2; ++pt)
#pragma unroll
        for (int i4 = 0; i4 < 4; ++i4) {
          const int p = 32 * pt + 8 * i4 + 4 * h2;
          const float4 n4 = *(const float4*)(ng + p);
          uint2 o;
          o.x = pk(acc[0][pt][4 * i4] * rn * n4.x, acc[0][pt][4 * i4 + 1] * rn * n4.y);
          o.y = pk(acc[0][pt][4 * i4 + 2] * rn * n4.z, acc[0][pt][4 * i4 + 3] * rn * n4.w);
          *(uint2*)(W.Ycat + Rr * 1024 + hg * 64 + p) = o;
        }
      __syncthreads();
    XCD_END
}

DI void ph5_outproj(KArgP kp, int l, unsigned char* lds) {
  const Params P = load_params(kp); WS W; ws_init(W, P.ws);
  const int tid = fresh_tid();
  const int nb = gridDim.x, bid = blockIdx.x;
  const int upx = (l == 0) ? 72 : 64;
  XCD_LOOP(upx, xcd, idx)
    const int mt = xcd * 9 + (idx >> 3) + (l == 0 ? 0 : 1), nt = idx & 7;
    gemm_tile_to_lds(W.Ycat, W.WoutT + (size_t)l * 1024 * 1024, mt * 256, nt * 128, lds);
    float v[64];
    load_row64(lds, v);
    const size_t R = (size_t)mt * 256 + (tid >> 1);
    float ss = 0.f;
#pragma unroll
    for (int j = 0; j < 64; ++j) ss += v[j] * v[j];
    W.Opart[R * 16 + nt * 2 + (tid & 1)] = ss;
    store64(W.Obuf + R * 1024 + nt * 128 + (tid & 1) * 64, v);
    __syncthreads();
  XCD_END
}

DI void ph6_post(KArgP kp, int l) {
  const Params P = load_params(kp); WS W; ws_init(W, P.ws);
  const int tid = fresh_tid(), lane = tid & 63, w = tid >> 6;
  const int nb = gridDim.x, bid = blockIdx.x;
  (void)lane; (void)w; (void)tid;
    XCD_LOOP(288, xcd, idx)
      const int R = xcd * TT + idx * 8 + w;
      const int b = xcd, t = idx * 8 + w;
      const bool isctx = t < 256;
      if (l == 1 && isctx) continue;
      const float* md = W.mod + ((size_t)l * 9 + (isctx ? 8 : b)) * 3072;
      const float* hsrc;
      if (isctx) hsrc = P.in[2] + ((size_t)b * 256 + t) * 1024;
      else hsrc = (l == 0 ? P.in[0] : (const float*)P.out) + ((size_t)b * 2048 + (t - 256)) * 1024;
      float pss = (lane < 16) ? W.Opart[(size_t)R * 16 + lane] : 0.f;
#pragma unroll
      for (int d = 8; d >= 1; d >>= 1) pss += __shfl_xor(pss, d);
      pss = __shfl(pss, 0);
      const float rn = rsqrtf(pss * (1.f / 1024.f) + EPS);
      const float* gpost = P.in[7] + l * 1024;
      float4 hn[4];
      float ss = 0.f;
#pragma unroll
      for (int i = 0; i < 4; ++i) {
        const int k = i * 256 + lane * 4;
        const float4 hv = *(const float4*)(hsrc + k);
        const uint2 ov = *(const uint2*)(W.Obuf + (size_t)R * 1024 + k);
        const float4 g4 = *(const float4*)(gpost + k);
        const float4 gt = *(const float4*)(md + 2048 + k);
        hn[i].x = hv.x + gt.x * (bflo(ov.x) * rn * g4.x);
        hn[i].y = hv.y + gt.y * (bfhi(ov.x) * rn * g4.y);
        hn[i].z = hv.z + gt.z * (bflo(ov.y) * rn * g4.z);
        hn[i].w = hv.w + gt.w * (bfhi(ov.y) * rn * g4.w);
        ss += hn[i].x * hn[i].x + hn[i].y * hn[i].y + hn[i].z * hn[i].z + hn[i].w * hn[i].w;
      }
      if (!isctx) {
        float* dst = P.out + ((size_t)b * 2048 + (t - 256)) * 1024;
#pragma unroll
        for (int i = 0; i < 4; ++i) *(float4*)(dst + i * 256 + lane * 4) = hn[i];
      }
      if (l == 0) {
#pragma unroll
        for (int d = 32; d >= 1; d >>= 1) ss += __shfl_xor(ss, d);
        const float r2 = rsqrtf(ss * (1.f / 1024.f) + EPS);
        const float* md1 = W.mod + ((size_t)9 + (isctx ? 8 : b)) * 3072;
        const float* gp = P.in[6] + 1024;
#pragma unroll
        for (int i = 0; i < 4; ++i) {
          const int k = i * 256 + lane * 4;
          const float4 g4 = *(const float4*)(gp + k);
          const float4 sh = *(const float4*)(md1 + k);
          const float4 sc = *(const float4*)(md1 + 1024 + k);
          uint2 o;
          o.x = pk(hn[i].x * r2 * g4.x * (1.f + sc.x) + sh.x, hn[i].y * r2 * g4.y * (1.f + sc.y) + sh.y);
          o.y = pk(hn[i].z * r2 * g4.z * (1.f + sc.z) + sh.z, hn[i].w * r2 * g4.w * (1.f + sc.w) + sh.w);
          *(uint2*)(W.U + (size_t)R * 1024 + k) = o;
        }
      }
    XCD_END
}


DI void grid_barrier(unsigned* bar, unsigned& epoch) {
  asm volatile("s_waitcnt vmcnt(0)" ::: "memory");
  __syncthreads();
  ++epoch;
  if (threadIdx.x == 0) {
    __builtin_amdgcn_fence(__ATOMIC_RELEASE, "agent");
    asm volatile("s_waitcnt vmcnt(0)" ::: "memory");
    const unsigned nb = gridDim.x, bid = blockIdx.x;
    const bool hier = (nb & 7u) == 0u;
    const unsigned ng = hier ? 8u : 1u, per = hier ? (nb >> 3) : nb;
    unsigned* grp = bar + 64 * (1 + (hier ? (bid & 7u) : 0u));
    const unsigned old = __hip_atomic_fetch_add(grp, 1u, __ATOMIC_RELAXED, __HIP_MEMORY_SCOPE_AGENT);
    if (old + 1u == epoch * per) __hip_atomic_fetch_add(bar, 1u, __ATOMIC_RELAXED, __HIP_MEMORY_SCOPE_AGENT);
    const unsigned target = epoch * ng;
    while (__hip_atomic_load(bar, __ATOMIC_RELAXED, __HIP_MEMORY_SCOPE_AGENT) < target) __builtin_amdgcn_s_sleep(1);
    __builtin_amdgcn_fence(__ATOMIC_ACQUIRE, "agent");
    asm volatile("s_waitcnt vmcnt(0)" ::: "memory");
  }
  __syncthreads();
}

__global__ void __launch_bounds__(NT) fwd_mega(Params Parg) {
  extern __shared__ __attribute__((aligned(16))) unsigned char lds[];
  cg::grid_group grid = cg::this_grid();
  KArgP kp = (KArgP)__builtin_amdgcn_kernarg_segment_ptr();
  unsigned* bar = (unsigned*)(Parg.ws + OFF_BAR);
  unsigned epoch = 0;
  if (gridDim.x == 0x7fffffffu) grid.sync();

  ph0_prologue(kp, lds);
  grid_barrier(bar, epoch);

  ph1_prep(kp);
  grid_barrier(bar, epoch);

  for (int l = 0; l < 2; ++l) {
    ph2_inproj(kp, l, lds);
    grid_barrier(bar, epoch);

    ph3_mix(kp, l, lds);
    grid_barrier(bar, epoch);

    ph4a_states(kp);
    grid_barrier(bar, epoch);

    ph4b_yoff(kp, l, lds);
    grid_barrier(bar, epoch);

    ph5_outproj(kp, l, lds);
    grid_barrier(bar, epoch);

    ph6_post(kp, l);
    if (l == 0) grid_barrier(bar, epoch);
  }
}

extern "C" void kernel_launch(void* const* d_in, const int* in_sizes, int n_in,
                              void* d_out, int out_size, void* d_ws, size_t ws_size,
                              hipStream_t stream) {
  static int grid_blocks = 0;
  if (!grid_blocks) {
    int dev = 0, cus = 0, per_cu = 0;
    (void)hipGetDevice(&dev);
    (void)hipDeviceGetAttribute(&cus, hipDeviceAttributeMultiprocessorCount, dev);
    (void)hipFuncSetAttribute((const void*)fwd_mega, hipFuncAttributeMaxDynamicSharedMemorySize, LDS_BYTES);
    (void)hipOccupancyMaxActiveBlocksPerMultiprocessor(&per_cu, (const void*)fwd_mega, NT, LDS_BYTES);
    if (per_cu < 1) per_cu = 1;
    grid_blocks = cus * per_cu;
    if (ws_size < WS_END) fprintf(stderr, "workspace too small: %zu < %zu\n", ws_size, (size_t)WS_END);
  }
  Params p{};
  for (int i = 0; i < 22; ++i) p.in[i] = (const float*)d_in[i];
  p.out = (float*)d_out;
  p.ws = (unsigned char*)d_ws;
  (void)hipMemsetAsync((unsigned char*)d_ws + OFF_BAR, 0, 4096, stream);
  void* args[] = {&p};
  hipError_t e = hipLaunchCooperativeKernel((const void*)fwd_mega, dim3(grid_blocks), dim3(NT), args, LDS_BYTES, stream);
  if (e != hipSuccess) fprintf(stderr, "cooperative launch failed: %s (grid %d)\n", hipGetErrorString(e), grid_blocks);
}
```

```cpp
#include <hip/hip_runtime.h>
#include <hip/hip_cooperative_groups.h>
#include <cstdio>
namespace cg = cooperative_groups;

#define DI __device__ __forceinline__
#define NT 512
static __device__ __forceinline__ int fresh_tid() { int t = threadIdx.x; asm volatile("" : "+v"(t)); return t; }
typedef unsigned short u16;
typedef __attribute__((ext_vector_type(8))) short bf16x8;
typedef __attribute__((ext_vector_type(4))) short s16x4;
typedef __attribute__((ext_vector_type(16))) float f32x16;
typedef __attribute__((ext_vector_type(4))) float f32x4;
typedef __attribute__((ext_vector_type(2))) __bf16 bf2v;
typedef __attribute__((ext_vector_type(2))) float f2v;
typedef unsigned __attribute__((ext_vector_type(4))) u32x4;

#define MFMA32(a, b, c) __builtin_amdgcn_mfma_f32_32x32x16_bf16((a), (b), (c), 0, 0, 0)
#define MFMA16(a, b, c) __builtin_amdgcn_mfma_f32_16x16x32_bf16((a), (b), (c), 0, 0, 0)

constexpr int LDS_BYTES = 140 * 1024;
constexpr int TT = 2304;
constexpr int RR = 18432;
constexpr int NPAD = 3456;
constexpr float EPS = 1e-6f;
constexpr float LOG2E = 1.4426950408889634f;

constexpr size_t SZ_WIN = (size_t)2 * NPAD * 1024 * 2;
constexpr size_t SZ_WOUT = (size_t)2 * 1024 * 1024 * 2;
constexpr size_t SZ_MOD = (size_t)2 * 9 * 3072 * 4;
constexpr size_t SZ_ROPE = 16384;
constexpr size_t SZ_R1024 = (size_t)RR * 1024 * 2;
constexpr size_t SZ_R512 = (size_t)RR * 512 * 2;
constexpr size_t SZ_R256 = (size_t)RR * 256 * 2;
constexpr size_t OFF_WIN = 0;
constexpr size_t OFF_WOUT = OFF_WIN + SZ_WIN;
constexpr size_t OFF_MOD = OFF_WOUT + SZ_WOUT;
constexpr size_t OFF_ROPE = OFF_MOD + SZ_MOD;
constexpr size_t OFF_U = OFF_ROPE + SZ_ROPE;
constexpr size_t OFF_XBC = OFF_U + SZ_R1024;
constexpr size_t OFF_Z = OFF_XBC + SZ_R1024;
constexpr size_t OFF_DT = OFF_Z + SZ_R512;
constexpr size_t SZ_DT = (size_t)RR * 16 * 4;
constexpr size_t OFF_Q = OFF_DT + SZ_DT;
constexpr size_t SZ_Q = (size_t)8 * 4 * TT * 64 * 2;
constexpr size_t OFF_K = OFF_Q + SZ_Q;
constexpr size_t SZ_K = (size_t)8 * 2 * TT * 64 * 2;
constexpr size_t OFF_VT = OFF_K + SZ_K;
constexpr size_t OFF_DQ = OFF_VT + SZ_K;
constexpr size_t SZ_DQ = (size_t)8 * 8 * TT * 32 * 2;
constexpr size_t OFF_DK = OFF_DQ + SZ_DQ;
constexpr size_t OFF_DVT = OFF_DK + SZ_DQ;
constexpr size_t SZ_DVT = (size_t)8 * 4 * 64 * TT * 2;
constexpr size_t OFF_GG = OFF_DVT + SZ_DVT;
constexpr size_t OFF_DG = OFF_GG + SZ_R256;
constexpr size_t OFF_CC = OFF_DG + SZ_R256;
constexpr size_t OFF_CUMF = OFF_CC + SZ_R256;
constexpr size_t SZ_CUM = (size_t)RR * 8 * 4;
constexpr size_t OFF_CUMB = OFF_CUMF + SZ_CUM;
constexpr size_t OFF_SLOC = OFF_CUMB + SZ_CUM;
constexpr size_t SZ_ST = (size_t)2 * 8 * 18 * 8 * 8192 * 2;
constexpr size_t OFF_OPART = OFF_SLOC + SZ_ST;
constexpr size_t OFF_BAR = OFF_OPART + SZ_DT;
constexpr size_t WS_END = OFF_BAR + 4096;
static_assert(SZ_ST <= (OFF_GG - OFF_Q), "Stin must fit in the q/k/v region");
static_assert(WS_END <= (size_t)256 * 1024 * 1024, "workspace");

struct Params {
  const float* in[22];
  float* out;
  unsigned char* ws;
};

struct WS {
  u16 *WinT, *WoutT, *U, *Ycat, *XBC, *Obuf, *Z, *Q, *K, *Vt, *DQ, *DK, *DVt, *GG, *DG, *Cc, *Sloc, *Stin;
  float *mod, *DT, *cumF, *cumB, *Opart;
  float2 *ropeG, *ropeD;
};

DI unsigned pk(float a, float b) { f2v v = {a, b}; return __builtin_bit_cast(unsigned, __builtin_convertvector(v, bf2v)); }
DI u16 f2bf(float a) { return (u16)(pk(a, 0.f) & 0xffffu); }
DI float bf2f(u16 b) { return __uint_as_float(((unsigned)b) << 16); }
DI float bflo(unsigned u) { return __uint_as_float(u << 16); }
DI float bfhi(unsigned u) { return __uint_as_float(u & 0xffff0000u); }
DI float silu(float x) { return x / (1.f + __expf(-x)); }
DI float softplus(float x) { return fmaxf(x, 0.f) + log1pf(__expf(-fabsf(x))); }
DI float fexp2(float x) { return __builtin_amdgcn_exp2f(x); }

DI void store64(u16* dst, const float (&v)[64]) {
#pragma unroll
  for (int i = 0; i < 8; ++i) {
    uint4 u;
    u.x = pk(v[8 * i], v[8 * i + 1]); u.y = pk(v[8 * i + 2], v[8 * i + 3]);
    u.z = pk(v[8 * i + 4], v[8 * i + 5]); u.w = pk(v[8 * i + 6], v[8 * i + 7]);
    ((uint4*)dst)[i] = u;
  }
}

struct GRegs { u32x4 a0, a1, a2, a3, b0, b1; };
DI void g_load(GRegs& R, const u16* ag, const u16* bg, int k0) {
  constexpr size_t K = 1024;
  R.a0 = *(const u32x4*)(ag + k0);
  R.a1 = *(const u32x4*)(ag + 64 * K + k0);
  R.a2 = *(const u32x4*)(ag + 128 * K + k0);
  R.a3 = *(const u32x4*)(ag + 192 * K + k0);
  R.b0 = *(const u32x4*)(bg + k0);
  R.b1 = *(const u32x4*)(bg + 64 * K + k0);
}
DI void g_store(const GRegs& R, u16* as, u16* bs) {
  *(u32x4*)(as) = R.a0;
  *(u32x4*)(as + 64 * 72) = R.a1;
  *(u32x4*)(as + 128 * 72) = R.a2;
  *(u32x4*)(as + 192 * 72) = R.a3;
  *(u32x4*)(bs) = R.b0;
  *(u32x4*)(bs + 64 * 72) = R.b1;
}
DI void g_compute(const u16* as, const u16* bs, f32x16 (&acc)[2][2]) {
#pragma unroll
  for (int ks = 0; ks < 4; ++ks) {
    bf16x8 a0 = *(const bf16x8*)(as + 16 * ks);
    bf16x8 a1 = *(const bf16x8*)(as + 32 * 72 + 16 * ks);
    bf16x8 b0 = *(const bf16x8*)(bs + 16 * ks);
    bf16x8 b1 = *(const bf16x8*)(bs + 32 * 72 + 16 * ks);
    acc[0][0] = MFMA32(a0, b0, acc[0][0]);
    acc[0][1] = MFMA32(a0, b1, acc[0][1]);
    acc[1][0] = MFMA32(a1, b0, acc[1][0]);
    acc[1][1] = MFMA32(a1, b1, acc[1][1]);
  }
}
constexpr int G_LDK = 72;
constexpr int G_CST = 132;
DI void gemm_tile_to_lds(const u16* __restrict__ A, const u16* __restrict__ Bt, int m0, int n0, unsigned char* lds) {
  constexpr int K = 1024;
  u16* As = (u16*)lds;
  u16* Bs = (u16*)(lds + 2 * 256 * G_LDK * 2);
  const int tid = fresh_tid(), lane = tid & 63, w = tid >> 6;
  const int r = lane & 31, h = lane >> 5;
  const int wm = w >> 1, wn = w & 1;
  const int arow = tid >> 3, akc = tid & 7;
  const u16* ag = A + (size_t)(m0 + arow) * K + akc * 8;
  const u16* bg = Bt + (size_t)(n0 + arow) * K + akc * 8;
  f32x16 acc[2][2];
#pragma unroll
  for (int i = 0; i < 2; ++i)
#pragma unroll
    for (int j = 0; j < 2; ++j)
#pragma unroll
      for (int e = 0; e < 16; ++e) acc[i][j][e] = 0.f;
  GRegs R0, R1;
  g_load(R0, ag, bg, 0);
  g_load(R1, ag, bg, 64);
  g_store(R0, As + arow * G_LDK + akc * 8, Bs + arow * G_LDK + akc * 8);
  __syncthreads();
  const u16* as0 = As + (64 * wm + r) * G_LDK + 8 * h;
  const u16* bs0 = Bs + (64 * wn + r) * G_LDK + 8 * h;
  for (int kt2 = 0; kt2 < 16; kt2 += 2) {
    if (kt2 + 2 < 16) g_load(R0, ag, bg, (kt2 + 2) * 64);
    g_compute(as0, bs0, acc);
    g_store(R1, As + 256 * G_LDK + arow * G_LDK + akc * 8, Bs + 128 * G_LDK + arow * G_LDK + akc * 8);
    __syncthreads();
    if (kt2 + 3 < 16) g_load(R1, ag, bg, (kt2 + 3) * 64);
    g_compute(as0 + 256 * G_LDK, bs0 + 128 * G_LDK, acc);
    if (kt2 + 2 < 16) g_store(R0, As + arow * G_LDK + akc * 8, Bs + arow * G_LDK + akc * 8);
    __syncthreads();
  }
  float* Cst = (float*)lds;
#pragma unroll
  for (int i = 0; i < 2; ++i)
#pragma unroll
    for (int j = 0; j < 2; ++j)
#pragma unroll
      for (int e = 0; e < 16; ++e) {
        const int row = 64 * wm + 32 * i + (e & 3) + 8 * (e >> 2) + 4 * h;
        Cst[row * G_CST + 64 * wn + 32 * j + r] = acc[i][j][e];
      }
  __syncthreads();
}

DI void load_row64(const unsigned char* lds, float (&v)[64]) {
  const int tid = fresh_tid();
  const float* src = (const float*)lds + (tid >> 1) * G_CST + (tid & 1) * 64;
#pragma unroll
  for (int i = 0; i < 16; ++i) {
    float4 f = ((const float4*)src)[i];
    v[4 * i] = f.x; v[4 * i + 1] = f.y; v[4 * i + 2] = f.z; v[4 * i + 3] = f.w;
  }
}

DI void inproj_epi(const Params& P, const WS& W, int l, int R, int nt, int half, float (&v)[64]) {
  const int b = R / TT;
  const int t = R - b * TT;
  if (nt < 8) {
    store64(W.XBC + (size_t)R * 1024 + nt * 128 + half * 64, v);
  } else if (nt < 12) {
    store64(W.Z + (size_t)R * 512 + (nt - 8) * 128 + half * 64, v);
  } else if (nt < 15) {
    const bool isq = nt < 14;
    const float* g = (isq ? P.in[17] : P.in[18]) + l * 64;
    float ss = 0.f;
#pragma unroll
    for (int j = 0; j < 64; ++j) ss += v[j] * v[j];
    const float rn = rsqrtf(ss * (1.f / 64.f) + EPS);
#pragma unroll
    for (int j = 0; j < 64; ++j) { if ((j & 15) == 0) __builtin_amdgcn_sched_barrier(0); v[j] = v[j] * rn * g[j]; }
    if (t >= 256) {
      const int pos = t - 256, ri = pos >> 6, ci = pos & 63;
#pragma unroll
      for (int i = 0; i < 32; ++i) {
        if ((i & 7) == 0) __builtin_amdgcn_sched_barrier(0);
        const float2 cs = (i < 16) ? W.ropeG[ri * 16 + i] : W.ropeG[ci * 16 + (i - 16)];
        const float x1 = v[i], x2 = v[i + 32];
        v[i] = x1 * cs.x - x2 * cs.y;
        v[i + 32] = x2 * cs.x + x1 * cs.y;
      }
    }
    if (isq) {
      const float sc = 0.125f * LOG2E;
#pragma unroll
      for (int j = 0; j < 64; ++j) v[j] *= sc;
      const int head = (nt - 12) * 2 + half;
      store64(W.Q + ((size_t)(b * 4 + head) * TT + t) * 64, v);
    } else {
      store64(W.K + ((size_t)(b * 2 + half) * TT + t) * 64, v);
    }
  } else if (nt == 15) {
    u16* dst = W.Vt + ((size_t)(b * 2 + half) * 64) * TT + t;
#pragma unroll
    for (int j = 0; j < 64; ++j) { if ((j & 7) == 0) __builtin_amdgcn_sched_barrier(0); dst[(size_t)j * TT] = f2bf(v[j]); }
  } else if (nt < 18) {
#pragma unroll
    for (int j = 0; j < 64; ++j) v[j] = silu(v[j]);
    store64(W.GG + (size_t)R * 256 + (nt - 16) * 128 + half * 64, v);
  } else if (nt < 22) {
    const bool isq = nt < 20;
    const int mbase = (nt - (isq ? 18 : 20)) * 4 + half * 2;
    if (t >= 256) {
      const int pos = t - 256, ri = pos >> 6, ci = pos & 63;
#pragma unroll
      for (int mm = 0; mm < 2; ++mm)
#pragma unroll
        for (int i = 0; i < 16; ++i) {
          if ((i & 7) == 0) __builtin_amdgcn_sched_barrier(0);
          const float2 cs = (i < 8) ? W.ropeD[ri * 8 + i] : W.ropeD[ci * 8 + (i - 8)];
          const float x1 = v[32 * mm + i], x2 = v[32 * mm + i + 16];
          v[32 * mm + i] = x1 * cs.x - x2 * cs.y;
          v[32 * mm + i + 16] = x2 * cs.x + x1 * cs.y;
        }
    }
    if (isq) {
      const float sc = 0.17677669529663687f * LOG2E;
#pragma unroll
      for (int j = 0; j < 64; ++j) v[j] *= sc;
    }
    u16* base = isq ? W.DQ : W.DK;
#pragma unroll
    for (int mm = 0; mm < 2; ++mm) {
      u16* dst = base + ((size_t)(b * 8 + mbase + mm) * TT + t) * 32;
#pragma unroll
      for (int i = 0; i < 4; ++i) {
        uint4 u;
        u.x = pk(v[32 * mm + 8 * i], v[32 * mm + 8 * i + 1]); u.y = pk(v[32 * mm + 8 * i + 2], v[32 * mm + 8 * i + 3]);
        u.z = pk(v[32 * mm + 8 * i + 4], v[32 * mm + 8 * i + 5]); u.w = pk(v[32 * mm + 8 * i + 6], v[32 * mm + 8 * i + 7]);
        ((uint4*)dst)[i] = u;
      }
    }
  } else if (nt < 24) {
    const int head = (nt - 22) * 2 + half;
    u16* dst = W.DVt + ((size_t)(b * 4 + head) * 64) * TT + t;
#pragma unroll
    for (int j = 0; j < 64; ++j) { if ((j & 7) == 0) __builtin_amdgcn_sched_barrier(0); dst[(size_t)j * TT] = f2bf(v[j]); }
  } else if (nt < 26) {
#pragma unroll
    for (int j = 0; j < 64; ++j) v[j] = silu(v[j]);
    store64(W.DG + (size_t)R * 256 + (nt - 24) * 128 + half * 64, v);
  } else if (nt == 26) {
    if (half == 0) {
      const float* bf = P.in[13] + l * 8;
      const float* bb = P.in[14] + l * 8;
#pragma unroll
      for (int j = 0; j < 16; ++j) {
        const float x = v[j] + (j < 8 ? bf[j] : bb[j - 8]);
        W.DT[(size_t)R * 16 + j] = softplus(x);
      }
    }
  }
}

template <int D, bool BOUNDED>
DI void attn_core(const u16* __restrict__ Qh, const u16* __restrict__ Kh, const u16* __restrict__ Vth, int q0, int nkeys,
                  float bound, unsigned char* lds, f32x16 (&O)[2], float& lout) {
  constexpr int KP = D + 8;
  constexpr int KS = D / 16;
  u16* Ks = (u16*)lds;
  u16* Vs = (u16*)(lds + 2 * 64 * 72 * 2);
  const int tid = fresh_tid(), lane = tid & 63, w = tid >> 6;
  const int r = lane & 31, h = lane >> 5;
  bf16x8 qf[KS];
  {
    const u16* qp = Qh + (size_t)(q0 + 32 * w + r) * D + 8 * h;
#pragma unroll
    for (int ks = 0; ks < KS; ++ks) qf[ks] = *(const bf16x8*)(qp + 16 * ks);
  }
#pragma unroll
  for (int e = 0; e < 16; ++e) { O[0][e] = 0.f; O[1][e] = 0.f; }
  float m = BOUNDED ? bound : 0.f, lsum = 0.f;
  const int krow = (D == 64) ? (tid >> 3) : (tid >> 2);
  const int kc = (D == 64) ? (tid & 7) : (tid & 3);
  const bool kact = (D == 64) ? true : (tid < 256);
  const int vrow = tid >> 3, vc = tid & 7;
  const u16* kg = Kh + (size_t)krow * D + kc * 8;
  const u16* vg = Vth + (size_t)vrow * TT + vc * 8;
  u32x4 rk0 = (u32x4){0u, 0u, 0u, 0u}, rk1 = rk0, rv0, rv1;
  const int nk = nkeys >> 6;
  if (kact) rk0 = *(const u32x4*)kg;
  rv0 = *(const u32x4*)vg;
  if (kact) rk1 = *(const u32x4*)(kg + (size_t)64 * D);
  rv1 = *(const u32x4*)(vg + 64);
  if (kact) *(u32x4*)&Ks[krow * KP + kc * 8] = rk0;
  *(u32x4*)&Vs[vrow * 72 + vc * 8] = rv0;
  __syncthreads();
  for (int kt2 = 0; kt2 < nk; kt2 += 2) {
#pragma unroll
  for (int ph = 0; ph < 2; ++ph) {
    const int kt = kt2 + ph;
    const int cur = ph;
    if (kt + 2 < nk) {
      if (ph == 0) {
        if (kact) rk0 = *(const u32x4*)(kg + (size_t)(kt + 2) * 64 * D);
        rv0 = *(const u32x4*)(vg + (kt + 2) * 64);
      } else {
        if (kact) rk1 = *(const u32x4*)(kg + (size_t)(kt + 2) * 64 * D);
        rv1 = *(const u32x4*)(vg + (kt + 2) * 64);
      }
    }
    const u16* ks_ = Ks + cur * 64 * KP + r * KP + 8 * h;
    bf16x8 kf0[KS], kf1[KS];
#pragma unroll
    for (int ks = 0; ks < KS; ++ks) {
      kf0[ks] = *(const bf16x8*)(ks_ + 16 * ks);
      kf1[ks] = *(const bf16x8*)(ks_ + 32 * KP + 16 * ks);
    }
    const u16* vs_ = Vs + cur * 64 * 72 + r * 72 + 4 * h;
    bf16x8 vf[8];
#pragma unroll
    for (int s = 0; s < 2; ++s)
#pragma unroll
      for (int dt = 0; dt < 2; ++dt) {
        const u16* vp = vs_ + dt * 32 * 72 + 16 * s;
        s16x4 lo = *(const s16x4*)vp;
        s16x4 hi = *(const s16x4*)(vp + 8);
        vf[s * 2 + dt] = __builtin_shufflevector(lo, hi, 0, 1, 2, 3, 4, 5, 6, 7);
      }
    __builtin_amdgcn_sched_barrier(0);
    f32x16 S[2];
    {
      const float nm = -m;
#pragma unroll
      for (int e = 0; e < 16; ++e) { S[0][e] = nm; S[1][e] = nm; }
    }
#pragma unroll
    for (int ks = 0; ks < KS; ++ks) {
      S[0] = MFMA32(kf0[ks], qf[ks], S[0]);
      S[1] = MFMA32(kf1[ks], qf[ks], S[1]);
    }
    __builtin_amdgcn_sched_barrier(0);
#pragma unroll
    for (int s = 0; s < 2; ++s)
#pragma unroll
      for (int dt = 0; dt < 2; ++dt) {
        const u16* vp = vs_ + dt * 32 * 72 + 32 + 16 * s;
        s16x4 lo = *(const s16x4*)vp;
        s16x4 hi = *(const s16x4*)(vp + 8);
        vf[(2 + s) * 2 + dt] = __builtin_shufflevector(lo, hi, 0, 1, 2, 3, 4, 5, 6, 7);
      }
    __builtin_amdgcn_sched_barrier(0);
    if (!BOUNDED) {
      float t0 = fmaxf(fmaxf(S[0][0], S[0][1]), S[0][2]);
      float t1 = fmaxf(fmaxf(S[1][0], S[1][1]), S[1][2]);
#pragma unroll
      for (int e = 3; e < 15; e += 2) { t0 = fmaxf(fmaxf(t0, S[0][e]), S[0][e + 1]); t1 = fmaxf(fmaxf(t1, S[1][e]), S[1][e + 1]); }
      float tm = fmaxf(fmaxf(t0, t1), fmaxf(S[0][15], S[1][15]));
      tm = fmaxf(tm, __shfl_xor(tm, 32));
      const bool first = (kt == 0);
      if (first || __any(tm > 0.f)) {
        const float adj = first ? tm : fmaxf(tm, 0.f);
        const float alpha = first ? 1.f : fexp2(-adj);
        m += adj;
        lsum *= alpha;
#pragma unroll
        for (int e = 0; e < 16; ++e) { O[0][e] *= alpha; O[1][e] *= alpha; S[0][e] -= adj; S[1][e] -= adj; }
      }
    }
    float rs = 0.f;
#pragma unroll
    for (int e = 0; e < 16; ++e) { S[0][e] = fexp2(S[0][e]); rs += S[0][e]; }
#pragma unroll
    for (int e = 0; e < 16; ++e) { S[1][e] = fexp2(S[1][e]); rs += S[1][e]; }
    lsum += rs;
#pragma unroll
    for (int t2 = 0; t2 < 2; ++t2)
#pragma unroll
      for (int s = 0; s < 2; ++s) {
        uint4 pu;
        pu.x = pk(S[t2][8 * s], S[t2][8 * s + 1]); pu.y = pk(S[t2][8 * s + 2], S[t2][8 * s + 3]);
        pu.z = pk(S[t2][8 * s + 4], S[t2][8 * s + 5]); pu.w = pk(S[t2][8 * s + 6], S[t2][8 * s + 7]);
        const bf16x8 pb = __builtin_bit_cast(bf16x8, pu);
        O[0] = MFMA32(vf[(t2 * 2 + s) * 2 + 0], pb, O[0]);
        O[1] = MFMA32(vf[(t2 * 2 + s) * 2 + 1], pb, O[1]);
      }
    if (kt + 1 < nk) {
      const int nx = cur ^ 1;
      if (kact) *(u32x4*)&Ks[nx * 64 * KP + krow * KP + kc * 8] = (ph == 0) ? rk1 : rk0;
      *(u32x4*)&Vs[nx * 64 * 72 + vrow * 72 + vc * 8] = (ph == 0) ? rv1 : rv0;
    }
    __syncthreads();
  }
  }
  lout = lsum + __shfl_xor(lsum, 32);
}

DI void gqa_unit(const WS& W, const float* qg, const float* kg_, int b, int head, int qb, unsigned char* lds) {
  const int tid = fresh_tid(), lane = tid & 63, w = tid >> 6, r = lane & 31, h = lane >> 5;
  const int q0 = qb * 256;
  const int nkeys = (qb == 0) ? 256 : TT;
  f32x16 O[2];
  float l;
  float bound;
  {
    float gq = fabsf(qg[lane]), gk = fabsf(kg_[lane]);
#pragma unroll
    for (int d = 32; d >= 1; d >>= 1) { gq = fmaxf(gq, __shfl_xor(gq, d)); gk = fmaxf(gk, __shfl_xor(gk, d)); }
    bound = 8.f * LOG2E * gq * gk * 1.02f + 0.25f;
  }
  attn_core<64, true>(W.Q + (size_t)(b * 4 + head) * TT * 64, W.K + (size_t)(b * 2 + (head >> 1)) * TT * 64,
                      W.Vt + (size_t)(b * 2 + (head >> 1)) * 64 * TT, q0, nkeys, bound, lds, O, l);
  const float il = 1.f / l;
  const size_t Rr = (size_t)b * TT + q0 + 32 * w + r;
#pragma unroll
  for (int dt = 0; dt < 2; ++dt)
#pragma unroll
    for (int i4 = 0; i4 < 4; ++i4) {
      const int dv = 32 * dt + 8 * i4 + 4 * h;
      const uint2 g = *(const uint2*)(W.GG + Rr * 256 + head * 64 + dv);
      uint2 o;
      o.x = pk(O[dt][4 * i4] * il * bflo(g.x), O[dt][4 * i4 + 1] * il * bfhi(g.x));
      o.y = pk(O[dt][4 * i4 + 2] * il * bflo(g.y), O[dt][4 * i4 + 3] * il * bfhi(g.y));
      *(uint2*)(W.Ycat + Rr * 1024 + 512 + head * 64 + dv) = o;
    }
}

DI void diff_unit(const Params& P, const WS& W, int l, int b, int hh, int qb, unsigned char* lds) {
  const int tid = fresh_tid(), lane = tid & 63, w = tid >> 6, r = lane & 31, h = lane >> 5;
  const int q0 = qb * 256;
  const int nkeys = (qb == 0) ? 256 : TT;
  const float lam_init = (l == 0) ? 0.2f : 0.35550906759f;
  float lam;
  {
    const float* lp = P.in[19] + l * 128;
    float s1 = (lane < 32) ? lp[lane] * lp[32 + lane] : 0.f;
    float s2 = (lane < 32) ? lp[64 + lane] * lp[96 + lane] : 0.f;
#pragma unroll
    for (int d = 32; d >= 1; d >>= 1) { s1 += __shfl_xor(s1, d); s2 += __shfl_xor(s2, d); }
    lam = __expf(s1) - __expf(s2) + lam_init;
  }
  f32x16 O1[2], O2[2];
  float l1, l2;
  const u16* vt = W.DVt + (size_t)(b * 4 + hh) * 64 * TT;
  attn_core<32, false>(W.DQ + (size_t)(b * 8 + 2 * hh) * TT * 32, W.DK + (size_t)(b * 8 + 2 * hh) * TT * 32, vt, q0, nkeys, 0.f, lds, O1, l1);
  attn_core<32, false>(W.DQ + (size_t)(b * 8 + 2 * hh + 1) * TT * 32, W.DK + (size_t)(b * 8 + 2 * hh + 1) * TT * 32, vt, q0, nkeys, 0.f, lds, O2, l2);
  const float i1 = 1.f / l1, i2 = lam / l2;
  float ss = 0.f;
#pragma unroll
  for (int dt = 0; dt < 2; ++dt)
#pragma unroll
    for (int e = 0; e < 16; ++e) {
      const float o = O1[dt][e] * i1 - O2[dt][e] * i2;
      O1[dt][e] = o;
      ss += o * o;
    }
  ss += __shfl_xor(ss, 32);
  const float rn = rsqrtf(ss * (1.f / 64.f) + EPS) * (1.f - lam_init);
  const float* ng = P.in[20] + l * 64;
  const size_t Rr = (size_t)b * TT + q0 + 32 * w + r;
#pragma unroll
  for (int dt = 0; dt < 2; ++dt)
#pragma unroll
    for (int i4 = 0; i4 < 4; ++i4) {
      const int dv = 32 * dt + 8 * i4 + 4 * h;
      const uint2 g = *(const uint2*)(W.DG + Rr * 256 + hh * 64 + dv);
      const float4 n4 = *(const float4*)(ng + dv);
      uint2 o;
      o.x = pk(O1[dt][4 * i4] * rn * n4.x * bflo(g.x), O1[dt][4 * i4 + 1] * rn * n4.y * bfhi(g.x));
      o.y = pk(O1[dt][4 * i4 + 2] * rn * n4.z * bflo(g.y), O1[dt][4 * i4 + 3] * rn * n4.w * bfhi(g.y));
      *(uint2*)(W.Ycat + Rr * 1024 + 768 + hh * 64 + dv) = o;
    }
}

DI void ssd_xload(uint2 (&raw)[8], const u16* src, int tb, int seg_lo, int seg_hi) {
#pragma unroll
  for (int i = 0; i < 8; ++i) {
    const int t = tb - 2 + i;
    const int tc = min(max(t, seg_lo), seg_hi - 1);
    uint2 v = *(const uint2*)(src + (size_t)tc * 1024);
    if (t < seg_lo || t >= seg_hi) v = make_uint2(0u, 0u);
    raw[i] = v;
  }
}
constexpr int S_LD = 136;
DI void ssd_local_unit(const Params& P, const WS& W, int l, int b, int c, int g, unsigned char* lds) {
  const int tid = fresh_tid(), lane = tid & 63, w = tid >> 6;
  u16* BsT = (u16*)lds;
  u16* Bs = (u16*)(lds + 34816);
  u16* Cs = (u16*)(lds + 69632);
  u16* xT = (u16*)(lds + 34816);
  u16* xsF = (u16*)(lds + 52224);
  u16* xsB = (u16*)(lds + 69632);
  float* cumF = (float*)(lds + 104448);
  float* cumB = cumF + 512;
  float* dtF = cumB + 512;
  float* dtB = dtF + 512;
  const size_t Rc0 = (size_t)b * TT + c * 128;
  const int seg_lo = (c < 2) ? 0 : 256;
  const int seg_hi = (c < 2) ? 256 : TT;
  const float* conv_w = P.in[9] + (size_t)l * 5 * 1024;
  const float* conv_b = P.in[10] + (size_t)l * 1024;
  uint2 xraw[8];
  ssd_xload(xraw, W.XBC + (size_t)b * TT * 1024 + (g * 4) * 64 + 4 * (tid & 15), c * 128 + 4 * (tid >> 4), seg_lo, seg_hi);
  {
    const int hh = w & 3, dir = w >> 2, hg = g * 4 + hh;
    const float a = -__expf((dir ? P.in[12] : P.in[11])[l * 8 + hg]);
    const float d0 = W.DT[(Rc0 + 2 * lane) * 16 + dir * 8 + hg];
    const float d1 = W.DT[(Rc0 + 2 * lane + 1) * 16 + dir * 8 + hg];
    const float a0 = d0 * a, a1 = d1 * a;
    float v = a0 + a1;
    float c0, c1;
    if (dir == 0) {
#pragma unroll
      for (int d = 1; d < 64; d <<= 1) { const float t = __shfl_up(v, d); if (lane >= d) v += t; }
      c0 = v - a1; c1 = v;
    } else {
#pragma unroll
      for (int d = 1; d < 64; d <<= 1) { const float t = __shfl_down(v, d); if (lane + d < 64) v += t; }
      c0 = v; c1 = v - a0;
    }
    float* lc = cumF + dir * 512 + hh * 128 + 2 * lane;
    lc[0] = c0; lc[1] = c1;
    lc[1024] = d0; lc[1025] = d1;
    float* gc = W.cumF + (size_t)dir * ((size_t)RR * 8) + (Rc0 + 2 * lane) * 8 + hg;
    gc[0] = c0; gc[8] = c1;
  }
  {
    const int cq = lane;
    const bool isB = cq < 32;
    const int ch0 = isB ? 4 * cq : 4 * (cq - 32);
    const int col = (isB ? 512 : 768) + g * 128 + ch0;
    float4 wj[5];
#pragma unroll
    for (int j = 0; j < 5; ++j) wj[j] = *(const float4*)(conv_w + j * 1024 + col);
    const float4 bias = *(const float4*)(conv_b + col);
    const u16* src = W.XBC + (size_t)b * TT * 1024 + col;
    const int tb = c * 128 + 16 * w;
    uint2 raw[20];
#pragma unroll
    for (int i = 0; i < 20; ++i) {
      const int t = tb - 2 + i;
      const int tc = min(max(t, seg_lo), seg_hi - 1);
      uint2 v = *(const uint2*)(src + (size_t)tc * 1024);
      if (t < seg_lo || t >= seg_hi) v = make_uint2(0u, 0u);
      raw[i] = v;
    }
    float y[4][16];
#pragma unroll
    for (int s2 = 0; s2 < 16; ++s2) {
      float a0 = bias.x, a1 = bias.y, a2 = bias.z, a3 = bias.w;
#pragma unroll
      for (int j = 0; j < 5; ++j) {
        const uint2 v = raw[s2 + j];
        a0 += wj[j].x * bflo(v.x); a1 += wj[j].y * bfhi(v.x); a2 += wj[j].z * bflo(v.y); a3 += wj[j].w * bfhi(v.y);
      }
      y[0][s2] = silu(a0); y[1][s2] = silu(a1); y[2][s2] = silu(a2); y[3][s2] = silu(a3);
    }
    const int s0 = 16 * w;
    if (isB) {
#pragma unroll
      for (int s2 = 0; s2 < 16; ++s2) {
        uint2 o; o.x = pk(y[0][s2], y[1][s2]); o.y = pk(y[2][s2], y[3][s2]);
        *(uint2*)&Bs[(s0 + s2) * S_LD + ch0] = o;
      }
#pragma unroll
      for (int ch = 0; ch < 4; ++ch) {
        uint4 u0, u1;
        u0.x = pk(y[ch][0], y[ch][1]); u0.y = pk(y[ch][2], y[ch][3]); u0.z = pk(y[ch][4], y[ch][5]); u0.w = pk(y[ch][6], y[ch][7]);
        u1.x = pk(y[ch][8], y[ch][9]); u1.y = pk(y[ch][10], y[ch][11]); u1.z = pk(y[ch][12], y[ch][13]); u1.w = pk(y[ch][14], y[ch][15]);
        *(uint4*)&BsT[(ch0 + ch) * S_LD + s0] = u0;
        *(uint4*)&BsT[(ch0 + ch) * S_LD + s0 + 8] = u1;
      }
    } else {
#pragma unroll
      for (int s2 = 0; s2 < 16; ++s2) {
        uint2 o; o.x = pk(y[0][s2], y[1][s2]); o.y = pk(y[2][s2], y[3][s2]);
        *(uint2*)&Cs[(s0 + s2) * S_LD + ch0] = o;
        *(uint2*)(W.Cc + (Rc0 + s0 + s2) * 256 + g * 128 + ch0) = o;
      }
    }
  }
  __syncthreads();
  const int c16 = lane & 15, q = lane >> 4;
  f32x4 G[8];
#pragma unroll
  for (int st = 0; st < 8; ++st) G[st] = (f32x4){0.f, 0.f, 0.f, 0.f};
#pragma unroll
  for (int ks = 0; ks < 4; ++ks) {
    const bf16x8 bfrag = *(const bf16x8*)&Cs[(16 * w + c16) * S_LD + 32 * ks + 8 * q];
#pragma unroll
    for (int st = 0; st < 8; ++st) {
      const bf16x8 afrag = *(const bf16x8*)&Bs[(16 * st + c16) * S_LD + 32 * ks + 8 * q];
      G[st] = MFMA16(afrag, bfrag, G[st]);
    }
  }
  __syncthreads();
  for (int hh = 0; hh < 4; ++hh) {
    const int hg = g * 4 + hh;
    {
      const int cq = tid & 15, tg = tid >> 4;
      const int col = hg * 64 + 4 * cq;
      float4 wj[5];
#pragma unroll
      for (int j = 0; j < 5; ++j) wj[j] = *(const float4*)(conv_w + j * 1024 + col);
      const float4 bias = *(const float4*)(conv_b + col);
      const float cF_end = cumF[hh * 128 + 127], cB_end = cumB[hh * 128];
      float y[4][4], ff[4], fb[4];
#pragma unroll
      for (int s2 = 0; s2 < 4; ++s2) {
        float a0 = bias.x, a1 = bias.y, a2 = bias.z, a3 = bias.w;
#pragma unroll
        for (int j = 0; j < 5; ++j) {
          const uint2 v = xraw[s2 + j];
          a0 += wj[j].x * bflo(v.x); a1 += wj[j].y * bfhi(v.x); a2 += wj[j].z * bflo(v.y); a3 += wj[j].w * bfhi(v.y);
        }
        y[0][s2] = silu(a0); y[1][s2] = silu(a1); y[2][s2] = silu(a2); y[3][s2] = silu(a3);
        const int sI = 4 * tg + s2;
        ff[s2] = dtF[hh * 128 + sI] * __expf(cF_end - cumF[hh * 128 + sI]);
        fb[s2] = dtB[hh * 128 + sI] * __expf(cB_end - cumB[hh * 128 + sI]);
      }
#pragma unroll
      for (int ch = 0; ch < 4; ++ch) {
        const int p = 4 * cq + ch;
        uint2 o;
        o.x = pk(y[ch][0], y[ch][1]); o.y = pk(y[ch][2], y[ch][3]);
        *(uint2*)&xT[p * S_LD + 4 * tg] = o;
        o.x = pk(y[ch][0] * ff[0], y[ch][1] * ff[1]); o.y = pk(y[ch][2] * ff[2], y[ch][3] * ff[3]);
        *(uint2*)&xsF[p * S_LD + 4 * tg] = o;
        o.x = pk(y[ch][0] * fb[0], y[ch][1] * fb[1]); o.y = pk(y[ch][2] * fb[2], y[ch][3] * fb[3]);
        *(uint2*)&xsB[p * S_LD + 4 * tg] = o;
      }
      if (hh < 3) ssd_xload(xraw, W.XBC + (size_t)b * TT * 1024 + (hg + 1) * 64 + 4 * cq, c * 128 + 4 * tg, seg_lo, seg_hi);
    }
    __syncthreads();
    {
      const int t = 16 * w + c16;
      const float cF_t = cumF[hh * 128 + t], cB_t = cumB[hh * 128 + t];
      const float Dh = P.in[15][l * 8 + hg];
      f32x4 Y[4];
#pragma unroll
      for (int pt = 0; pt < 4; ++pt) Y[pt] = (f32x4){0.f, 0.f, 0.f, 0.f};
#pragma unroll
      for (int m = 0; m < 4; ++m) {
        __builtin_amdgcn_sched_barrier(0);
        float mv[8];
#pragma unroll
        for (int jj = 0; jj < 2; ++jj) {
          const int st = 2 * m + jj;
          const int sb = 16 * st + 4 * q;
          const float4 cf4 = *(const float4*)&cumF[hh * 128 + sb];
          const float4 df4 = *(const float4*)&dtF[hh * 128 + sb];
          const float4 cb4 = *(const float4*)&cumB[hh * 128 + sb];
          const float4 db4 = *(const float4*)&dtB[hh * 128 + sb];
          const float cfv[4] = {cf4.x, cf4.y, cf4.z, cf4.w}, dfv[4] = {df4.x, df4.y, df4.z, df4.w};
          const float cbv[4] = {cb4.x, cb4.y, cb4.z, cb4.w}, dbv[4] = {db4.x, db4.y, db4.z, db4.w};
#pragma unroll
          for (int i = 0; i < 4; ++i) {
            const int s = sb + i;
            const float ef = (s <= t) ? __expf(cF_t - cfv[i]) * dfv[i] : 0.f;
            const float eb = (s >= t) ? __expf(cB_t - cbv[i]) * dbv[i] : 0.f;
            mv[4 * jj + i] = G[st][i] * (ef + eb) + ((s == t) ? Dh : 0.f);
          }
        }
        uint4 mu;
        mu.x = pk(mv[0], mv[1]); mu.y = pk(mv[2], mv[3]); mu.z = pk(mv[4], mv[5]); mu.w = pk(mv[6], mv[7]);
        const bf16x8 Mf = __builtin_bit_cast(bf16x8, mu);
#pragma unroll
        for (int pt = 0; pt < 4; ++pt) {
          const u16* xp = xT + (16 * pt + c16) * S_LD + 32 * m + 4 * q;
          s16x4 lo = *(const s16x4*)xp;
          s16x4 hi = *(const s16x4*)(xp + 16);
          const bf16x8 af = __builtin_shufflevector(lo, hi, 0, 1, 2, 3, 4, 5, 6, 7);
          Y[pt] = MFMA16(af, Mf, Y[pt]);
        }
      }
#pragma unroll
      for (int pt = 0; pt < 4; ++pt) {
        uint2 o;
        o.x = pk(Y[pt][0], Y[pt][1]); o.y = pk(Y[pt][2], Y[pt][3]);
        *(uint2*)(W.Ycat + (Rc0 + t) * 1024 + hg * 64 + 16 * pt + 4 * q) = o;
      }
    }
#pragma unroll
    for (int dir = 0; dir < 2; ++dir) {
      const u16* xs = dir ? xsB : xsF;
      f32x4 acc[4];
#pragma unroll
      for (int pt = 0; pt < 4; ++pt) acc[pt] = (f32x4){0.f, 0.f, 0.f, 0.f};
#pragma unroll
      for (int ks = 0; ks < 4; ++ks) {
        const bf16x8 af = *(const bf16x8*)&BsT[(16 * w + c16) * S_LD + 32 * ks + 8 * q];
#pragma unroll
        for (int pt = 0; pt < 4; ++pt) {
          const bf16x8 bfr = *(const bf16x8*)&xs[(16 * pt + c16) * S_LD + 32 * ks + 8 * q];
          acc[pt] = MFMA16(af, bfr, acc[pt]);
        }
      }
      u16* dst = W.Sloc + ((((size_t)dir * 8 + b) * 18 + c) * 8 + hg) * 8192;
#pragma unroll
      for (int pt = 0; pt < 4; ++pt) {
        uint2 o;
        o.x = pk(acc[pt][0], acc[pt][1]); o.y = pk(acc[pt][2], acc[pt][3]);
        *(uint2*)(dst + (16 * pt + c16) * 128 + 16 * w + 4 * q) = o;
      }
    }
    __syncthreads();
  }
}

DI void ws_init(WS& W, unsigned char* ws) {
        W.WinT = (u16*)(ws + OFF_WIN); W.WoutT = (u16*)(ws + OFF_WOUT); W.mod = (float*)(ws + OFF_MOD);
    W.ropeG = (float2*)(ws + OFF_ROPE); W.ropeD = (float2*)(ws + OFF_ROPE + 8192);
    W.U = (u16*)(ws + OFF_U); W.Ycat = (u16*)(ws + OFF_U); W.XBC = (u16*)(ws + OFF_XBC); W.Obuf = (u16*)(ws + OFF_XBC);
    W.Z = (u16*)(ws + OFF_Z); W.DT = (float*)(ws + OFF_DT);
    W.Q = (u16*)(ws + OFF_Q); W.K = (u16*)(ws + OFF_K); W.Vt = (u16*)(ws + OFF_VT);
    W.DQ = (u16*)(ws + OFF_DQ); W.DK = (u16*)(ws + OFF_DK); W.DVt = (u16*)(ws + OFF_DVT); W.Stin = (u16*)(ws + OFF_Q);
    W.GG = (u16*)(ws + OFF_GG); W.DG = (u16*)(ws + OFF_DG); W.Cc = (u16*)(ws + OFF_CC);
    W.cumF = (float*)(ws + OFF_CUMF); W.cumB = (float*)(ws + OFF_CUMB); W.Sloc = (u16*)(ws + OFF_SLOC);
    W.Opart = (float*)(ws + OFF_OPART);
}

#define XCD_LOOP(UPX, xcd, idx) \
  const bool sw_ = (nb & 7) == 0; \
  for (int t_ = sw_ ? (bid >> 3) : bid; t_ < (sw_ ? (UPX) : 8 * (UPX)); t_ += (sw_ ? (nb >> 3) : nb)) { \
    const int xcd = sw_ ? (bid & 7) : t_ / (UPX); const int idx = sw_ ? t_ : t_ % (UPX);
#define XCD_END }

typedef const Params __attribute__((address_space(4)))* KArgP;
DI Params load_params(KArgP kp) {
  asm volatile("" : "+s"(kp));
  Params P;
#pragma unroll
  for (int i = 0; i < 22; ++i) P.in[i] = kp->in[i];
  P.out = kp->out; P.ws = kp->ws;
  return P;
}

DI void ph0_prologue(KArgP kp, unsigned char* lds) {
  const Params P = load_params(kp); WS W; ws_init(W, P.ws);
  const int tid = fresh_tid(), lane = tid & 63, w = tid >> 6;
  const int nb = gridDim.x, bid = blockIdx.x;
  (void)lane; (void)w; (void)tid;
  {
    float* S = (float*)(lds + 65536);
    for (int i = tid; i < 9 * 1024; i += NT) {
      const float x = (i < 8192) ? P.in[1][i] : P.in[3][i - 8192];
      S[i] = silu(x);
    }
    __syncthreads();
    constexpr int U_WIN = 2 * 54 * 16, U_WOUT = 2 * 16 * 16, U_MOD = 384;
    for (int u = bid; u < U_WIN + U_WOUT + U_MOD + 1; u += nb) {
      if (u < U_WIN + U_WOUT) {
        const float* src; u16* dst; int ldn, n0, k0; bool inproj;
        if (u < U_WIN) {
          const int l = u / (54 * 16), rem = u % (54 * 16);
          n0 = (rem >> 4) * 64; k0 = (rem & 15) * 64; ldn = 3344; inproj = true;
          src = P.in[8] + (size_t)l * 1024 * 3344; dst = W.WinT + (size_t)l * NPAD * 1024;
        } else {
          const int v = u - U_WIN; const int l = v >> 8, rem = v & 255;
          n0 = (rem >> 4) * 64; k0 = (rem & 15) * 64; ldn = 1024; inproj = false;
          src = P.in[21] + (size_t)l * 1024 * 1024; dst = W.WoutT + (size_t)l * 1024 * 1024;
        }
        float* tile = (float*)lds;
        {
          const int n = tid & 63, kq = tid >> 6;
          const int nd = n0 + n;
          int ns = nd;
          if (inproj) { ns = (nd < 1536) ? nd : (nd < 3328 ? nd + 16 : (nd < 3344 ? nd - 3328 + 1536 : -1)); }
#pragma unroll
          for (int i = 0; i < 8; ++i) {
            const int k = kq * 8 + i;
            tile[k * 65 + n] = (ns >= 0) ? src[(size_t)(k0 + k) * ldn + ns] : 0.f;
          }
        }
        __syncthreads();
        {
          const int n = tid >> 3, kc = tid & 7;
          float f[8];
#pragma unroll
          for (int i = 0; i < 8; ++i) f[i] = tile[(kc * 8 + i) * 65 + n];
          uint4 o;
          o.x = pk(f[0], f[1]); o.y = pk(f[2], f[3]); o.z = pk(f[4], f[5]); o.w = pk(f[6], f[7]);
          *(uint4*)(dst + (size_t)(n0 + n) * 1024 + k0 + kc * 8) = o;
        }
        __syncthreads();
      } else if (u < U_WIN + U_WOUT + U_MOD) {
        const int v = u - U_WIN - U_WOUT;
        const int l = v / 192, n0 = (v % 192) * 16;
        const int c16 = tid & 15, kg = tid >> 4;
        const float* wm = P.in[4] + (size_t)l * 1024 * 3072 + n0 + c16;
        float acc[9];
#pragma unroll
        for (int rr = 0; rr < 9; ++rr) acc[rr] = 0.f;
#pragma unroll 8
        for (int kk = 0; kk < 32; ++kk) {
          const int k = kg * 32 + kk;
          const float wv = wm[(size_t)k * 3072];
#pragma unroll
          for (int rr = 0; rr < 9; ++rr) acc[rr] += S[rr * 1024 + k] * wv;
        }
        float* red = (float*)lds;
#pragma unroll
        for (int rr = 0; rr < 9; ++rr) red[(kg * 16 + c16) * 9 + rr] = acc[rr];
        __syncthreads();
        if (tid < 144) {
          const int cc = tid / 9, rr = tid % 9;
          float s = 0.f;
          for (int k2 = 0; k2 < 32; ++k2) s += red[(k2 * 16 + cc) * 9 + rr];
          W.mod[((size_t)l * 9 + rr) * 3072 + n0 + cc] = s + P.in[5][l * 3072 + n0 + cc];
        }
        __syncthreads();
      } else {
        for (int i = tid; i < 64 * 16; i += NT) {
          const int idx = i >> 4, k = i & 15;
          const float inv = powf(10000.f, -(float)k / 16.f);
          float sn, cs; sincosf((float)idx * inv, &sn, &cs);
          W.ropeG[i] = make_float2(cs, sn);
        }
        for (int i = tid; i < 64 * 8; i += NT) {
          const int idx = i >> 3, k = i & 7;
          const float inv = powf(10000.f, -(float)k / 8.f);
          float sn, cs; sincosf((float)idx * inv, &sn, &cs);
          W.ropeD[i] = make_float2(cs, sn);
        }
      }
    }
  }
}

DI void ph1_prep(KArgP kp) {
  const Params P = load_params(kp); WS W; ws_init(W, P.ws);
  const int tid = fresh_tid(), lane = tid & 63, w = tid >> 6;
  const int nb = gridDim.x, bid = blockIdx.x;
  (void)lane; (void)w; (void)tid;
  XCD_LOOP(288, xcd, idx)
    const int R = xcd * TT + idx * 8 + w;
    const int b = xcd, t = idx * 8 + w;
    const float* src = (t < 256) ? (P.in[2] + ((size_t)b * 256 + t) * 1024) : (P.in[0] + ((size_t)b * 2048 + (t - 256)) * 1024);
    const float* md = W.mod + (size_t)((t < 256) ? 8 : b) * 3072;
    const float* gp = P.in[6];
    float4 x[4];
    float ss = 0.f;
#pragma unroll
    for (int i = 0; i < 4; ++i) {
      x[i] = *(const float4*)(src + i * 256 + lane * 4);
      ss += x[i].x * x[i].x + x[i].y * x[i].y + x[i].z * x[i].z + x[i].w * x[i].w;
    }
#pragma unroll
    for (int d = 32; d >= 1; d >>= 1) ss += __shfl_xor(ss, d);
    const float rn = rsqrtf(ss * (1.f / 1024.f) + EPS);
#pragma unroll
    for (int i = 0; i < 4; ++i) {
      const int k = i * 256 + lane * 4;
      const float4 g4 = *(const float4*)(gp + k);
      const float4 sh = *(const float4*)(md + k);
      const float4 sc = *(const float4*)(md + 1024 + k);
      uint2 o;
      o.x = pk(x[i].x * rn * g4.x * (1.f + sc.x) + sh.x, x[i].y * rn * g4.y * (1.f + sc.y) + sh.y);
      o.y = pk(x[i].z * rn * g4.z * (1.f + sc.z) + sh.z, x[i].w * rn * g4.w * (1.f + sc.w) + sh.w);
      *(uint2*)(W.U + (size_t)R * 1024 + k) = o;
    }
  XCD_END
}

DI void ph2_inproj(KArgP kp, int l, unsigned char* lds) {
  const Params P = load_params(kp); WS W; ws_init(W, P.ws);
  const int tid = fresh_tid();
  const int nb = gridDim.x, bid = blockIdx.x;
  XCD_LOOP(243, xcd, idx)
    const int nt = idx / 9, mt = xcd * 9 + idx % 9;
    gemm_tile_to_lds(W.U, W.WinT + (size_t)l * NPAD * 1024, mt * 256, nt * 128, lds);
    float v[64];
    load_row64(lds, v);
    inproj_epi(P, W, l, mt * 256 + (tid >> 1), nt, tid & 1, v);
    __syncthreads();
  XCD_END
}

DI void ph3_mix(KArgP kp, int l, unsigned char* lds) {
  const Params P = load_params(kp); WS W; ws_init(W, P.ws);
  const int nb = gridDim.x, bid = blockIdx.x;
  const int upx = (l == 0) ? 108 : 100;
  XCD_LOOP(upx, xcd, idx)
    const int b = xcd;
    if (idx < 32) {
      diff_unit(P, W, l, b, idx >> 3, 1 + (idx & 7), lds);
    } else if (idx < 64) {
      gqa_unit(W, P.in[17] + l * 64, P.in[18] + l * 64, b, (idx - 32) >> 3, 1 + (idx & 7), lds);
    } else if (idx < 100) {
      const int v = idx - 64;
      ssd_local_unit(P, W, l, b, v >> 1, v & 1, lds);
    } else if (idx < 104) {
      diff_unit(P, W, l, b, idx - 100, 0, lds);
    } else {
      gqa_unit(W, P.in[17] + l * 64, P.in[18] + l * 64, b, idx - 104, 0, lds);
    }
    __syncthreads();
  XCD_END
}

DI void ph4a_states(KArgP kp) {
  const Params P = load_params(kp); WS W; ws_init(W, P.ws);
  const int tid = fresh_tid(), lane = tid & 63, w = tid >> 6;
  const int nb = gridDim.x, bid = blockIdx.x;
  (void)lane; (void)w; (void)tid;
    XCD_LOOP(64, xcd, idx)
      const int gid = idx * NT + tid;
      const int e4 = gid & 2047, hg = (gid >> 11) & 7, b = xcd, dir = gid >> 14;
      float s0 = 0.f, s1 = 0.f, s2 = 0.f, s3 = 0.f;
      for (int step = 0; step < 18; ++step) {
        const int c = dir ? (step == 0 ? 1 : (step == 1 ? 0 : 19 - step)) : step;
        const size_t idx = ((((size_t)dir * 8 + b) * 18 + c) * 8 + hg) * 8192 + (size_t)e4 * 4;
        uint2 o;
        o.x = pk(s0, s1); o.y = pk(s2, s3);
        *(uint2*)(W.Stin + idx) = o;
        const float tot = W.cumF[(size_t)dir * ((size_t)RR * 8) + ((size_t)b * TT + c * 128 + (dir ? 0 : 127)) * 8 + hg];
        const float dec = __expf(tot);
        const uint2 sv = *(const uint2*)(W.Sloc + idx);
        s0 = s0 * dec + bflo(sv.x); s1 = s1 * dec + bfhi(sv.x);
        s2 = s2 * dec + bflo(sv.y); s3 = s3 * dec + bfhi(sv.y);
      }
    XCD_END
}

DI void ph4b_yoff(KArgP kp, int l, unsigned char* lds) {
  const Params P = load_params(kp); WS W; ws_init(W, P.ws);
  const int tid = fresh_tid(), lane = tid & 63, w = tid >> 6;
  const int nb = gridDim.x, bid = blockIdx.x;
  (void)lane; (void)w; (void)tid;
    XCD_LOOP(72, xcd, idx)
      const int b = xcd, c = idx >> 2, tb = idx & 3;
      const int r = lane & 31, h2 = lane >> 5;
      const int hg = w, g = w >> 2;
      const size_t Rr = (size_t)b * TT + c * 128 + 32 * tb + r;
      f32x16 acc[2][2];
#pragma unroll
      for (int d = 0; d < 2; ++d)
#pragma unroll
        for (int pt = 0; pt < 2; ++pt)
#pragma unroll
          for (int e = 0; e < 16; ++e) acc[d][pt][e] = 0.f;
      const u16* cp = W.Cc + Rr * 256 + g * 128 + 8 * h2;
      const u16* sf = W.Stin + ((((size_t)0 * 8 + b) * 18 + c) * 8 + hg) * 8192 + (size_t)r * 128 + 8 * h2;
      const u16* sb = W.Stin + ((((size_t)1 * 8 + b) * 18 + c) * 8 + hg) * 8192 + (size_t)r * 128 + 8 * h2;
#pragma unroll 2
      for (int ks = 0; ks < 8; ++ks) {
        const bf16x8 bfr = *(const bf16x8*)(cp + 16 * ks);
        const bf16x8 f0 = *(const bf16x8*)(sf + 16 * ks);
        const bf16x8 f1 = *(const bf16x8*)(sf + 32 * 128 + 16 * ks);
        const bf16x8 b0 = *(const bf16x8*)(sb + 16 * ks);
        const bf16x8 b1 = *(const bf16x8*)(sb + 32 * 128 + 16 * ks);
        acc[0][0] = MFMA32(f0, bfr, acc[0][0]);
        acc[0][1] = MFMA32(f1, bfr, acc[0][1]);
        acc[1][0] = MFMA32(b0, bfr, acc[1][0]);
        acc[1][1] = MFMA32(b1, bfr, acc[1][1]);
      }
      const float eF = __expf(W.cumF[Rr * 8 + hg]), eB = __expf(W.cumB[Rr * 8 + hg]);
      float ss = 0.f;
#pragma unroll
      for (int pt = 0; pt < 2; ++pt)
#pragma unroll
        for (int i4 = 0; i4 < 4; ++i4) {
          const int p = 32 * pt + 8 * i4 + 4 * h2;
          const uint2 yd = *(const uint2*)(W.Ycat + Rr * 1024 + hg * 64 + p);
          const uint2 zz = *(const uint2*)(W.Z + Rr * 512 + hg * 64 + p);
          float y0 = bflo(yd.x) + eF * acc[0][pt][4 * i4] + eB * acc[1][pt][4 * i4];
          float y1 = bfhi(yd.x) + eF * acc[0][pt][4 * i4 + 1] + eB * acc[1][pt][4 * i4 + 1];
          float y2 = bflo(yd.y) + eF * acc[0][pt][4 * i4 + 2] + eB * acc[1][pt][4 * i4 + 2];
          float y3 = bfhi(yd.y) + eF * acc[0][pt][4 * i4 + 3] + eB * acc[1][pt][4 * i4 + 3];
          y0 *= silu(bflo(zz.x)); y1 *= silu(bfhi(zz.x)); y2 *= silu(bflo(zz.y)); y3 *= silu(bfhi(zz.y));
          acc[0][pt][4 * i4] = y0; acc[0][pt][4 * i4 + 1] = y1; acc[0][pt][4 * i4 + 2] = y2; acc[0][pt][4 * i4 + 3] = y3;
          ss += y0 * y0 + y1 * y1 + y2 * y2 + y3 * y3;
        }
      ss += __shfl_xor(ss, 32);
      float* red = (float*)lds;
      if (h2 == 0) red[w * 32 + r] = ss;
      __syncthreads();
      float tot = 0.f;
#pragma unroll
      for (int k = 0; k < 8; ++k) tot += red[k * 32 + r];
      const float rn = rsqrtf(tot * (1.f / 512.f) + EPS);
      const float* ng = P.in[16] + l * 512 + hg * 64;
#pragma unroll
      for (int pt = 0; pt < 2; ++pt)
#pragma unroll
        for (int i4 = 0; i4 < 4; ++i4) {
          const int p = 32 * pt + 8 * i4 + 4 * h2;
          const float4 n4 = *(const float4*)(ng + p);
          uint2 o;
          o.x = pk(acc[0][pt][4 * i4] * rn * n4.x, acc[0][pt][4 * i4 + 1] * rn * n4.y);
          o.y = pk(acc[0][pt][4 * i4 + 2] * rn * n4.z, acc[0][pt][4 * i4 + 3] * rn * n4.w);
          *(uint2*)(W.Ycat + Rr * 1024 + hg * 64 + p) = o;
        }
      __syncthreads();
    XCD_END
}

DI void ph5_outproj(KArgP kp, int l, unsigned char* lds) {
  const Params P = load_params(kp); WS W; ws_init(W, P.ws);
  const int tid = fresh_tid();
  const int nb = gridDim.x, bid = blockIdx.x;
  const int upx = (l == 0) ? 72 : 64;
  XCD_LOOP(upx, xcd, idx)
    const int mt = xcd * 9 + (idx >> 3) + (l == 0 ? 0 : 1), nt = idx & 7;
    gemm_tile_to_lds(W.Ycat, W.WoutT + (size_t)l * 1024 * 1024, mt * 256, nt * 128, lds);
    float v[64];
    load_row64(lds, v);
    const size_t R = (size_t)mt * 256 + (tid >> 1);
    float ss = 0.f;
#pragma unroll
    for (int j = 0; j < 64; ++j) ss += v[j] * v[j];
    W.Opart[R * 16 + nt * 2 + (tid & 1)] = ss;
    store64(W.Obuf + R * 1024 + nt * 128 + (tid & 1) * 64, v);
    __syncthreads();
  XCD_END
}

DI void ph6_post(KArgP kp, int l) {
  const Params P = load_params(kp); WS W; ws_init(W, P.ws);
  const int tid = fresh_tid(), lane = tid & 63, w = tid >> 6;
  const int nb = gridDim.x, bid = blockIdx.x;
  (void)lane; (void)w; (void)tid;
    XCD_LOOP(288, xcd, idx)
      const int R = xcd * TT + idx * 8 + w;
      const int b = xcd, t = idx * 8 + w;
      const bool isctx = t < 256;
      if (l == 1 && isctx) continue;
      const float* md = W.mod + ((size_t)l * 9 + (isctx ? 8 : b)) * 3072;
      const float* hsrc;
      if (isctx) hsrc = P.in[2] + ((size_t)b * 256 + t) * 1024;
      else hsrc = (l == 0 ? P.in[0] : (const float*)P.out) + ((size_t)b * 2048 + (t - 256)) * 1024;
      float pss = (lane < 16) ? W.Opart[(size_t)R * 16 + lane] : 0.f;
#pragma unroll
      for (int d = 8; d >= 1; d >>= 1) pss += __shfl_xor(pss, d);
      pss = __shfl(pss, 0);
      const float rn = rsqrtf(pss * (1.f / 1024.f) + EPS);
      const float* gpost = P.in[7] + l * 1024;
      float4 hn[4];
      float ss = 0.f;
#pragma unroll
      for (int i = 0; i < 4; ++i) {
        const int k = i * 256 + lane * 4;
        const float4 hv = *(const float4*)(hsrc + k);
        const uint2 ov = *(const uint2*)(W.Obuf + (size_t)R * 1024 + k);
        const float4 g4 = *(const float4*)(gpost + k);
        const float4 gt = *(const float4*)(md + 2048 + k);
        hn[i].x = hv.x + gt.x * (bflo(ov.x) * rn * g4.x);
        hn[i].y = hv.y + gt.y * (bfhi(ov.x) * rn * g4.y);
        hn[i].z = hv.z + gt.z * (bflo(ov.y) * rn * g4.z);
        hn[i].w = hv.w + gt.w * (bfhi(ov.y) * rn * g4.w);
        ss += hn[i].x * hn[i].x + hn[i].y * hn[i].y + hn[i].z * hn[i].z + hn[i].w * hn[i].w;
      }
      if (!isctx) {
        float* dst = P.out + ((size_t)b * 2048 + (t - 256)) * 1024;
#pragma unroll
        for (int i = 0; i < 4; ++i) *(float4*)(dst + i * 256 + lane * 4) = hn[i];
      }
      if (l == 0) {
#pragma unroll
        for (int d = 32; d >= 1; d >>= 1) ss += __shfl_xor(ss, d);
        const float r2 = rsqrtf(ss * (1.f / 1024.f) + EPS);
        const float* md1 = W.mod + ((size_t)9 + (isctx ? 8 : b)) * 3072;
        const float* gp = P.in[6] + 1024;
#pragma unroll
        for (int i = 0; i < 4; ++i) {
          const int k = i * 256 + lane * 4;
          const float4 g4 = *(const float4*)(gp + k);
          const float4 sh = *(const float4*)(md1 + k);
          const float4 sc = *(const float4*)(md1 + 1024 + k);
          uint2 o;
          o.x = pk(hn[i].x * r2 * g4.x * (1.f + sc.x) + sh.x, hn[i].y * r2 * g4.y * (1.f + sc.y) + sh.y);
          o.y = pk(hn[i].z * r2 * g4.z * (1.f + sc.z) + sh.z, hn[i].w * r2 * g4.w * (1.f + sc.w) + sh.w);
          *(uint2*)(W.U + (size_t)R * 1024 + k) = o;
        }
      }
    XCD_END
}


DI void grid_barrier(unsigned* bar, unsigned& epoch) {
  asm volatile("s_waitcnt vmcnt(0)" ::: "memory");
  __syncthreads();
  ++epoch;
  if (threadIdx.x == 0) {
    __builtin_amdgcn_fence(__ATOMIC_RELEASE, "agent");
    asm volatile("s_waitcnt vmcnt(0)" ::: "memory");
    const unsigned nb = gridDim.x, bid = blockIdx.x;
    const bool hier = (nb & 7u) == 0u;
    const unsigned ng = hier ? 8u : 1u, per = hier ? (nb >> 3) : nb;
    unsigned* grp = bar + 64 * (1 + (hier ? (bid & 7u) : 0u));
    const unsigned old = __hip_atomic_fetch_add(grp, 1u, __ATOMIC_RELAXED, __HIP_MEMORY_SCOPE_AGENT);
    if (old + 1u == epoch * per) __hip_atomic_fetch_add(bar, 1u, __ATOMIC_RELAXED, __HIP_MEMORY_SCOPE_AGENT);
    const unsigned target = epoch * ng;
    while (__hip_atomic_load(bar, __ATOMIC_RELAXED, __HIP_MEMORY_SCOPE_AGENT) < target) __builtin_amdgcn_s_sleep(1);
    __builtin_amdgcn_fence(__ATOMIC_ACQUIRE, "agent");
    asm volatile("s_waitcnt vmcnt(0)" ::: "memory");
  }
  __syncthreads();
}

__global__ void __launch_bounds__(NT) fwd_mega(Params Parg) {
  extern __shared__ __attribute__((aligned(16))) unsigned char lds[];
  cg::grid_group grid = cg::this_grid();
  KArgP kp = (KArgP)__builtin_amdgcn_kernarg_segment_ptr();
  unsigned* bar = (unsigned*)(Parg.ws + OFF_BAR);
  unsigned epoch = 0;
  if (gridDim.x == 0x7fffffffu) grid.sync();

  ph0_prologue(kp, lds);
  grid_barrier(bar, epoch);

  ph1_prep(kp);
  grid_barrier(bar, epoch);

  for (int l = 0; l < 2; ++l) {
    ph2_inproj(kp, l, lds);
    grid_barrier(bar, epoch);

    ph3_mix(kp, l, lds);
    grid_barrier(bar, epoch);

    ph4a_states(kp);
    grid_barrier(bar, epoch);

    ph4b_yoff(kp, l, lds);
    grid_barrier(bar, epoch);

    ph5_outproj(kp, l, lds);
    grid_barrier(bar, epoch);

    ph6_post(kp, l);
    if (l == 0) grid_barrier(bar, epoch);
  }
}

extern "C" void kernel_launch(void* const* d_in, const int* in_sizes, int n_in,
                              void* d_out, int out_size, void* d_ws, size_t ws_size,
                              hipStream_t stream) {
  static int grid_blocks = 0;
  if (!grid_blocks) {
    int dev = 0, cus = 0, per_cu = 0;
    (void)hipGetDevice(&dev);
    (void)hipDeviceGetAttribute(&cus, hipDeviceAttributeMultiprocessorCount, dev);
    (void)hipFuncSetAttribute((const void*)fwd_mega, hipFuncAttributeMaxDynamicSharedMemorySize, LDS_BYTES);
    (void)hipOccupancyMaxActiveBlocksPerMultiprocessor(&per_cu, (const void*)fwd_mega, NT, LDS_BYTES);
    if (per_cu < 1) per_cu = 1;
    grid_blocks = cus * per_cu;
    if (ws_size < WS_END) fprintf(stderr, "workspace too small: %zu < %zu\n", ws_size, (size_t)WS_END);
  }
  Params p{};
  for (int i = 0; i < 22; ++i) p.in[i] = (const float*)d_in[i];
  p.out = (float*)d_out;
  p.ws = (unsigned char*)d_ws;
  (void)hipMemsetAsync((unsigned char*)d_ws + OFF_BAR, 0, 4096, stream);
  void* args[] = {&p};
  hipError_t e = hipLaunchCooperativeKernel((const void*)fwd_mega, dim3(grid_blocks), dim3(NT), args, LDS_BYTES, stream);
  if (e != hipSuccess) fprintf(stderr, "cooperative launch failed: %s (grid %d)\n", hipGetErrorString(e), grid_blocks);
}
```

```cpp
#include <hip/hip_runtime.h>
#include <hip/hip_cooperative_groups.h>
#include <cstdio>
namespace cg = cooperative_groups;

#define DI __device__ __forceinline__
#define NT 512
static __device__ __forceinline__ int fresh_tid() { int t = threadIdx.x; asm volatile("" : "+v"(t)); return t; }
typedef unsigned short u16;
typedef __attribute__((ext_vector_type(8))) short bf16x8;
typedef __attribute__((ext_vector_type(4))) short s16x4;
typedef __attribute__((ext_vector_type(16))) float f32x16;
typedef __attribute__((ext_vector_type(4))) float f32x4;
typedef __attribute__((ext_vector_type(2))) __bf16 bf2v;
typedef __attribute__((ext_vector_type(2))) float f2v;
typedef unsigned __attribute__((ext_vector_type(4))) u32x4;

#define MFMA32(a, b, c) __builtin_amdgcn_mfma_f32_32x32x16_bf16((a), (b), (c), 0, 0, 0)
#define MFMA16(a, b, c) __builtin_amdgcn_mfma_f32_16x16x32_bf16((a), (b), (c), 0, 0, 0)

constexpr int LDS_BYTES = 140 * 1024;
constexpr int TT = 2304;
constexpr int RR = 18432;
constexpr int NPAD = 3456;
constexpr float EPS = 1e-6f;
constexpr float LOG2E = 1.4426950408889634f;

constexpr size_t SZ_WIN = (size_t)2 * NPAD * 1024 * 2;
constexpr size_t SZ_WOUT = (size_t)2 * 1024 * 1024 * 2;
constexpr size_t SZ_MOD = (size_t)2 * 9 * 3072 * 4;
constexpr size_t SZ_ROPE = 16384;
constexpr size_t SZ_R1024 = (size_t)RR * 1024 * 2;
constexpr size_t SZ_R512 = (size_t)RR * 512 * 2;
constexpr size_t SZ_R256 = (size_t)RR * 256 * 2;
constexpr size_t OFF_WIN = 0;
constexpr size_t OFF_WOUT = OFF_WIN + SZ_WIN;
constexpr size_t OFF_MOD = OFF_WOUT + SZ_WOUT;
constexpr size_t OFF_ROPE = OFF_MOD + SZ_MOD;
constexpr size_t OFF_U = OFF_ROPE + SZ_ROPE;
constexpr size_t OFF_XBC = OFF_U + SZ_R1024;
constexpr size_t OFF_Z = OFF_XBC + SZ_R1024;
constexpr size_t OFF_DT = OFF_Z + SZ_R512;
constexpr size_t SZ_DT = (size_t)RR * 16 * 4;
constexpr size_t OFF_Q = OFF_DT + SZ_DT;
constexpr size_t SZ_Q = (size_t)8 * 4 * TT * 64 * 2;
constexpr size_t OFF_K = OFF_Q + SZ_Q;
constexpr size_t SZ_K = (size_t)8 * 2 * TT * 64 * 2;
constexpr size_t OFF_VT = OFF_K + SZ_K;
constexpr size_t OFF_DQ = OFF_VT + SZ_K;
constexpr size_t SZ_DQ = (size_t)8 * 8 * TT * 32 * 2;
constexpr size_t OFF_DK = OFF_DQ + SZ_DQ;
constexpr size_t OFF_DVT = OFF_DK + SZ_DQ;
constexpr size_t SZ_DVT = (size_t)8 * 4 * 64 * TT * 2;
constexpr size_t OFF_GG = OFF_DVT + SZ_DVT;
constexpr size_t OFF_DG = OFF_GG + SZ_R256;
constexpr size_t OFF_CC = OFF_DG + SZ_R256;
constexpr size_t OFF_CUMF = OFF_CC + SZ_R256;
constexpr size_t SZ_CUM = (size_t)RR * 8 * 4;
constexpr size_t OFF_CUMB = OFF_CUMF + SZ_CUM;
constexpr size_t OFF_SLOC = OFF_CUMB + SZ_CUM;
constexpr size_t SZ_ST = (size_t)2 * 8 * 18 * 8 * 8192 * 2;
constexpr size_t OFF_OPART = OFF_SLOC + SZ_ST;
constexpr size_t OFF_BAR = OFF_OPART + SZ_DT;
constexpr size_t WS_END = OFF_BAR + 4096;
static_assert(SZ_ST <= (OFF_GG - OFF_Q), "Stin must fit in the q/k/v region");
static_assert(WS_END <= (size_t)256 * 1024 * 1024, "workspace");

struct Params {
  const float* in[22];
  float* out;
  unsigned char* ws;
};

struct WS {
  u16 *WinT, *WoutT, *U, *Ycat, *XBC, *Obuf, *Z, *Q, *K, *Vt, *DQ, *DK, *DVt, *GG, *DG, *Cc, *Sloc, *Stin;
  float *mod, *DT, *cumF, *cumB, *Opart;
  float2 *ropeG, *ropeD;
};

DI unsigned pk(float a, float b) { f2v v = {a, b}; return __builtin_bit_cast(unsigned, __builtin_convertvector(v, bf2v)); }
DI u16 f2bf(float a) { return (u16)(pk(a, 0.f) & 0xffffu); }
DI float bf2f(u16 b) { return __uint_as_float(((unsigned)b) << 16); }
DI float bflo(unsigned u) { return __uint_as_float(u << 16); }
DI float bfhi(unsigned u) { return __uint_as_float(u & 0xffff0000u); }
DI float silu(float x) { return x / (1.f + __expf(-x)); }
DI float softplus(float x) { return fmaxf(x, 0.f) + log1pf(__expf(-fabsf(x))); }
DI float fexp2(float x) { return __builtin_amdgcn_exp2f(x); }

DI void store64(u16* dst, const float (&v)[64]) {
#pragma unroll
  for (int i = 0; i < 8; ++i) {
    uint4 u;
    u.x = pk(v[8 * i], v[8 * i + 1]); u.y = pk(v[8 * i + 2], v[8 * i + 3]);
    u.z = pk(v[8 * i + 4], v[8 * i + 5]); u.w = pk(v[8 * i + 6], v[8 * i + 7]);
    ((uint4*)dst)[i] = u;
  }
}

struct GRegs { u32x4 a0, a1, a2, a3, b0, b1; };
DI void g_load(GRegs& R, const u16* ag, const u16* bg, int k0) {
  constexpr size_t K = 1024;
  R.a0 = *(const u32x4*)(ag + k0);
  R.a1 = *(const u32x4*)(ag + 64 * K + k0);
  R.a2 = *(const u32x4*)(ag + 128 * K + k0);
  R.a3 = *(const u32x4*)(ag + 192 * K + k0);
  R.b0 = *(const u32x4*)(bg + k0);
  R.b1 = *(const u32x4*)(bg + 64 * K + k0);
}
DI void g_store(const GRegs& R, u16* as, u16* bs) {
  *(u32x4*)(as) = R.a0;
  *(u32x4*)(as + 64 * 72) = R.a1;
  *(u32x4*)(as + 128 * 72) = R.a2;
  *(u32x4*)(as + 192 * 72) = R.a3;
  *(u32x4*)(bs) = R.b0;
  *(u32x4*)(bs + 64 * 72) = R.b1;
}
DI void g_compute(const u16* as, const u16* bs, f32x16 (&acc)[2][2]) {
#pragma unroll
  for (int ks = 0; ks < 4; ++ks) {
    bf16x8 a0 = *(const bf16x8*)(as + 16 * ks);
    bf16x8 a1 = *(const bf16x8*)(as + 32 * 72 + 16 * ks);
    bf16x8 b0 = *(const bf16x8*)(bs + 16 * ks);
    bf16x8 b1 = *(const bf16x8*)(bs + 32 * 72 + 16 * ks);
    acc[0][0] = MFMA32(a0, b0, acc[0][0]);
    acc[0][1] = MFMA32(a0, b1, acc[0][1]);
    acc[1][0] = MFMA32(a1, b0, acc[1][0]);
    acc[1][1] = MFMA32(a1, b1, acc[1][1]);
  }
}
constexpr int G_LDK = 72;
constexpr int G_CST = 132;
DI void gemm_tile_to_lds(const u16* __restrict__ A, const u16* __restrict__ Bt, int m0, int n0, unsigned char* lds) {
  constexpr int K = 1024;
  u16* As = (u16*)lds;
  u16* Bs = (u16*)(lds + 2 * 256 * G_LDK * 2);
  const int tid = fresh_tid(), lane = tid & 63, w = tid >> 6;
  const int r = lane & 31, h = lane >> 5;
  const int wm = w >> 1, wn = w & 1;
  const int arow = tid >> 3, akc = tid & 7;
  const u16* ag = A + (size_t)(m0 + arow) * K + akc * 8;
  const u16* bg = Bt + (size_t)(n0 + arow) * K + akc * 8;
  f32x16 acc[2][2];
#pragma unroll
  for (int i = 0; i < 2; ++i)
#pragma unroll
    for (int j = 0; j < 2; ++j)
#pragma unroll
      for (int e = 0; e < 16; ++e) acc[i][j][e] = 0.f;
  GRegs R0, R1;
  g_load(R0, ag, bg, 0);
  g_load(R1, ag, bg, 64);
  g_store(R0, As + arow * G_LDK + akc * 8, Bs + arow * G_LDK + akc * 8);
  __syncthreads();
  const u16* as0 = As + (64 * wm + r) * G_LDK + 8 * h;
  const u16* bs0 = Bs + (64 * wn + r) * G_LDK + 8 * h;
  for (int kt2 = 0; kt2 < 16; kt2 += 2) {
    if (kt2 + 2 < 16) g_load(R0, ag, bg, (kt2 + 2) * 64);
    g_compute(as0, bs0, acc);
    g_store(R1, As + 256 * G_LDK + arow * G_LDK + akc * 8, Bs + 128 * G_LDK + arow * G_LDK + akc * 8);
    __syncthreads();
    if (kt2 + 3 < 16) g_load(R1, ag, bg, (kt2 + 3) * 64);
    g_compute(as0 + 256 * G_LDK, bs0 + 128 * G_LDK, acc);
    if (kt2 + 2 < 16) g_store(R0, As + arow * G_LDK + akc * 8, Bs + arow * G_LDK + akc * 8);
    __syncthreads();
  }
  float* Cst = (float*)lds;
#pragma unroll
  for (int i = 0; i < 2; ++i)
#pragma unroll
    for (int j = 0; j < 2; ++j)
#pragma unroll
      for (int e = 0; e < 16; ++e) {
        const int row = 64 * wm + 32 * i + (e & 3) + 8 * (e >> 2) + 4 * h;
        Cst[row * G_CST + 64 * wn + 32 * j + r] = acc[i][j][e];
      }
  __syncthreads();
}

DI void load_row64(const unsigned char* lds, float (&v)[64]) {
  const int tid = fresh_tid();
  const float* src = (const float*)lds + (tid >> 1) * G_CST + (tid & 1) * 64;
#pragma unroll
  for (int i = 0; i < 16; ++i) {
    float4 f = ((const float4*)src)[i];
    v[4 * i] = f.x; v[4 * i + 1] = f.y; v[4 * i + 2] = f.z; v[4 * i + 3] = f.w;
  }
}

DI void inproj_epi(const Params& P, const WS& W, int l, int R, int nt, int half, float (&v)[64]) {
  const int b = R / TT;
  const int t = R - b * TT;
  if (nt < 8) {
    store64(W.XBC + (size_t)R * 1024 + nt * 128 + half * 64, v);
  } else if (nt < 12) {
    store64(W.Z + (size_t)R * 512 + (nt - 8) * 128 + half * 64, v);
  } else if (nt < 15) {
    const bool isq = nt < 14;
    const float* g = (isq ? P.in[17] : P.in[18]) + l * 64;
    float ss = 0.f;
#pragma unroll
    for (int j = 0; j < 64; ++j) ss += v[j] * v[j];
    const float rn = rsqrtf(ss * (1.f / 64.f) + EPS);
#pragma unroll
    for (int j = 0; j < 64; ++j) { if ((j & 15) == 0) __builtin_amdgcn_sched_barrier(0); v[j] = v[j] * rn * g[j]; }
    if (t >= 256) {
      const int pos = t - 256, ri = pos >> 6, ci = pos & 63;
#pragma unroll
      for (int i = 0; i < 32; ++i) {
        if ((i & 7) == 0) __builtin_amdgcn_sched_barrier(0);
        const float2 cs = (i < 16) ? W.ropeG[ri * 16 + i] : W.ropeG[ci * 16 + (i - 16)];
        const float x1 = v[i], x2 = v[i + 32];
        v[i] = x1 * cs.x - x2 * cs.y;
        v[i + 32] = x2 * cs.x + x1 * cs.y;
      }
    }
    if (isq) {
      const float sc = 0.125f * LOG2E;
#pragma unroll
      for (int j = 0; j < 64; ++j) v[j] *= sc;
      const int head = (nt - 12) * 2 + half;
      store64(W.Q + ((size_t)(b * 4 + head) * TT + t) * 64, v);
    } else {
      store64(W.K + ((size_t)(b * 2 + half) * TT + t) * 64, v);
    }
  } else if (nt == 15) {
    u16* dst = W.Vt + ((size_t)(b * 2 + half) * 64) * TT + t;
#pragma unroll
    for (int j = 0; j < 64; ++j) { if ((j & 7) == 0) __builtin_amdgcn_sched_barrier(0); dst[(size_t)j * TT] = f2bf(v[j]); }
  } else if (nt < 18) {
#pragma unroll
    for (int j = 0; j < 64; ++j) v[j] = silu(v[j]);
    store64(W.GG + (size_t)R * 256 + (nt - 16) * 128 + half * 64, v);
  } else if (nt < 22) {
    const bool isq = nt < 20;
    const int mbase = (nt - (isq ? 18 : 20)) * 4 + half * 2;
    if (t >= 256) {
      const int pos = t - 256, ri = pos >> 6, ci = pos & 63;
#pragma unroll
      for (int mm = 0; mm < 2; ++mm)
#pragma unroll
        for (int i = 0; i < 16; ++i) {
          if ((i & 7) == 0) __builtin_amdgcn_sched_barrier(0);
          const float2 cs = (i < 8) ? W.ropeD[ri * 8 + i] : W.ropeD[ci * 8 + (i - 8)];
          const float x1 = v[32 * mm + i], x2 = v[32 * mm + i + 16];
          v[32 * mm + i] = x1 * cs.x - x2 * cs.y;
          v[32 * mm + i + 16] = x2 * cs.x + x1 * cs.y;
        }
    }
    if (isq) {
      const float sc = 0.17677669529663687f * LOG2E;
#pragma unroll
      for (int j = 0; j < 64; ++j) v[j] *= sc;
    }
    u16* base = isq ? W.DQ : W.DK;
#pragma unroll
    for (int mm = 0; mm < 2; ++mm) {
      u16* dst = base + ((size_t)(b * 8 + mbase + mm) * TT + t) * 32;
#pragma unroll
      for (int i = 0; i < 4; ++i) {
        uint4 u;
        u.x = pk(v[32 * mm + 8 * i], v[32 * mm + 8 * i + 1]); u.y = pk(v[32 * mm + 8 * i + 2], v[32 * mm + 8 * i + 3]);
        u.z = pk(v[32 * mm + 8 * i + 4], v[32 * mm + 8 * i + 5]); u.w = pk(v[32 * mm + 8 * i + 6], v[32 * mm + 8 * i + 7]);
        ((uint4*)dst)[i] = u;
      }
    }
  } else if (nt < 24) {
    const int head = (nt - 22) * 2 + half;
    u16* dst = W.DVt + ((size_t)(b * 4 + head) * 64) * TT + t;
#pragma unroll
    for (int j = 0; j < 64; ++j) { if ((j & 7) == 0) __builtin_amdgcn_sched_barrier(0); dst[(size_t)j * TT] = f2bf(v[j]); }
  } else if (nt < 26) {
#pragma unroll
    for (int j = 0; j < 64; ++j) v[j] = silu(v[j]);
    store64(W.DG + (size_t)R * 256 + (nt - 24) * 128 + half * 64, v);
  } else if (nt == 26) {
    if (half == 0) {
      const float* bf = P.in[13] + l * 8;
      const float* bb = P.in[14] + l * 8;
#pragma unroll
      for (int j = 0; j < 16; ++j) {
        const float x = v[j] + (j < 8 ? bf[j] : bb[j - 8]);
        W.DT[(size_t)R * 16 + j] = softplus(x);
      }
    }
  }
}

template <int D, bool BOUNDED>
DI void attn_core(const u16* __restrict__ Qh, const u16* __restrict__ Kh, const u16* __restrict__ Vth, int q0, int nkeys,
                  float bound, unsigned char* lds, f32x16 (&O)[2], float& lout) {
  constexpr int KP = D + 8;
  constexpr int KS = D / 16;
  u16* Ks = (u16*)lds;
  constexpr int VP = 68;
  u16* Vs = (u16*)(lds + 2 * 64 * 72 * 2);
  const int tid = fresh_tid(), lane = tid & 63, w = tid >> 6;
  const int r = lane & 31, h = lane >> 5;
  bf16x8 qf[KS];
  {
    const u16* qp = Qh + (size_t)(q0 + 32 * w + r) * D + 8 * h;
#pragma unroll
    for (int ks = 0; ks < KS; ++ks) qf[ks] = *(const bf16x8*)(qp + 16 * ks);
  }
#pragma unroll
  for (int e = 0; e < 16; ++e) { O[0][e] = 0.f; O[1][e] = 0.f; }
  float m = BOUNDED ? bound : 0.f, lsum = 0.f;
  const int krow = (D == 64) ? (tid >> 3) : (tid >> 2);
  const int kc = (D == 64) ? (tid & 7) : (tid & 3);
  const bool kact = (D == 64) ? true : (tid < 256);
  const int vrow = tid >> 3, vc = tid & 7;
  const u16* kg = Kh + (size_t)krow * D + kc * 8;
  const u16* vg = Vth + (size_t)vrow * TT + vc * 8;
  u32x4 rk0 = (u32x4){0u, 0u, 0u, 0u}, rk1 = rk0, rv0, rv1;
  const int nk = nkeys >> 6;
  if (kact) rk0 = *(const u32x4*)kg;
  rv0 = *(const u32x4*)vg;
  __builtin_amdgcn_s_waitcnt(0x0F70);
  if (kact) *(u32x4*)&Ks[krow * KP + kc * 8] = rk0;
  { const u32x4 t_ = rv0; *(uint2*)&Vs[vrow * VP + vc * 8] = make_uint2(t_.x, t_.y); *(uint2*)&Vs[vrow * VP + vc * 8 + 4] = make_uint2(t_.z, t_.w); }
  if (kact) rk1 = *(const u32x4*)(kg + (size_t)64 * D);
  rv1 = *(const u32x4*)(vg + 64);
  __syncthreads();
  for (int kt2 = 0; kt2 < nk; kt2 += 2) {
#pragma unroll
  for (int ph = 0; ph < 2; ++ph) {
    const int kt = kt2 + ph;
    const int cur = ph;
    {
      const int tx = min(kt + 2, nk - 1);
      if (ph == 0) {
        if (kact) rk0 = *(const u32x4*)(kg + (size_t)tx * 64 * D);
        rv0 = *(const u32x4*)(vg + tx * 64);
      } else {
        if (kact) rk1 = *(const u32x4*)(kg + (size_t)tx * 64 * D);
        rv1 = *(const u32x4*)(vg + tx * 64);
      }
    }
    __builtin_amdgcn_sched_barrier(0);
    const u16* ks_ = Ks + cur * 64 * KP + r * KP + 8 * h;
    bf16x8 kf0[KS], kf1[KS];
#pragma unroll
    for (int ks = 0; ks < KS; ++ks) {
      kf0[ks] = *(const bf16x8*)(ks_ + 16 * ks);
      kf1[ks] = *(const bf16x8*)(ks_ + 32 * KP + 16 * ks);
    }
    const u16* vs_ = Vs + cur * 64 * VP + r * VP + 4 * h;
    bf16x8 vf[8];
#pragma unroll
    for (int s = 0; s < 2; ++s)
#pragma unroll
      for (int dt = 0; dt < 2; ++dt) {
        const u16* vp = vs_ + dt * 32 * VP + 16 * s;
        s16x4 lo = *(const s16x4*)vp;
        s16x4 hi = *(const s16x4*)(vp + 8);
        vf[s * 2 + dt] = __builtin_shufflevector(lo, hi, 0, 1, 2, 3, 4, 5, 6, 7);
      }
    __builtin_amdgcn_sched_barrier(0);
    f32x16 S[2];
    {
      const float nm = -m;
#pragma unroll
      for (int e = 0; e < 16; ++e) { S[0][e] = nm; S[1][e] = nm; }
    }
#pragma unroll
    for (int ks = 0; ks < KS; ++ks) {
      S[0] = MFMA32(kf0[ks], qf[ks], S[0]);
      S[1] = MFMA32(kf1[ks], qf[ks], S[1]);
    }
    __builtin_amdgcn_sched_barrier(0);
#pragma unroll
    for (int s = 0; s < 2; ++s)
#pragma unroll
      for (int dt = 0; dt < 2; ++dt) {
        const u16* vp = vs_ + dt * 32 * VP + 32 + 16 * s;
        s16x4 lo = *(const s16x4*)vp;
        s16x4 hi = *(const s16x4*)(vp + 8);
        vf[(2 + s) * 2 + dt] = __builtin_shufflevector(lo, hi, 0, 1, 2, 3, 4, 5, 6, 7);
      }
    __builtin_amdgcn_sched_barrier(0);
    if (!BOUNDED) {
      float t0 = fmaxf(fmaxf(S[0][0], S[0][1]), S[0][2]);
      float t1 = fmaxf(fmaxf(S[1][0], S[1][1]), S[1][2]);
#pragma unroll
      for (int e = 3; e < 15; e += 2) { t0 = fmaxf(fmaxf(t0, S[0][e]), S[0][e + 1]); t1 = fmaxf(fmaxf(t1, S[1][e]), S[1][e + 1]); }
      float tm = fmaxf(fmaxf(t0, t1), fmaxf(S[0][15], S[1][15]));
      tm = fmaxf(tm, __shfl_xor(tm, 32));
      const bool first = (kt == 0);
      if (first || __any(tm > 0.f)) {
        const float adj = first ? tm : fmaxf(tm, 0.f);
        const float alpha = first ? 1.f : fexp2(-adj);
        m += adj;
        lsum *= alpha;
#pragma unroll
        for (int e = 0; e < 16; ++e) { O[0][e] *= alpha; O[1][e] *= alpha; S[0][e] -= adj; S[1][e] -= adj; }
      }
    }
    float rs = 0.f;
#pragma unroll
    for (int e = 0; e < 16; ++e) { S[0][e] = fexp2(S[0][e]); rs += S[0][e]; }
#pragma unroll
    for (int e = 0; e < 16; ++e) { S[1][e] = fexp2(S[1][e]); rs += S[1][e]; }
    lsum += rs;
#pragma unroll
    for (int t2 = 0; t2 < 2; ++t2)
#pragma unroll
      for (int s = 0; s < 2; ++s) {
        uint4 pu;
        pu.x = pk(S[t2][8 * s], S[t2][8 * s + 1]); pu.y = pk(S[t2][8 * s + 2], S[t2][8 * s + 3]);
        pu.z = pk(S[t2][8 * s + 4], S[t2][8 * s + 5]); pu.w = pk(S[t2][8 * s + 6], S[t2][8 * s + 7]);
        const bf16x8 pb = __builtin_bit_cast(bf16x8, pu);
        O[0] = MFMA32(vf[(t2 * 2 + s) * 2 + 0], pb, O[0]);
        O[1] = MFMA32(vf[(t2 * 2 + s) * 2 + 1], pb, O[1]);
      }
    if (kt + 1 < nk) {
      const int nx = cur ^ 1;
      if (kact) *(u32x4*)&Ks[nx * 64 * KP + krow * KP + kc * 8] = (ph == 0) ? rk1 : rk0;
      { const u32x4 t_ = (ph == 0) ? rv1 : rv0; *(uint2*)&Vs[nx * 64 * VP + vrow * VP + vc * 8] = make_uint2(t_.x, t_.y); *(uint2*)&Vs[nx * 64 * VP + vrow * VP + vc * 8 + 4] = make_uint2(t_.z, t_.w); }
    }
    __syncthreads();
  }
  }
  lout = lsum + __shfl_xor(lsum, 32);
}

DI void gqa_unit(const WS& W, const float* qg, const float* kg_, int b, int head, int qb, unsigned char* lds) {
  const int tid = fresh_tid(), lane = tid & 63, w = tid >> 6, r = lane & 31, h = lane >> 5;
  const int q0 = qb * 256;
  const int nkeys = (qb == 0) ? 256 : TT;
  f32x16 O[2];
  float l;
  float bound;
  {
    float gq = fabsf(qg[lane]), gk = fabsf(kg_[lane]);
#pragma unroll
    for (int d = 32; d >= 1; d >>= 1) { gq = fmaxf(gq, __shfl_xor(gq, d)); gk = fmaxf(gk, __shfl_xor(gk, d)); }
    bound = 8.f * LOG2E * gq * gk * 1.02f + 0.25f;
  }
  attn_core<64, true>(W.Q + (size_t)(b * 4 + head) * TT * 64, W.K + (size_t)(b * 2 + (head >> 1)) * TT * 64,
                      W.Vt + (size_t)(b * 2 + (head >> 1)) * 64 * TT, q0, nkeys, bound, lds, O, l);
  const float il = 1.f / l;
  const size_t Rr = (size_t)b * TT + q0 + 32 * w + r;
#pragma unroll
  for (int dt = 0; dt < 2; ++dt)
#pragma unroll
    for (int i4 = 0; i4 < 4; ++i4) {
      const int dv = 32 * dt + 8 * i4 + 4 * h;
      const uint2 g = *(const uint2*)(W.GG + Rr * 256 + head * 64 + dv);
      uint2 o;
      o.x = pk(O[dt][4 * i4] * il * bflo(g.x), O[dt][4 * i4 + 1] * il * bfhi(g.x));
      o.y = pk(O[dt][4 * i4 + 2] * il * bflo(g.y), O[dt][4 * i4 + 3] * il * bfhi(g.y));
      *(uint2*)(W.Ycat + Rr * 1024 + 512 + head * 64 + dv) = o;
    }
}

DI void diff_unit(const Params& P, const WS& W, int l, int b, int hh, int qb, unsigned char* lds) {
  const int tid = fresh_tid(), lane = tid & 63, w = tid >> 6, r = lane & 31, h = lane >> 5;
  const int q0 = qb * 256;
  const int nkeys = (qb == 0) ? 256 : TT;
  const float lam_init = (l == 0) ? 0.2f : 0.35550906759f;
  float lam;
  {
    const float* lp = P.in[19] + l * 128;
    float s1 = (lane < 32) ? lp[lane] * lp[32 + lane] : 0.f;
    float s2 = (lane < 32) ? lp[64 + lane] * lp[96 + lane] : 0.f;
#pragma unroll
    for (int d = 32; d >= 1; d >>= 1) { s1 += __shfl_xor(s1, d); s2 += __shfl_xor(s2, d); }
    lam = __expf(s1) - __expf(s2) + lam_init;
  }
  f32x16 O1[2], O2[2];
  float l1, l2;
  const u16* vt = W.DVt + (size_t)(b * 4 + hh) * 64 * TT;
  attn_core<32, false>(W.DQ + (size_t)(b * 8 + 2 * hh) * TT * 32, W.DK + (size_t)(b * 8 + 2 * hh) * TT * 32, vt, q0, nkeys, 0.f, lds, O1, l1);
  attn_core<32, false>(W.DQ + (size_t)(b * 8 + 2 * hh + 1) * TT * 32, W.DK + (size_t)(b * 8 + 2 * hh + 1) * TT * 32, vt, q0, nkeys, 0.f, lds, O2, l2);
  const float i1 = 1.f / l1, i2 = lam / l2;
  float ss = 0.f;
#pragma unroll
  for (int dt = 0; dt < 2; ++dt)
#pragma unroll
    for (int e = 0; e < 16; ++e) {
      const float o = O1[dt][e] * i1 - O2[dt][e] * i2;
      O1[dt][e] = o;
      ss += o * o;
    }
  ss += __shfl_xor(ss, 32);
  const float rn = rsqrtf(ss * (1.f / 64.f) + EPS) * (1.f - lam_init);
  const float* ng = P.in[20] + l * 64;
  const size_t Rr = (size_t)b * TT + q0 + 32 * w + r;
#pragma unroll
  for (int dt = 0; dt < 2; ++dt)
#pragma unroll
    for (int i4 = 0; i4 < 4; ++i4) {
      const int dv = 32 * dt + 8 * i4 + 4 * h;
      const uint2 g = *(const uint2*)(W.DG + Rr * 256 + hh * 64 + dv);
      const float4 n4 = *(const float4*)(ng + dv);
      uint2 o;
      o.x = pk(O1[dt][4 * i4] * rn * n4.x * bflo(g.x), O1[dt][4 * i4 + 1] * rn * n4.y * bfhi(g.x));
      o.y = pk(O1[dt][4 * i4 + 2] * rn * n4.z * bflo(g.y), O1[dt][4 * i4 + 3] * rn * n4.w * bfhi(g.y));
      *(uint2*)(W.Ycat + Rr * 1024 + 768 + hh * 64 + dv) = o;
    }
}

DI void ssd_xload(uint2 (&raw)[8], const u16* src, int tb, int seg_lo, int seg_hi) {
#pragma unroll
  for (int i = 0; i < 8; ++i) {
    const int t = tb - 2 + i;
    const int tc = min(max(t, seg_lo), seg_hi - 1);
    uint2 v = *(const uint2*)(src + (size_t)tc * 1024);
    if (t < seg_lo || t >= seg_hi) v = make_uint2(0u, 0u);
    raw[i] = v;
  }
}
constexpr int S_LD = 136;
DI void ssd_local_unit(const Params& P, const WS& W, int l, int b, int c, int g, unsigned char* lds) {
  const int tid = fresh_tid(), lane = tid & 63, w = tid >> 6;
  u16* BsT = (u16*)lds;
  u16* Bs = (u16*)(lds + 34816);
  u16* Cs = (u16*)(lds + 69632);
  u16* xT = (u16*)(lds + 34816);
  u16* xsF = (u16*)(lds + 52224);
  u16* xsB = (u16*)(lds + 69632);
  float* cumF = (float*)(lds + 104448);
  float* cumB = cumF + 512;
  float* dtF = cumB + 512;
  float* dtB = dtF + 512;
  const size_t Rc0 = (size_t)b * TT + c * 128;
  const int seg_lo = (c < 2) ? 0 : 256;
  const int seg_hi = (c < 2) ? 256 : TT;
  const float* conv_w = P.in[9] + (size_t)l * 5 * 1024;
  const float* conv_b = P.in[10] + (size_t)l * 1024;
  const int cqB = lane;
  const bool isB = cqB < 32;
  const int ch0 = isB ? 4 * cqB : 4 * (cqB - 32);
  float4 wjB[5];
  float4 biasB;
  uint2 rawB[20];
  {
    const int col = (isB ? 512 : 768) + g * 128 + ch0;
#pragma unroll
    for (int j = 0; j < 5; ++j) wjB[j] = *(const float4*)(conv_w + j * 1024 + col);
    biasB = *(const float4*)(conv_b + col);
    const u16* src = W.XBC + (size_t)b * TT * 1024 + col;
    const int tb = c * 128 + 16 * w;
#pragma unroll
    for (int i = 0; i < 20; ++i) {
      const int t = tb - 2 + i;
      const int tc = min(max(t, seg_lo), seg_hi - 1);
      uint2 v = *(const uint2*)(src + (size_t)tc * 1024);
      if (t < seg_lo || t >= seg_hi) v = make_uint2(0u, 0u);
      rawB[i] = v;
    }
  }
  uint2 xraw[8];
  ssd_xload(xraw, W.XBC + (size_t)b * TT * 1024 + (g * 4) * 64 + 4 * (tid & 15), c * 128 + 4 * (tid >> 4), seg_lo, seg_hi);
  float4 xw[5], xbias;
  {
    const int col = (g * 4) * 64 + 4 * (tid & 15);
#pragma unroll
    for (int j = 0; j < 5; ++j) xw[j] = *(const float4*)(conv_w + j * 1024 + col);
    xbias = *(const float4*)(conv_b + col);
  }
  {
    const int hh = w & 3, dir = w >> 2, hg = g * 4 + hh;
    const float a = -__expf((dir ? P.in[12] : P.in[11])[l * 8 + hg]);
    const float d0 = W.DT[(Rc0 + 2 * lane) * 16 + dir * 8 + hg];
    const float d1 = W.DT[(Rc0 + 2 * lane + 1) * 16 + dir * 8 + hg];
    const float a0 = d0 * a, a1 = d1 * a;
    float v = a0 + a1;
    float c0, c1;
    if (dir == 0) {
#pragma unroll
      for (int d = 1; d < 64; d <<= 1) { const float t = __shfl_up(v, d); if (lane >= d) v += t; }
      c0 = v - a1; c1 = v;
    } else {
#pragma unroll
      for (int d = 1; d < 64; d <<= 1) { const float t = __shfl_down(v, d); if (lane + d < 64) v += t; }
      c0 = v; c1 = v - a0;
    }
    float* lc = cumF + dir * 512 + hh * 128 + 2 * lane;
    lc[0] = c0; lc[1] = c1;
    lc[1024] = d0; lc[1025] = d1;
    float* gc = W.cumF + (size_t)dir * ((size_t)RR * 8) + (Rc0 + 2 * lane) * 8 + hg;
    gc[0] = c0; gc[8] = c1;
  }
  {
    float y[4][16];
#pragma unroll
    for (int s2 = 0; s2 < 16; ++s2) {
      float a0 = biasB.x, a1 = biasB.y, a2 = biasB.z, a3 = biasB.w;
#pragma unroll
      for (int j = 0; j < 5; ++j) {
        const uint2 v = rawB[s2 + j];
        a0 += wjB[j].x * bflo(v.x); a1 += wjB[j].y * bfhi(v.x); a2 += wjB[j].z * bflo(v.y); a3 += wjB[j].w * bfhi(v.y);
      }
      y[0][s2] = silu(a0); y[1][s2] = silu(a1); y[2][s2] = silu(a2); y[3][s2] = silu(a3);
    }
    const int s0 = 16 * w;
    if (isB) {
#pragma unroll
      for (int s2 = 0; s2 < 16; ++s2) {
        uint2 o; o.x = pk(y[0][s2], y[1][s2]); o.y = pk(y[2][s2], y[3][s2]);
        *(uint2*)&Bs[(s0 + s2) * S_LD + ch0] = o;
      }
#pragma unroll
      for (int ch = 0; ch < 4; ++ch) {
        uint4 u0, u1;
        u0.x = pk(y[ch][0], y[ch][1]); u0.y = pk(y[ch][2], y[ch][3]); u0.z = pk(y[ch][4], y[ch][5]); u0.w = pk(y[ch][6], y[ch][7]);
        u1.x = pk(y[ch][8], y[ch][9]); u1.y = pk(y[ch][10], y[ch][11]); u1.z = pk(y[ch][12], y[ch][13]); u1.w = pk(y[ch][14], y[ch][15]);
        *(uint4*)&BsT[(ch0 + ch) * S_LD + s0] = u0;
        *(uint4*)&BsT[(ch0 + ch) * S_LD + s0 + 8] = u1;
      }
    } else {
#pragma unroll
      for (int s2 = 0; s2 < 16; ++s2) {
        uint2 o; o.x = pk(y[0][s2], y[1][s2]); o.y = pk(y[2][s2], y[3][s2]);
        *(uint2*)&Cs[(s0 + s2) * S_LD + ch0] = o;
        *(uint2*)(W.Cc + (Rc0 + s0 + s2) * 256 + g * 128 + ch0) = o;
      }
    }
  }
  __syncthreads();
  const int c16 = lane & 15, q = lane >> 4;
  f32x4 G[8];
#pragma unroll
  for (int st = 0; st < 8; ++st) G[st] = (f32x4){0.f, 0.f, 0.f, 0.f};
#pragma unroll
  for (int ks = 0; ks < 4; ++ks) {
    const bf16x8 bfrag = *(const bf16x8*)&Cs[(16 * w + c16) * S_LD + 32 * ks + 8 * q];
#pragma unroll
    for (int st = 0; st < 8; ++st) {
      const bf16x8 afrag = *(const bf16x8*)&Bs[(16 * st + c16) * S_LD + 32 * ks + 8 * q];
      G[st] = MFMA16(afrag, bfrag, G[st]);
    }
  }
  __syncthreads();
  for (int hh = 0; hh < 4; ++hh) {
    const int hg = g * 4 + hh;
    {
      const int cq = tid & 15, tg = tid >> 4;
      const int col = hg * 64 + 4 * cq;
      float4 wj[5];
#pragma unroll
      for (int j = 0; j < 5; ++j) wj[j] = xw[j];
      const float4 bias = xbias;
      (void)col;
      const float cF_end = cumF[hh * 128 + 127], cB_end = cumB[hh * 128];
      float y[4][4], ff[4], fb[4];
#pragma unroll
      for (int s2 = 0; s2 < 4; ++s2) {
        float a0 = bias.x, a1 = bias.y, a2 = bias.z, a3 = bias.w;
#pragma unroll
        for (int j = 0; j < 5; ++j) {
          const uint2 v = xraw[s2 + j];
          a0 += wj[j].x * bflo(v.x); a1 += wj[j].y * bfhi(v.x); a2 += wj[j].z * bflo(v.y); a3 += wj[j].w * bfhi(v.y);
        }
        y[0][s2] = silu(a0); y[1][s2] = silu(a1); y[2][s2] = silu(a2); y[3][s2] = silu(a3);
        const int sI = 4 * tg + s2;
        ff[s2] = dtF[hh * 128 + sI] * __expf(cF_end - cumF[hh * 128 + sI]);
        fb[s2] = dtB[hh * 128 + sI] * __expf(cB_end - cumB[hh * 128 + sI]);
      }
#pragma unroll
      for (int ch = 0; ch < 4; ++ch) {
        const int p = 4 * cq + ch;
        uint2 o;
        o.x = pk(y[ch][0], y[ch][1]); o.y = pk(y[ch][2], y[ch][3]);
        *(uint2*)&xT[p * S_LD + 4 * tg] = o;
        o.x = pk(y[ch][0] * ff[0], y[ch][1] * ff[1]); o.y = pk(y[ch][2] * ff[2], y[ch][3] * ff[3]);
        *(uint2*)&xsF[p * S_LD + 4 * tg] = o;
        o.x = pk(y[ch][0] * fb[0], y[ch][1] * fb[1]); o.y = pk(y[ch][2] * fb[2], y[ch][3] * fb[3]);
        *(uint2*)&xsB[p * S_LD + 4 * tg] = o;
      }
      if (hh < 3) {
        ssd_xload(xraw, W.XBC + (size_t)b * TT * 1024 + (hg + 1) * 64 + 4 * cq, c * 128 + 4 * tg, seg_lo, seg_hi);
        const int coln = (hg + 1) * 64 + 4 * cq;
#pragma unroll
        for (int j = 0; j < 5; ++j) xw[j] = *(const float4*)(conv_w + j * 1024 + coln);
        xbias = *(const float4*)(conv_b + coln);
      }
    }
    __syncthreads();
    {
      const int t = 16 * w + c16;
      const float cF_t = cumF[hh * 128 + t], cB_t = cumB[hh * 128 + t];
      const float Dh = P.in[15][l * 8 + hg];
      f32x4 Y[4];
#pragma unroll
      for (int pt = 0; pt < 4; ++pt) Y[pt] = (f32x4){0.f, 0.f, 0.f, 0.f};
#pragma unroll
      for (int m = 0; m < 4; ++m) {
        __builtin_amdgcn_sched_barrier(0);
        float mv[8];
#pragma unroll
        for (int jj = 0; jj < 2; ++jj) {
          const int st = 2 * m + jj;
          const int sb = 16 * st + 4 * q;
          const float4 cf4 = *(const float4*)&cumF[hh * 128 + sb];
          const float4 df4 = *(const float4*)&dtF[hh * 128 + sb];
          const float4 cb4 = *(const float4*)&cumB[hh * 128 + sb];
          const float4 db4 = *(const float4*)&dtB[hh * 128 + sb];
          const float cfv[4] = {cf4.x, cf4.y, cf4.z, cf4.w}, dfv[4] = {df4.x, df4.y, df4.z, df4.w};
          const float cbv[4] = {cb4.x, cb4.y, cb4.z, cb4.w}, dbv[4] = {db4.x, db4.y, db4.z, db4.w};
#pragma unroll
          for (int i = 0; i < 4; ++i) {
            const int s = sb + i;
            const float ef = (s <= t) ? __expf(cF_t - cfv[i]) * dfv[i] : 0.f;
            const float eb = (s >= t) ? __expf(cB_t - cbv[i]) * dbv[i] : 0.f;
            mv[4 * jj + i] = G[st][i] * (ef + eb) + ((s == t) ? Dh : 0.f);
          }
        }
        uint4 mu;
        mu.x = pk(mv[0], mv[1]); mu.y = pk(mv[2], mv[3]); mu.z = pk(mv[4], mv[5]); mu.w = pk(mv[6], mv[7]);
        const bf16x8 Mf = __builtin_bit_cast(bf16x8, mu);
#pragma unroll
        for (int pt = 0; pt < 4; ++pt) {
          const u16* xp = xT + (16 * pt + c16) * S_LD + 32 * m + 4 * q;
          s16x4 lo = *(const s16x4*)xp;
          s16x4 hi = *(const s16x4*)(xp + 16);
          const bf16x8 af = __builtin_shufflevector(lo, hi, 0, 1, 2, 3, 4, 5, 6, 7);
          Y[pt] = MFMA16(af, Mf, Y[pt]);
        }
      }
#pragma unroll
      for (int pt = 0; pt < 4; ++pt) {
        uint2 o;
        o.x = pk(Y[pt][0], Y[pt][1]); o.y = pk(Y[pt][2], Y[pt][3]);
        *(uint2*)(W.Ycat + (Rc0 + t) * 1024 + hg * 64 + 16 * pt + 4 * q) = o;
      }
    }
#pragma unroll
    for (int dir = 0; dir < 2; ++dir) {
      const u16* xs = dir ? xsB : xsF;
      f32x4 acc[4];
#pragma unroll
      for (int pt = 0; pt < 4; ++pt) acc[pt] = (f32x4){0.f, 0.f, 0.f, 0.f};
#pragma unroll
      for (int ks = 0; ks < 4; ++ks) {
        const bf16x8 af = *(const bf16x8*)&BsT[(16 * w + c16) * S_LD + 32 * ks + 8 * q];
#pragma unroll
        for (int pt = 0; pt < 4; ++pt) {
          const bf16x8 bfr = *(const bf16x8*)&xs[(16 * pt + c16) * S_LD + 32 * ks + 8 * q];
          acc[pt] = MFMA16(af, bfr, acc[pt]);
        }
      }
      u16* dst = W.Sloc + ((((size_t)dir * 8 + b) * 18 + c) * 8 + hg) * 8192;
#pragma unroll
      for (int pt = 0; pt < 4; ++pt) {
        uint2 o;
        o.x = pk(acc[pt][0], acc[pt][1]); o.y = pk(acc[pt][2], acc[pt][3]);
        *(uint2*)(dst + (16 * pt + c16) * 128 + 16 * w + 4 * q) = o;
      }
    }
    __syncthreads();
  }
}

DI void ws_init(WS& W, unsigned char* ws) {
        W.WinT = (u16*)(ws + OFF_WIN); W.WoutT = (u16*)(ws + OFF_WOUT); W.mod = (float*)(ws + OFF_MOD);
    W.ropeG = (float2*)(ws + OFF_ROPE); W.ropeD = (float2*)(ws + OFF_ROPE + 8192);
    W.U = (u16*)(ws + OFF_U); W.Ycat = (u16*)(ws + OFF_U); W.XBC = (u16*)(ws + OFF_XBC); W.Obuf = (u16*)(ws + OFF_XBC);
    W.Z = (u16*)(ws + OFF_Z); W.DT = (float*)(ws + OFF_DT);
    W.Q = (u16*)(ws + OFF_Q); W.K = (u16*)(ws + OFF_K); W.Vt = (u16*)(ws + OFF_VT);
    W.DQ = (u16*)(ws + OFF_DQ); W.DK = (u16*)(ws + OFF_DK); W.DVt = (u16*)(ws + OFF_DVT); W.Stin = (u16*)(ws + OFF_Q);
    W.GG = (u16*)(ws + OFF_GG); W.DG = (u16*)(ws + OFF_DG); W.Cc = (u16*)(ws + OFF_CC);
    W.cumF = (float*)(ws + OFF_CUMF); W.cumB = (float*)(ws + OFF_CUMB); W.Sloc = (u16*)(ws + OFF_SLOC);
    W.Opart = (float*)(ws + OFF_OPART);
}

#define XCD_LOOP(UPX, xcd, idx) \
  const bool sw_ = (nb & 7) == 0; \
  for (int t_ = sw_ ? (bid >> 3) : bid; t_ < (sw_ ? (UPX) : 8 * (UPX)); t_ += (sw_ ? (nb >> 3) : nb)) { \
    const int xcd = sw_ ? (bid & 7) : t_ / (UPX); const int idx = sw_ ? t_ : t_ % (UPX);
#define XCD_END }

typedef const Params __attribute__((address_space(4)))* KArgP;
DI Params load_params(KArgP kp) {
  asm volatile("" : "+s"(kp));
  Params P;
#pragma unroll
  for (int i = 0; i < 22; ++i) P.in[i] = kp->in[i];
  P.out = kp->out; P.ws = kp->ws;
  return P;
}

DI void ph0_prologue(KArgP kp, unsigned char* lds) {
  const Params P = load_params(kp); WS W; ws_init(W, P.ws);
  const int tid = fresh_tid(), lane = tid & 63, w = tid >> 6;
  const int nb = gridDim.x, bid = blockIdx.x;
  (void)lane; (void)w; (void)tid;
  {
    float* S = (float*)(lds + 69632);
    for (int i = tid; i < 9 * 1024; i += NT) {
      const float x = (i < 8192) ? P.in[1][i] : P.in[3][i - 8192];
      S[i] = silu(x);
    }
    __syncthreads();
    constexpr int U_WIN = 2 * 14 * 16, U_WOUT = 2 * 4 * 16, U_MOD = 384;
    for (int u = bid; u < U_WIN + U_WOUT + U_MOD + 1; u += nb) {
      if (u < U_WIN + U_WOUT) {
        const float* src; u16* dst; int ldn, n0, k0, nrows; bool inproj;
        if (u < U_WIN) {
          const int l = u / (14 * 16), rem = u % (14 * 16);
          n0 = (rem >> 4) * 256; k0 = (rem & 15) * 64; ldn = 3344; inproj = true; nrows = NPAD;
          src = P.in[8] + (size_t)l * 1024 * 3344; dst = W.WinT + (size_t)l * NPAD * 1024;
        } else {
          const int v = u - U_WIN; const int l = v >> 6, rem = v & 63;
          n0 = (rem >> 4) * 256; k0 = (rem & 15) * 64; ldn = 1024; inproj = false; nrows = 1024;
          src = P.in[21] + (size_t)l * 1024 * 1024; dst = W.WoutT + (size_t)l * 1024 * 1024;
        }
        float* tile = (float*)lds;
        {
          const int n = tid & 63, kq = tid >> 6;
#pragma unroll
          for (int sub = 0; sub < 4; ++sub) {
            const int nd = n0 + sub * 64 + n;
            int ns = nd;
            if (inproj) { ns = (nd < 1536) ? nd : (nd < 3328 ? nd + 16 : (nd < 3344 ? nd - 3328 + 1536 : -1)); }
#pragma unroll
            for (int i = 0; i < 8; ++i) {
              const int k = kq * 8 + i;
              tile[sub * 4160 + k * 65 + n] = (ns >= 0) ? src[(size_t)(k0 + k) * ldn + ns] : 0.f;
            }
          }
        }
        __syncthreads();
        {
          const int n = tid >> 3, kc = tid & 7;
#pragma unroll
          for (int sub = 0; sub < 4; ++sub) {
            float f[8];
#pragma unroll
            for (int i = 0; i < 8; ++i) f[i] = tile[sub * 4160 + (kc * 8 + i) * 65 + n];
            uint4 o;
            o.x = pk(f[0], f[1]); o.y = pk(f[2], f[3]); o.z = pk(f[4], f[5]); o.w = pk(f[6], f[7]);
            if (n0 + sub * 64 + n < nrows) *(uint4*)(dst + (size_t)(n0 + sub * 64 + n) * 1024 + k0 + kc * 8) = o;
          }
        }
        __syncthreads();
      } else if (u < U_WIN + U_WOUT + U_MOD) {
        const int v = u - U_WIN - U_WOUT;
        const int l = v / 192, n0 = (v % 192) * 16;
        const int c16 = tid & 15, kg = tid >> 4;
        const float* wm = P.in[4] + (size_t)l * 1024 * 3072 + n0 + c16;
        float acc[9];
#pragma unroll
        for (int rr = 0; rr < 9; ++rr) acc[rr] = 0.f;
#pragma unroll 8
        for (int kk = 0; kk < 32; ++kk) {
          const int k = kg * 32 + kk;
          const float wv = wm[(size_t)k * 3072];
#pragma unroll
          for (int rr = 0; rr < 9; ++rr) acc[rr] += S[rr * 1024 + k] * wv;
        }
        float* red = (float*)lds;
#pragma unroll
        for (int rr = 0; rr < 9; ++rr) red[(kg * 16 + c16) * 9 + rr] = acc[rr];
        __syncthreads();
        if (tid < 144) {
          const int cc = tid / 9, rr = tid % 9;
          float s = 0.f;
          for (int k2 = 0; k2 < 32; ++k2) s += red[(k2 * 16 + cc) * 9 + rr];
          W.mod[((size_t)l * 9 + rr) * 3072 + n0 + cc] = s + P.in[5][l * 3072 + n0 + cc];
        }
        __syncthreads();
      } else {
        for (int i = tid; i < 64 * 16; i += NT) {
          const int idx = i >> 4, k = i & 15;
          const float inv = powf(10000.f, -(float)k / 16.f);
          float sn, cs; sincosf((float)idx * inv, &sn, &cs);
          W.ropeG[i] = make_float2(cs, sn);
        }
        for (int i = tid; i < 64 * 8; i += NT) {
          const int idx = i >> 3, k = i & 7;
          const float inv = powf(10000.f, -(float)k / 8.f);
          float sn, cs; sincosf((float)idx * inv, &sn, &cs);
          W.ropeD[i] = make_float2(cs, sn);
        }
      }
    }
  }
}

DI void ph1_prep(KArgP kp) {
  const Params P = load_params(kp); WS W; ws_init(W, P.ws);
  const int tid = fresh_tid(), lane = tid & 63, w = tid >> 6;
  const int nb = gridDim.x, bid = blockIdx.x;
  (void)lane; (void)w; (void)tid;
  XCD_LOOP(288, xcd, idx)
    const int R = xcd * TT + idx * 8 + w;
    const int b = xcd, t = idx * 8 + w;
    const float* src = (t < 256) ? (P.in[2] + ((size_t)b * 256 + t) * 1024) : (P.in[0] + ((size_t)b * 2048 + (t - 256)) * 1024);
    const float* md = W.mod + (size_t)((t < 256) ? 8 : b) * 3072;
    const float* gp = P.in[6];
    float4 x[4];
    float ss = 0.f;
#pragma unroll
    for (int i = 0; i < 4; ++i) {
      x[i] = *(const float4*)(src + i * 256 + lane * 4);
      ss += x[i].x * x[i].x + x[i].y * x[i].y + x[i].z * x[i].z + x[i].w * x[i].w;
    }
#pragma unroll
    for (int d = 32; d >= 1; d >>= 1) ss += __shfl_xor(ss, d);
    const float rn = rsqrtf(ss * (1.f / 1024.f) + EPS);
#pragma unroll
    for (int i = 0; i < 4; ++i) {
      const int k = i * 256 + lane * 4;
      const float4 g4 = *(const float4*)(gp + k);
      const float4 sh = *(const float4*)(md + k);
      const float4 sc = *(const float4*)(md + 1024 + k);
      uint2 o;
      o.x = pk(x[i].x * rn * g4.x * (1.f + sc.x) + sh.x, x[i].y * rn * g4.y * (1.f + sc.y) + sh.y);
      o.y = pk(x[i].z * rn * g4.z * (1.f + sc.z) + sh.z, x[i].w * rn * g4.w * (1.f + sc.w) + sh.w);
      *(uint2*)(W.U + (size_t)R * 1024 + k) = o;
    }
  XCD_END
}

DI void ph2_inproj(KArgP kp, int l, unsigned char* lds) {
  const Params P = load_params(kp); WS W; ws_init(W, P.ws);
  const int tid = fresh_tid();
  const int nb = gridDim.x, bid = blockIdx.x;
  XCD_LOOP(243, xcd, idx)
    const int nt = idx / 9, mt = xcd * 9 + idx % 9;
    gemm_tile_to_lds(W.U, W.WinT + (size_t)l * NPAD * 1024, mt * 256, nt * 128, lds);
    float v[64];
    load_row64(lds, v);
    inproj_epi(P, W, l, mt * 256 + (tid >> 1), nt, tid & 1, v);
    __syncthreads();
  XCD_END
}

DI void ph3_mix(KArgP kp, int l, unsigned char* lds) {
  const Params P = load_params(kp); WS W; ws_init(W, P.ws);
  const int nb = gridDim.x, bid = blockIdx.x;
  const int upx = (l == 0) ? 108 : 100;
  XCD_LOOP(upx, xcd, idx)
    const int b = xcd;
    if (idx < 32) {
      diff_unit(P, W, l, b, idx >> 3, 1 + (idx & 7), lds);
    } else if (idx < 64) {
      gqa_unit(W, P.in[17] + l * 64, P.in[18] + l * 64, b, (idx - 32) >> 3, 1 + (idx & 7), lds);
    } else if (idx < 100) {
      const int v = idx - 64;
      ssd_local_unit(P, W, l, b, v >> 1, v & 1, lds);
    } else if (idx < 104) {
      diff_unit(P, W, l, b, idx - 100, 0, lds);
    } else {
      gqa_unit(W, P.in[17] + l * 64, P.in[18] + l * 64, b, idx - 104, 0, lds);
    }
    __syncthreads();
  XCD_END
}

DI void ph4a_states(KArgP kp) {
  const Params P = load_params(kp); WS W; ws_init(W, P.ws);
  const int tid = fresh_tid(), lane = tid & 63, w = tid >> 6;
  const int nb = gridDim.x, bid = blockIdx.x;
  (void)lane; (void)w; (void)tid;
    XCD_LOOP(64, xcd, idx)
      const int gid = idx * NT + tid;
      const int e4 = gid & 2047, hg = (gid >> 11) & 7, b = xcd, dir = gid >> 14;
      float s0 = 0.f, s1 = 0.f, s2 = 0.f, s3 = 0.f;
      for (int step = 0; step < 18; ++step) {
        const int c = dir ? (step == 0 ? 1 : (step == 1 ? 0 : 19 - step)) : step;
        const size_t idx = ((((size_t)dir * 8 + b) * 18 + c) * 8 + hg) * 8192 + (size_t)e4 * 4;
        uint2 o;
        o.x = pk(s0, s1); o.y = pk(s2, s3);
        *(uint2*)(W.Stin + idx) = o;
        const float tot = W.cumF[(size_t)dir * ((size_t)RR * 8) + ((size_t)b * TT + c * 128 + (dir ? 0 : 127)) * 8 + hg];
        const float dec = __expf(tot);
        const uint2 sv = *(const uint2*)(W.Sloc + idx);
        s0 = s0 * dec + bflo(sv.x); s1 = s1 * dec + bfhi(sv.x);
        s2 = s2 * dec + bflo(sv.y); s3 = s3 * dec + bfhi(sv.y);
      }
    XCD_END
}

DI void ph4b_yoff(KArgP kp, int l, unsigned char* lds) {
  const Params P = load_params(kp); WS W; ws_init(W, P.ws);
  const int tid = fresh_tid(), lane = tid & 63, w = tid >> 6;
  const int nb = gridDim.x, bid = blockIdx.x;
  (void)lane; (void)w; (void)tid;
    XCD_LOOP((l == 0 ? 72 : 64), xcd, idx)
      const int b = xcd, c = (idx >> 2) + (l == 0 ? 0 : 2), tb = idx & 3;
      const int r = lane & 31, h2 = lane >> 5;
      const int hg = w, g = w >> 2;
      const size_t Rr = (size_t)b * TT + c * 128 + 32 * tb + r;
      f32x16 acc[2][2];
#pragma unroll
      for (int d = 0; d < 2; ++d)
#pragma unroll
        for (int pt = 0; pt < 2; ++pt)
#pragma unroll
          for (int e = 0; e < 16; ++e) acc[d][pt][e] = 0.f;
      const u16* cp = W.Cc + Rr * 256 + g * 128 + 8 * h2;
      bf16x8 bfr[8];
#pragma unroll
      for (int ks = 0; ks < 8; ++ks) bfr[ks] = *(const bf16x8*)(cp + 16 * ks);
      u16* myl = (u16*)lds + w * (64 * 136);
#pragma unroll
      for (int d = 0; d < 2; ++d) {
        const u16* sp = W.Stin + ((((size_t)d * 8 + b) * 18 + c) * 8 + hg) * 8192 + lane * 8;
        u32x4 sv[16];
#pragma unroll
        for (int i = 0; i < 16; ++i) sv[i] = *(const u32x4*)(sp + i * 512);
#pragma unroll
        for (int i = 0; i < 16; ++i) *(u32x4*)(myl + (4 * i + (lane >> 4)) * 136 + (lane & 15) * 8) = sv[i];
        __builtin_amdgcn_wave_barrier();
#pragma unroll
        for (int ks = 0; ks < 8; ++ks) {
          const bf16x8 f0 = *(const bf16x8*)(myl + r * 136 + 16 * ks + 8 * h2);
          const bf16x8 f1 = *(const bf16x8*)(myl + (32 + r) * 136 + 16 * ks + 8 * h2);
          acc[d][0] = MFMA32(f0, bfr[ks], acc[d][0]);
          acc[d][1] = MFMA32(f1, bfr[ks], acc[d][1]);
        }
        __builtin_amdgcn_wave_barrier();
      }
      const float eF = __expf(W.cumF[Rr * 8 + hg]), eB = __expf(W.cumB[Rr * 8 + hg]);
      float ss = 0.f;
#pragma unroll
      for (int pt = 0; pt < 2; ++pt)
#pragma unroll
        for (int i4 = 0; i4 < 4; ++i4) {
          const int p = 32 * pt + 8 * i4 + 4 * h2;
          const uint2 yd = *(const uint2*)(W.Ycat + Rr * 1024 + hg * 64 + p);
          const uint2 zz = *(const uint2*)(W.Z + Rr * 512 + hg * 64 + p);
          float y0 = bflo(yd.x) + eF * acc[0][pt][4 * i4] + eB * acc[1][pt][4 * i4];
          float y1 = bfhi(yd.x) + eF * acc[0][pt][4 * i4 + 1] + eB * acc[1][pt][4 * i4 + 1];
          float y2 = bflo(yd.y) + eF * acc[0][pt][4 * i4 + 2] + eB * acc[1][pt][4 * i4 + 2];
          float y3 = bfhi(yd.y) + eF * acc[0][pt][4 * i4 + 3] + eB * acc[1][pt][4 * i4 + 3];
          y0 *= silu(bflo(zz.x)); y1 *= silu(bfhi(zz.x)); y2 *= silu(bflo(zz.y)); y3 *= silu(bfhi(zz.y));
          acc[0][pt][4 * i4] = y0; acc[0][pt][4 * i4 + 1] = y1; acc[0][pt][4 * i4 + 2] = y2; acc[0][pt][4 * i4 + 3] = y3;
          ss += y0 * y0 + y1 * y1 + y2 * y2 + y3 * y3;
        }
      ss += __shfl_xor(ss, 32);
      float* red = (float*)(lds + 8 * 64 * 136 * 2);
      if (h2 == 0) red[w * 32 + r] = ss;
      __syncthreads();
      float tot = 0.f;
#pragma unroll
      for (int k = 0; k < 8; ++k) tot += red[k * 32 + r];
      const float rn = rsqrtf(tot * (1.f / 512.f) + EPS);
      const float* ng = P.in[16] + l * 512 + hg * 64;
#pragma unroll
      for (int pt = 0; pt < 2; ++pt)
#pragma unroll
        for (int i4 = 0; i4 < 4; ++i4) {
          const int p = 32 * pt + 8 * i4 + 4 * h2;
          const float4 n4 = *(const float4*)(ng + p);
          uint2 o;
          o.x = pk(acc[0][pt][4 * i4] * rn * n4.x, acc[0][pt][4 * i4 + 1] * rn * n4.y);
          o.y = pk(acc[0][pt][4 * i4 + 2] * rn * n4.z, acc[0][pt][4 * i4 + 3] * rn * n4.w);
          *(uint2*)(W.Ycat + Rr * 1024 + hg * 64 + p) = o;
        }
      __syncthreads();
    XCD_END
}

DI void ph5_outproj(KArgP kp, int l, unsigned char* lds) {
  const Params P = load_params(kp); WS W; ws_init(W, P.ws);
  const int tid = fresh_tid();
  const int nb = gridDim.x, bid = blockIdx.x;
  const int upx = (l == 0) ? 72 : 64;
  XCD_LOOP(upx, xcd, idx)
    const int mt = xcd * 9 + (idx >> 3) + (l == 0 ? 0 : 1), nt = idx & 7;
    gemm_tile_to_lds(W.Ycat, W.WoutT + (size_t)l * 1024 * 1024, mt * 256, nt * 128, lds);
    float v[64];
    load_row64(lds, v);
    const size_t R = (size_t)mt * 256 + (tid >> 1);
    float ss = 0.f;
#pragma unroll
    for (int j = 0; j < 64; ++j) ss += v[j] * v[j];
    W.Opart[R * 16 + nt * 2 + (tid & 1)] = ss;
    store64(W.Obuf + R * 1024 + nt * 128 + (tid & 1) * 64, v);
    __syncthreads();
  XCD_END
}

DI void ph6_post(KArgP kp, int l) {
  const Params P = load_params(kp); WS W; ws_init(W, P.ws);
  const int tid = fresh_tid(), lane = tid & 63, w = tid >> 6;
  const int nb = gridDim.x, bid = blockIdx.x;
  (void)lane; (void)w; (void)tid;
    XCD_LOOP(288, xcd, idx)
      const int R = xcd * TT + idx * 8 + w;
      const int b = xcd, t = idx * 8 + w;
      const bool isctx = t < 256;
      if (l == 1 && isctx) continue;
      const float* md = W.mod + ((size_t)l * 9 + (isctx ? 8 : b)) * 3072;
      const float* hsrc;
      if (isctx) hsrc = P.in[2] + ((size_t)b * 256 + t) * 1024;
      else hsrc = (l == 0 ? P.in[0] : (const float*)P.out) + ((size_t)b * 2048 + (t - 256)) * 1024;
      float pss = (lane < 16) ? W.Opart[(size_t)R * 16 + lane] : 0.f;
#pragma unroll
      for (int d = 8; d >= 1; d >>= 1) pss += __shfl_xor(pss, d);
      pss = __shfl(pss, 0);
      const float rn = rsqrtf(pss * (1.f / 1024.f) + EPS);
      const float* gpost = P.in[7] + l * 1024;
      float4 hn[4];
      float ss = 0.f;
#pragma unroll
      for (int i = 0; i < 4; ++i) {
        const int k = i * 256 + lane * 4;
        const float4 hv = *(const float4*)(hsrc + k);
        const uint2 ov = *(const uint2*)(W.Obuf + (size_t)R * 1024 + k);
        const float4 g4 = *(const float4*)(gpost + k);
        const float4 gt = *(const float4*)(md + 2048 + k);
        hn[i].x = hv.x + gt.x * (bflo(ov.x) * rn * g4.x);
        hn[i].y = hv.y + gt.y * (bfhi(ov.x) * rn * g4.y);
        hn[i].z = hv.z + gt.z * (bflo(ov.y) * rn * g4.z);
        hn[i].w = hv.w + gt.w * (bfhi(ov.y) * rn * g4.w);
        ss += hn[i].x * hn[i].x + hn[i].y * hn[i].y + hn[i].z * hn[i].z + hn[i].w * hn[i].w;
      }
      if (!isctx) {
        float* dst = P.out + ((size_t)b * 2048 + (t - 256)) * 1024;
#pragma unroll
        for (int i = 0; i < 4; ++i) *(float4*)(dst + i * 256 + lane * 4) = hn[i];
      }
      if (l == 0) {
#pragma unroll
        for (int d = 32; d >= 1; d >>= 1) ss += __shfl_xor(ss, d);
        const float r2 = rsqrtf(ss * (1.f / 1024.f) + EPS);
        const float* md1 = W.mod + ((size_t)9 + (isctx ? 8 : b)) * 3072;
        const float* gp = P.in[6] + 1024;
#pragma unroll
        for (int i = 0; i < 4; ++i) {
          const int k = i * 256 + lane * 4;
          const float4 g4 = *(const float4*)(gp + k);
          const float4 sh = *(const float4*)(md1 + k);
          const float4 sc = *(const float4*)(md1 + 1024 + k);
          uint2 o;
          o.x = pk(hn[i].x * r2 * g4.x * (1.f + sc.x) + sh.x, hn[i].y * r2 * g4.y * (1.f + sc.y) + sh.y);
          o.y = pk(hn[i].z * r2 * g4.z * (1.f + sc.z) + sh.z, hn[i].w * r2 * g4.w * (1.f + sc.w) + sh.w);
          *(uint2*)(W.U + (size_t)R * 1024 + k) = o;
        }
      }
    XCD_END
}


DI void grid_barrier(unsigned* bar, unsigned& epoch) {
  asm volatile("s_waitcnt vmcnt(0)" ::: "memory");
  __syncthreads();
  ++epoch;
  if (threadIdx.x == 0) {
    __builtin_amdgcn_fence(__ATOMIC_RELEASE, "agent");
    asm volatile("s_waitcnt vmcnt(0)" ::: "memory");
    const unsigned nb = gridDim.x, bid = blockIdx.x;
    const bool hier = (nb & 7u) == 0u;
    const unsigned ng = hier ? 8u : 1u, per = hier ? (nb >> 3) : nb;
    unsigned* grp = bar + 64 * (1 + (hier ? (bid & 7u) : 0u));
    const unsigned old = __hip_atomic_fetch_add(grp, 1u, __ATOMIC_RELAXED, __HIP_MEMORY_SCOPE_AGENT);
    if (old + 1u == epoch * per) __hip_atomic_fetch_add(bar, 1u, __ATOMIC_RELAXED, __HIP_MEMORY_SCOPE_AGENT);
    const unsigned target = epoch * ng;
    while (__hip_atomic_load(bar, __ATOMIC_RELAXED, __HIP_MEMORY_SCOPE_AGENT) < target) __builtin_amdgcn_s_sleep(1);
    __builtin_amdgcn_fence(__ATOMIC_ACQUIRE, "agent");
    asm volatile("s_waitcnt vmcnt(0)" ::: "memory");
  }
  __syncthreads();
}

__global__ void __launch_bounds__(NT) fwd_mega(Params Parg) {
  extern __shared__ __attribute__((aligned(16))) unsigned char lds[];
  cg::grid_group grid = cg::this_grid();
  KArgP kp = (KArgP)__builtin_amdgcn_kernarg_segment_ptr();
  unsigned* bar = (unsigned*)(Parg.ws + OFF_BAR);
  unsigned epoch = 0;
  if (gridDim.x == 0x7fffffffu) grid.sync();

  ph0_prologue(kp, lds);
  grid_barrier(bar, epoch);

  ph1_prep(kp);
  grid_barrier(bar, epoch);

  for (int l = 0; l < 2; ++l) {
    ph2_inproj(kp, l, lds);
    grid_barrier(bar, epoch);

    ph3_mix(kp, l, lds);
    grid_barrier(bar, epoch);

    ph4a_states(kp);
    grid_barrier(bar, epoch);

    ph4b_yoff(kp, l, lds);
    grid_barrier(bar, epoch);

    ph5_outproj(kp, l, lds);
    grid_barrier(bar, epoch);

    ph6_post(kp, l);
    if (l == 0) grid_barrier(bar, epoch);
  }
}

extern "C" void kernel_launch(void* const* d_in, const int* in_sizes, int n_in,
                              void* d_out, int out_size, void* d_ws, size_t ws_size,
                              hipStream_t stream) {
  static int grid_blocks = 0;
  if (!grid_blocks) {
    int dev = 0, cus = 0, per_cu = 0;
    (void)hipGetDevice(&dev);
    (void)hipDeviceGetAttribute(&cus, hipDeviceAttributeMultiprocessorCount, dev);
    (void)hipFuncSetAttribute((const void*)fwd_mega, hipFuncAttributeMaxDynamicSharedMemorySize, LDS_BYTES);
    (void)hipOccupancyMaxActiveBlocksPerMultiprocessor(&per_cu, (const void*)fwd_mega, NT, LDS_BYTES);
    if (per_cu < 1) per_cu = 1;
    grid_blocks = cus * per_cu;
    if (ws_size < WS_END) fprintf(stderr, "workspace too small: %zu < %zu\n", ws_size, (size_t)WS_END);
  }
  Params p{};
  for (int i = 0; i < 22; ++i) p.in[i] = (const float*)d_in[i];
  p.out = (float*)d_out;
  p.ws = (unsigned char*)d_ws;
  (void)hipMemsetAsync((unsigned char*)d_ws + OFF_BAR, 0, 4096, stream);
  void* args[] = {&p};
  hipError_t e = hipLaunchCooperativeKernel((const void*)fwd_mega, dim3(grid_blocks), dim3(NT), args, LDS_BYTES, stream);
  if (e != hipSuccess) fprintf(stderr, "cooperative launch failed: %s (grid %d)\n", hipGetErrorString(e), grid_blocks);
}
```

```cpp
#include <hip/hip_runtime.h>
#include <hip/hip_cooperative_groups.h>
#include <cstdio>
namespace cg = cooperative_groups;

#define DI __device__ __forceinline__
#define NT 512
static __device__ __forceinline__ int fresh_tid() { int t = threadIdx.x; asm volatile("" : "+v"(t)); return t; }
typedef unsigned short u16;
typedef __attribute__((ext_vector_type(8))) short bf16x8;
typedef __attribute__((ext_vector_type(4))) short s16x4;
typedef __attribute__((ext_vector_type(16))) float f32x16;
typedef __attribute__((ext_vector_type(4))) float f32x4;
typedef __attribute__((ext_vector_type(2))) __bf16 bf2v;
typedef __attribute__((ext_vector_type(2))) float f2v;
typedef unsigned __attribute__((ext_vector_type(4))) u32x4;

#define MFMA32(a, b, c) __builtin_amdgcn_mfma_f32_32x32x16_bf16((a), (b), (c), 0, 0, 0)
#define MFMA16(a, b, c) __builtin_amdgcn_mfma_f32_16x16x32_bf16((a), (b), (c), 0, 0, 0)

constexpr int LDS_BYTES = 140 * 1024;
constexpr int TT = 2304;
constexpr int RR = 18432;
constexpr int NPAD = 3456;
constexpr float EPS = 1e-6f;
constexpr float LOG2E = 1.4426950408889634f;

constexpr size_t SZ_WIN = (size_t)2 * NPAD * 1024 * 2;
constexpr size_t SZ_WOUT = (size_t)2 * 1024 * 1024 * 2;
constexpr size_t SZ_MOD = (size_t)2 * 9 * 3072 * 4;
constexpr size_t SZ_ROPE = 16384;
constexpr size_t SZ_R1024 = (size_t)RR * 1024 * 2;
constexpr size_t SZ_R512 = (size_t)RR * 512 * 2;
constexpr size_t SZ_R256 = (size_t)RR * 256 * 2;
constexpr size_t OFF_WIN = 0;
constexpr size_t OFF_WOUT = OFF_WIN + SZ_WIN;
constexpr size_t OFF_MOD = OFF_WOUT + SZ_WOUT;
constexpr size_t OFF_ROPE = OFF_MOD + SZ_MOD;
constexpr size_t OFF_U = OFF_ROPE + SZ_ROPE;
constexpr size_t OFF_XBC = OFF_U + SZ_R1024;
constexpr size_t OFF_Z = OFF_XBC + SZ_R1024;
constexpr size_t OFF_DT = OFF_Z + SZ_R512;
constexpr size_t SZ_DT = (size_t)RR * 16 * 4;
constexpr size_t OFF_Q = OFF_DT + SZ_DT;
constexpr size_t SZ_Q = (size_t)8 * 4 * TT * 64 * 2;
constexpr size_t OFF_K = OFF_Q + SZ_Q;
constexpr size_t SZ_K = (size_t)8 * 2 * TT * 64 * 2;
constexpr size_t OFF_VT = OFF_K + SZ_K;
constexpr size_t OFF_DQ = OFF_VT + SZ_K;
constexpr size_t SZ_DQ = (size_t)8 * 8 * TT * 32 * 2;
constexpr size_t OFF_DK = OFF_DQ + SZ_DQ;
constexpr size_t OFF_DVT = OFF_DK + SZ_DQ;
constexpr size_t SZ_DVT = (size_t)8 * 4 * 64 * TT * 2;
constexpr size_t OFF_GG = OFF_DVT + SZ_DVT;
constexpr size_t OFF_DG = OFF_GG + SZ_R256;
constexpr size_t OFF_CC = OFF_DG + SZ_R256;
constexpr size_t OFF_CUMF = OFF_CC + SZ_R256;
constexpr size_t SZ_CUM = (size_t)RR * 8 * 4;
constexpr size_t OFF_CUMB = OFF_CUMF + SZ_CUM;
constexpr size_t OFF_SLOC = OFF_CUMB + SZ_CUM;
constexpr size_t SZ_ST = (size_t)2 * 8 * 18 * 8 * 8192 * 2;
constexpr size_t OFF_OPART = OFF_SLOC + SZ_ST;
constexpr size_t OFF_BAR = OFF_OPART + SZ_DT;
constexpr size_t WS_END = OFF_BAR + 16384;
static_assert(SZ_ST <= (OFF_GG - OFF_Q), "Stin must fit in the q/k/v region");
static_assert(WS_END <= (size_t)256 * 1024 * 1024, "workspace");

struct Params {
  const float* in[22];
  float* out;
  unsigned char* ws;
};

struct WS {
  u16 *WinT, *WoutT, *U, *Ycat, *XBC, *Obuf, *Z, *Q, *K, *Vt, *DQ, *DK, *DVt, *GG, *DG, *Cc, *Sloc, *Stin;
  float *mod, *DT, *cumF, *cumB, *Opart;
  float2 *ropeG, *ropeD;
};

DI unsigned pk(float a, float b) { f2v v = {a, b}; return __builtin_bit_cast(unsigned, __builtin_convertvector(v, bf2v)); }
DI u16 f2bf(float a) { return (u16)(pk(a, 0.f) & 0xffffu); }
DI float bf2f(u16 b) { return __uint_as_float(((unsigned)b) << 16); }
DI float bflo(unsigned u) { return __uint_as_float(u << 16); }
DI float bfhi(unsigned u) { return __uint_as_float(u & 0xffff0000u); }
DI float silu(float x) { return x / (1.f + __expf(-x)); }
DI float softplus(float x) { return fmaxf(x, 0.f) + log1pf(__expf(-fabsf(x))); }
DI float fexp2(float x) { return __builtin_amdgcn_exp2f(x); }

DI void store64(u16* dst, const float (&v)[64]) {
#pragma unroll
  for (int i = 0; i < 8; ++i) {
    uint4 u;
    u.x = pk(v[8 * i], v[8 * i + 1]); u.y = pk(v[8 * i + 2], v[8 * i + 3]);
    u.z = pk(v[8 * i + 4], v[8 * i + 5]); u.w = pk(v[8 * i + 6], v[8 * i + 7]);
    ((uint4*)dst)[i] = u;
  }
}

struct GRegs { u32x4 a0, a1, a2, a3, b0, b1; };
DI void g_load(GRegs& R, const u16* ag, const u16* bg, int k0) {
  constexpr size_t K = 1024;
  R.a0 = *(const u32x4*)(ag + k0);
  R.a1 = *(const u32x4*)(ag + 64 * K + k0);
  R.a2 = *(const u32x4*)(ag + 128 * K + k0);
  R.a3 = *(const u32x4*)(ag + 192 * K + k0);
  R.b0 = *(const u32x4*)(bg + k0);
  R.b1 = *(const u32x4*)(bg + 64 * K + k0);
}
DI void g_store(const GRegs& R, u16* as, u16* bs) {
  *(u32x4*)(as) = R.a0;
  *(u32x4*)(as + 64 * 72) = R.a1;
  *(u32x4*)(as + 128 * 72) = R.a2;
  *(u32x4*)(as + 192 * 72) = R.a3;
  *(u32x4*)(bs) = R.b0;
  *(u32x4*)(bs + 64 * 72) = R.b1;
}
DI void g_compute(const u16* as, const u16* bs, f32x16 (&acc)[2][2]) {
#pragma unroll
  for (int ks = 0; ks < 4; ++ks) {
    bf16x8 a0 = *(const bf16x8*)(as + 16 * ks);
    bf16x8 a1 = *(const bf16x8*)(as + 32 * 72 + 16 * ks);
    bf16x8 b0 = *(const bf16x8*)(bs + 16 * ks);
    bf16x8 b1 = *(const bf16x8*)(bs + 32 * 72 + 16 * ks);
    acc[0][0] = MFMA32(a0, b0, acc[0][0]);
    acc[0][1] = MFMA32(a0, b1, acc[0][1]);
    acc[1][0] = MFMA32(a1, b0, acc[1][0]);
    acc[1][1] = MFMA32(a1, b1, acc[1][1]);
  }
}
constexpr int G_LDK = 72;
constexpr int G_CST = 132;
DI void gemm_tile_to_lds(const u16* __restrict__ A, const u16* __restrict__ Bt, int m0, int n0, unsigned char* lds) {
  constexpr int K = 1024;
  u16* As = (u16*)lds;
  u16* Bs = (u16*)(lds + 2 * 256 * G_LDK * 2);
  const int tid = fresh_tid(), lane = tid & 63, w = tid >> 6;
  const int r = lane & 31, h = lane >> 5;
  const int wm = w >> 1, wn = w & 1;
  const int arow = tid >> 3, akc = tid & 7;
  const u16* ag = A + (size_t)(m0 + arow) * K + akc * 8;
  const u16* bg = Bt + (size_t)(n0 + arow) * K + akc * 8;
  f32x16 acc[2][2];
#pragma unroll
  for (int i = 0; i < 2; ++i)
#pragma unroll
    for (int j = 0; j < 2; ++j)
#pragma unroll
      for (int e = 0; e < 16; ++e) acc[i][j][e] = 0.f;
  GRegs R0, R1;
  g_load(R0, ag, bg, 0);
  g_load(R1, ag, bg, 64);
  g_store(R0, As + arow * G_LDK + akc * 8, Bs + arow * G_LDK + akc * 8);
  __syncthreads();
  const u16* as0 = As + (64 * wm + r) * G_LDK + 8 * h;
  const u16* bs0 = Bs + (64 * wn + r) * G_LDK + 8 * h;
  for (int kt2 = 0; kt2 < 16; kt2 += 2) {
    if (kt2 + 2 < 16) g_load(R0, ag, bg, (kt2 + 2) * 64);
    g_compute(as0, bs0, acc);
    g_store(R1, As + 256 * G_LDK + arow * G_LDK + akc * 8, Bs + 128 * G_LDK + arow * G_LDK + akc * 8);
    __syncthreads();
    if (kt2 + 3 < 16) g_load(R1, ag, bg, (kt2 + 3) * 64);
    g_compute(as0 + 256 * G_LDK, bs0 + 128 * G_LDK, acc);
    if (kt2 + 2 < 16) g_store(R0, As + arow * G_LDK + akc * 8, Bs + arow * G_LDK + akc * 8);
    __syncthreads();
  }
  float* Cst = (float*)lds;
#pragma unroll
  for (int i = 0; i < 2; ++i)
#pragma unroll
    for (int j = 0; j < 2; ++j)
#pragma unroll
      for (int e = 0; e < 16; ++e) {
        const int row = 64 * wm + 32 * i + (e & 3) + 8 * (e >> 2) + 4 * h;
        Cst[row * G_CST + 64 * wn + 32 * j + r] = acc[i][j][e];
      }
  __syncthreads();
}

DI void load_row64(const unsigned char* lds, float (&v)[64]) {
  const int tid = fresh_tid();
  const float* src = (const float*)lds + (tid >> 1) * G_CST + (tid & 1) * 64;
#pragma unroll
  for (int i = 0; i < 16; ++i) {
    float4 f = ((const float4*)src)[i];
    v[4 * i] = f.x; v[4 * i + 1] = f.y; v[4 * i + 2] = f.z; v[4 * i + 3] = f.w;
  }
}

DI void inproj_epi(const Params& P, const WS& W, int l, int R, int nt, int half, float (&v)[64]) {
  const int b = R / TT;
  const int t = R - b * TT;
  if (nt < 8) {
    store64(W.XBC + (size_t)R * 1024 + nt * 128 + half * 64, v);
  } else if (nt < 12) {
    store64(W.Z + (size_t)R * 512 + (nt - 8) * 128 + half * 64, v);
  } else if (nt < 15) {
    const bool isq = nt < 14;
    const float* g = (isq ? P.in[17] : P.in[18]) + l * 64;
    float ss = 0.f;
#pragma unroll
    for (int j = 0; j < 64; ++j) ss += v[j] * v[j];
    const float rn = rsqrtf(ss * (1.f / 64.f) + EPS);
#pragma unroll
    for (int j = 0; j < 64; ++j) { if ((j & 15) == 0) __builtin_amdgcn_sched_barrier(0); v[j] = v[j] * rn * g[j]; }
    if (t >= 256) {
      const int pos = t - 256, ri = pos >> 6, ci = pos & 63;
#pragma unroll
      for (int i = 0; i < 32; ++i) {
        if ((i & 7) == 0) __builtin_amdgcn_sched_barrier(0);
        const float2 cs = (i < 16) ? W.ropeG[ri * 16 + i] : W.ropeG[ci * 16 + (i - 16)];
        const float x1 = v[i], x2 = v[i + 32];
        v[i] = x1 * cs.x - x2 * cs.y;
        v[i + 32] = x2 * cs.x + x1 * cs.y;
      }
    }
    if (isq) {
      const float sc = 0.125f * LOG2E;
#pragma unroll
      for (int j = 0; j < 64; ++j) v[j] *= sc;
      const int head = (nt - 12) * 2 + half;
      store64(W.Q + ((size_t)(b * 4 + head) * TT + t) * 64, v);
    } else {
      store64(W.K + ((size_t)(b * 2 + half) * TT + t) * 64, v);
    }
  } else if (nt == 15) {
    u16* dst = W.Vt + ((size_t)(b * 2 + half) * 64) * TT + t;
#pragma unroll
    for (int j = 0; j < 64; ++j) { if ((j & 7) == 0) __builtin_amdgcn_sched_barrier(0); dst[(size_t)j * TT] = f2bf(v[j]); }
  } else if (nt < 18) {
#pragma unroll
    for (int j = 0; j < 64; ++j) v[j] = silu(v[j]);
    store64(W.GG + (size_t)R * 256 + (nt - 16) * 128 + half * 64, v);
  } else if (nt < 22) {
    const bool isq = nt < 20;
    const int mbase = (nt - (isq ? 18 : 20)) * 4 + half * 2;
    if (t >= 256) {
      const int pos = t - 256, ri = pos >> 6, ci = pos & 63;
#pragma unroll
      for (int mm = 0; mm < 2; ++mm)
#pragma unroll
        for (int i = 0; i < 16; ++i) {
          if ((i & 7) == 0) __builtin_amdgcn_sched_barrier(0);
          const float2 cs = (i < 8) ? W.ropeD[ri * 8 + i] : W.ropeD[ci * 8 + (i - 8)];
          const float x1 = v[32 * mm + i], x2 = v[32 * mm + i + 16];
          v[32 * mm + i] = x1 * cs.x - x2 * cs.y;
          v[32 * mm + i + 16] = x2 * cs.x + x1 * cs.y;
        }
    }
    if (isq) {
      const float sc = 0.17677669529663687f * LOG2E;
#pragma unroll
      for (int j = 0; j < 64; ++j) v[j] *= sc;
    }
    u16* base = isq ? W.DQ : W.DK;
#pragma unroll
    for (int mm = 0; mm < 2; ++mm) {
      u16* dst = base + ((size_t)(b * 8 + mbase + mm) * TT + t) * 32;
#pragma unroll
      for (int i = 0; i < 4; ++i) {
        uint4 u;
        u.x = pk(v[32 * mm + 8 * i], v[32 * mm + 8 * i + 1]); u.y = pk(v[32 * mm + 8 * i + 2], v[32 * mm + 8 * i + 3]);
        u.z = pk(v[32 * mm + 8 * i + 4], v[32 * mm + 8 * i + 5]); u.w = pk(v[32 * mm + 8 * i + 6], v[32 * mm + 8 * i + 7]);
        ((uint4*)dst)[i] = u;
      }
    }
  } else if (nt < 24) {
    const int head = (nt - 22) * 2 + half;
    u16* dst = W.DVt + ((size_t)(b * 4 + head) * 64) * TT + t;
#pragma unroll
    for (int j = 0; j < 64; ++j) { if ((j & 7) == 0) __builtin_amdgcn_sched_barrier(0); dst[(size_t)j * TT] = f2bf(v[j]); }
  } else if (nt < 26) {
#pragma unroll
    for (int j = 0; j < 64; ++j) v[j] = silu(v[j]);
    store64(W.DG + (size_t)R * 256 + (nt - 24) * 128 + half * 64, v);
  } else if (nt == 26) {
    if (half == 0) {
      const float* bf = P.in[13] + l * 8;
      const float* bb = P.in[14] + l * 8;
#pragma unroll
      for (int j = 0; j < 16; ++j) {
        const float x = v[j] + (j < 8 ? bf[j] : bb[j - 8]);
        W.DT[(size_t)R * 16 + j] = softplus(x);
      }
    }
  }
}

template <int D, bool BOUNDED>
DI void attn_core(const u16* __restrict__ Qh, const u16* __restrict__ Kh, const u16* __restrict__ Vth, int q0, int nkeys,
                  float bound, unsigned char* lds, f32x16 (&O)[2], float& lout) {
  constexpr int KP = D + 8;
  constexpr int KS = D / 16;
  u16* Ks = (u16*)lds;
  constexpr int VP = 68;
  u16* Vs = (u16*)(lds + 2 * 64 * 72 * 2);
  const int tid = fresh_tid(), lane = tid & 63, w = tid >> 6;
  const int r = lane & 31, h = lane >> 5;
  bf16x8 qf[KS];
  {
    const u16* qp = Qh + (size_t)(q0 + 32 * w + r) * D + 8 * h;
#pragma unroll
    for (int ks = 0; ks < KS; ++ks) qf[ks] = *(const bf16x8*)(qp + 16 * ks);
  }
#pragma unroll
  for (int e = 0; e < 16; ++e) { O[0][e] = 0.f; O[1][e] = 0.f; }
  float m = BOUNDED ? bound : 0.f, lsum = 0.f;
  const int krow = (D == 64) ? (tid >> 3) : (tid >> 2);
  const int kc = (D == 64) ? (tid & 7) : (tid & 3);
  const bool kact = (D == 64) ? true : (tid < 256);
  const int vrow = tid >> 3, vc = tid & 7;
  const u16* kg = Kh + (size_t)krow * D + kc * 8;
  const u16* vg = Vth + (size_t)vrow * TT + vc * 8;
  u32x4 rk0 = (u32x4){0u, 0u, 0u, 0u}, rk1 = rk0, rv0, rv1;
  const int nk = nkeys >> 6;
  if (kact) rk0 = *(const u32x4*)kg;
  rv0 = *(const u32x4*)vg;
  __builtin_amdgcn_s_waitcnt(0x0F70);
  if (kact) *(u32x4*)&Ks[krow * KP + kc * 8] = rk0;
  { const u32x4 t_ = rv0; *(uint2*)&Vs[vrow * VP + vc * 8] = make_uint2(t_.x, t_.y); *(uint2*)&Vs[vrow * VP + vc * 8 + 4] = make_uint2(t_.z, t_.w); }
  if (kact) rk1 = *(const u32x4*)(kg + (size_t)64 * D);
  rv1 = *(const u32x4*)(vg + 64);
  __syncthreads();
  for (int kt2 = 0; kt2 < nk; kt2 += 2) {
#pragma unroll
  for (int ph = 0; ph < 2; ++ph) {
    const int kt = kt2 + ph;
    const int cur = ph;
    {
      const int tx = min(kt + 2, nk - 1);
      if (ph == 0) {
        if (kact) rk0 = *(const u32x4*)(kg + (size_t)tx * 64 * D);
        rv0 = *(const u32x4*)(vg + tx * 64);
      } else {
        if (kact) rk1 = *(const u32x4*)(kg + (size_t)tx * 64 * D);
        rv1 = *(const u32x4*)(vg + tx * 64);
      }
    }
    __builtin_amdgcn_sched_barrier(0);
    const u16* ks_ = Ks + cur * 64 * KP + r * KP + 8 * h;
    bf16x8 kf0[KS], kf1[KS];
#pragma unroll
    for (int ks = 0; ks < KS; ++ks) {
      kf0[ks] = *(const bf16x8*)(ks_ + 16 * ks);
      kf1[ks] = *(const bf16x8*)(ks_ + 32 * KP + 16 * ks);
    }
    const u16* vs_ = Vs + cur * 64 * VP + r * VP + 4 * h;
    bf16x8 vf[8];
#pragma unroll
    for (int s = 0; s < 2; ++s)
#pragma unroll
      for (int dt = 0; dt < 2; ++dt) {
        const u16* vp = vs_ + dt * 32 * VP + 16 * s;
        s16x4 lo = *(const s16x4*)vp;
        s16x4 hi = *(const s16x4*)(vp + 8);
        vf[s * 2 + dt] = __builtin_shufflevector(lo, hi, 0, 1, 2, 3, 4, 5, 6, 7);
      }
    __builtin_amdgcn_sched_barrier(0);
    f32x16 S[2];
    {
      const float nm = -m;
#pragma unroll
      for (int e = 0; e < 16; ++e) { S[0][e] = nm; S[1][e] = nm; }
    }
#pragma unroll
    for (int ks = 0; ks < KS; ++ks) {
      S[0] = MFMA32(kf0[ks], qf[ks], S[0]);
      S[1] = MFMA32(kf1[ks], qf[ks], S[1]);
    }
    __builtin_amdgcn_sched_barrier(0);
#pragma unroll
    for (int s = 0; s < 2; ++s)
#pragma unroll
      for (int dt = 0; dt < 2; ++dt) {
        const u16* vp = vs_ + dt * 32 * VP + 32 + 16 * s;
        s16x4 lo = *(const s16x4*)vp;
        s16x4 hi = *(const s16x4*)(vp + 8);
        vf[(2 + s) * 2 + dt] = __builtin_shufflevector(lo, hi, 0, 1, 2, 3, 4, 5, 6, 7);
      }
    __builtin_amdgcn_sched_barrier(0);
    if (!BOUNDED) {
      float t0 = fmaxf(fmaxf(S[0][0], S[0][1]), S[0][2]);
      float t1 = fmaxf(fmaxf(S[1][0], S[1][1]), S[1][2]);
#pragma unroll
      for (int e = 3; e < 15; e += 2) { t0 = fmaxf(fmaxf(t0, S[0][e]), S[0][e + 1]); t1 = fmaxf(fmaxf(t1, S[1][e]), S[1][e + 1]); }
      float tm = fmaxf(fmaxf(t0, t1), fmaxf(S[0][15], S[1][15]));
      tm = fmaxf(tm, __shfl_xor(tm, 32));
      const bool first = (kt == 0);
      if (first || __any(tm > 0.f)) {
        const float adj = first ? tm : fmaxf(tm, 0.f);
        const float alpha = first ? 1.f : fexp2(-adj);
        m += adj;
        lsum *= alpha;
#pragma unroll
        for (int e = 0; e < 16; ++e) { O[0][e] *= alpha; O[1][e] *= alpha; S[0][e] -= adj; S[1][e] -= adj; }
      }
    }
    float rs = 0.f;
#pragma unroll
    for (int e = 0; e < 16; ++e) { S[0][e] = fexp2(S[0][e]); rs += S[0][e]; }
#pragma unroll
    for (int e = 0; e < 16; ++e) { S[1][e] = fexp2(S[1][e]); rs += S[1][e]; }
    lsum += rs;
#pragma unroll
    for (int t2 = 0; t2 < 2; ++t2)
#pragma unroll
      for (int s = 0; s < 2; ++s) {
        uint4 pu;
        pu.x = pk(S[t2][8 * s], S[t2][8 * s + 1]); pu.y = pk(S[t2][8 * s + 2], S[t2][8 * s + 3]);
        pu.z = pk(S[t2][8 * s + 4], S[t2][8 * s + 5]); pu.w = pk(S[t2][8 * s + 6], S[t2][8 * s + 7]);
        const bf16x8 pb = __builtin_bit_cast(bf16x8, pu);
        O[0] = MFMA32(vf[(t2 * 2 + s) * 2 + 0], pb, O[0]);
        O[1] = MFMA32(vf[(t2 * 2 + s) * 2 + 1], pb, O[1]);
      }
    if (kt + 1 < nk) {
      const int nx = cur ^ 1;
      if (kact) *(u32x4*)&Ks[nx * 64 * KP + krow * KP + kc * 8] = (ph == 0) ? rk1 : rk0;
      { const u32x4 t_ = (ph == 0) ? rv1 : rv0; *(uint2*)&Vs[nx * 64 * VP + vrow * VP + vc * 8] = make_uint2(t_.x, t_.y); *(uint2*)&Vs[nx * 64 * VP + vrow * VP + vc * 8 + 4] = make_uint2(t_.z, t_.w); }
    }
    __syncthreads();
  }
  }
  lout = lsum + __shfl_xor(lsum, 32);
}

DI void gqa_unit(const WS& W, const float* qg, const float* kg_, int b, int head, int qb, unsigned char* lds) {
  const int tid = fresh_tid(), lane = tid & 63, w = tid >> 6, r = lane & 31, h = lane >> 5;
  const int q0 = qb * 256;
  const int nkeys = (qb == 0) ? 256 : TT;
  f32x16 O[2];
  float l;
  float bound;
  {
    float gq = fabsf(qg[lane]), gk = fabsf(kg_[lane]);
#pragma unroll
    for (int d = 32; d >= 1; d >>= 1) { gq = fmaxf(gq, __shfl_xor(gq, d)); gk = fmaxf(gk, __shfl_xor(gk, d)); }
    bound = 8.f * LOG2E * gq * gk * 1.02f + 0.25f;
  }
  attn_core<64, true>(W.Q + (size_t)(b * 4 + head) * TT * 64, W.K + (size_t)(b * 2 + (head >> 1)) * TT * 64,
                      W.Vt + (size_t)(b * 2 + (head >> 1)) * 64 * TT, q0, nkeys, bound, lds, O, l);
  const float il = 1.f / l;
  const size_t Rr = (size_t)b * TT + q0 + 32 * w + r;
#pragma unroll
  for (int dt = 0; dt < 2; ++dt)
#pragma unroll
    for (int i4 = 0; i4 < 4; ++i4) {
      const int dv = 32 * dt + 8 * i4 + 4 * h;
      const uint2 g = *(const uint2*)(W.GG + Rr * 256 + head * 64 + dv);
      uint2 o;
      o.x = pk(O[dt][4 * i4] * il * bflo(g.x), O[dt][4 * i4 + 1] * il * bfhi(g.x));
      o.y = pk(O[dt][4 * i4 + 2] * il * bflo(g.y), O[dt][4 * i4 + 3] * il * bfhi(g.y));
      *(uint2*)(W.Ycat + Rr * 1024 + 512 + head * 64 + dv) = o;
    }
}

DI void diff_unit(const Params& P, const WS& W, int l, int b, int hh, int qb, unsigned char* lds) {
  const int tid = fresh_tid(), lane = tid & 63, w = tid >> 6, r = lane & 31, h = lane >> 5;
  const int q0 = qb * 256;
  const int nkeys = (qb == 0) ? 256 : TT;
  const float lam_init = (l == 0) ? 0.2f : 0.35550906759f;
  float lam;
  {
    const float* lp = P.in[19] + l * 128;
    float s1 = (lane < 32) ? lp[lane] * lp[32 + lane] : 0.f;
    float s2 = (lane < 32) ? lp[64 + lane] * lp[96 + lane] : 0.f;
#pragma unroll
    for (int d = 32; d >= 1; d >>= 1) { s1 += __shfl_xor(s1, d); s2 += __shfl_xor(s2, d); }
    lam = __expf(s1) - __expf(s2) + lam_init;
  }
  f32x16 O1[2], O2[2];
  float l1, l2;
  const u16* vt = W.DVt + (size_t)(b * 4 + hh) * 64 * TT;
  attn_core<32, false>(W.DQ + (size_t)(b * 8 + 2 * hh) * TT * 32, W.DK + (size_t)(b * 8 + 2 * hh) * TT * 32, vt, q0, nkeys, 0.f, lds, O1, l1);
  attn_core<32, false>(W.DQ + (size_t)(b * 8 + 2 * hh + 1) * TT * 32, W.DK + (size_t)(b * 8 + 2 * hh + 1) * TT * 32, vt, q0, nkeys, 0.f, lds, O2, l2);
  const float i1 = 1.f / l1, i2 = lam / l2;
  float ss = 0.f;
#pragma unroll
  for (int dt = 0; dt < 2; ++dt)
#pragma unroll
    for (int e = 0; e < 16; ++e) {
      const float o = O1[dt][e] * i1 - O2[dt][e] * i2;
      O1[dt][e] = o;
      ss += o * o;
    }
  ss += __shfl_xor(ss, 32);
  const float rn = rsqrtf(ss * (1.f / 64.f) + EPS) * (1.f - lam_init);
  const float* ng = P.in[20] + l * 64;
  const size_t Rr = (size_t)b * TT + q0 + 32 * w + r;
#pragma unroll
  for (int dt = 0; dt < 2; ++dt)
#pragma unroll
    for (int i4 = 0; i4 < 4; ++i4) {
      const int dv = 32 * dt + 8 * i4 + 4 * h;
      const uint2 g = *(const uint2*)(W.DG + Rr * 256 + hh * 64 + dv);
      const float4 n4 = *(const float4*)(ng + dv);
      uint2 o;
      o.x = pk(O1[dt][4 * i4] * rn * n4.x * bflo(g.x), O1[dt][4 * i4 + 1] * rn * n4.y * bfhi(g.x));
      o.y = pk(O1[dt][4 * i4 + 2] * rn * n4.z * bflo(g.y), O1[dt][4 * i4 + 3] * rn * n4.w * bfhi(g.y));
      *(uint2*)(W.Ycat + Rr * 1024 + 768 + hh * 64 + dv) = o;
    }
}

DI void ssd_xload(uint2 (&raw)[8], const u16* src, int tb, int seg_lo, int seg_hi) {
#pragma unroll
  for (int i = 0; i < 8; ++i) {
    const int t = tb - 2 + i;
    const int tc = min(max(t, seg_lo), seg_hi - 1);
    uint2 v = *(const uint2*)(src + (size_t)tc * 1024);
    if (t < seg_lo || t >= seg_hi) v = make_uint2(0u, 0u);
    raw[i] = v;
  }
}
constexpr int S_LD = 136;
DI void ssd_local_unit(const Params& P, const WS& W, int l, int b, int c, int g, unsigned char* lds) {
  const int tid = fresh_tid(), lane = tid & 63, w = tid >> 6;
  u16* BsT = (u16*)lds;
  u16* Bs = (u16*)(lds + 34816);
  u16* Cs = (u16*)(lds + 69632);
  u16* xT = (u16*)(lds + 34816);
  u16* xsF = (u16*)(lds + 52224);
  u16* xsB = (u16*)(lds + 69632);
  float* cumF = (float*)(lds + 104448);
  float* cumB = cumF + 512;
  float* dtF = cumB + 512;
  float* dtB = dtF + 512;
  const size_t Rc0 = (size_t)b * TT + c * 128;
  const int seg_lo = (c < 2) ? 0 : 256;
  const int seg_hi = (c < 2) ? 256 : TT;
  const float* conv_w = P.in[9] + (size_t)l * 5 * 1024;
  const float* conv_b = P.in[10] + (size_t)l * 1024;
  const int cqB = lane;
  const bool isB = cqB < 32;
  const int ch0 = isB ? 4 * cqB : 4 * (cqB - 32);
  float4 wjB[5];
  float4 biasB;
  uint2 rawB[20];
  {
    const int col = (isB ? 512 : 768) + g * 128 + ch0;
#pragma unroll
    for (int j = 0; j < 5; ++j) wjB[j] = *(const float4*)(conv_w + j * 1024 + col);
    biasB = *(const float4*)(conv_b + col);
    const u16* src = W.XBC + (size_t)b * TT * 1024 + col;
    const int tb = c * 128 + 16 * w;
#pragma unroll
    for (int i = 0; i < 20; ++i) {
      const int t = tb - 2 + i;
      const int tc = min(max(t, seg_lo), seg_hi - 1);
      uint2 v = *(const uint2*)(src + (size_t)tc * 1024);
      if (t < seg_lo || t >= seg_hi) v = make_uint2(0u, 0u);
      rawB[i] = v;
    }
  }
  uint2 xraw[8];
  ssd_xload(xraw, W.XBC + (size_t)b * TT * 1024 + (g * 4) * 64 + 4 * (tid & 15), c * 128 + 4 * (tid >> 4), seg_lo, seg_hi);
  float4 xw[5], xbias;
  {
    const int col = (g * 4) * 64 + 4 * (tid & 15);
#pragma unroll
    for (int j = 0; j < 5; ++j) xw[j] = *(const float4*)(conv_w + j * 1024 + col);
    xbias = *(const float4*)(conv_b + col);
  }
  {
    const int hh = w & 3, dir = w >> 2, hg = g * 4 + hh;
    const float a = -__expf((dir ? P.in[12] : P.in[11])[l * 8 + hg]);
    const float d0 = W.DT[(Rc0 + 2 * lane) * 16 + dir * 8 + hg];
    const float d1 = W.DT[(Rc0 + 2 * lane + 1) * 16 + dir * 8 + hg];
    const float a0 = d0 * a, a1 = d1 * a;
    float v = a0 + a1;
    float c0, c1;
    if (dir == 0) {
#pragma unroll
      for (int d = 1; d < 64; d <<= 1) { const float t = __shfl_up(v, d); if (lane >= d) v += t; }
      c0 = v - a1; c1 = v;
    } else {
#pragma unroll
      for (int d = 1; d < 64; d <<= 1) { const float t = __shfl_down(v, d); if (lane + d < 64) v += t; }
      c0 = v; c1 = v - a0;
    }
    float* lc = cumF + dir * 512 + hh * 128 + 2 * lane;
    lc[0] = c0; lc[1] = c1;
    lc[1024] = d0; lc[1025] = d1;
    float* gc = W.cumF + (size_t)dir * ((size_t)RR * 8) + (Rc0 + 2 * lane) * 8 + hg;
    gc[0] = c0; gc[8] = c1;
  }
  {
    float y[4][16];
#pragma unroll
    for (int s2 = 0; s2 < 16; ++s2) {
      float a0 = biasB.x, a1 = biasB.y, a2 = biasB.z, a3 = biasB.w;
#pragma unroll
      for (int j = 0; j < 5; ++j) {
        const uint2 v = rawB[s2 + j];
        a0 += wjB[j].x * bflo(v.x); a1 += wjB[j].y * bfhi(v.x); a2 += wjB[j].z * bflo(v.y); a3 += wjB[j].w * bfhi(v.y);
      }
      y[0][s2] = silu(a0); y[1][s2] = silu(a1); y[2][s2] = silu(a2); y[3][s2] = silu(a3);
    }
    const int s0 = 16 * w;
    if (isB) {
#pragma unroll
      for (int s2 = 0; s2 < 16; ++s2) {
        uint2 o; o.x = pk(y[0][s2], y[1][s2]); o.y = pk(y[2][s2], y[3][s2]);
        *(uint2*)&Bs[(s0 + s2) * S_LD + ch0] = o;
      }
#pragma unroll
      for (int ch = 0; ch < 4; ++ch) {
        uint4 u0, u1;
        u0.x = pk(y[ch][0], y[ch][1]); u0.y = pk(y[ch][2], y[ch][3]); u0.z = pk(y[ch][4], y[ch][5]); u0.w = pk(y[ch][6], y[ch][7]);
        u1.x = pk(y[ch][8], y[ch][9]); u1.y = pk(y[ch][10], y[ch][11]); u1.z = pk(y[ch][12], y[ch][13]); u1.w = pk(y[ch][14], y[ch][15]);
        *(uint4*)&BsT[(ch0 + ch) * S_LD + s0] = u0;
        *(uint4*)&BsT[(ch0 + ch) * S_LD + s0 + 8] = u1;
      }
    } else {
#pragma unroll
      for (int s2 = 0; s2 < 16; ++s2) {
        uint2 o; o.x = pk(y[0][s2], y[1][s2]); o.y = pk(y[2][s2], y[3][s2]);
        *(uint2*)&Cs[(s0 + s2) * S_LD + ch0] = o;
        *(uint2*)(W.Cc + (Rc0 + s0 + s2) * 256 + g * 128 + ch0) = o;
      }
    }
  }
  __syncthreads();
  const int c16 = lane & 15, q = lane >> 4;
  f32x4 G[8];
#pragma unroll
  for (int st = 0; st < 8; ++st) G[st] = (f32x4){0.f, 0.f, 0.f, 0.f};
#pragma unroll
  for (int ks = 0; ks < 4; ++ks) {
    const bf16x8 bfrag = *(const bf16x8*)&Cs[(16 * w + c16) * S_LD + 32 * ks + 8 * q];
#pragma unroll
    for (int st = 0; st < 8; ++st) {
      const bf16x8 afrag = *(const bf16x8*)&Bs[(16 * st + c16) * S_LD + 32 * ks + 8 * q];
      G[st] = MFMA16(afrag, bfrag, G[st]);
    }
  }
  __syncthreads();
  for (int hh = 0; hh < 4; ++hh) {
    const int hg = g * 4 + hh;
    {
      const int cq = tid & 15, tg = tid >> 4;
      const int col = hg * 64 + 4 * cq;
      float4 wj[5];
#pragma unroll
      for (int j = 0; j < 5; ++j) wj[j] = xw[j];
      const float4 bias = xbias;
      (void)col;
      const float cF_end = cumF[hh * 128 + 127], cB_end = cumB[hh * 128];
      float y[4][4], ff[4], fb[4];
#pragma unroll
      for (int s2 = 0; s2 < 4; ++s2) {
        float a0 = bias.x, a1 = bias.y, a2 = bias.z, a3 = bias.w;
#pragma unroll
        for (int j = 0; j < 5; ++j) {
          const uint2 v = xraw[s2 + j];
          a0 += wj[j].x * bflo(v.x); a1 += wj[j].y * bfhi(v.x); a2 += wj[j].z * bflo(v.y); a3 += wj[j].w * bfhi(v.y);
        }
        y[0][s2] = silu(a0); y[1][s2] = silu(a1); y[2][s2] = silu(a2); y[3][s2] = silu(a3);
        const int sI = 4 * tg + s2;
        ff[s2] = dtF[hh * 128 + sI] * __expf(cF_end - cumF[hh * 128 + sI]);
        fb[s2] = dtB[hh * 128 + sI] * __expf(cB_end - cumB[hh * 128 + sI]);
      }
#pragma unroll
      for (int ch = 0; ch < 4; ++ch) {
        const int p = 4 * cq + ch;
        uint2 o;
        o.x = pk(y[ch][0], y[ch][1]); o.y = pk(y[ch][2], y[ch][3]);
        *(uint2*)&xT[p * S_LD + 4 * tg] = o;
        o.x = pk(y[ch][0] * ff[0], y[ch][1] * ff[1]); o.y = pk(y[ch][2] * ff[2], y[ch][3] * ff[3]);
        *(uint2*)&xsF[p * S_LD + 4 * tg] = o;
        o.x = pk(y[ch][0] * fb[0], y[ch][1] * fb[1]); o.y = pk(y[ch][2] * fb[2], y[ch][3] * fb[3]);
        *(uint2*)&xsB[p * S_LD + 4 * tg] = o;
      }
      if (hh < 3) {
        ssd_xload(xraw, W.XBC + (size_t)b * TT * 1024 + (hg + 1) * 64 + 4 * cq, c * 128 + 4 * tg, seg_lo, seg_hi);
        const int coln = (hg + 1) * 64 + 4 * cq;
#pragma unroll
        for (int j = 0; j < 5; ++j) xw[j] = *(const float4*)(conv_w + j * 1024 + coln);
        xbias = *(const float4*)(conv_b + coln);
      }
    }
    __syncthreads();
    {
      const int t = 16 * w + c16;
      const float cF_t = cumF[hh * 128 + t], cB_t = cumB[hh * 128 + t];
      const float Dh = P.in[15][l * 8 + hg];
      f32x4 Y[4];
#pragma unroll
      for (int pt = 0; pt < 4; ++pt) Y[pt] = (f32x4){0.f, 0.f, 0.f, 0.f};
#pragma unroll
      for (int m = 0; m < 4; ++m) {
        __builtin_amdgcn_sched_barrier(0);
        float mv[8];
#pragma unroll
        for (int jj = 0; jj < 2; ++jj) {
          const int st = 2 * m + jj;
          const int sb = 16 * st + 4 * q;
          const float4 cf4 = *(const float4*)&cumF[hh * 128 + sb];
          const float4 df4 = *(const float4*)&dtF[hh * 128 + sb];
          const float4 cb4 = *(const float4*)&cumB[hh * 128 + sb];
          const float4 db4 = *(const float4*)&dtB[hh * 128 + sb];
          const float cfv[4] = {cf4.x, cf4.y, cf4.z, cf4.w}, dfv[4] = {df4.x, df4.y, df4.z, df4.w};
          const float cbv[4] = {cb4.x, cb4.y, cb4.z, cb4.w}, dbv[4] = {db4.x, db4.y, db4.z, db4.w};
#pragma unroll
          for (int i = 0; i < 4; ++i) {
            const int s = sb + i;
            const float ef = (s <= t) ? __expf(cF_t - cfv[i]) * dfv[i] : 0.f;
            const float eb = (s >= t) ? __expf(cB_t - cbv[i]) * dbv[i] : 0.f;
            mv[4 * jj + i] = G[st][i] * (ef + eb) + ((s == t) ? Dh : 0.f);
          }
        }
        uint4 mu;
        mu.x = pk(mv[0], mv[1]); mu.y = pk(mv[2], mv[3]); mu.z = pk(mv[4], mv[5]); mu.w = pk(mv[6], mv[7]);
        const bf16x8 Mf = __builtin_bit_cast(bf16x8, mu);
#pragma unroll
        for (int pt = 0; pt < 4; ++pt) {
          const u16* xp = xT + (16 * pt + c16) * S_LD + 32 * m + 4 * q;
          s16x4 lo = *(const s16x4*)xp;
          s16x4 hi = *(const s16x4*)(xp + 16);
          const bf16x8 af = __builtin_shufflevector(lo, hi, 0, 1, 2, 3, 4, 5, 6, 7);
          Y[pt] = MFMA16(af, Mf, Y[pt]);
        }
      }
#pragma unroll
      for (int pt = 0; pt < 4; ++pt) {
        uint2 o;
        o.x = pk(Y[pt][0], Y[pt][1]); o.y = pk(Y[pt][2], Y[pt][3]);
        *(uint2*)(W.Ycat + (Rc0 + t) * 1024 + hg * 64 + 16 * pt + 4 * q) = o;
      }
    }
#pragma unroll
    for (int dir = 0; dir < 2; ++dir) {
      const u16* xs = dir ? xsB : xsF;
      f32x4 acc[4];
#pragma unroll
      for (int pt = 0; pt < 4; ++pt) acc[pt] = (f32x4){0.f, 0.f, 0.f, 0.f};
#pragma unroll
      for (int ks = 0; ks < 4; ++ks) {
        const bf16x8 af = *(const bf16x8*)&BsT[(16 * w + c16) * S_LD + 32 * ks + 8 * q];
#pragma unroll
        for (int pt = 0; pt < 4; ++pt) {
          const bf16x8 bfr = *(const bf16x8*)&xs[(16 * pt + c16) * S_LD + 32 * ks + 8 * q];
          acc[pt] = MFMA16(af, bfr, acc[pt]);
        }
      }
      u16* dst = W.Sloc + ((((size_t)dir * 8 + b) * 18 + c) * 8 + hg) * 8192;
#pragma unroll
      for (int pt = 0; pt < 4; ++pt) {
        uint2 o;
        o.x = pk(acc[pt][0], acc[pt][1]); o.y = pk(acc[pt][2], acc[pt][3]);
        *(uint2*)(dst + (16 * pt + c16) * 128 + 16 * w + 4 * q) = o;
      }
    }
    __syncthreads();
  }
}

DI void ws_init(WS& W, unsigned char* ws) {
        W.WinT = (u16*)(ws + OFF_WIN); W.WoutT = (u16*)(ws + OFF_WOUT); W.mod = (float*)(ws + OFF_MOD);
    W.ropeG = (float2*)(ws + OFF_ROPE); W.ropeD = (float2*)(ws + OFF_ROPE + 8192);
    W.U = (u16*)(ws + OFF_U); W.Ycat = (u16*)(ws + OFF_U); W.XBC = (u16*)(ws + OFF_XBC); W.Obuf = (u16*)(ws + OFF_XBC);
    W.Z = (u16*)(ws + OFF_Z); W.DT = (float*)(ws + OFF_DT);
    W.Q = (u16*)(ws + OFF_Q); W.K = (u16*)(ws + OFF_K); W.Vt = (u16*)(ws + OFF_VT);
    W.DQ = (u16*)(ws + OFF_DQ); W.DK = (u16*)(ws + OFF_DK); W.DVt = (u16*)(ws + OFF_DVT); W.Stin = (u16*)(ws + OFF_Q);
    W.GG = (u16*)(ws + OFF_GG); W.DG = (u16*)(ws + OFF_DG); W.Cc = (u16*)(ws + OFF_CC);
    W.cumF = (float*)(ws + OFF_CUMF); W.cumB = (float*)(ws + OFF_CUMB); W.Sloc = (u16*)(ws + OFF_SLOC);
    W.Opart = (float*)(ws + OFF_OPART);
}

#define XCD_LOOP(UPX, xcd, idx) \
  const bool sw_ = (nb & 7) == 0; \
  for (int t_ = sw_ ? (bid >> 3) : bid; t_ < (sw_ ? (UPX) : 8 * (UPX)); t_ += (sw_ ? (nb >> 3) : nb)) { \
    const int xcd = sw_ ? (bid & 7) : t_ / (UPX); const int idx = sw_ ? t_ : t_ % (UPX);
#define XCD_END }

typedef const Params __attribute__((address_space(4)))* KArgP;
DI Params load_params(KArgP kp) {
  asm volatile("" : "+s"(kp));
  Params P;
#pragma unroll
  for (int i = 0; i < 22; ++i) P.in[i] = kp->in[i];
  P.out = kp->out; P.ws = kp->ws;
  return P;
}

DI void ph0_prologue(KArgP kp, unsigned char* lds) {
  const Params P = load_params(kp); WS W; ws_init(W, P.ws);
  const int tid = fresh_tid(), lane = tid & 63, w = tid >> 6;
  const int nb = gridDim.x, bid = blockIdx.x;
  (void)lane; (void)w; (void)tid;
  {
    float* S = (float*)(lds + 69632);
    for (int i = tid; i < 9 * 1024; i += NT) {
      const float x = (i < 8192) ? P.in[1][i] : P.in[3][i - 8192];
      S[i] = silu(x);
    }
    __syncthreads();
    constexpr int U_WIN = 2 * 14 * 16, U_WOUT = 2 * 4 * 16, U_MOD = 384;
    for (int u = bid; u < U_WIN + U_WOUT + U_MOD + 1; u += nb) {
      if (u < U_WIN + U_WOUT) {
        const float* src; u16* dst; int ldn, n0, k0, nrows; bool inproj;
        if (u < U_WIN) {
          const int l = u / (14 * 16), rem = u % (14 * 16);
          n0 = (rem >> 4) * 256; k0 = (rem & 15) * 64; ldn = 3344; inproj = true; nrows = NPAD;
          src = P.in[8] + (size_t)l * 1024 * 3344; dst = W.WinT + (size_t)l * NPAD * 1024;
        } else {
          const int v = u - U_WIN; const int l = v >> 6, rem = v & 63;
          n0 = (rem >> 4) * 256; k0 = (rem & 15) * 64; ldn = 1024; inproj = false; nrows = 1024;
          src = P.in[21] + (size_t)l * 1024 * 1024; dst = W.WoutT + (size_t)l * 1024 * 1024;
        }
        float* tile = (float*)lds;
        {
          const int n = tid & 63, kq = tid >> 6;
#pragma unroll
          for (int sub = 0; sub < 4; ++sub) {
            const int nd = n0 + sub * 64 + n;
            int ns = nd;
            if (inproj) { ns = (nd < 1536) ? nd : (nd < 3328 ? nd + 16 : (nd < 3344 ? nd - 3328 + 1536 : -1)); }
#pragma unroll
            for (int i = 0; i < 8; ++i) {
              const int k = kq * 8 + i;
              tile[sub * 4160 + k * 65 + n] = (ns >= 0) ? src[(size_t)(k0 + k) * ldn + ns] : 0.f;
            }
          }
        }
        __syncthreads();
        {
          const int n = tid >> 3, kc = tid & 7;
#pragma unroll
          for (int sub = 0; sub < 4; ++sub) {
            float f[8];
#pragma unroll
            for (int i = 0; i < 8; ++i) f[i] = tile[sub * 4160 + (kc * 8 + i) * 65 + n];
            uint4 o;
            o.x = pk(f[0], f[1]); o.y = pk(f[2], f[3]); o.z = pk(f[4], f[5]); o.w = pk(f[6], f[7]);
            if (n0 + sub * 64 + n < nrows) *(uint4*)(dst + (size_t)(n0 + sub * 64 + n) * 1024 + k0 + kc * 8) = o;
          }
        }
        __syncthreads();
      } else if (u < U_WIN + U_WOUT + U_MOD) {
        const int v = u - U_WIN - U_WOUT;
        const int l = v / 192, n0 = (v % 192) * 16;
        const int c16 = tid & 15, kg = tid >> 4;
        const float* wm = P.in[4] + (size_t)l * 1024 * 3072 + n0 + c16;
        float acc[9];
#pragma unroll
        for (int rr = 0; rr < 9; ++rr) acc[rr] = 0.f;
#pragma unroll 8
        for (int kk = 0; kk < 32; ++kk) {
          const int k = kg * 32 + kk;
          const float wv = wm[(size_t)k * 3072];
#pragma unroll
          for (int rr = 0; rr < 9; ++rr) acc[rr] += S[rr * 1024 + k] * wv;
        }
        float* red = (float*)lds;
#pragma unroll
        for (int rr = 0; rr < 9; ++rr) red[(kg * 16 + c16) * 9 + rr] = acc[rr];
        __syncthreads();
        if (tid < 144) {
          const int cc = tid / 9, rr = tid % 9;
          float s = 0.f;
          for (int k2 = 0; k2 < 32; ++k2) s += red[(k2 * 16 + cc) * 9 + rr];
          W.mod[((size_t)l * 9 + rr) * 3072 + n0 + cc] = s + P.in[5][l * 3072 + n0 + cc];
        }
        __syncthreads();
      } else {
        for (int i = tid; i < 64 * 16; i += NT) {
          const int idx = i >> 4, k = i & 15;
          const float inv = powf(10000.f, -(float)k / 16.f);
          float sn, cs; sincosf((float)idx * inv, &sn, &cs);
          W.ropeG[i] = make_float2(cs, sn);
        }
        for (int i = tid; i < 64 * 8; i += NT) {
          const int idx = i >> 3, k = i & 7;
          const float inv = powf(10000.f, -(float)k / 8.f);
          float sn, cs; sincosf((float)idx * inv, &sn, &cs);
          W.ropeD[i] = make_float2(cs, sn);
        }
      }
    }
  }
}

DI void ph1_prep(KArgP kp) {
  const Params P = load_params(kp); WS W; ws_init(W, P.ws);
  const int tid = fresh_tid(), lane = tid & 63, w = tid >> 6;
  const int nb = gridDim.x, bid = blockIdx.x;
  (void)lane; (void)w; (void)tid;
  XCD_LOOP(288, xcd, idx)
    const int R = xcd * TT + idx * 8 + w;
    const int b = xcd, t = idx * 8 + w;
    const float* src = (t < 256) ? (P.in[2] + ((size_t)b * 256 + t) * 1024) : (P.in[0] + ((size_t)b * 2048 + (t - 256)) * 1024);
    const float* md = W.mod + (size_t)((t < 256) ? 8 : b) * 3072;
    const float* gp = P.in[6];
    float4 x[4];
    float ss = 0.f;
#pragma unroll
    for (int i = 0; i < 4; ++i) {
      x[i] = *(const float4*)(src + i * 256 + lane * 4);
      ss += x[i].x * x[i].x + x[i].y * x[i].y + x[i].z * x[i].z + x[i].w * x[i].w;
    }
#pragma unroll
    for (int d = 32; d >= 1; d >>= 1) ss += __shfl_xor(ss, d);
    const float rn = rsqrtf(ss * (1.f / 1024.f) + EPS);
#pragma unroll
    for (int i = 0; i < 4; ++i) {
      const int k = i * 256 + lane * 4;
      const float4 g4 = *(const float4*)(gp + k);
      const float4 sh = *(const float4*)(md + k);
      const float4 sc = *(const float4*)(md + 1024 + k);
      uint2 o;
      o.x = pk(x[i].x * rn * g4.x * (1.f + sc.x) + sh.x, x[i].y * rn * g4.y * (1.f + sc.y) + sh.y);
      o.y = pk(x[i].z * rn * g4.z * (1.f + sc.z) + sh.z, x[i].w * rn * g4.w * (1.f + sc.w) + sh.w);
      *(uint2*)(W.U + (size_t)R * 1024 + k) = o;
    }
  XCD_END
}

DI void ph2_inproj(KArgP kp, int l, unsigned char* lds) {
  const Params P = load_params(kp); WS W; ws_init(W, P.ws);
  const int tid = fresh_tid();
  const int nb = gridDim.x, bid = blockIdx.x;
  XCD_LOOP(243, xcd, idx)
    const int nt = idx / 9, mt = xcd * 9 + idx % 9;
    gemm_tile_to_lds(W.U, W.WinT + (size_t)l * NPAD * 1024, mt * 256, nt * 128, lds);
    float v[64];
    load_row64(lds, v);
    inproj_epi(P, W, l, mt * 256 + (tid >> 1), nt, tid & 1, v);
    __syncthreads();
  XCD_END
}

DI void ph3_mix(KArgP kp, int l, unsigned char* lds) {
  const Params P = load_params(kp); WS W; ws_init(W, P.ws);
  const int nb = gridDim.x, bid = blockIdx.x;
  const int upx = (l == 0) ? 108 : 100;
  XCD_LOOP(upx, xcd, idx)
    const int b = xcd;
    if (idx < 32) {
      diff_unit(P, W, l, b, idx >> 3, 1 + (idx & 7), lds);
    } else if (idx < 64) {
      gqa_unit(W, P.in[17] + l * 64, P.in[18] + l * 64, b, (idx - 32) >> 3, 1 + (idx & 7), lds);
    } else if (idx < 100) {
      const int v = idx - 64;
      ssd_local_unit(P, W, l, b, v >> 1, v & 1, lds);
    } else if (idx < 104) {
      diff_unit(P, W, l, b, idx - 100, 0, lds);
    } else {
      gqa_unit(W, P.in[17] + l * 64, P.in[18] + l * 64, b, idx - 104, 0, lds);
    }
    __syncthreads();
  XCD_END
}

DI void ph4a_states(KArgP kp) {
  const Params P = load_params(kp); WS W; ws_init(W, P.ws);
  const int tid = fresh_tid(), lane = tid & 63, w = tid >> 6;
  const int nb = gridDim.x, bid = blockIdx.x;
  (void)lane; (void)w; (void)tid;
    XCD_LOOP(64, xcd, idx)
      const int gid = idx * NT + tid;
      const int e4 = gid & 2047, hg = (gid >> 11) & 7, b = xcd, dir = gid >> 14;
      float s0 = 0.f, s1 = 0.f, s2 = 0.f, s3 = 0.f;
      for (int step = 0; step < 18; ++step) {
        const int c = dir ? (step == 0 ? 1 : (step == 1 ? 0 : 19 - step)) : step;
        const size_t idx = ((((size_t)dir * 8 + b) * 18 + c) * 8 + hg) * 8192 + (size_t)e4 * 4;
        uint2 o;
        o.x = pk(s0, s1); o.y = pk(s2, s3);
        *(uint2*)(W.Stin + idx) = o;
        const float tot = W.cumF[(size_t)dir * ((size_t)RR * 8) + ((size_t)b * TT + c * 128 + (dir ? 0 : 127)) * 8 + hg];
        const float dec = __expf(tot);
        const uint2 sv = *(const uint2*)(W.Sloc + idx);
        s0 = s0 * dec + bflo(sv.x); s1 = s1 * dec + bfhi(sv.x);
        s2 = s2 * dec + bflo(sv.y); s3 = s3 * dec + bfhi(sv.y);
      }
    XCD_END
}

DI void ph4b_yoff(KArgP kp, int l, unsigned char* lds) {
  const Params P = load_params(kp); WS W; ws_init(W, P.ws);
  const int tid = fresh_tid(), lane = tid & 63, w = tid >> 6;
  const int nb = gridDim.x, bid = blockIdx.x;
  (void)lane; (void)w; (void)tid;
    XCD_LOOP((l == 0 ? 72 : 64), xcd, idx)
      const int b = xcd, c = (idx >> 2) + (l == 0 ? 0 : 2), tb = idx & 3;
      const int r = lane & 31, h2 = lane >> 5;
      const int hg = w, g = w >> 2;
      const size_t Rr = (size_t)b * TT + c * 128 + 32 * tb + r;
      f32x16 acc[2][2];
#pragma unroll
      for (int d = 0; d < 2; ++d)
#pragma unroll
        for (int pt = 0; pt < 2; ++pt)
#pragma unroll
          for (int e = 0; e < 16; ++e) acc[d][pt][e] = 0.f;
      const u16* cp = W.Cc + Rr * 256 + g * 128 + 8 * h2;
      bf16x8 bfr[8];
#pragma unroll
      for (int ks = 0; ks < 8; ++ks) bfr[ks] = *(const bf16x8*)(cp + 16 * ks);
      u16* myl = (u16*)lds + w * (64 * 136);
#pragma unroll
      for (int d = 0; d < 2; ++d) {
        const u16* sp = W.Stin + ((((size_t)d * 8 + b) * 18 + c) * 8 + hg) * 8192 + lane * 8;
        u32x4 sv[16];
#pragma unroll
        for (int i = 0; i < 16; ++i) sv[i] = *(const u32x4*)(sp + i * 512);
#pragma unroll
        for (int i = 0; i < 16; ++i) *(u32x4*)(myl + (4 * i + (lane >> 4)) * 136 + (lane & 15) * 8) = sv[i];
        __builtin_amdgcn_wave_barrier();
#pragma unroll
        for (int ks = 0; ks < 8; ++ks) {
          const bf16x8 f0 = *(const bf16x8*)(myl + r * 136 + 16 * ks + 8 * h2);
          const bf16x8 f1 = *(const bf16x8*)(myl + (32 + r) * 136 + 16 * ks + 8 * h2);
          acc[d][0] = MFMA32(f0, bfr[ks], acc[d][0]);
          acc[d][1] = MFMA32(f1, bfr[ks], acc[d][1]);
        }
        __builtin_amdgcn_wave_barrier();
      }
      const float eF = __expf(W.cumF[Rr * 8 + hg]), eB = __expf(W.cumB[Rr * 8 + hg]);
      float ss = 0.f;
#pragma unroll
      for (int pt = 0; pt < 2; ++pt)
#pragma unroll
        for (int i4 = 0; i4 < 4; ++i4) {
          const int p = 32 * pt + 8 * i4 + 4 * h2;
          const uint2 yd = *(const uint2*)(W.Ycat + Rr * 1024 + hg * 64 + p);
          const uint2 zz = *(const uint2*)(W.Z + Rr * 512 + hg * 64 + p);
          float y0 = bflo(yd.x) + eF * acc[0][pt][4 * i4] + eB * acc[1][pt][4 * i4];
          float y1 = bfhi(yd.x) + eF * acc[0][pt][4 * i4 + 1] + eB * acc[1][pt][4 * i4 + 1];
          float y2 = bflo(yd.y) + eF * acc[0][pt][4 * i4 + 2] + eB * acc[1][pt][4 * i4 + 2];
          float y3 = bfhi(yd.y) + eF * acc[0][pt][4 * i4 + 3] + eB * acc[1][pt][4 * i4 + 3];
          y0 *= silu(bflo(zz.x)); y1 *= silu(bfhi(zz.x)); y2 *= silu(bflo(zz.y)); y3 *= silu(bfhi(zz.y));
          acc[0][pt][4 * i4] = y0; acc[0][pt][4 * i4 + 1] = y1; acc[0][pt][4 * i4 + 2] = y2; acc[0][pt][4 * i4 + 3] = y3;
          ss += y0 * y0 + y1 * y1 + y2 * y2 + y3 * y3;
        }
      ss += __shfl_xor(ss, 32);
      float* red = (float*)(lds + 8 * 64 * 136 * 2);
      if (h2 == 0) red[w * 32 + r] = ss;
      __syncthreads();
      float tot = 0.f;
#pragma unroll
      for (int k = 0; k < 8; ++k) tot += red[k * 32 + r];
      const float rn = rsqrtf(tot * (1.f / 512.f) + EPS);
      const float* ng = P.in[16] + l * 512 + hg * 64;
#pragma unroll
      for (int pt = 0; pt < 2; ++pt)
#pragma unroll
        for (int i4 = 0; i4 < 4; ++i4) {
          const int p = 32 * pt + 8 * i4 + 4 * h2;
          const float4 n4 = *(const float4*)(ng + p);
          uint2 o;
          o.x = pk(acc[0][pt][4 * i4] * rn * n4.x, acc[0][pt][4 * i4 + 1] * rn * n4.y);
          o.y = pk(acc[0][pt][4 * i4 + 2] * rn * n4.z, acc[0][pt][4 * i4 + 3] * rn * n4.w);
          *(uint2*)(W.Ycat + Rr * 1024 + hg * 64 + p) = o;
        }
      __syncthreads();
    XCD_END
}

DI void ph5_outproj(KArgP kp, int l, unsigned char* lds) {
  const Params P = load_params(kp); WS W; ws_init(W, P.ws);
  const int tid = fresh_tid();
  const int nb = gridDim.x, bid = blockIdx.x;
  const int upx = (l == 0) ? 72 : 64;
  XCD_LOOP(upx, xcd, idx)
    const int mt = xcd * 9 + (idx >> 3) + (l == 0 ? 0 : 1), nt = idx & 7;
    gemm_tile_to_lds(W.Ycat, W.WoutT + (size_t)l * 1024 * 1024, mt * 256, nt * 128, lds);
    float v[64];
    load_row64(lds, v);
    const size_t R = (size_t)mt * 256 + (tid >> 1);
    float ss = 0.f;
#pragma unroll
    for (int j = 0; j < 64; ++j) ss += v[j] * v[j];
    W.Opart[R * 16 + nt * 2 + (tid & 1)] = ss;
    store64(W.Obuf + R * 1024 + nt * 128 + (tid & 1) * 64, v);
    __syncthreads();
  XCD_END
}

DI void ph6_post(KArgP kp, int l) {
  const Params P = load_params(kp); WS W; ws_init(W, P.ws);
  const int tid = fresh_tid(), lane = tid & 63, w = tid >> 6;
  const int nb = gridDim.x, bid = blockIdx.x;
  (void)lane; (void)w; (void)tid;
    XCD_LOOP(288, xcd, idx)
      const int R = xcd * TT + idx * 8 + w;
      const int b = xcd, t = idx * 8 + w;
      const bool isctx = t < 256;
      if (l == 1 && isctx) continue;
      const float* md = W.mod + ((size_t)l * 9 + (isctx ? 8 : b)) * 3072;
      const float* hsrc;
      if (isctx) hsrc = P.in[2] + ((size_t)b * 256 + t) * 1024;
      else hsrc = (l == 0 ? P.in[0] : (const float*)P.out) + ((size_t)b * 2048 + (t - 256)) * 1024;
      float pss = (lane < 16) ? W.Opart[(size_t)R * 16 + lane] : 0.f;
#pragma unroll
      for (int d = 8; d >= 1; d >>= 1) pss += __shfl_xor(pss, d);
      pss = __shfl(pss, 0);
      const float rn = rsqrtf(pss * (1.f / 1024.f) + EPS);
      const float* gpost = P.in[7] + l * 1024;
      float4 hn[4];
      float ss = 0.f;
#pragma unroll
      for (int i = 0; i < 4; ++i) {
        const int k = i * 256 + lane * 4;
        const float4 hv = *(const float4*)(hsrc + k);
        const uint2 ov = *(const uint2*)(W.Obuf + (size_t)R * 1024 + k);
        const float4 g4 = *(const float4*)(gpost + k);
        const float4 gt = *(const float4*)(md + 2048 + k);
        hn[i].x = hv.x + gt.x * (bflo(ov.x) * rn * g4.x);
        hn[i].y = hv.y + gt.y * (bfhi(ov.x) * rn * g4.y);
        hn[i].z = hv.z + gt.z * (bflo(ov.y) * rn * g4.z);
        hn[i].w = hv.w + gt.w * (bfhi(ov.y) * rn * g4.w);
        ss += hn[i].x * hn[i].x + hn[i].y * hn[i].y + hn[i].z * hn[i].z + hn[i].w * hn[i].w;
      }
      if (!isctx) {
        float* dst = P.out + ((size_t)b * 2048 + (t - 256)) * 1024;
#pragma unroll
        for (int i = 0; i < 4; ++i) *(float4*)(dst + i * 256 + lane * 4) = hn[i];
      }
      if (l == 0) {
#pragma unroll
        for (int d = 32; d >= 1; d >>= 1) ss += __shfl_xor(ss, d);
        const float r2 = rsqrtf(ss * (1.f / 1024.f) + EPS);
        const float* md1 = W.mod + ((size_t)9 + (isctx ? 8 : b)) * 3072;
        const float* gp = P.in[6] + 1024;
#pragma unroll
        for (int i = 0; i < 4; ++i) {
          const int k = i * 256 + lane * 4;
          const float4 g4 = *(const float4*)(gp + k);
          const float4 sh = *(const float4*)(md1 + k);
          const float4 sc = *(const float4*)(md1 + 1024 + k);
          uint2 o;
          o.x = pk(hn[i].x * r2 * g4.x * (1.f + sc.x) + sh.x, hn[i].y * r2 * g4.y * (1.f + sc.y) + sh.y);
          o.y = pk(hn[i].z * r2 * g4.z * (1.f + sc.z) + sh.z, hn[i].w * r2 * g4.w * (1.f + sc.w) + sh.w);
          *(uint2*)(W.U + (size_t)R * 1024 + k) = o;
        }
      }
    XCD_END
}


#define XB_TMO      128
#define XB_XCNT(j)  (256  + 64 * (j))
#define XB_XSUB(j)  (1280 + 64 * (j))
#define XB_XGEN(j)  (2304 + 64 * (j))
#define XB_TOP      3328
#define XB_TOPGEN   3392
#define XCD_BAR_WORDS 3456
#define XB_SPIN_CAP (1u << 18)
#define LAS __attribute__((address_space(3)))

__device__ __forceinline__ unsigned xb_ld(unsigned* p)              { return __hip_atomic_load(p, __ATOMIC_RELAXED, __HIP_MEMORY_SCOPE_AGENT); }
__device__ __forceinline__ unsigned xb_add(unsigned* p, unsigned v) { return __hip_atomic_fetch_add(p, v, __ATOMIC_RELAXED, __HIP_MEMORY_SCOPE_AGENT); }
__device__ __forceinline__ unsigned xb_xcc_id() { return (unsigned)__builtin_amdgcn_s_getreg((3 << 11) | 20) & 0xFu; }
#define XB_SPIN(cond, bar) do { unsigned _sp = 0; while (cond) { __builtin_amdgcn_s_sleep(1); \
    if ((++_sp & 255u) == 0u) { if (xb_ld(&(bar)[XB_TMO])) break; if (_sp > XB_SPIN_CAP) { atomicAdd(&(bar)[XB_TMO], 1u); break; } } } } while (0)

struct XcdBarrier {
    unsigned* bar; unsigned x;
    volatile LAS unsigned* st;
};

__device__ __forceinline__ XcdBarrier xcd_barrier_post(unsigned* bar, volatile LAS unsigned* st) {
    XcdBarrier b; b.bar = bar; b.x = xb_xcc_id(); b.st = st;
    if (threadIdx.x == 0) (void)xb_add(&bar[XB_XCNT(b.x)], 1u);
    return b;
}
__device__ __forceinline__ void xcd_barrier_complete(unsigned* bar, unsigned x, unsigned& nloc, unsigned& nx) {
    const unsigned G = gridDim.x * gridDim.y * gridDim.z;
    unsigned sum, cnt, mine, sp = 0u;
    for (;;) {
        sum = 0u; cnt = 0u; mine = 0u;
#pragma unroll
        for (unsigned j = 0; j < 16; ++j) { const unsigned c = xb_ld(&bar[XB_XCNT(j)]); sum += c; cnt += (c > 0u) ? 1u : 0u; mine = (j == x) ? c : mine; }
        if (sum == G) break;
        __builtin_amdgcn_s_sleep(1);
        if ((++sp & 255u) == 0u) { if (xb_ld(&bar[XB_TMO])) break; if (sp > XB_SPIN_CAP) { atomicAdd(&bar[XB_TMO], 1u); break; } }
    }
    nloc = mine > 0u ? mine : 1u; nx = cnt > 0u ? cnt : 1u;
}

__device__ __forceinline__ void xcd_barrier(const XcdBarrier& b) {
    asm volatile("s_waitcnt vmcnt(0)" ::: "memory");
    __syncthreads();
    if (threadIdx.x == 0) {
        unsigned* bar = b.bar;
        __builtin_amdgcn_s_waitcnt(0);
        unsigned nloc = b.st[0], nx = b.st[1];
        if (nloc == 0u) { xcd_barrier_complete(bar, b.x, nloc, nx); b.st[0] = nloc; b.st[1] = nx; }
        const unsigned old = xb_add(&bar[XB_XSUB(b.x)], 1u);
        const unsigned gen = old / nloc;
        if (old + 1u == (gen + 1u) * nloc) {
            __builtin_amdgcn_fence(__ATOMIC_RELEASE, "agent");
            asm volatile("s_waitcnt vmcnt(0)" ::: "memory");
            const unsigned og = xb_add(&bar[XB_TOP], 1u);
            const unsigned tg = og / nx;
            if (og + 1u == (tg + 1u) * nx) xb_add(&bar[XB_TOPGEN], 1u);
            else XB_SPIN(xb_ld(&bar[XB_TOPGEN]) == tg, bar);
            __builtin_amdgcn_fence(__ATOMIC_ACQUIRE, "agent");
            xb_add(&bar[XB_XGEN(b.x)], 1u);
            asm volatile("s_waitcnt vmcnt(0)" ::: "memory");
        } else {
            XB_SPIN(xb_ld(&bar[XB_XGEN(b.x)]) == gen, bar);
            __builtin_amdgcn_fence(__ATOMIC_ACQUIRE, "agent");
            asm volatile("s_waitcnt vmcnt(0)" ::: "memory");
        }
    }
    __syncthreads();
}

DI void grid_barrier(unsigned* bar, unsigned& epoch) {
  asm volatile("s_waitcnt vmcnt(0)" ::: "memory");
  __syncthreads();
  ++epoch;
  if (threadIdx.x == 0) {
    __builtin_amdgcn_fence(__ATOMIC_RELEASE, "agent");
    asm volatile("s_waitcnt vmcnt(0)" ::: "memory");
    const unsigned nb = gridDim.x, bid = blockIdx.x;
    const bool hier = (nb & 7u) == 0u;
    const unsigned ng = hier ? 8u : 1u, per = hier ? (nb >> 3) : nb;
    unsigned* grp = bar + 64 * (1 + (hier ? (bid & 7u) : 0u));
    const unsigned old = __hip_atomic_fetch_add(grp, 1u, __ATOMIC_RELAXED, __HIP_MEMORY_SCOPE_AGENT);
    if (old + 1u == epoch * per) __hip_atomic_fetch_add(bar, 1u, __ATOMIC_RELAXED, __HIP_MEMORY_SCOPE_AGENT);
    const unsigned target = epoch * ng;
    while (__hip_atomic_load(bar, __ATOMIC_RELAXED, __HIP_MEMORY_SCOPE_AGENT) < target) __builtin_amdgcn_s_sleep(1);
    __builtin_amdgcn_fence(__ATOMIC_ACQUIRE, "agent");
    asm volatile("s_waitcnt vmcnt(0)" ::: "memory");
  }
  __syncthreads();
}

__global__ void __launch_bounds__(NT) fwd_mega(Params Parg) {
  extern __shared__ __attribute__((aligned(16))) unsigned char lds[];
  cg::grid_group grid = cg::this_grid();
  KArgP kp = (KArgP)__builtin_amdgcn_kernarg_segment_ptr();
  unsigned* bar = (unsigned*)(Parg.ws + OFF_BAR);
  if (gridDim.x == 0x7fffffffu) grid.sync();
  volatile LAS unsigned* xst = (volatile LAS unsigned*)((LAS unsigned char*)lds + (LDS_BYTES - 64));
  if (threadIdx.x == 0) { xst[0] = 0u; xst[1] = 0u; }
  __syncthreads();
  const XcdBarrier xb = xcd_barrier_post(bar, xst);

  ph0_prologue(kp, lds);
  xcd_barrier(xb);

  ph1_prep(kp);
  xcd_barrier(xb);

  for (int l = 0; l < 2; ++l) {
    ph2_inproj(kp, l, lds);
    xcd_barrier(xb);

    ph3_mix(kp, l, lds);
    xcd_barrier(xb);

    ph4a_states(kp);
    xcd_barrier(xb);

    ph4b_yoff(kp, l, lds);
    xcd_barrier(xb);

    ph5_outproj(kp, l, lds);
    xcd_barrier(xb);

    ph6_post(kp, l);
    if (l == 0) xcd_barrier(xb);
  }
}

extern "C" void kernel_launch(void* const* d_in, const int* in_sizes, int n_in,
                              void* d_out, int out_size, void* d_ws, size_t ws_size,
                              hipStream_t stream) {
  static int grid_blocks = 0;
  if (!grid_blocks) {
    int dev = 0, cus = 0, per_cu = 0;
    (void)hipGetDevice(&dev);
    (void)hipDeviceGetAttribute(&cus, hipDeviceAttributeMultiprocessorCount, dev);
    (void)hipFuncSetAttribute((const void*)fwd_mega, hipFuncAttributeMaxDynamicSharedMemorySize, LDS_BYTES);
    (void)hipOccupancyMaxActiveBlocksPerMultiprocessor(&per_cu, (const void*)fwd_mega, NT, LDS_BYTES);
    if (per_cu < 1) per_cu = 1;
    grid_blocks = cus * per_cu;
    if (ws_size < WS_END) fprintf(stderr, "workspace too small: %zu < %zu\n", ws_size, (size_t)WS_END);
  }
  Params p{};
  for (int i = 0; i < 22; ++i) p.in[i] = (const float*)d_in[i];
  p.out = (float*)d_out;
  p.ws = (unsigned char*)d_ws;
  (void)hipMemsetAsync((unsigned char*)d_ws + OFF_BAR, 0, 16384, stream);
  void* args[] = {&p};
  hipError_t e = hipLaunchCooperativeKernel((const void*)fwd_mega, dim3(grid_blocks), dim3(NT), args, LDS_BYTES, stream);
  if (e != hipSuccess) fprintf(stderr, "cooperative launch failed: %s (grid %d)\n", hipGetErrorString(e), grid_blocks);
}
```

```cpp
#include <hip/hip_runtime.h>
#include <hip/hip_cooperative_groups.h>
#include <cstdio>
namespace cg = cooperative_groups;

#define DI __device__ __forceinline__
#define NT 512
static __device__ __forceinline__ int fresh_tid() { int t = threadIdx.x; asm volatile("" : "+v"(t)); return t; }
typedef unsigned short u16;
typedef __attribute__((ext_vector_type(8))) short bf16x8;
typedef __attribute__((ext_vector_type(4))) short s16x4;
typedef __attribute__((ext_vector_type(16))) float f32x16;
typedef __attribute__((ext_vector_type(4))) float f32x4;
typedef __attribute__((ext_vector_type(2))) __bf16 bf2v;
typedef __attribute__((ext_vector_type(2))) float f2v;
typedef unsigned __attribute__((ext_vector_type(4))) u32x4;

#define MFMA32(a, b, c) __builtin_amdgcn_mfma_f32_32x32x16_bf16((a), (b), (c), 0, 0, 0)
#define MFMA16(a, b, c) __builtin_amdgcn_mfma_f32_16x16x32_bf16((a), (b), (c), 0, 0, 0)

constexpr int LDS_BYTES = 140 * 1024;
constexpr int TT = 2304;
constexpr int RR = 18432;
constexpr int NPAD = 3456;
constexpr float EPS = 1e-6f;
constexpr float LOG2E = 1.4426950408889634f;

constexpr size_t SZ_WIN = (size_t)2 * NPAD * 1024 * 2;
constexpr size_t SZ_WOUT = (size_t)2 * 1024 * 1024 * 2;
constexpr size_t SZ_MOD = (size_t)2 * 9 * 3072 * 4;
constexpr size_t SZ_ROPE = 16384;
constexpr size_t SZ_R1024 = (size_t)RR * 1024 * 2;
constexpr size_t SZ_R512 = (size_t)RR * 512 * 2;
constexpr size_t SZ_R256 = (size_t)RR * 256 * 2;
constexpr size_t OFF_WIN = 0;
constexpr size_t OFF_WOUT = OFF_WIN + SZ_WIN;
constexpr size_t OFF_MOD = OFF_WOUT + SZ_WOUT;
constexpr size_t OFF_ROPE = OFF_MOD + SZ_MOD;
constexpr size_t OFF_U = OFF_ROPE + SZ_ROPE;
constexpr size_t OFF_XBC = OFF_U + SZ_R1024;
constexpr size_t OFF_Z = OFF_XBC + SZ_R1024;
constexpr size_t OFF_DT = OFF_Z + SZ_R512;
constexpr size_t SZ_DT = (size_t)RR * 16 * 4;
constexpr size_t OFF_Q = OFF_DT + SZ_DT;
constexpr size_t SZ_Q = (size_t)8 * 4 * TT * 64 * 2;
constexpr size_t OFF_K = OFF_Q + SZ_Q;
constexpr size_t SZ_K = (size_t)8 * 2 * TT * 64 * 2;
constexpr size_t OFF_VT = OFF_K + SZ_K;
constexpr size_t OFF_DQ = OFF_VT + SZ_K;
constexpr size_t SZ_DQ = (size_t)8 * 8 * TT * 32 * 2;
constexpr size_t OFF_DK = OFF_DQ + SZ_DQ;
constexpr size_t OFF_DVT = OFF_DK + SZ_DQ;
constexpr size_t SZ_DVT = (size_t)8 * 4 * 64 * TT * 2;
constexpr size_t OFF_GG = OFF_DVT + SZ_DVT;
constexpr size_t OFF_DG = OFF_GG + SZ_R256;
constexpr size_t OFF_CC = OFF_DG + SZ_R256;
constexpr size_t OFF_CUMF = OFF_CC + SZ_R256;
constexpr size_t SZ_CUM = (size_t)RR * 8 * 4;
constexpr size_t OFF_CUMB = OFF_CUMF + SZ_CUM;
constexpr size_t OFF_SLOC = OFF_CUMB + SZ_CUM;
constexpr size_t SZ_ST = (size_t)2 * 8 * 18 * 8 * 8192 * 2;
constexpr size_t OFF_OPART = OFF_SLOC + SZ_ST;
constexpr size_t OFF_BAR = OFF_OPART + SZ_DT;
constexpr size_t WS_END = OFF_BAR + 16384;
static_assert(SZ_ST <= (OFF_GG - OFF_Q), "Stin must fit in the q/k/v region");
static_assert(WS_END <= (size_t)256 * 1024 * 1024, "workspace");

struct Params {
  const float* in[22];
  float* out;
  unsigned char* ws;
};

struct WS {
  u16 *WinT, *WoutT, *U, *Ycat, *XBC, *Obuf, *Z, *Q, *K, *Vt, *DQ, *DK, *DVt, *GG, *DG, *Cc, *Sloc, *Stin;
  float *mod, *DT, *cumF, *cumB, *Opart;
  float2 *ropeG, *ropeD;
};

DI unsigned pk(float a, float b) { f2v v = {a, b}; return __builtin_bit_cast(unsigned, __builtin_convertvector(v, bf2v)); }
DI u16 f2bf(float a) { return (u16)(pk(a, 0.f) & 0xffffu); }
DI float bf2f(u16 b) { return __uint_as_float(((unsigned)b) << 16); }
DI float bflo(unsigned u) { return __uint_as_float(u << 16); }
DI float bfhi(unsigned u) { return __uint_as_float(u & 0xffff0000u); }
DI float silu(float x) { return x / (1.f + __expf(-x)); }
DI float softplus(float x) { return fmaxf(x, 0.f) + log1pf(__expf(-fabsf(x))); }
DI float fexp2(float x) { return __builtin_amdgcn_exp2f(x); }

DI void store64(u16* dst, const float (&v)[64]) {
#pragma unroll
  for (int i = 0; i < 8; ++i) {
    uint4 u;
    u.x = pk(v[8 * i], v[8 * i + 1]); u.y = pk(v[8 * i + 2], v[8 * i + 3]);
    u.z = pk(v[8 * i + 4], v[8 * i + 5]); u.w = pk(v[8 * i + 6], v[8 * i + 7]);
    ((uint4*)dst)[i] = u;
  }
}

struct GRegs { u32x4 a0, a1, a2, a3, b0, b1; };
DI void g_load(GRegs& R, const u16* ag, const u16* bg, int k0) {
  constexpr size_t K = 1024;
  R.a0 = *(const u32x4*)(ag + k0);
  R.a1 = *(const u32x4*)(ag + 64 * K + k0);
  R.a2 = *(const u32x4*)(ag + 128 * K + k0);
  R.a3 = *(const u32x4*)(ag + 192 * K + k0);
  R.b0 = *(const u32x4*)(bg + k0);
  R.b1 = *(const u32x4*)(bg + 64 * K + k0);
}
DI void g_store(const GRegs& R, u16* as, u16* bs) {
  *(u32x4*)(as) = R.a0;
  *(u32x4*)(as + 64 * 72) = R.a1;
  *(u32x4*)(as + 128 * 72) = R.a2;
  *(u32x4*)(as + 192 * 72) = R.a3;
  *(u32x4*)(bs) = R.b0;
  *(u32x4*)(bs + 64 * 72) = R.b1;
}
DI void g_compute(const u16* as, const u16* bs, f32x16 (&acc)[2][2]) {
#pragma unroll
  for (int ks = 0; ks < 4; ++ks) {
    bf16x8 a0 = *(const bf16x8*)(as + 16 * ks);
    bf16x8 a1 = *(const bf16x8*)(as + 32 * 72 + 16 * ks);
    bf16x8 b0 = *(const bf16x8*)(bs + 16 * ks);
    bf16x8 b1 = *(const bf16x8*)(bs + 32 * 72 + 16 * ks);
    acc[0][0] = MFMA32(a0, b0, acc[0][0]);
    acc[0][1] = MFMA32(a0, b1, acc[0][1]);
    acc[1][0] = MFMA32(a1, b0, acc[1][0]);
    acc[1][1] = MFMA32(a1, b1, acc[1][1]);
  }
}
constexpr int G_LDK = 72;
constexpr int G_CST = 132;
DI void gemm_tile_to_lds(const u16* __restrict__ A, const u16* __restrict__ Bt, int m0, int n0, unsigned char* lds) {
  constexpr int K = 1024;
  u16* As = (u16*)lds;
  u16* Bs = (u16*)(lds + 2 * 256 * G_LDK * 2);
  const int tid = fresh_tid(), lane = tid & 63, w = tid >> 6;
  const int r = lane & 31, h = lane >> 5;
  const int wm = w >> 1, wn = w & 1;
  const int arow = tid >> 3, akc = tid & 7;
  const u16* ag = A + (size_t)(m0 + arow) * K + akc * 8;
  const u16* bg = Bt + (size_t)(n0 + arow) * K + akc * 8;
  f32x16 acc[2][2];
#pragma unroll
  for (int i = 0; i < 2; ++i)
#pragma unroll
    for (int j = 0; j < 2; ++j)
#pragma unroll
      for (int e = 0; e < 16; ++e) acc[i][j][e] = 0.f;
  GRegs R0, R1;
  g_load(R0, ag, bg, 0);
  g_load(R1, ag, bg, 64);
  g_store(R0, As + arow * G_LDK + akc * 8, Bs + arow * G_LDK + akc * 8);
  __syncthreads();
  const u16* as0 = As + (64 * wm + r) * G_LDK + 8 * h;
  const u16* bs0 = Bs + (64 * wn + r) * G_LDK + 8 * h;
  for (int kt2 = 0; kt2 < 16; kt2 += 2) {
    if (kt2 + 2 < 16) g_load(R0, ag, bg, (kt2 + 2) * 64);
    g_compute(as0, bs0, acc);
    g_store(R1, As + 256 * G_LDK + arow * G_LDK + akc * 8, Bs + 128 * G_LDK + arow * G_LDK + akc * 8);
    __syncthreads();
    if (kt2 + 3 < 16) g_load(R1, ag, bg, (kt2 + 3) * 64);
    g_compute(as0 + 256 * G_LDK, bs0 + 128 * G_LDK, acc);
    if (kt2 + 2 < 16) g_store(R0, As + arow * G_LDK + akc * 8, Bs + arow * G_LDK + akc * 8);
    __syncthreads();
  }
  float* Cst = (float*)lds;
#pragma unroll
  for (int i = 0; i < 2; ++i)
#pragma unroll
    for (int j = 0; j < 2; ++j)
#pragma unroll
      for (int e = 0; e < 16; ++e) {
        const int row = 64 * wm + 32 * i + (e & 3) + 8 * (e >> 2) + 4 * h;
        Cst[row * G_CST + 64 * wn + 32 * j + r] = acc[i][j][e];
      }
  __syncthreads();
}

DI void load_row64(const unsigned char* lds, float (&v)[64]) {
  const int tid = fresh_tid();
  const float* src = (const float*)lds + (tid >> 1) * G_CST + (tid & 1) * 64;
#pragma unroll
  for (int i = 0; i < 16; ++i) {
    float4 f = ((const float4*)src)[i];
    v[4 * i] = f.x; v[4 * i + 1] = f.y; v[4 * i + 2] = f.z; v[4 * i + 3] = f.w;
  }
}

DI void store_tile_transposed(const unsigned char* lds, u16* vt, int t0) {
  const int tid = fresh_tid();
  const int col = tid & 127, rg = tid >> 7;
  const float* src = (const float*)lds + (rg * 64) * G_CST + col;
  u16* dst = vt + (size_t)col * TT + t0 + rg * 64;
#pragma unroll
  for (int i = 0; i < 8; ++i) {
    float f[8];
#pragma unroll
    for (int k = 0; k < 8; ++k) f[k] = src[(8 * i + k) * G_CST];
    uint4 u;
    u.x = pk(f[0], f[1]); u.y = pk(f[2], f[3]); u.z = pk(f[4], f[5]); u.w = pk(f[6], f[7]);
    ((uint4*)dst)[i] = u;
  }
}

DI void inproj_epi(const Params& P, const WS& W, int l, int R, int nt, int half, float (&v)[64]) {
  const int b = R / TT;
  const int t = R - b * TT;
  if (nt < 8) {
    store64(W.XBC + (size_t)R * 1024 + nt * 128 + half * 64, v);
  } else if (nt < 12) {
    store64(W.Z + (size_t)R * 512 + (nt - 8) * 128 + half * 64, v);
  } else if (nt < 15) {
    const bool isq = nt < 14;
    const float* g = (isq ? P.in[17] : P.in[18]) + l * 64;
    float ss = 0.f;
#pragma unroll
    for (int j = 0; j < 64; ++j) ss += v[j] * v[j];
    const float rn = rsqrtf(ss * (1.f / 64.f) + EPS);
#pragma unroll
    for (int j = 0; j < 64; ++j) { if ((j & 15) == 0) __builtin_amdgcn_sched_barrier(0); v[j] = v[j] * rn * g[j]; }
    if (t >= 256) {
      const int pos = t - 256, ri = pos >> 6, ci = pos & 63;
#pragma unroll
      for (int i = 0; i < 32; ++i) {
        if ((i & 7) == 0) __builtin_amdgcn_sched_barrier(0);
        const float2 cs = (i < 16) ? W.ropeG[ri * 16 + i] : W.ropeG[ci * 16 + (i - 16)];
        const float x1 = v[i], x2 = v[i + 32];
        v[i] = x1 * cs.x - x2 * cs.y;
        v[i + 32] = x2 * cs.x + x1 * cs.y;
      }
    }
    if (isq) {
      const float sc = 0.125f * LOG2E;
#pragma unroll
      for (int j = 0; j < 64; ++j) v[j] *= sc;
      const int head = (nt - 12) * 2 + half;
      store64(W.Q + ((size_t)(b * 4 + head) * TT + t) * 64, v);
    } else {
      store64(W.K + ((size_t)(b * 2 + half) * TT + t) * 64, v);
    }
  } else if (nt == 15) {
    u16* dst = W.Vt + ((size_t)(b * 2 + half) * 64) * TT + t;
#pragma unroll
    for (int j = 0; j < 64; ++j) { if ((j & 7) == 0) __builtin_amdgcn_sched_barrier(0); dst[(size_t)j * TT] = f2bf(v[j]); }
  } else if (nt < 18) {
#pragma unroll
    for (int j = 0; j < 64; ++j) v[j] = silu(v[j]);
    store64(W.GG + (size_t)R * 256 + (nt - 16) * 128 + half * 64, v);
  } else if (nt < 22) {
    const bool isq = nt < 20;
    const int mbase = (nt - (isq ? 18 : 20)) * 4 + half * 2;
    if (t >= 256) {
      const int pos = t - 256, ri = pos >> 6, ci = pos & 63;
#pragma unroll
      for (int mm = 0; mm < 2; ++mm)
#pragma unroll
        for (int i = 0; i < 16; ++i) {
          if ((i & 7) == 0) __builtin_amdgcn_sched_barrier(0);
          const float2 cs = (i < 8) ? W.ropeD[ri * 8 + i] : W.ropeD[ci * 8 + (i - 8)];
          const float x1 = v[32 * mm + i], x2 = v[32 * mm + i + 16];
          v[32 * mm + i] = x1 * cs.x - x2 * cs.y;
          v[32 * mm + i + 16] = x2 * cs.x + x1 * cs.y;
        }
    }
    if (isq) {
      const float sc = 0.17677669529663687f * LOG2E;
#pragma unroll
      for (int j = 0; j < 64; ++j) v[j] *= sc;
    }
    u16* base = isq ? W.DQ : W.DK;
#pragma unroll
    for (int mm = 0; mm < 2; ++mm) {
      u16* dst = base + ((size_t)(b * 8 + mbase + mm) * TT + t) * 32;
#pragma unroll
      for (int i = 0; i < 4; ++i) {
        uint4 u;
        u.x = pk(v[32 * mm + 8 * i], v[32 * mm + 8 * i + 1]); u.y = pk(v[32 * mm + 8 * i + 2], v[32 * mm + 8 * i + 3]);
        u.z = pk(v[32 * mm + 8 * i + 4], v[32 * mm + 8 * i + 5]); u.w = pk(v[32 * mm + 8 * i + 6], v[32 * mm + 8 * i + 7]);
        ((uint4*)dst)[i] = u;
      }
    }
  } else if (nt < 24) {
    const int head = (nt - 22) * 2 + half;
    u16* dst = W.DVt + ((size_t)(b * 4 + head) * 64) * TT + t;
#pragma unroll
    for (int j = 0; j < 64; ++j) { if ((j & 7) == 0) __builtin_amdgcn_sched_barrier(0); dst[(size_t)j * TT] = f2bf(v[j]); }
  } else if (nt < 26) {
#pragma unroll
    for (int j = 0; j < 64; ++j) v[j] = silu(v[j]);
    store64(W.DG + (size_t)R * 256 + (nt - 24) * 128 + half * 64, v);
  } else if (nt == 26) {
    if (half == 0) {
      const float* bf = P.in[13] + l * 8;
      const float* bb = P.in[14] + l * 8;
#pragma unroll
      for (int j = 0; j < 16; ++j) {
        const float x = v[j] + (j < 8 ? bf[j] : bb[j - 8]);
        W.DT[(size_t)R * 16 + j] = softplus(x);
      }
    }
  }
}

template <int D, bool BOUNDED>
DI void attn_core(const u16* __restrict__ Qh, const u16* __restrict__ Kh, const u16* __restrict__ Vth, int q0, int nkeys,
                  float bound, unsigned char* lds, f32x16 (&O)[2], float& lout) {
  constexpr int KP = D + 8;
  constexpr int KS = D / 16;
  u16* Ks = (u16*)lds;
  constexpr int VP = 68;
  u16* Vs = (u16*)(lds + 2 * 64 * 72 * 2);
  const int tid = fresh_tid(), lane = tid & 63, w = tid >> 6;
  const int r = lane & 31, h = lane >> 5;
  bf16x8 qf[KS];
  {
    const u16* qp = Qh + (size_t)(q0 + 32 * w + r) * D + 8 * h;
#pragma unroll
    for (int ks = 0; ks < KS; ++ks) qf[ks] = *(const bf16x8*)(qp + 16 * ks);
  }
#pragma unroll
  for (int e = 0; e < 16; ++e) { O[0][e] = 0.f; O[1][e] = 0.f; }
  float m = BOUNDED ? bound : 0.f, lsum = 0.f;
  const int krow = (D == 64) ? (tid >> 3) : (tid >> 2);
  const int kc = (D == 64) ? (tid & 7) : (tid & 3);
  const bool kact = (D == 64) ? true : (tid < 256);
  const int vrow = tid >> 3, vc = tid & 7;
  const u16* kg = Kh + (size_t)krow * D + kc * 8;
  const u16* vg = Vth + (size_t)vrow * TT + vc * 8;
  u32x4 rk0 = (u32x4){0u, 0u, 0u, 0u}, rk1 = rk0, rv0, rv1;
  const int nk = nkeys >> 6;
  if (kact) rk0 = *(const u32x4*)kg;
  rv0 = *(const u32x4*)vg;
  __builtin_amdgcn_s_waitcnt(0x0F70);
  if (kact) *(u32x4*)&Ks[krow * KP + kc * 8] = rk0;
  { const u32x4 t_ = rv0; *(uint2*)&Vs[vrow * VP + vc * 8] = make_uint2(t_.x, t_.y); *(uint2*)&Vs[vrow * VP + vc * 8 + 4] = make_uint2(t_.z, t_.w); }
  if (kact) rk1 = *(const u32x4*)(kg + (size_t)64 * D);
  rv1 = *(const u32x4*)(vg + 64);
  __syncthreads();
  for (int kt2 = 0; kt2 < nk; kt2 += 2) {
#pragma unroll
  for (int ph = 0; ph < 2; ++ph) {
    const int kt = kt2 + ph;
    const int cur = ph;
    {
      const int tx = min(kt + 2, nk - 1);
      if (ph == 0) {
        if (kact) rk0 = *(const u32x4*)(kg + (size_t)tx * 64 * D);
        rv0 = *(const u32x4*)(vg + tx * 64);
      } else {
        if (kact) rk1 = *(const u32x4*)(kg + (size_t)tx * 64 * D);
        rv1 = *(const u32x4*)(vg + tx * 64);
      }
    }
    __builtin_amdgcn_sched_barrier(0);
    const u16* ks_ = Ks + cur * 64 * KP + r * KP + 8 * h;
    bf16x8 kf0[KS], kf1[KS];
#pragma unroll
    for (int ks = 0; ks < KS; ++ks) {
      kf0[ks] = *(const bf16x8*)(ks_ + 16 * ks);
      kf1[ks] = *(const bf16x8*)(ks_ + 32 * KP + 16 * ks);
    }
    const u16* vs_ = Vs + cur * 64 * VP + r * VP + 4 * h;
    bf16x8 vf[8];
#pragma unroll
    for (int s = 0; s < 2; ++s)
#pragma unroll
      for (int dt = 0; dt < 2; ++dt) {
        const u16* vp = vs_ + dt * 32 * VP + 16 * s;
        s16x4 lo = *(const s16x4*)vp;
        s16x4 hi = *(const s16x4*)(vp + 8);
        vf[s * 2 + dt] = __builtin_shufflevector(lo, hi, 0, 1, 2, 3, 4, 5, 6, 7);
      }
    __builtin_amdgcn_sched_barrier(0);
    f32x16 S[2];
    {
      const float nm = -m;
#pragma unroll
      for (int e = 0; e < 16; ++e) { S[0][e] = nm; S[1][e] = nm; }
    }
#pragma unroll
    for (int ks = 0; ks < KS; ++ks) {
      S[0] = MFMA32(kf0[ks], qf[ks], S[0]);
      S[1] = MFMA32(kf1[ks], qf[ks], S[1]);
    }
    __builtin_amdgcn_sched_barrier(0);
#pragma unroll
    for (int s = 0; s < 2; ++s)
#pragma unroll
      for (int dt = 0; dt < 2; ++dt) {
        const u16* vp = vs_ + dt * 32 * VP + 32 + 16 * s;
        s16x4 lo = *(const s16x4*)vp;
        s16x4 hi = *(const s16x4*)(vp + 8);
        vf[(2 + s) * 2 + dt] = __builtin_shufflevector(lo, hi, 0, 1, 2, 3, 4, 5, 6, 7);
      }
    __builtin_amdgcn_sched_barrier(0);
    if (!BOUNDED) {
      float t0 = fmaxf(fmaxf(S[0][0], S[0][1]), S[0][2]);
      float t1 = fmaxf(fmaxf(S[1][0], S[1][1]), S[1][2]);
#pragma unroll
      for (int e = 3; e < 15; e += 2) { t0 = fmaxf(fmaxf(t0, S[0][e]), S[0][e + 1]); t1 = fmaxf(fmaxf(t1, S[1][e]), S[1][e + 1]); }
      float tm = fmaxf(fmaxf(t0, t1), fmaxf(S[0][15], S[1][15]));
      tm = fmaxf(tm, __shfl_xor(tm, 32));
      const bool first = (kt == 0);
      if (first || __any(tm > 0.f)) {
        const float adj = first ? tm : fmaxf(tm, 0.f);
        const float alpha = first ? 1.f : fexp2(-adj);
        m += adj;
        lsum *= alpha;
#pragma unroll
        for (int e = 0; e < 16; ++e) { O[0][e] *= alpha; O[1][e] *= alpha; S[0][e] -= adj; S[1][e] -= adj; }
      }
    }
    float rs = 0.f;
#pragma unroll
    for (int e = 0; e < 16; ++e) { S[0][e] = fexp2(S[0][e]); rs += S[0][e]; }
#pragma unroll
    for (int e = 0; e < 16; ++e) { S[1][e] = fexp2(S[1][e]); rs += S[1][e]; }
    lsum += rs;
#pragma unroll
    for (int t2 = 0; t2 < 2; ++t2)
#pragma unroll
      for (int s = 0; s < 2; ++s) {
        uint4 pu;
        pu.x = pk(S[t2][8 * s], S[t2][8 * s + 1]); pu.y = pk(S[t2][8 * s + 2], S[t2][8 * s + 3]);
        pu.z = pk(S[t2][8 * s + 4], S[t2][8 * s + 5]); pu.w = pk(S[t2][8 * s + 6], S[t2][8 * s + 7]);
        const bf16x8 pb = __builtin_bit_cast(bf16x8, pu);
        O[0] = MFMA32(vf[(t2 * 2 + s) * 2 + 0], pb, O[0]);
        O[1] = MFMA32(vf[(t2 * 2 + s) * 2 + 1], pb, O[1]);
      }
    if (kt + 1 < nk) {
      const int nx = cur ^ 1;
      if (kact) *(u32x4*)&Ks[nx * 64 * KP + krow * KP + kc * 8] = (ph == 0) ? rk1 : rk0;
      { const u32x4 t_ = (ph == 0) ? rv1 : rv0; *(uint2*)&Vs[nx * 64 * VP + vrow * VP + vc * 8] = make_uint2(t_.x, t_.y); *(uint2*)&Vs[nx * 64 * VP + vrow * VP + vc * 8 + 4] = make_uint2(t_.z, t_.w); }
    }
    __syncthreads();
  }
  }
  lout = lsum + __shfl_xor(lsum, 32);
}

DI void gqa_unit(const WS& W, const float* qg, const float* kg_, int b, int head, int qb, unsigned char* lds) {
  const int tid = fresh_tid(), lane = tid & 63, w = tid >> 6, r = lane & 31, h = lane >> 5;
  const int q0 = qb * 256;
  const int nkeys = (qb == 0) ? 256 : TT;
  f32x16 O[2];
  float l;
  float bound;
  {
    float gq = fabsf(qg[lane]), gk = fabsf(kg_[lane]);
#pragma unroll
    for (int d = 32; d >= 1; d >>= 1) { gq = fmaxf(gq, __shfl_xor(gq, d)); gk = fmaxf(gk, __shfl_xor(gk, d)); }
    bound = 8.f * LOG2E * gq * gk * 1.02f + 0.25f;
  }
  attn_core<64, true>(W.Q + (size_t)(b * 4 + head) * TT * 64, W.K + (size_t)(b * 2 + (head >> 1)) * TT * 64,
                      W.Vt + (size_t)(b * 2 + (head >> 1)) * 64 * TT, q0, nkeys, bound, lds, O, l);
  const float il = 1.f / l;
  const size_t Rr = (size_t)b * TT + q0 + 32 * w + r;
#pragma unroll
  for (int dt = 0; dt < 2; ++dt)
#pragma unroll
    for (int i4 = 0; i4 < 4; ++i4) {
      const int dv = 32 * dt + 8 * i4 + 4 * h;
      const uint2 g = *(const uint2*)(W.GG + Rr * 256 + head * 64 + dv);
      uint2 o;
      o.x = pk(O[dt][4 * i4] * il * bflo(g.x), O[dt][4 * i4 + 1] * il * bfhi(g.x));
      o.y = pk(O[dt][4 * i4 + 2] * il * bflo(g.y), O[dt][4 * i4 + 3] * il * bfhi(g.y));
      *(uint2*)(W.Ycat + Rr * 1024 + 512 + head * 64 + dv) = o;
    }
}

DI void diff_unit(const Params& P, const WS& W, int l, int b, int hh, int qb, unsigned char* lds) {
  const int tid = fresh_tid(), lane = tid & 63, w = tid >> 6, r = lane & 31, h = lane >> 5;
  const int q0 = qb * 256;
  const int nkeys = (qb == 0) ? 256 : TT;
  const float lam_init = (l == 0) ? 0.2f : 0.35550906759f;
  float lam;
  {
    const float* lp = P.in[19] + l * 128;
    float s1 = (lane < 32) ? lp[lane] * lp[32 + lane] : 0.f;
    float s2 = (lane < 32) ? lp[64 + lane] * lp[96 + lane] : 0.f;
#pragma unroll
    for (int d = 32; d >= 1; d >>= 1) { s1 += __shfl_xor(s1, d); s2 += __shfl_xor(s2, d); }
    lam = __expf(s1) - __expf(s2) + lam_init;
  }
  f32x16 O1[2], O2[2];
  float l1, l2;
  const u16* vt = W.DVt + (size_t)(b * 4 + hh) * 64 * TT;
  attn_core<32, false>(W.DQ + (size_t)(b * 8 + 2 * hh) * TT * 32, W.DK + (size_t)(b * 8 + 2 * hh) * TT * 32, vt, q0, nkeys, 0.f, lds, O1, l1);
  attn_core<32, false>(W.DQ + (size_t)(b * 8 + 2 * hh + 1) * TT * 32, W.DK + (size_t)(b * 8 + 2 * hh + 1) * TT * 32, vt, q0, nkeys, 0.f, lds, O2, l2);
  const float i1 = 1.f / l1, i2 = lam / l2;
  float ss = 0.f;
#pragma unroll
  for (int dt = 0; dt < 2; ++dt)
#pragma unroll
    for (int e = 0; e < 16; ++e) {
      const float o = O1[dt][e] * i1 - O2[dt][e] * i2;
      O1[dt][e] = o;
      ss += o * o;
    }
  ss += __shfl_xor(ss, 32);
  const float rn = rsqrtf(ss * (1.f / 64.f) + EPS) * (1.f - lam_init);
  const float* ng = P.in[20] + l * 64;
  const size_t Rr = (size_t)b * TT + q0 + 32 * w + r;
#pragma unroll
  for (int dt = 0; dt < 2; ++dt)
#pragma unroll
    for (int i4 = 0; i4 < 4; ++i4) {
      const int dv = 32 * dt + 8 * i4 + 4 * h;
      const uint2 g = *(const uint2*)(W.DG + Rr * 256 + hh * 64 + dv);
      const float4 n4 = *(const float4*)(ng + dv);
      uint2 o;
      o.x = pk(O1[dt][4 * i4] * rn * n4.x * bflo(g.x), O1[dt][4 * i4 + 1] * rn * n4.y * bfhi(g.x));
      o.y = pk(O1[dt][4 * i4 + 2] * rn * n4.z * bflo(g.y), O1[dt][4 * i4 + 3] * rn * n4.w * bfhi(g.y));
      *(uint2*)(W.Ycat + Rr * 1024 + 768 + hh * 64 + dv) = o;
    }
}

DI void ssd_xload(uint2 (&raw)[8], const u16* src, int tb, int seg_lo, int seg_hi) {
#pragma unroll
  for (int i = 0; i < 8; ++i) {
    const int t = tb - 2 + i;
    const int tc = min(max(t, seg_lo), seg_hi - 1);
    uint2 v = *(const uint2*)(src + (size_t)tc * 1024);
    if (t < seg_lo || t >= seg_hi) v = make_uint2(0u, 0u);
    raw[i] = v;
  }
}
constexpr int S_LD = 136;
DI void ssd_local_unit(const Params& P, const WS& W, int l, int b, int c, int g, int h_lo, int h_hi, unsigned char* lds) {
  const int tid = fresh_tid(), lane = tid & 63, w = tid >> 6;
  u16* BsT = (u16*)lds;
  u16* Bs = (u16*)(lds + 34816);
  u16* Cs = (u16*)(lds + 69632);
  u16* xT = (u16*)(lds + 34816);
  u16* xsF = (u16*)(lds + 52224);
  u16* xsB = (u16*)(lds + 69632);
  float* cumF = (float*)(lds + 104448);
  float* cumB = cumF + 512;
  float* dtF = cumB + 512;
  float* dtB = dtF + 512;
  const size_t Rc0 = (size_t)b * TT + c * 128;
  const int seg_lo = (c < 2) ? 0 : 256;
  const int seg_hi = (c < 2) ? 256 : TT;
  const float* conv_w = P.in[9] + (size_t)l * 5 * 1024;
  const float* conv_b = P.in[10] + (size_t)l * 1024;
  const int cqB = lane;
  const bool isB = cqB < 32;
  const int ch0 = isB ? 4 * cqB : 4 * (cqB - 32);
  float4 wjB[5];
  float4 biasB;
  uint2 rawB[20];
  {
    const int col = (isB ? 512 : 768) + g * 128 + ch0;
#pragma unroll
    for (int j = 0; j < 5; ++j) wjB[j] = *(const float4*)(conv_w + j * 1024 + col);
    biasB = *(const float4*)(conv_b + col);
    const u16* src = W.XBC + (size_t)b * TT * 1024 + col;
    const int tb = c * 128 + 16 * w;
#pragma unroll
    for (int i = 0; i < 20; ++i) {
      const int t = tb - 2 + i;
      const int tc = min(max(t, seg_lo), seg_hi - 1);
      uint2 v = *(const uint2*)(src + (size_t)tc * 1024);
      if (t < seg_lo || t >= seg_hi) v = make_uint2(0u, 0u);
      rawB[i] = v;
    }
  }
  uint2 xraw[8];
  ssd_xload(xraw, W.XBC + (size_t)b * TT * 1024 + (g * 4 + h_lo) * 64 + 4 * (tid & 15), c * 128 + 4 * (tid >> 4), seg_lo, seg_hi);
  float4 xw[5], xbias;
  {
    const int col = (g * 4 + h_lo) * 64 + 4 * (tid & 15);
#pragma unroll
    for (int j = 0; j < 5; ++j) xw[j] = *(const float4*)(conv_w + j * 1024 + col);
    xbias = *(const float4*)(conv_b + col);
  }
  {
    const int hh = w & 3, dir = w >> 2, hg = g * 4 + hh;
    const float a = -__expf((dir ? P.in[12] : P.in[11])[l * 8 + hg]);
    const float d0 = W.DT[(Rc0 + 2 * lane) * 16 + dir * 8 + hg];
    const float d1 = W.DT[(Rc0 + 2 * lane + 1) * 16 + dir * 8 + hg];
    const float a0 = d0 * a, a1 = d1 * a;
    float v = a0 + a1;
    float c0, c1;
    if (dir == 0) {
#pragma unroll
      for (int d = 1; d < 64; d <<= 1) { const float t = __shfl_up(v, d); if (lane >= d) v += t; }
      c0 = v - a1; c1 = v;
    } else {
#pragma unroll
      for (int d = 1; d < 64; d <<= 1) { const float t = __shfl_down(v, d); if (lane + d < 64) v += t; }
      c0 = v; c1 = v - a0;
    }
    float* lc = cumF + dir * 512 + hh * 128 + 2 * lane;
    lc[0] = c0; lc[1] = c1;
    lc[1024] = d0; lc[1025] = d1;
    float* gc = W.cumF + (size_t)dir * ((size_t)RR * 8) + (Rc0 + 2 * lane) * 8 + hg;
    gc[0] = c0; gc[8] = c1;
  }
  {
    float y[4][16];
#pragma unroll
    for (int s2 = 0; s2 < 16; ++s2) {
      float a0 = biasB.x, a1 = biasB.y, a2 = biasB.z, a3 = biasB.w;
#pragma unroll
      for (int j = 0; j < 5; ++j) {
        const uint2 v = rawB[s2 + j];
        a0 += wjB[j].x * bflo(v.x); a1 += wjB[j].y * bfhi(v.x); a2 += wjB[j].z * bflo(v.y); a3 += wjB[j].w * bfhi(v.y);
      }
      y[0][s2] = silu(a0); y[1][s2] = silu(a1); y[2][s2] = silu(a2); y[3][s2] = silu(a3);
    }
    const int s0 = 16 * w;
    if (isB) {
#pragma unroll
      for (int s2 = 0; s2 < 16; ++s2) {
        uint2 o; o.x = pk(y[0][s2], y[1][s2]); o.y = pk(y[2][s2], y[3][s2]);
        *(uint2*)&Bs[(s0 + s2) * S_LD + ch0] = o;
      }
#pragma unroll
      for (int ch = 0; ch < 4; ++ch) {
        uint4 u0, u1;
        u0.x = pk(y[ch][0], y[ch][1]); u0.y = pk(y[ch][2], y[ch][3]); u0.z = pk(y[ch][4], y[ch][5]); u0.w = pk(y[ch][6], y[ch][7]);
        u1.x = pk(y[ch][8], y[ch][9]); u1.y = pk(y[ch][10], y[ch][11]); u1.z = pk(y[ch][12], y[ch][13]); u1.w = pk(y[ch][14], y[ch][15]);
        *(uint4*)&BsT[(ch0 + ch) * S_LD + s0] = u0;
        *(uint4*)&BsT[(ch0 + ch) * S_LD + s0 + 8] = u1;
      }
    } else {
#pragma unroll
      for (int s2 = 0; s2 < 16; ++s2) {
        uint2 o; o.x = pk(y[0][s2], y[1][s2]); o.y = pk(y[2][s2], y[3][s2]);
        *(uint2*)&Cs[(s0 + s2) * S_LD + ch0] = o;
        *(uint2*)(W.Cc + (Rc0 + s0 + s2) * 256 + g * 128 + ch0) = o;
      }
    }
  }
  __syncthreads();
  const int c16 = lane & 15, q = lane >> 4;
  f32x4 G[8];
#pragma unroll
  for (int st = 0; st < 8; ++st) G[st] = (f32x4){0.f, 0.f, 0.f, 0.f};
#pragma unroll
  for (int ks = 0; ks < 4; ++ks) {
    const bf16x8 bfrag = *(const bf16x8*)&Cs[(16 * w + c16) * S_LD + 32 * ks + 8 * q];
#pragma unroll
    for (int st = 0; st < 8; ++st) {
      const bf16x8 afrag = *(const bf16x8*)&Bs[(16 * st + c16) * S_LD + 32 * ks + 8 * q];
      G[st] = MFMA16(afrag, bfrag, G[st]);
    }
  }
  __syncthreads();
  for (int hh = h_lo; hh < h_hi; ++hh) {
    const int hg = g * 4 + hh;
    {
      const int cq = tid & 15, tg = tid >> 4;
      const int col = hg * 64 + 4 * cq;
      float4 wj[5];
#pragma unroll
      for (int j = 0; j < 5; ++j) wj[j] = xw[j];
      const float4 bias = xbias;
      (void)col;
      const float cF_end = cumF[hh * 128 + 127], cB_end = cumB[hh * 128];
      float y[4][4], ff[4], fb[4];
#pragma unroll
      for (int s2 = 0; s2 < 4; ++s2) {
        float a0 = bias.x, a1 = bias.y, a2 = bias.z, a3 = bias.w;
#pragma unroll
        for (int j = 0; j < 5; ++j) {
          const uint2 v = xraw[s2 + j];
          a0 += wj[j].x * bflo(v.x); a1 += wj[j].y * bfhi(v.x); a2 += wj[j].z * bflo(v.y); a3 += wj[j].w * bfhi(v.y);
        }
        y[0][s2] = silu(a0); y[1][s2] = silu(a1); y[2][s2] = silu(a2); y[3][s2] = silu(a3);
        const int sI = 4 * tg + s2;
        ff[s2] = dtF[hh * 128 + sI] * __expf(cF_end - cumF[hh * 128 + sI]);
        fb[s2] = dtB[hh * 128 + sI] * __expf(cB_end - cumB[hh * 128 + sI]);
      }
#pragma unroll
      for (int ch = 0; ch < 4; ++ch) {
        const int p = 4 * cq + ch;
        uint2 o;
        o.x = pk(y[ch][0], y[ch][1]); o.y = pk(y[ch][2], y[ch][3]);
        *(uint2*)&xT[p * S_LD + 4 * tg] = o;
        o.x = pk(y[ch][0] * ff[0], y[ch][1] * ff[1]); o.y = pk(y[ch][2] * ff[2], y[ch][3] * ff[3]);
        *(uint2*)&xsF[p * S_LD + 4 * tg] = o;
        o.x = pk(y[ch][0] * fb[0], y[ch][1] * fb[1]); o.y = pk(y[ch][2] * fb[2], y[ch][3] * fb[3]);
        *(uint2*)&xsB[p * S_LD + 4 * tg] = o;
      }
      if (hh + 1 < h_hi) {
        ssd_xload(xraw, W.XBC + (size_t)b * TT * 1024 + (hg + 1) * 64 + 4 * cq, c * 128 + 4 * tg, seg_lo, seg_hi);
        const int coln = (hg + 1) * 64 + 4 * cq;
#pragma unroll
        for (int j = 0; j < 5; ++j) xw[j] = *(const float4*)(conv_w + j * 1024 + coln);
        xbias = *(const float4*)(conv_b + coln);
      }
    }
    __syncthreads();
    {
      const int t = 16 * w + c16;
      const float cF_t = cumF[hh * 128 + t], cB_t = cumB[hh * 128 + t];
      const float Dh = P.in[15][l * 8 + hg];
      f32x4 Y[4];
#pragma unroll
      for (int pt = 0; pt < 4; ++pt) Y[pt] = (f32x4){0.f, 0.f, 0.f, 0.f};
#pragma unroll
      for (int m = 0; m < 4; ++m) {
        __builtin_amdgcn_sched_barrier(0);
        float mv[8];
#pragma unroll
        for (int jj = 0; jj < 2; ++jj) {
          const int st = 2 * m + jj;
          const int sb = 16 * st + 4 * q;
          const float4 cf4 = *(const float4*)&cumF[hh * 128 + sb];
          const float4 df4 = *(const float4*)&dtF[hh * 128 + sb];
          const float4 cb4 = *(const float4*)&cumB[hh * 128 + sb];
          const float4 db4 = *(const float4*)&dtB[hh * 128 + sb];
          const float cfv[4] = {cf4.x, cf4.y, cf4.z, cf4.w}, dfv[4] = {df4.x, df4.y, df4.z, df4.w};
          const float cbv[4] = {cb4.x, cb4.y, cb4.z, cb4.w}, dbv[4] = {db4.x, db4.y, db4.z, db4.w};
#pragma unroll
          for (int i = 0; i < 4; ++i) {
            const int s = sb + i;
            const float ef = (s <= t) ? __expf(cF_t - cfv[i]) * dfv[i] : 0.f;
            const float eb = (s >= t) ? __expf(cB_t - cbv[i]) * dbv[i] : 0.f;
            mv[4 * jj + i] = G[st][i] * (ef + eb) + ((s == t) ? Dh : 0.f);
          }
        }
        uint4 mu;
        mu.x = pk(mv[0], mv[1]); mu.y = pk(mv[2], mv[3]); mu.z = pk(mv[4], mv[5]); mu.w = pk(mv[6], mv[7]);
        const bf16x8 Mf = __builtin_bit_cast(bf16x8, mu);
#pragma unroll
        for (int pt = 0; pt < 4; ++pt) {
          const u16* xp = xT + (16 * pt + c16) * S_LD + 32 * m + 4 * q;
          s16x4 lo = *(const s16x4*)xp;
          s16x4 hi = *(const s16x4*)(xp + 16);
          const bf16x8 af = __builtin_shufflevector(lo, hi, 0, 1, 2, 3, 4, 5, 6, 7);
          Y[pt] = MFMA16(af, Mf, Y[pt]);
        }
      }
#pragma unroll
      for (int pt = 0; pt < 4; ++pt) {
        uint2 o;
        o.x = pk(Y[pt][0], Y[pt][1]); o.y = pk(Y[pt][2], Y[pt][3]);
        *(uint2*)(W.Ycat + (Rc0 + t) * 1024 + hg * 64 + 16 * pt + 4 * q) = o;
      }
    }
#pragma unroll
    for (int dir = 0; dir < 2; ++dir) {
      const u16* xs = dir ? xsB : xsF;
      f32x4 acc[4];
#pragma unroll
      for (int pt = 0; pt < 4; ++pt) acc[pt] = (f32x4){0.f, 0.f, 0.f, 0.f};
#pragma unroll
      for (int ks = 0; ks < 4; ++ks) {
        const bf16x8 af = *(const bf16x8*)&BsT[(16 * w + c16) * S_LD + 32 * ks + 8 * q];
#pragma unroll
        for (int pt = 0; pt < 4; ++pt) {
          const bf16x8 bfr = *(const bf16x8*)&xs[(16 * pt + c16) * S_LD + 32 * ks + 8 * q];
          acc[pt] = MFMA16(af, bfr, acc[pt]);
        }
      }
      u16* dst = W.Sloc + ((((size_t)dir * 8 + b) * 18 + c) * 8 + hg) * 8192;
#pragma unroll
      for (int pt = 0; pt < 4; ++pt) {
        uint2 o;
        o.x = pk(acc[pt][0], acc[pt][1]); o.y = pk(acc[pt][2], acc[pt][3]);
        *(uint2*)(dst + (16 * pt + c16) * 128 + 16 * w + 4 * q) = o;
      }
    }
    __syncthreads();
  }
}

DI void ws_init(WS& W, unsigned char* ws) {
        W.WinT = (u16*)(ws + OFF_WIN); W.WoutT = (u16*)(ws + OFF_WOUT); W.mod = (float*)(ws + OFF_MOD);
    W.ropeG = (float2*)(ws + OFF_ROPE); W.ropeD = (float2*)(ws + OFF_ROPE + 8192);
    W.U = (u16*)(ws + OFF_U); W.Ycat = (u16*)(ws + OFF_U); W.XBC = (u16*)(ws + OFF_XBC); W.Obuf = (u16*)(ws + OFF_XBC);
    W.Z = (u16*)(ws + OFF_Z); W.DT = (float*)(ws + OFF_DT);
    W.Q = (u16*)(ws + OFF_Q); W.K = (u16*)(ws + OFF_K); W.Vt = (u16*)(ws + OFF_VT);
    W.DQ = (u16*)(ws + OFF_DQ); W.DK = (u16*)(ws + OFF_DK); W.DVt = (u16*)(ws + OFF_DVT); W.Stin = (u16*)(ws + OFF_Q);
    W.GG = (u16*)(ws + OFF_GG); W.DG = (u16*)(ws + OFF_DG); W.Cc = (u16*)(ws + OFF_CC);
    W.cumF = (float*)(ws + OFF_CUMF); W.cumB = (float*)(ws + OFF_CUMB); W.Sloc = (u16*)(ws + OFF_SLOC);
    W.Opart = (float*)(ws + OFF_OPART);
}

#define XCD_LOOP(UPX, xcd, idx) \
  const bool sw_ = (nb & 7) == 0; \
  for (int t_ = sw_ ? (bid >> 3) : bid; t_ < (sw_ ? (UPX) : 8 * (UPX)); t_ += (sw_ ? (nb >> 3) : nb)) { \
    const int xcd = sw_ ? (bid & 7) : t_ / (UPX); const int idx = sw_ ? t_ : t_ % (UPX);
#define XCD_END }

typedef const Params __attribute__((address_space(4)))* KArgP;
DI Params load_params(KArgP kp) {
  asm volatile("" : "+s"(kp));
  Params P;
#pragma unroll
  for (int i = 0; i < 22; ++i) P.in[i] = kp->in[i];
  P.out = kp->out; P.ws = kp->ws;
  return P;
}

DI void ph0_prologue(KArgP kp, unsigned char* lds) {
  const Params P = load_params(kp); WS W; ws_init(W, P.ws);
  const int tid = fresh_tid(), lane = tid & 63, w = tid >> 6;
  const int nb = gridDim.x, bid = blockIdx.x;
  (void)lane; (void)w; (void)tid;
  {
    float* S = (float*)(lds + 69632);
    for (int i = tid; i < 9 * 1024; i += NT) {
      const float x = (i < 8192) ? P.in[1][i] : P.in[3][i - 8192];
      S[i] = silu(x);
    }
    __syncthreads();
    constexpr int U_WIN = 2 * 14 * 16, U_WOUT = 2 * 4 * 16, U_MOD = 384;
    for (int u = bid; u < U_WIN + U_WOUT + U_MOD + 1; u += nb) {
      if (u < U_WIN + U_WOUT) {
        const float* src; u16* dst; int ldn, n0, k0, nrows; bool inproj;
        if (u < U_WIN) {
          const int l = u / (14 * 16), rem = u % (14 * 16);
          n0 = (rem >> 4) * 256; k0 = (rem & 15) * 64; ldn = 3344; inproj = true; nrows = NPAD;
          src = P.in[8] + (size_t)l * 1024 * 3344; dst = W.WinT + (size_t)l * NPAD * 1024;
        } else {
          const int v = u - U_WIN; const int l = v >> 6, rem = v & 63;
          n0 = (rem >> 4) * 256; k0 = (rem & 15) * 64; ldn = 1024; inproj = false; nrows = 1024;
          src = P.in[21] + (size_t)l * 1024 * 1024; dst = W.WoutT + (size_t)l * 1024 * 1024;
        }
        float* tile = (float*)lds;
        {
          const int n = tid & 63, kq = tid >> 6;
#pragma unroll
          for (int sub = 0; sub < 4; ++sub) {
            const int nd = n0 + sub * 64 + n;
            int ns = nd;
            if (inproj) { ns = (nd < 1536) ? nd : (nd < 3328 ? nd + 16 : (nd < 3344 ? nd - 3328 + 1536 : -1)); }
#pragma unroll
            for (int i = 0; i < 8; ++i) {
              const int k = kq * 8 + i;
              tile[sub * 4160 + k * 65 + n] = (ns >= 0) ? src[(size_t)(k0 + k) * ldn + ns] : 0.f;
            }
          }
        }
        __syncthreads();
        {
          const int n = tid >> 3, kc = tid & 7;
#pragma unroll
          for (int sub = 0; sub < 4; ++sub) {
            float f[8];
#pragma unroll
            for (int i = 0; i < 8; ++i) f[i] = tile[sub * 4160 + (kc * 8 + i) * 65 + n];
            uint4 o;
            o.x = pk(f[0], f[1]); o.y = pk(f[2], f[3]); o.z = pk(f[4], f[5]); o.w = pk(f[6], f[7]);
            if (n0 + sub * 64 + n < nrows) *(uint4*)(dst + (size_t)(n0 + sub * 64 + n) * 1024 + k0 + kc * 8) = o;
          }
        }
        __syncthreads();
      } else if (u < U_WIN + U_WOUT + U_MOD) {
        const int v = u - U_WIN - U_WOUT;
        const int l = v / 192, n0 = (v % 192) * 16;
        const int c16 = tid & 15, kg = tid >> 4;
        const float* wm = P.in[4] + (size_t)l * 1024 * 3072 + n0 + c16;
        float acc[9];
#pragma unroll
        for (int rr = 0; rr < 9; ++rr) acc[rr] = 0.f;
#pragma unroll 8
        for (int kk = 0; kk < 32; ++kk) {
          const int k = kg * 32 + kk;
          const float wv = wm[(size_t)k * 3072];
#pragma unroll
          for (int rr = 0; rr < 9; ++rr) acc[rr] += S[rr * 1024 + k] * wv;
        }
        float* red = (float*)lds;
#pragma unroll
        for (int rr = 0; rr < 9; ++rr) red[(kg * 16 + c16) * 9 + rr] = acc[rr];
        __syncthreads();
        if (tid < 144) {
          const int cc = tid / 9, rr = tid % 9;
          float s = 0.f;
          for (int k2 = 0; k2 < 32; ++k2) s += red[(k2 * 16 + cc) * 9 + rr];
          W.mod[((size_t)l * 9 + rr) * 3072 + n0 + cc] = s + P.in[5][l * 3072 + n0 + cc];
        }
        __syncthreads();
      } else {
        for (int i = tid; i < 64 * 16; i += NT) {
          const int idx = i >> 4, k = i & 15;
          const float inv = powf(10000.f, -(float)k / 16.f);
          float sn, cs; sincosf((float)idx * inv, &sn, &cs);
          W.ropeG[i] = make_float2(cs, sn);
        }
        for (int i = tid; i < 64 * 8; i += NT) {
          const int idx = i >> 3, k = i & 7;
          const float inv = powf(10000.f, -(float)k / 8.f);
          float sn, cs; sincosf((float)idx * inv, &sn, &cs);
          W.ropeD[i] = make_float2(cs, sn);
        }
      }
    }
  }
}

DI void ph1_prep(KArgP kp) {
  const Params P = load_params(kp); WS W; ws_init(W, P.ws);
  const int tid = fresh_tid(), lane = tid & 63, w = tid >> 6;
  const int nb = gridDim.x, bid = blockIdx.x;
  (void)lane; (void)w; (void)tid;
  XCD_LOOP(288, xcd, idx)
    const int R = xcd * TT + idx * 8 + w;
    const int b = xcd, t = idx * 8 + w;
    const float* src = (t < 256) ? (P.in[2] + ((size_t)b * 256 + t) * 1024) : (P.in[0] + ((size_t)b * 2048 + (t - 256)) * 1024);
    const float* md = W.mod + (size_t)((t < 256) ? 8 : b) * 3072;
    const float* gp = P.in[6];
    float4 x[4];
    float ss = 0.f;
#pragma unroll
    for (int i = 0; i < 4; ++i) {
      x[i] = *(const float4*)(src + i * 256 + lane * 4);
      ss += x[i].x * x[i].x + x[i].y * x[i].y + x[i].z * x[i].z + x[i].w * x[i].w;
    }
#pragma unroll
    for (int d = 32; d >= 1; d >>= 1) ss += __shfl_xor(ss, d);
    const float rn = rsqrtf(ss * (1.f / 1024.f) + EPS);
#pragma unroll
    for (int i = 0; i < 4; ++i) {
      const int k = i * 256 + lane * 4;
      const float4 g4 = *(const float4*)(gp + k);
      const float4 sh = *(const float4*)(md + k);
      const float4 sc = *(const float4*)(md + 1024 + k);
      uint2 o;
      o.x = pk(x[i].x * rn * g4.x * (1.f + sc.x) + sh.x, x[i].y * rn * g4.y * (1.f + sc.y) + sh.y);
      o.y = pk(x[i].z * rn * g4.z * (1.f + sc.z) + sh.z, x[i].w * rn * g4.w * (1.f + sc.w) + sh.w);
      *(uint2*)(W.U + (size_t)R * 1024 + k) = o;
    }
  XCD_END
}

DI void ph2_inproj(KArgP kp, int l, unsigned char* lds) {
  const Params P = load_params(kp); WS W; ws_init(W, P.ws);
  const int tid = fresh_tid();
  const int nb = gridDim.x, bid = blockIdx.x;
  XCD_LOOP(243, xcd, idx)
    const int nt = idx / 9, mt = xcd * 9 + idx % 9;
    gemm_tile_to_lds(W.U, W.WinT + (size_t)l * NPAD * 1024, mt * 256, nt * 128, lds);
    if (nt == 15 || nt == 22 || nt == 23) {
      const int b = mt / 9, t0 = (mt - b * 9) * 256;
      u16* vt = (nt == 15) ? (W.Vt + (size_t)(b * 2) * 64 * TT) : (W.DVt + (size_t)(b * 4 + (nt - 22) * 2) * 64 * TT);
      store_tile_transposed(lds, vt, t0);
    } else {
      float v[64];
      load_row64(lds, v);
      inproj_epi(P, W, l, mt * 256 + (tid >> 1), nt, tid & 1, v);
    }
    __syncthreads();
  XCD_END
}

DI void ph3_mix(KArgP kp, int l, unsigned char* lds) {
  const Params P = load_params(kp); WS W; ws_init(W, P.ws);
  const int nb = gridDim.x, bid = blockIdx.x;
  const int upx = (l == 0) ? 120 : 112;
  XCD_LOOP(upx, xcd, idx)
    const int b = xcd;
    if (idx < 32) {
      diff_unit(P, W, l, b, idx >> 3, 1 + (idx & 7), lds);
    } else if (idx < 64) {
      gqa_unit(W, P.in[17] + l * 64, P.in[18] + l * 64, b, (idx - 32) >> 3, 1 + (idx & 7), lds);
    } else if (idx < 96) {
      const int v = idx - 64;
      ssd_local_unit(P, W, l, b, v >> 1, v & 1, 0, 4, lds);
    } else if (idx < 112) {
      const int v = idx - 96, u = 32 + (v >> 2), hq = v & 3;
      ssd_local_unit(P, W, l, b, u >> 1, u & 1, hq, hq + 1, lds);
    } else if (idx < 116) {
      diff_unit(P, W, l, b, idx - 112, 0, lds);
    } else {
      gqa_unit(W, P.in[17] + l * 64, P.in[18] + l * 64, b, idx - 116, 0, lds);
    }
    __syncthreads();
  XCD_END
}

DI void ph4a_states(KArgP kp) {
  const Params P = load_params(kp); WS W; ws_init(W, P.ws);
  const int tid = fresh_tid(), lane = tid & 63, w = tid >> 6;
  const int nb = gridDim.x, bid = blockIdx.x;
  (void)lane; (void)w; (void)tid;
    XCD_LOOP(64, xcd, idx)
      const int gid = idx * NT + tid;
      const int e4 = gid & 2047, hg = (gid >> 11) & 7, b = xcd, dir = gid >> 14;
      float s0 = 0.f, s1 = 0.f, s2 = 0.f, s3 = 0.f;
      for (int step = 0; step < 18; ++step) {
        const int c = dir ? (step == 0 ? 1 : (step == 1 ? 0 : 19 - step)) : step;
        const size_t idx = ((((size_t)dir * 8 + b) * 18 + c) * 8 + hg) * 8192 + (size_t)e4 * 4;
        uint2 o;
        o.x = pk(s0, s1); o.y = pk(s2, s3);
        *(uint2*)(W.Stin + idx) = o;
        const float tot = W.cumF[(size_t)dir * ((size_t)RR * 8) + ((size_t)b * TT + c * 128 + (dir ? 0 : 127)) * 8 + hg];
        const float dec = __expf(tot);
        const uint2 sv = *(const uint2*)(W.Sloc + idx);
        s0 = s0 * dec + bflo(sv.x); s1 = s1 * dec + bfhi(sv.x);
        s2 = s2 * dec + bflo(sv.y); s3 = s3 * dec + bfhi(sv.y);
      }
    XCD_END
}

DI void ph4b_yoff(KArgP kp, int l, unsigned char* lds) {
  const Params P = load_params(kp); WS W; ws_init(W, P.ws);
  const int tid = fresh_tid(), lane = tid & 63, w = tid >> 6;
  const int nb = gridDim.x, bid = blockIdx.x;
  (void)lane; (void)w; (void)tid;
    XCD_LOOP((l == 0 ? 72 : 64), xcd, idx)
      const int b = xcd, c = (idx >> 2) + (l == 0 ? 0 : 2), tb = idx & 3;
      const int r = lane & 31, h2 = lane >> 5;
      const int hg = w, g = w >> 2;
      const size_t Rr = (size_t)b * TT + c * 128 + 32 * tb + r;
      f32x16 acc[2][2];
#pragma unroll
      for (int d = 0; d < 2; ++d)
#pragma unroll
        for (int pt = 0; pt < 2; ++pt)
#pragma unroll
          for (int e = 0; e < 16; ++e) acc[d][pt][e] = 0.f;
      const u16* cp = W.Cc + Rr * 256 + g * 128 + 8 * h2;
      bf16x8 bfr[8];
#pragma unroll
      for (int ks = 0; ks < 8; ++ks) bfr[ks] = *(const bf16x8*)(cp + 16 * ks);
      u16* myl = (u16*)lds + w * (64 * 136);
#pragma unroll
      for (int d = 0; d < 2; ++d) {
        const u16* sp = W.Stin + ((((size_t)d * 8 + b) * 18 + c) * 8 + hg) * 8192 + lane * 8;
        u32x4 sv[16];
#pragma unroll
        for (int i = 0; i < 16; ++i) sv[i] = *(const u32x4*)(sp + i * 512);
#pragma unroll
        for (int i = 0; i < 16; ++i) *(u32x4*)(myl + (4 * i + (lane >> 4)) * 136 + (lane & 15) * 8) = sv[i];
        __builtin_amdgcn_wave_barrier();
#pragma unroll
        for (int ks = 0; ks < 8; ++ks) {
          const bf16x8 f0 = *(const bf16x8*)(myl + r * 136 + 16 * ks + 8 * h2);
          const bf16x8 f1 = *(const bf16x8*)(myl + (32 + r) * 136 + 16 * ks + 8 * h2);
          acc[d][0] = MFMA32(f0, bfr[ks], acc[d][0]);
          acc[d][1] = MFMA32(f1, bfr[ks], acc[d][1]);
        }
        __builtin_amdgcn_wave_barrier();
      }
      const float eF = __expf(W.cumF[Rr * 8 + hg]), eB = __expf(W.cumB[Rr * 8 + hg]);
      float ss = 0.f;
#pragma unroll
      for (int pt = 0; pt < 2; ++pt)
#pragma unroll
        for (int i4 = 0; i4 < 4; ++i4) {
          const int p = 32 * pt + 8 * i4 + 4 * h2;
          const uint2 yd = *(const uint2*)(W.Ycat + Rr * 1024 + hg * 64 + p);
          const uint2 zz = *(const uint2*)(W.Z + Rr * 512 + hg * 64 + p);
          float y0 = bflo(yd.x) + eF * acc[0][pt][4 * i4] + eB * acc[1][pt][4 * i4];
          float y1 = bfhi(yd.x) + eF * acc[0][pt][4 * i4 + 1] + eB * acc[1][pt][4 * i4 + 1];
          float y2 = bflo(yd.y) + eF * acc[0][pt][4 * i4 + 2] + eB * acc[1][pt][4 * i4 + 2];
          float y3 = bfhi(yd.y) + eF * acc[0][pt][4 * i4 + 3] + eB * acc[1][pt][4 * i4 + 3];
          y0 *= silu(bflo(zz.x)); y1 *= silu(bfhi(zz.x)); y2 *= silu(bflo(zz.y)); y3 *= silu(bfhi(zz.y));
          acc[0][pt][4 * i4] = y0; acc[0][pt][4 * i4 + 1] = y1; acc[0][pt][4 * i4 + 2] = y2; acc[0][pt][4 * i4 + 3] = y3;
          ss += y0 * y0 + y1 * y1 + y2 * y2 + y3 * y3;
        }
      ss += __shfl_xor(ss, 32);
      float* red = (float*)(lds + 8 * 64 * 136 * 2);
      if (h2 == 0) red[w * 32 + r] = ss;
      __syncthreads();
      float tot = 0.f;
#pragma unroll
      for (int k = 0; k < 8; ++k) tot += red[k * 32 + r];
      const float rn = rsqrtf(tot * (1.f / 512.f) + EPS);
      const float* ng = P.in[16] + l * 512 + hg * 64;
#pragma unroll
      for (int pt = 0; pt < 2; ++pt)
#pragma unroll
        for (int i4 = 0; i4 < 4; ++i4) {
          const int p = 32 * pt + 8 * i4 + 4 * h2;
          const float4 n4 = *(const float4*)(ng + p);
          uint2 o;
          o.x = pk(acc[0][pt][4 * i4] * rn * n4.x, acc[0][pt][4 * i4 + 1] * rn * n4.y);
          o.y = pk(acc[0][pt][4 * i4 + 2] * rn * n4.z, acc[0][pt][4 * i4 + 3] * rn * n4.w);
          *(uint2*)(W.Ycat + Rr * 1024 + hg * 64 + p) = o;
        }
      __syncthreads();
    XCD_END
}

DI void ph5_outproj(KArgP kp, int l, unsigned char* lds) {
  const Params P = load_params(kp); WS W; ws_init(W, P.ws);
  const int tid = fresh_tid();
  const int nb = gridDim.x, bid = blockIdx.x;
  const int upx = (l == 0) ? 72 : 64;
  XCD_LOOP(upx, xcd, idx)
    const int mt = xcd * 9 + (idx >> 3) + (l == 0 ? 0 : 1), nt = idx & 7;
    gemm_tile_to_lds(W.Ycat, W.WoutT + (size_t)l * 1024 * 1024, mt * 256, nt * 128, lds);
    float v[64];
    load_row64(lds, v);
    const size_t R = (size_t)mt * 256 + (tid >> 1);
    float ss = 0.f;
#pragma unroll
    for (int j = 0; j < 64; ++j) ss += v[j] * v[j];
    W.Opart[R * 16 + nt * 2 + (tid & 1)] = ss;
    store64(W.Obuf + R * 1024 + nt * 128 + (tid & 1) * 64, v);
    __syncthreads();
  XCD_END
}

DI void ph6_post(KArgP kp, int l) {
  const Params P = load_params(kp); WS W; ws_init(W, P.ws);
  const int tid = fresh_tid(), lane = tid & 63, w = tid >> 6;
  const int nb = gridDim.x, bid = blockIdx.x;
  (void)lane; (void)w; (void)tid;
    XCD_LOOP(288, xcd, idx)
      const int R = xcd * TT + idx * 8 + w;
      const int b = xcd, t = idx * 8 + w;
      const bool isctx = t < 256;
      if (l == 1 && isctx) continue;
      const float* md = W.mod + ((size_t)l * 9 + (isctx ? 8 : b)) * 3072;
      const float* hsrc;
      if (isctx) hsrc = P.in[2] + ((size_t)b * 256 + t) * 1024;
      else hsrc = (l == 0 ? P.in[0] : (const float*)P.out) + ((size_t)b * 2048 + (t - 256)) * 1024;
      float pss = (lane < 16) ? W.Opart[(size_t)R * 16 + lane] : 0.f;
#pragma unroll
      for (int d = 8; d >= 1; d >>= 1) pss += __shfl_xor(pss, d);
      pss = __shfl(pss, 0);
      const float rn = rsqrtf(pss * (1.f / 1024.f) + EPS);
      const float* gpost = P.in[7] + l * 1024;
      float4 hn[4];
      float ss = 0.f;
#pragma unroll
      for (int i = 0; i < 4; ++i) {
        const int k = i * 256 + lane * 4;
        const float4 hv = *(const float4*)(hsrc + k);
        const uint2 ov = *(const uint2*)(W.Obuf + (size_t)R * 1024 + k);
        const float4 g4 = *(const float4*)(gpost + k);
        const float4 gt = *(const float4*)(md + 2048 + k);
        hn[i].x = hv.x + gt.x * (bflo(ov.x) * rn * g4.x);
        hn[i].y = hv.y + gt.y * (bfhi(ov.x) * rn * g4.y);
        hn[i].z = hv.z + gt.z * (bflo(ov.y) * rn * g4.z);
        hn[i].w = hv.w + gt.w * (bfhi(ov.y) * rn * g4.w);
        ss += hn[i].x * hn[i].x + hn[i].y * hn[i].y + hn[i].z * hn[i].z + hn[i].w * hn[i].w;
      }
      if (!isctx) {
        float* dst = P.out + ((size_t)b * 2048 + (t - 256)) * 1024;
#pragma unroll
        for (int i = 0; i < 4; ++i) *(float4*)(dst + i * 256 + lane * 4) = hn[i];
      }
      if (l == 0) {
#pragma unroll
        for (int d = 32; d >= 1; d >>= 1) ss += __shfl_xor(ss, d);
        const float r2 = rsqrtf(ss * (1.f / 1024.f) + EPS);
        const float* md1 = W.mod + ((size_t)9 + (isctx ? 8 : b)) * 3072;
        const float* gp = P.in[6] + 1024;
#pragma unroll
        for (int i = 0; i < 4; ++i) {
          const int k = i * 256 + lane * 4;
          const float4 g4 = *(const float4*)(gp + k);
          const float4 sh = *(const float4*)(md1 + k);
          const float4 sc = *(const float4*)(md1 + 1024 + k);
          uint2 o;
          o.x = pk(hn[i].x * r2 * g4.x * (1.f + sc.x) + sh.x, hn[i].y * r2 * g4.y * (1.f + sc.y) + sh.y);
          o.y = pk(hn[i].z * r2 * g4.z * (1.f + sc.z) + sh.z, hn[i].w * r2 * g4.w * (1.f + sc.w) + sh.w);
          *(uint2*)(W.U + (size_t)R * 1024 + k) = o;
        }
      }
    XCD_END
}


#define XB_TMO      128
#define XB_XCNT(j)  (256  + 64 * (j))
#define XB_XSUB(j)  (1280 + 64 * (j))
#define XB_XGEN(j)  (2304 + 64 * (j))
#define XB_TOP      3328
#define XB_TOPGEN   3392
#define XCD_BAR_WORDS 3456
#define XB_SPIN_CAP (1u << 18)
#define LAS __attribute__((address_space(3)))

__device__ __forceinline__ unsigned xb_ld(unsigned* p)              { return __hip_atomic_load(p, __ATOMIC_RELAXED, __HIP_MEMORY_SCOPE_AGENT); }
__device__ __forceinline__ unsigned xb_add(unsigned* p, unsigned v) { return __hip_atomic_fetch_add(p, v, __ATOMIC_RELAXED, __HIP_MEMORY_SCOPE_AGENT); }
__device__ __forceinline__ unsigned xb_xcc_id() { return (unsigned)__builtin_amdgcn_s_getreg((3 << 11) | 20) & 0xFu; }
#define XB_SPIN(cond, bar) do { unsigned _sp = 0; while (cond) { __builtin_amdgcn_s_sleep(1); \
    if ((++_sp & 255u) == 0u) { if (xb_ld(&(bar)[XB_TMO])) break; if (_sp > XB_SPIN_CAP) { atomicAdd(&(bar)[XB_TMO], 1u); break; } } } } while (0)

struct XcdBarrier {
    unsigned* bar; unsigned x;
    volatile LAS unsigned* st;
};

__device__ __forceinline__ XcdBarrier xcd_barrier_post(unsigned* bar, volatile LAS unsigned* st) {
    XcdBarrier b; b.bar = bar; b.x = xb_xcc_id(); b.st = st;
    if (threadIdx.x == 0) (void)xb_add(&bar[XB_XCNT(b.x)], 1u);
    return b;
}
__device__ __forceinline__ void xcd_barrier_complete(unsigned* bar, unsigned x, unsigned& nloc, unsigned& nx) {
    const unsigned G = gridDim.x * gridDim.y * gridDim.z;
    unsigned sum, cnt, mine, sp = 0u;
    for (;;) {
        sum = 0u; cnt = 0u; mine = 0u;
#pragma unroll
        for (unsigned j = 0; j < 16; ++j) { const unsigned c = xb_ld(&bar[XB_XCNT(j)]); sum += c; cnt += (c > 0u) ? 1u : 0u; mine = (j == x) ? c : mine; }
        if (sum == G) break;
        __builtin_amdgcn_s_sleep(1);
        if ((++sp & 255u) == 0u) { if (xb_ld(&bar[XB_TMO])) break; if (sp > XB_SPIN_CAP) { atomicAdd(&bar[XB_TMO], 1u); break; } }
    }
    nloc = mine > 0u ? mine : 1u; nx = cnt > 0u ? cnt : 1u;
}

__device__ __forceinline__ void xcd_barrier(const XcdBarrier& b) {
    asm volatile("s_waitcnt vmcnt(0)" ::: "memory");
    __syncthreads();
    if (threadIdx.x == 0) {
        unsigned* bar = b.bar;
        __builtin_amdgcn_s_waitcnt(0);
        unsigned nloc = b.st[0], nx = b.st[1];
        if (nloc == 0u) { xcd_barrier_complete(bar, b.x, nloc, nx); b.st[0] = nloc; b.st[1] = nx; }
        const unsigned old = xb_add(&bar[XB_XSUB(b.x)], 1u);
        const unsigned gen = old / nloc;
        if (old + 1u == (gen + 1u) * nloc) {
            __builtin_amdgcn_fence(__ATOMIC_RELEASE, "agent");
            asm volatile("s_waitcnt vmcnt(0)" ::: "memory");
            const unsigned og = xb_add(&bar[XB_TOP], 1u);
            const unsigned tg = og / nx;
            if (og + 1u == (tg + 1u) * nx) xb_add(&bar[XB_TOPGEN], 1u);
            else XB_SPIN(xb_ld(&bar[XB_TOPGEN]) == tg, bar);
            __builtin_amdgcn_fence(__ATOMIC_ACQUIRE, "agent");
            xb_add(&bar[XB_XGEN(b.x)], 1u);
            asm volatile("s_waitcnt vmcnt(0)" ::: "memory");
        } else {
            XB_SPIN(xb_ld(&bar[XB_XGEN(b.x)]) == gen, bar);
            __builtin_amdgcn_fence(__ATOMIC_ACQUIRE, "agent");
            asm volatile("s_waitcnt vmcnt(0)" ::: "memory");
        }
    }
    __syncthreads();
}

DI void grid_barrier(unsigned* bar, unsigned& epoch) {
  asm volatile("s_waitcnt vmcnt(0)" ::: "memory");
  __syncthreads();
  ++epoch;
  if (threadIdx.x == 0) {
    __builtin_amdgcn_fence(__ATOMIC_RELEASE, "agent");
    asm volatile("s_waitcnt vmcnt(0)" ::: "memory");
    const unsigned nb = gridDim.x, bid = blockIdx.x;
    const bool hier = (nb & 7u) == 0u;
    const unsigned ng = hier ? 8u : 1u, per = hier ? (nb >> 3) : nb;
    unsigned* grp = bar + 64 * (1 + (hier ? (bid & 7u) : 0u));
    const unsigned old = __hip_atomic_fetch_add(grp, 1u, __ATOMIC_RELAXED, __HIP_MEMORY_SCOPE_AGENT);
    if (old + 1u == epoch * per) __hip_atomic_fetch_add(bar, 1u, __ATOMIC_RELAXED, __HIP_MEMORY_SCOPE_AGENT);
    const unsigned target = epoch * ng;
    while (__hip_atomic_load(bar, __ATOMIC_RELAXED, __HIP_MEMORY_SCOPE_AGENT) < target) __builtin_amdgcn_s_sleep(1);
    __builtin_amdgcn_fence(__ATOMIC_ACQUIRE, "agent");
    asm volatile("s_waitcnt vmcnt(0)" ::: "memory");
  }
  __syncthreads();
}

__global__ void __launch_bounds__(NT) fwd_mega(Params Parg) {
  extern __shared__ __attribute__((aligned(16))) unsigned char lds[];
  cg::grid_group grid = cg::this_grid();
  KArgP kp = (KArgP)__builtin_amdgcn_kernarg_segment_ptr();
  unsigned* bar = (unsigned*)(Parg.ws + OFF_BAR);
  if (gridDim.x == 0x7fffffffu) grid.sync();
  volatile LAS unsigned* xst = (volatile LAS unsigned*)((LAS unsigned char*)lds + (LDS_BYTES - 64));
  if (threadIdx.x == 0) { xst[0] = 0u; xst[1] = 0u; }
  __syncthreads();
  const XcdBarrier xb = xcd_barrier_post(bar, xst);

  ph0_prologue(kp, lds);
  xcd_barrier(xb);

  ph1_prep(kp);
  xcd_barrier(xb);

  for (int l = 0; l < 2; ++l) {
    ph2_inproj(kp, l, lds);
    xcd_barrier(xb);

    ph3_mix(kp, l, lds);
    xcd_barrier(xb);

    ph4a_states(kp);
    xcd_barrier(xb);

    ph4b_yoff(kp, l, lds);
    xcd_barrier(xb);

    ph5_outproj(kp, l, lds);
    xcd_barrier(xb);

    ph6_post(kp, l);
    if (l == 0) xcd_barrier(xb);
  }
}

extern "C" void kernel_launch(void* const* d_in, const int* in_sizes, int n_in,
                              void* d_out, int out_size, void* d_ws, size_t ws_size,
                              hipStream_t stream) {
  static int grid_blocks = 0;
  if (!grid_blocks) {
    int dev = 0, cus = 0, per_cu = 0;
    (void)hipGetDevice(&dev);
    (void)hipDeviceGetAttribute(&cus, hipDeviceAttributeMultiprocessorCount, dev);
    (void)hipFuncSetAttribute((const void*)fwd_mega, hipFuncAttributeMaxDynamicSharedMemorySize, LDS_BYTES);
    (void)hipOccupancyMaxActiveBlocksPerMultiprocessor(&per_cu, (const void*)fwd_mega, NT, LDS_BYTES);
    if (per_cu < 1) per_cu = 1;
    grid_blocks = cus * per_cu;
    if (ws_size < WS_END) fprintf(stderr, "workspace too small: %zu < %zu\n", ws_size, (size_t)WS_END);
  }
  Params p{};
  for (int i = 0; i < 22; ++i) p.in[i] = (const float*)d_in[i];
  p.out = (float*)d_out;
  p.ws = (unsigned char*)d_ws;
  (void)hipMemsetAsync((unsigned char*)d_ws + OFF_BAR, 0, 16384, stream);
  void* args[] = {&p};
  hipError_t e = hipLaunchCooperativeKernel((const void*)fwd_mega, dim3(grid_blocks), dim3(NT), args, LDS_BYTES, stream);
  if (e != hipSuccess) fprintf(stderr, "cooperative launch failed: %s (grid %d)\n", hipGetErrorString(e), grid_blocks);
}
```

```cpp
#include <hip/hip_runtime.h>
#include <hip/hip_cooperative_groups.h>
#include <cstdio>
namespace cg = cooperative_groups;

#define DI __device__ __forceinline__
#define NT 512
static __device__ __forceinline__ int fresh_tid() { int t = threadIdx.x; asm volatile("" : "+v"(t)); return t; }
typedef unsigned short u16;
typedef __attribute__((ext_vector_type(8))) short bf16x8;
typedef __attribute__((ext_vector_type(4))) short s16x4;
typedef __attribute__((ext_vector_type(16))) float f32x16;
typedef __attribute__((ext_vector_type(4))) float f32x4;
typedef __attribute__((ext_vector_type(2))) __bf16 bf2v;
typedef __attribute__((ext_vector_type(2))) float f2v;
typedef unsigned __attribute__((ext_vector_type(4))) u32x4;

#define MFMA32(a, b, c) __builtin_amdgcn_mfma_f32_32x32x16_bf16((a), (b), (c), 0, 0, 0)
#define MFMA16(a, b, c) __builtin_amdgcn_mfma_f32_16x16x32_bf16((a), (b), (c), 0, 0, 0)

constexpr int LDS_BYTES = 140 * 1024;
constexpr int TT = 2304;
constexpr int RR = 18432;
constexpr int NPAD = 3456;
constexpr float EPS = 1e-6f;
constexpr float LOG2E = 1.4426950408889634f;

constexpr size_t SZ_WIN = (size_t)2 * NPAD * 1024 * 2;
constexpr size_t SZ_WOUT = (size_t)2 * 1024 * 1024 * 2;
constexpr size_t SZ_MOD = (size_t)2 * 9 * 3072 * 4;
constexpr size_t SZ_ROPE = 16384;
constexpr size_t SZ_R1024 = (size_t)RR * 1024 * 2;
constexpr size_t SZ_R512 = (size_t)RR * 512 * 2;
constexpr size_t SZ_R256 = (size_t)RR * 256 * 2;
constexpr size_t OFF_WIN = 0;
constexpr size_t OFF_WOUT = OFF_WIN + SZ_WIN;
constexpr size_t OFF_MOD = OFF_WOUT + SZ_WOUT;
constexpr size_t OFF_ROPE = OFF_MOD + SZ_MOD;
constexpr size_t OFF_U = OFF_ROPE + SZ_ROPE;
constexpr size_t OFF_XBC = OFF_U + SZ_R1024;
constexpr size_t OFF_Z = OFF_XBC + SZ_R1024;
constexpr size_t OFF_DT = OFF_Z + SZ_R512;
constexpr size_t SZ_DT = (size_t)RR * 16 * 4;
constexpr size_t OFF_Q = OFF_DT + SZ_DT;
constexpr size_t SZ_Q = (size_t)8 * 4 * TT * 64 * 2;
constexpr size_t OFF_K = OFF_Q + SZ_Q;
constexpr size_t SZ_K = (size_t)8 * 2 * TT * 64 * 2;
constexpr size_t OFF_VT = OFF_K + SZ_K;
constexpr size_t OFF_DQ = OFF_VT + SZ_K;
constexpr size_t SZ_DQ = (size_t)8 * 8 * TT * 32 * 2;
constexpr size_t OFF_DK = OFF_DQ + SZ_DQ;
constexpr size_t OFF_DVT = OFF_DK + SZ_DQ;
constexpr size_t SZ_DVT = (size_t)8 * 4 * 64 * TT * 2;
constexpr size_t OFF_GG = OFF_DVT + SZ_DVT;
constexpr size_t OFF_DG = OFF_GG + SZ_R256;
constexpr size_t OFF_CC = OFF_DG + SZ_R256;
constexpr size_t OFF_CUMF = OFF_CC + SZ_R256;
constexpr size_t SZ_CUM = (size_t)RR * 8 * 4;
constexpr size_t OFF_CUMB = OFF_CUMF + SZ_CUM;
constexpr size_t OFF_SLOC = OFF_CUMB + SZ_CUM;
constexpr size_t SZ_ST = (size_t)2 * 8 * 18 * 8 * 8192 * 2;
constexpr size_t OFF_OPART = OFF_SLOC + SZ_ST;
constexpr size_t OFF_HB = OFF_OPART + SZ_DT;
constexpr size_t SZ_HB = (size_t)8 * 2048 * 1024 * 2;
constexpr size_t OFF_BAR = OFF_HB + SZ_HB;
constexpr size_t WS_END = OFF_BAR + 16384;
static_assert(SZ_ST <= (OFF_GG - OFF_Q), "Stin must fit in the q/k/v region");
static_assert(WS_END <= (size_t)256 * 1024 * 1024, "workspace");

struct Params {
  const float* in[22];
  float* out;
  unsigned char* ws;
};

struct WS {
  u16 *WinT, *WoutT, *U, *Ycat, *XBC, *Obuf, *Z, *Q, *K, *Vt, *DQ, *DK, *DVt, *GG, *DG, *Cc, *Sloc, *Stin;
  float *mod, *DT, *cumF, *cumB, *Opart;
  float2 *ropeG, *ropeD;
};

DI unsigned pk(float a, float b) { f2v v = {a, b}; return __builtin_bit_cast(unsigned, __builtin_convertvector(v, bf2v)); }
DI u16 f2bf(float a) { return (u16)(pk(a, 0.f) & 0xffffu); }
DI float bf2f(u16 b) { return __uint_as_float(((unsigned)b) << 16); }
DI float bflo(unsigned u) { return __uint_as_float(u << 16); }
DI float bfhi(unsigned u) { return __uint_as_float(u & 0xffff0000u); }
DI float silu(float x) { return x / (1.f + __expf(-x)); }
DI float softplus(float x) { return fmaxf(x, 0.f) + log1pf(__expf(-fabsf(x))); }
DI float fexp2(float x) { return __builtin_amdgcn_exp2f(x); }

DI void store64(u16* dst, const float (&v)[64]) {
#pragma unroll
  for (int i = 0; i < 8; ++i) {
    uint4 u;
    u.x = pk(v[8 * i], v[8 * i + 1]); u.y = pk(v[8 * i + 2], v[8 * i + 3]);
    u.z = pk(v[8 * i + 4], v[8 * i + 5]); u.w = pk(v[8 * i + 6], v[8 * i + 7]);
    ((uint4*)dst)[i] = u;
  }
}

struct GRegs { u32x4 a0, a1, a2, a3, b0, b1; };
DI void g_load(GRegs& R, const u16* ag, const u16* bg, int k0) {
  constexpr size_t K = 1024;
  R.a0 = *(const u32x4*)(ag + k0);
  R.a1 = *(const u32x4*)(ag + 64 * K + k0);
  R.a2 = *(const u32x4*)(ag + 128 * K + k0);
  R.a3 = *(const u32x4*)(ag + 192 * K + k0);
  R.b0 = *(const u32x4*)(bg + k0);
  R.b1 = *(const u32x4*)(bg + 64 * K + k0);
}
DI void g_store(const GRegs& R, u16* as, u16* bs) {
  *(u32x4*)(as) = R.a0;
  *(u32x4*)(as + 64 * 72) = R.a1;
  *(u32x4*)(as + 128 * 72) = R.a2;
  *(u32x4*)(as + 192 * 72) = R.a3;
  *(u32x4*)(bs) = R.b0;
  *(u32x4*)(bs + 64 * 72) = R.b1;
}
DI void g_compute(const u16* as, const u16* bs, f32x16 (&acc)[2][2]) {
#pragma unroll
  for (int ks = 0; ks < 4; ++ks) {
    bf16x8 a0 = *(const bf16x8*)(as + 16 * ks);
    bf16x8 a1 = *(const bf16x8*)(as + 32 * 72 + 16 * ks);
    bf16x8 b0 = *(const bf16x8*)(bs + 16 * ks);
    bf16x8 b1 = *(const bf16x8*)(bs + 32 * 72 + 16 * ks);
    acc[0][0] = MFMA32(a0, b0, acc[0][0]);
    acc[0][1] = MFMA32(a0, b1, acc[0][1]);
    acc[1][0] = MFMA32(a1, b0, acc[1][0]);
    acc[1][1] = MFMA32(a1, b1, acc[1][1]);
  }
}
constexpr int G_LDK = 72;
constexpr int G_CST = 132;
DI void gemm_tile_to_lds(const u16* __restrict__ A, const u16* __restrict__ Bt, int m0, int n0, unsigned char* lds) {
  constexpr int K = 1024;
  u16* As = (u16*)lds;
  u16* Bs = (u16*)(lds + 2 * 256 * G_LDK * 2);
  const int tid = fresh_tid(), lane = tid & 63, w = tid >> 6;
  const int r = lane & 31, h = lane >> 5;
  const int wm = w >> 1, wn = w & 1;
  const int arow = tid >> 3, akc = tid & 7;
  const u16* ag = A + (size_t)(m0 + arow) * K + akc * 8;
  const u16* bg = Bt + (size_t)(n0 + arow) * K + akc * 8;
  f32x16 acc[2][2];
#pragma unroll
  for (int i = 0; i < 2; ++i)
#pragma unroll
    for (int j = 0; j < 2; ++j)
#pragma unroll
      for (int e = 0; e < 16; ++e) acc[i][j][e] = 0.f;
  GRegs R0, R1;
  g_load(R0, ag, bg, 0);
  g_load(R1, ag, bg, 64);
  g_store(R0, As + arow * G_LDK + akc * 8, Bs + arow * G_LDK + akc * 8);
  __syncthreads();
  const u16* as0 = As + (64 * wm + r) * G_LDK + 8 * h;
  const u16* bs0 = Bs + (64 * wn + r) * G_LDK + 8 * h;
  for (int kt2 = 0; kt2 < 16; kt2 += 2) {
    if (kt2 + 2 < 16) g_load(R0, ag, bg, (kt2 + 2) * 64);
    g_compute(as0, bs0, acc);
    g_store(R1, As + 256 * G_LDK + arow * G_LDK + akc * 8, Bs + 128 * G_LDK + arow * G_LDK + akc * 8);
    __syncthreads();
    if (kt2 + 3 < 16) g_load(R1, ag, bg, (kt2 + 3) * 64);
    g_compute(as0 + 256 * G_LDK, bs0 + 128 * G_LDK, acc);
    if (kt2 + 2 < 16) g_store(R0, As + arow * G_LDK + akc * 8, Bs + arow * G_LDK + akc * 8);
    __syncthreads();
  }
  float* Cst = (float*)lds;
#pragma unroll
  for (int i = 0; i < 2; ++i)
#pragma unroll
    for (int j = 0; j < 2; ++j)
#pragma unroll
      for (int e = 0; e < 16; ++e) {
        const int row = 64 * wm + 32 * i + (e & 3) + 8 * (e >> 2) + 4 * h;
        Cst[row * G_CST + 64 * wn + 32 * j + r] = acc[i][j][e];
      }
  __syncthreads();
}

DI void load_row64(const unsigned char* lds, float (&v)[64]) {
  const int tid = fresh_tid();
  const float* src = (const float*)lds + (tid >> 1) * G_CST + (tid & 1) * 64;
#pragma unroll
  for (int i = 0; i < 16; ++i) {
    float4 f = ((const float4*)src)[i];
    v[4 * i] = f.x; v[4 * i + 1] = f.y; v[4 * i + 2] = f.z; v[4 * i + 3] = f.w;
  }
}

DI void store_tile_transposed(const unsigned char* lds, u16* vt, int t0) {
  const int tid = fresh_tid();
  const int col = tid & 127, rg = tid >> 7;
  const float* src = (const float*)lds + (rg * 64) * G_CST + col;
  u16* dst = vt + (size_t)col * TT + t0 + rg * 64;
#pragma unroll
  for (int i = 0; i < 8; ++i) {
    float f[8];
#pragma unroll
    for (int k = 0; k < 8; ++k) f[k] = src[(8 * i + k) * G_CST];
    uint4 u;
    u.x = pk(f[0], f[1]); u.y = pk(f[2], f[3]); u.z = pk(f[4], f[5]); u.w = pk(f[6], f[7]);
    ((uint4*)dst)[i] = u;
  }
}

DI void inproj_epi(const Params& P, const WS& W, int l, int R, int nt, int half, float (&v)[64]) {
  const int b = R / TT;
  const int t = R - b * TT;
  if (nt < 8) {
    store64(W.XBC + (size_t)R * 1024 + nt * 128 + half * 64, v);
  } else if (nt < 12) {
    store64(W.Z + (size_t)R * 512 + (nt - 8) * 128 + half * 64, v);
  } else if (nt < 15) {
    const bool isq = nt < 14;
    const float* g = (isq ? P.in[17] : P.in[18]) + l * 64;
    float ss = 0.f;
#pragma unroll
    for (int j = 0; j < 64; ++j) ss += v[j] * v[j];
    const float rn = rsqrtf(ss * (1.f / 64.f) + EPS);
#pragma unroll
    for (int j = 0; j < 64; ++j) { if ((j & 15) == 0) __builtin_amdgcn_sched_barrier(0); v[j] = v[j] * rn * g[j]; }
    if (t >= 256) {
      const int pos = t - 256, ri = pos >> 6, ci = pos & 63;
#pragma unroll
      for (int i = 0; i < 32; ++i) {
        if ((i & 7) == 0) __builtin_amdgcn_sched_barrier(0);
        const float2 cs = (i < 16) ? W.ropeG[ri * 16 + i] : W.ropeG[ci * 16 + (i - 16)];
        const float x1 = v[i], x2 = v[i + 32];
        v[i] = x1 * cs.x - x2 * cs.y;
        v[i + 32] = x2 * cs.x + x1 * cs.y;
      }
    }
    if (isq) {
      const float sc = 0.125f * LOG2E;
#pragma unroll
      for (int j = 0; j < 64; ++j) v[j] *= sc;
      const int head = (nt - 12) * 2 + half;
      store64(W.Q + ((size_t)(b * 4 + head) * TT + t) * 64, v);
    } else {
      store64(W.K + ((size_t)(b * 2 + half) * TT + t) * 64, v);
    }
  } else if (nt == 15) {
    u16* dst = W.Vt + ((size_t)(b * 2 + half) * 64) * TT + t;
#pragma unroll
    for (int j = 0; j < 64; ++j) { if ((j & 7) == 0) __builtin_amdgcn_sched_barrier(0); dst[(size_t)j * TT] = f2bf(v[j]); }
  } else if (nt < 18) {
#pragma unroll
    for (int j = 0; j < 64; ++j) v[j] = silu(v[j]);
    store64(W.GG + (size_t)R * 256 + (nt - 16) * 128 + half * 64, v);
  } else if (nt < 22) {
    const bool isq = nt < 20;
    const int mbase = (nt - (isq ? 18 : 20)) * 4 + half * 2;
    if (t >= 256) {
      const int pos = t - 256, ri = pos >> 6, ci = pos & 63;
#pragma unroll
      for (int mm = 0; mm < 2; ++mm)
#pragma unroll
        for (int i = 0; i < 16; ++i) {
          if ((i & 7) == 0) __builtin_amdgcn_sched_barrier(0);
          const float2 cs = (i < 8) ? W.ropeD[ri * 8 + i] : W.ropeD[ci * 8 + (i - 8)];
          const float x1 = v[32 * mm + i], x2 = v[32 * mm + i + 16];
          v[32 * mm + i] = x1 * cs.x - x2 * cs.y;
          v[32 * mm + i + 16] = x2 * cs.x + x1 * cs.y;
        }
    }
    if (isq) {
      const float sc = 0.17677669529663687f * LOG2E;
#pragma unroll
      for (int j = 0; j < 64; ++j) v[j] *= sc;
    }
    u16* base = isq ? W.DQ : W.DK;
#pragma unroll
    for (int mm = 0; mm < 2; ++mm) {
      u16* dst = base + ((size_t)(b * 8 + mbase + mm) * TT + t) * 32;
#pragma unroll
      for (int i = 0; i < 4; ++i) {
        uint4 u;
        u.x = pk(v[32 * mm + 8 * i], v[32 * mm + 8 * i + 1]); u.y = pk(v[32 * mm + 8 * i + 2], v[32 * mm + 8 * i + 3]);
        u.z = pk(v[32 * mm + 8 * i + 4], v[32 * mm + 8 * i + 5]); u.w = pk(v[32 * mm + 8 * i + 6], v[32 * mm + 8 * i + 7]);
        ((uint4*)dst)[i] = u;
      }
    }
  } else if (nt < 24) {
    const int head = (nt - 22) * 2 + half;
    u16* dst = W.DVt + ((size_t)(b * 4 + head) * 64) * TT + t;
#pragma unroll
    for (int j = 0; j < 64; ++j) { if ((j & 7) == 0) __builtin_amdgcn_sched_barrier(0); dst[(size_t)j * TT] = f2bf(v[j]); }
  } else if (nt < 26) {
#pragma unroll
    for (int j = 0; j < 64; ++j) v[j] = silu(v[j]);
    store64(W.DG + (size_t)R * 256 + (nt - 24) * 128 + half * 64, v);
  } else if (nt == 26) {
    if (half == 0) {
      const float* bf = P.in[13] + l * 8;
      const float* bb = P.in[14] + l * 8;
#pragma unroll
      for (int j = 0; j < 16; ++j) {
        const float x = v[j] + (j < 8 ? bf[j] : bb[j - 8]);
        W.DT[(size_t)R * 16 + j] = softplus(x);
      }
    }
  }
}

template <int D, bool BOUNDED>
DI void attn_core(const u16* __restrict__ Qh, const u16* __restrict__ Kh, const u16* __restrict__ Vth, int q0, int nkeys,
                  float bound, unsigned char* lds, f32x16 (&O)[2], float& lout) {
  constexpr int KP = D + 8;
  constexpr int KS = D / 16;
  u16* Ks = (u16*)lds;
  constexpr int VP = 68;
  u16* Vs = (u16*)(lds + 2 * 64 * 72 * 2);
  const int tid = fresh_tid(), lane = tid & 63, w = tid >> 6;
  const int r = lane & 31, h = lane >> 5;
  bf16x8 qf[KS];
  {
    const u16* qp = Qh + (size_t)(q0 + 32 * w + r) * D + 8 * h;
#pragma unroll
    for (int ks = 0; ks < KS; ++ks) qf[ks] = *(const bf16x8*)(qp + 16 * ks);
  }
#pragma unroll
  for (int e = 0; e < 16; ++e) { O[0][e] = 0.f; O[1][e] = 0.f; }
  float m = BOUNDED ? bound : 0.f, lsum = 0.f;
  const int krow = (D == 64) ? (tid >> 3) : (tid >> 2);
  const int kc = (D == 64) ? (tid & 7) : (tid & 3);
  const bool kact = (D == 64) ? true : (tid < 256);
  const int vrow = tid >> 3, vc = tid & 7;
  const u16* kg = Kh + (size_t)krow * D + kc * 8;
  const u16* vg = Vth + (size_t)vrow * TT + vc * 8;
  u32x4 rk0 = (u32x4){0u, 0u, 0u, 0u}, rk1 = rk0, rv0, rv1;
  const int nk = nkeys >> 6;
  if (kact) rk0 = *(const u32x4*)kg;
  rv0 = *(const u32x4*)vg;
  __builtin_amdgcn_s_waitcnt(0x0F70);
  if (kact) *(u32x4*)&Ks[krow * KP + kc * 8] = rk0;
  { const u32x4 t_ = rv0; *(uint2*)&Vs[vrow * VP + vc * 8] = make_uint2(t_.x, t_.y); *(uint2*)&Vs[vrow * VP + vc * 8 + 4] = make_uint2(t_.z, t_.w); }
  if (kact) rk1 = *(const u32x4*)(kg + (size_t)64 * D);
  rv1 = *(const u32x4*)(vg + 64);
  __syncthreads();
  for (int kt2 = 0; kt2 < nk; kt2 += 2) {
#pragma unroll
  for (int ph = 0; ph < 2; ++ph) {
    const int kt = kt2 + ph;
    const int cur = ph;
    {
      const int tx = min(kt + 2, nk - 1);
      if (ph == 0) {
        if (kact) rk0 = *(const u32x4*)(kg + (size_t)tx * 64 * D);
        rv0 = *(const u32x4*)(vg + tx * 64);
      } else {
        if (kact) rk1 = *(const u32x4*)(kg + (size_t)tx * 64 * D);
        rv1 = *(const u32x4*)(vg + tx * 64);
      }
    }
    __builtin_amdgcn_sched_barrier(0);
    const u16* ks_ = Ks + cur * 64 * KP + r * KP + 8 * h;
    bf16x8 kf0[KS], kf1[KS];
#pragma unroll
    for (int ks = 0; ks < KS; ++ks) {
      kf0[ks] = *(const bf16x8*)(ks_ + 16 * ks);
      kf1[ks] = *(const bf16x8*)(ks_ + 32 * KP + 16 * ks);
    }
    const u16* vs_ = Vs + cur * 64 * VP + r * VP + 4 * h;
    bf16x8 vf[8];
#pragma unroll
    for (int s = 0; s < 2; ++s)
#pragma unroll
      for (int dt = 0; dt < 2; ++dt) {
        const u16* vp = vs_ + dt * 32 * VP + 16 * s;
        s16x4 lo = *(const s16x4*)vp;
        s16x4 hi = *(const s16x4*)(vp + 8);
        vf[s * 2 + dt] = __builtin_shufflevector(lo, hi, 0, 1, 2, 3, 4, 5, 6, 7);
      }
    __builtin_amdgcn_sched_barrier(0);
    f32x16 S[2];
    {
      const float nm = -m;
#pragma unroll
      for (int e = 0; e < 16; ++e) { S[0][e] = nm; S[1][e] = nm; }
    }
#pragma unroll
    for (int ks = 0; ks < KS; ++ks) {
      S[0] = MFMA32(kf0[ks], qf[ks], S[0]);
      S[1] = MFMA32(kf1[ks], qf[ks], S[1]);
    }
    __builtin_amdgcn_sched_barrier(0);
#pragma unroll
    for (int s = 0; s < 2; ++s)
#pragma unroll
      for (int dt = 0; dt < 2; ++dt) {
        const u16* vp = vs_ + dt * 32 * VP + 32 + 16 * s;
        s16x4 lo = *(const s16x4*)vp;
        s16x4 hi = *(const s16x4*)(vp + 8);
        vf[(2 + s) * 2 + dt] = __builtin_shufflevector(lo, hi, 0, 1, 2, 3, 4, 5, 6, 7);
      }
    __builtin_amdgcn_sched_barrier(0);
    if (!BOUNDED) {
      float t0 = fmaxf(fmaxf(S[0][0], S[0][1]), S[0][2]);
      float t1 = fmaxf(fmaxf(S[1][0], S[1][1]), S[1][2]);
#pragma unroll
      for (int e = 3; e < 15; e += 2) { t0 = fmaxf(fmaxf(t0, S[0][e]), S[0][e + 1]); t1 = fmaxf(fmaxf(t1, S[1][e]), S[1][e + 1]); }
      float tm = fmaxf(fmaxf(t0, t1), fmaxf(S[0][15], S[1][15]));
      tm = fmaxf(tm, __shfl_xor(tm, 32));
      const bool first = (kt == 0);
      if (first || __any(tm > 0.f)) {
        const float adj = first ? tm : fmaxf(tm, 0.f);
        const float alpha = first ? 1.f : fexp2(-adj);
        m += adj;
        lsum *= alpha;
#pragma unroll
        for (int e = 0; e < 16; ++e) { O[0][e] *= alpha; O[1][e] *= alpha; S[0][e] -= adj; S[1][e] -= adj; }
      }
    }
    float rs = 0.f;
#pragma unroll
    for (int e = 0; e < 16; ++e) { S[0][e] = fexp2(S[0][e]); rs += S[0][e]; }
#pragma unroll
    for (int e = 0; e < 16; ++e) { S[1][e] = fexp2(S[1][e]); rs += S[1][e]; }
    lsum += rs;
#pragma unroll
    for (int t2 = 0; t2 < 2; ++t2)
#pragma unroll
      for (int s = 0; s < 2; ++s) {
        uint4 pu;
        pu.x = pk(S[t2][8 * s], S[t2][8 * s + 1]); pu.y = pk(S[t2][8 * s + 2], S[t2][8 * s + 3]);
        pu.z = pk(S[t2][8 * s + 4], S[t2][8 * s + 5]); pu.w = pk(S[t2][8 * s + 6], S[t2][8 * s + 7]);
        const bf16x8 pb = __builtin_bit_cast(bf16x8, pu);
        O[0] = MFMA32(vf[(t2 * 2 + s) * 2 + 0], pb, O[0]);
        O[1] = MFMA32(vf[(t2 * 2 + s) * 2 + 1], pb, O[1]);
      }
    if (kt + 1 < nk) {
      const int nx = cur ^ 1;
      if (kact) *(u32x4*)&Ks[nx * 64 * KP + krow * KP + kc * 8] = (ph == 0) ? rk1 : rk0;
      { const u32x4 t_ = (ph == 0) ? rv1 : rv0; *(uint2*)&Vs[nx * 64 * VP + vrow * VP + vc * 8] = make_uint2(t_.x, t_.y); *(uint2*)&Vs[nx * 64 * VP + vrow * VP + vc * 8 + 4] = make_uint2(t_.z, t_.w); }
    }
    __syncthreads();
  }
  }
  lout = lsum + __shfl_xor(lsum, 32);
}

DI void gqa_unit(const WS& W, const float* qg, const float* kg_, int b, int head, int qb, unsigned char* lds) {
  const int tid = fresh_tid(), lane = tid & 63, w = tid >> 6, r = lane & 31, h = lane >> 5;
  const int q0 = qb * 256;
  const int nkeys = (qb == 0) ? 256 : TT;
  f32x16 O[2];
  float l;
  float bound;
  {
    float gq = fabsf(qg[lane]), gk = fabsf(kg_[lane]);
#pragma unroll
    for (int d = 32; d >= 1; d >>= 1) { gq = fmaxf(gq, __shfl_xor(gq, d)); gk = fmaxf(gk, __shfl_xor(gk, d)); }
    bound = 8.f * LOG2E * gq * gk * 1.02f + 0.25f;
  }
  attn_core<64, true>(W.Q + (size_t)(b * 4 + head) * TT * 64, W.K + (size_t)(b * 2 + (head >> 1)) * TT * 64,
                      W.Vt + (size_t)(b * 2 + (head >> 1)) * 64 * TT, q0, nkeys, bound, lds, O, l);
  const float il = 1.f / l;
  const size_t Rr = (size_t)b * TT + q0 + 32 * w + r;
#pragma unroll
  for (int dt = 0; dt < 2; ++dt)
#pragma unroll
    for (int i4 = 0; i4 < 4; ++i4) {
      const int dv = 32 * dt + 8 * i4 + 4 * h;
      const uint2 g = *(const uint2*)(W.GG + Rr * 256 + head * 64 + dv);
      uint2 o;
      o.x = pk(O[dt][4 * i4] * il * bflo(g.x), O[dt][4 * i4 + 1] * il * bfhi(g.x));
      o.y = pk(O[dt][4 * i4 + 2] * il * bflo(g.y), O[dt][4 * i4 + 3] * il * bfhi(g.y));
      *(uint2*)(W.Ycat + Rr * 1024 + 512 + head * 64 + dv) = o;
    }
}

DI void diff_unit(const Params& P, const WS& W, int l, int b, int hh, int qb, unsigned char* lds) {
  const int tid = fresh_tid(), lane = tid & 63, w = tid >> 6, r = lane & 31, h = lane >> 5;
  const int q0 = qb * 256;
  const int nkeys = (qb == 0) ? 256 : TT;
  const float lam_init = (l == 0) ? 0.2f : 0.35550906759f;
  float lam;
  {
    const float* lp = P.in[19] + l * 128;
    float s1 = (lane < 32) ? lp[lane] * lp[32 + lane] : 0.f;
    float s2 = (lane < 32) ? lp[64 + lane] * lp[96 + lane] : 0.f;
#pragma unroll
    for (int d = 32; d >= 1; d >>= 1) { s1 += __shfl_xor(s1, d); s2 += __shfl_xor(s2, d); }
    lam = __expf(s1) - __expf(s2) + lam_init;
  }
  f32x16 O1[2], O2[2];
  float l1, l2;
  const u16* vt = W.DVt + (size_t)(b * 4 + hh) * 64 * TT;
  attn_core<32, false>(W.DQ + (size_t)(b * 8 + 2 * hh) * TT * 32, W.DK + (size_t)(b * 8 + 2 * hh) * TT * 32, vt, q0, nkeys, 0.f, lds, O1, l1);
  attn_core<32, false>(W.DQ + (size_t)(b * 8 + 2 * hh + 1) * TT * 32, W.DK + (size_t)(b * 8 + 2 * hh + 1) * TT * 32, vt, q0, nkeys, 0.f, lds, O2, l2);
  const float i1 = 1.f / l1, i2 = lam / l2;
  float ss = 0.f;
#pragma unroll
  for (int dt = 0; dt < 2; ++dt)
#pragma unroll
    for (int e = 0; e < 16; ++e) {
      const float o = O1[dt][e] * i1 - O2[dt][e] * i2;
      O1[dt][e] = o;
      ss += o * o;
    }
  ss += __shfl_xor(ss, 32);
  const float rn = rsqrtf(ss * (1.f / 64.f) + EPS) * (1.f - lam_init);
  const float* ng = P.in[20] + l * 64;
  const size_t Rr = (size_t)b * TT + q0 + 32 * w + r;
#pragma unroll
  for (int dt = 0; dt < 2; ++dt)
#pragma unroll
    for (int i4 = 0; i4 < 4; ++i4) {
      const int dv = 32 * dt + 8 * i4 + 4 * h;
      const uint2 g = *(const uint2*)(W.DG + Rr * 256 + hh * 64 + dv);
      const float4 n4 = *(const float4*)(ng + dv);
      uint2 o;
      o.x = pk(O1[dt][4 * i4] * rn * n4.x * bflo(g.x), O1[dt][4 * i4 + 1] * rn * n4.y * bfhi(g.x));
      o.y = pk(O1[dt][4 * i4 + 2] * rn * n4.z * bflo(g.y), O1[dt][4 * i4 + 3] * rn * n4.w * bfhi(g.y));
      *(uint2*)(W.Ycat + Rr * 1024 + 768 + hh * 64 + dv) = o;
    }
}

DI void ssd_xload(uint2 (&raw)[8], const u16* src, int tb, int seg_lo, int seg_hi) {
#pragma unroll
  for (int i = 0; i < 8; ++i) {
    const int t = tb - 2 + i;
    const int tc = min(max(t, seg_lo), seg_hi - 1);
    uint2 v = *(const uint2*)(src + (size_t)tc * 1024);
    if (t < seg_lo || t >= seg_hi) v = make_uint2(0u, 0u);
    raw[i] = v;
  }
}
constexpr int S_LD = 136;
DI void ssd_local_unit(const Params& P, const WS& W, int l, int b, int c, int g, int h_lo, int h_hi, unsigned char* lds) {
  const int tid = fresh_tid(), lane = tid & 63, w = tid >> 6;
  u16* BsT = (u16*)lds;
  u16* Bs = (u16*)(lds + 34816);
  u16* Cs = (u16*)(lds + 69632);
  u16* xT = (u16*)(lds + 34816);
  u16* xsF = (u16*)(lds + 52224);
  u16* xsB = (u16*)(lds + 69632);
  float* cumF = (float*)(lds + 104448);
  float* cumB = cumF + 512;
  float* dtF = cumB + 512;
  float* dtB = dtF + 512;
  const size_t Rc0 = (size_t)b * TT + c * 128;
  const int seg_lo = (c < 2) ? 0 : 256;
  const int seg_hi = (c < 2) ? 256 : TT;
  const float* conv_w = P.in[9] + (size_t)l * 5 * 1024;
  const float* conv_b = P.in[10] + (size_t)l * 1024;
  const int cqB = lane;
  const bool isB = cqB < 32;
  const int ch0 = isB ? 4 * cqB : 4 * (cqB - 32);
  float4 wjB[5];
  float4 biasB;
  uint2 rawB[20];
  {
    const int col = (isB ? 512 : 768) + g * 128 + ch0;
#pragma unroll
    for (int j = 0; j < 5; ++j) wjB[j] = *(const float4*)(conv_w + j * 1024 + col);
    biasB = *(const float4*)(conv_b + col);
    const u16* src = W.XBC + (size_t)b * TT * 1024 + col;
    const int tb = c * 128 + 16 * w;
#pragma unroll
    for (int i = 0; i < 20; ++i) {
      const int t = tb - 2 + i;
      const int tc = min(max(t, seg_lo), seg_hi - 1);
      uint2 v = *(const uint2*)(src + (size_t)tc * 1024);
      if (t < seg_lo || t >= seg_hi) v = make_uint2(0u, 0u);
      rawB[i] = v;
    }
  }
  uint2 xraw[8];
  ssd_xload(xraw, W.XBC + (size_t)b * TT * 1024 + (g * 4 + h_lo) * 64 + 4 * (tid & 15), c * 128 + 4 * (tid >> 4), seg_lo, seg_hi);
  float4 xw[5], xbias;
  {
    const int col = (g * 4 + h_lo) * 64 + 4 * (tid & 15);
#pragma unroll
    for (int j = 0; j < 5; ++j) xw[j] = *(const float4*)(conv_w + j * 1024 + col);
    xbias = *(const float4*)(conv_b + col);
  }
  {
    const int hh = w & 3, dir = w >> 2, hg = g * 4 + hh;
    const float a = -__expf((dir ? P.in[12] : P.in[11])[l * 8 + hg]);
    const float d0 = W.DT[(Rc0 + 2 * lane) * 16 + dir * 8 + hg];
    const float d1 = W.DT[(Rc0 + 2 * lane + 1) * 16 + dir * 8 + hg];
    const float a0 = d0 * a, a1 = d1 * a;
    float v = a0 + a1;
    float c0, c1;
    if (dir == 0) {
#pragma unroll
      for (int d = 1; d < 64; d <<= 1) { const float t = __shfl_up(v, d); if (lane >= d) v += t; }
      c0 = v - a1; c1 = v;
    } else {
#pragma unroll
      for (int d = 1; d < 64; d <<= 1) { const float t = __shfl_down(v, d); if (lane + d < 64) v += t; }
      c0 = v; c1 = v - a0;
    }
    float* lc = cumF + dir * 512 + hh * 128 + 2 * lane;
    lc[0] = c0; lc[1] = c1;
    lc[1024] = d0; lc[1025] = d1;
    float* gc = W.cumF + (size_t)dir * ((size_t)RR * 8) + (Rc0 + 2 * lane) * 8 + hg;
    gc[0] = c0; gc[8] = c1;
  }
  {
    float y[4][16];
#pragma unroll
    for (int s2 = 0; s2 < 16; ++s2) {
      float a0 = biasB.x, a1 = biasB.y, a2 = biasB.z, a3 = biasB.w;
#pragma unroll
      for (int j = 0; j < 5; ++j) {
        const uint2 v = rawB[s2 + j];
        a0 += wjB[j].x * bflo(v.x); a1 += wjB[j].y * bfhi(v.x); a2 += wjB[j].z * bflo(v.y); a3 += wjB[j].w * bfhi(v.y);
      }
      y[0][s2] = silu(a0); y[1][s2] = silu(a1); y[2][s2] = silu(a2); y[3][s2] = silu(a3);
    }
    const int s0 = 16 * w;
    if (isB) {
#pragma unroll
      for (int s2 = 0; s2 < 16; ++s2) {
        uint2 o; o.x = pk(y[0][s2], y[1][s2]); o.y = pk(y[2][s2], y[3][s2]);
        *(uint2*)&Bs[(s0 + s2) * S_LD + ch0] = o;
      }
#pragma unroll
      for (int ch = 0; ch < 4; ++ch) {
        uint4 u0, u1;
        u0.x = pk(y[ch][0], y[ch][1]); u0.y = pk(y[ch][2], y[ch][3]); u0.z = pk(y[ch][4], y[ch][5]); u0.w = pk(y[ch][6], y[ch][7]);
        u1.x = pk(y[ch][8], y[ch][9]); u1.y = pk(y[ch][10], y[ch][11]); u1.z = pk(y[ch][12], y[ch][13]); u1.w = pk(y[ch][14], y[ch][15]);
        *(uint4*)&BsT[(ch0 + ch) * S_LD + s0] = u0;
        *(uint4*)&BsT[(ch0 + ch) * S_LD + s0 + 8] = u1;
      }
    } else {
#pragma unroll
      for (int s2 = 0; s2 < 16; ++s2) {
        uint2 o; o.x = pk(y[0][s2], y[1][s2]); o.y = pk(y[2][s2], y[3][s2]);
        *(uint2*)&Cs[(s0 + s2) * S_LD + ch0] = o;
        *(uint2*)(W.Cc + (Rc0 + s0 + s2) * 256 + g * 128 + ch0) = o;
      }
    }
  }
  __syncthreads();
  const int c16 = lane & 15, q = lane >> 4;
  f32x4 G[8];
#pragma unroll
  for (int st = 0; st < 8; ++st) G[st] = (f32x4){0.f, 0.f, 0.f, 0.f};
#pragma unroll
  for (int ks = 0; ks < 4; ++ks) {
    const bf16x8 bfrag = *(const bf16x8*)&Cs[(16 * w + c16) * S_LD + 32 * ks + 8 * q];
#pragma unroll
    for (int st = 0; st < 8; ++st) {
      const bf16x8 afrag = *(const bf16x8*)&Bs[(16 * st + c16) * S_LD + 32 * ks + 8 * q];
      G[st] = MFMA16(afrag, bfrag, G[st]);
    }
  }
  __syncthreads();
  for (int hh = h_lo; hh < h_hi; ++hh) {
    const int hg = g * 4 + hh;
    {
      const int cq = tid & 15, tg = tid >> 4;
      const int col = hg * 64 + 4 * cq;
      float4 wj[5];
#pragma unroll
      for (int j = 0; j < 5; ++j) wj[j] = xw[j];
      const float4 bias = xbias;
      (void)col;
      const float cF_end = cumF[hh * 128 + 127], cB_end = cumB[hh * 128];
      float y[4][4], ff[4], fb[4];
#pragma unroll
      for (int s2 = 0; s2 < 4; ++s2) {
        float a0 = bias.x, a1 = bias.y, a2 = bias.z, a3 = bias.w;
#pragma unroll
        for (int j = 0; j < 5; ++j) {
          const uint2 v = xraw[s2 + j];
          a0 += wj[j].x * bflo(v.x); a1 += wj[j].y * bfhi(v.x); a2 += wj[j].z * bflo(v.y); a3 += wj[j].w * bfhi(v.y);
        }
        y[0][s2] = silu(a0); y[1][s2] = silu(a1); y[2][s2] = silu(a2); y[3][s2] = silu(a3);
        const int sI = 4 * tg + s2;
        ff[s2] = dtF[hh * 128 + sI] * __expf(cF_end - cumF[hh * 128 + sI]);
        fb[s2] = dtB[hh * 128 + sI] * __expf(cB_end - cumB[hh * 128 + sI]);
      }
#pragma unroll
      for (int ch = 0; ch < 4; ++ch) {
        const int p = 4 * cq + ch;
        uint2 o;
        o.x = pk(y[ch][0], y[ch][1]); o.y = pk(y[ch][2], y[ch][3]);
        *(uint2*)&xT[p * S_LD + 4 * tg] = o;
        o.x = pk(y[ch][0] * ff[0], y[ch][1] * ff[1]); o.y = pk(y[ch][2] * ff[2], y[ch][3] * ff[3]);
        *(uint2*)&xsF[p * S_LD + 4 * tg] = o;
        o.x = pk(y[ch][0] * fb[0], y[ch][1] * fb[1]); o.y = pk(y[ch][2] * fb[2], y[ch][3] * fb[3]);
        *(uint2*)&xsB[p * S_LD + 4 * tg] = o;
      }
      if (hh + 1 < h_hi) {
        ssd_xload(xraw, W.XBC + (size_t)b * TT * 1024 + (hg + 1) * 64 + 4 * cq, c * 128 + 4 * tg, seg_lo, seg_hi);
        const int coln = (hg + 1) * 64 + 4 * cq;
#pragma unroll
        for (int j = 0; j < 5; ++j) xw[j] = *(const float4*)(conv_w + j * 1024 + coln);
        xbias = *(const float4*)(conv_b + coln);
      }
    }
    __syncthreads();
    {
      const int t = 16 * w + c16;
      const float cF_t = cumF[hh * 128 + t], cB_t = cumB[hh * 128 + t];
      const float Dh = P.in[15][l * 8 + hg];
      f32x4 Y[4];
#pragma unroll
      for (int pt = 0; pt < 4; ++pt) Y[pt] = (f32x4){0.f, 0.f, 0.f, 0.f};
#pragma unroll
      for (int m = 0; m < 4; ++m) {
        __builtin_amdgcn_sched_barrier(0);
        float mv[8];
#pragma unroll
        for (int jj = 0; jj < 2; ++jj) {
          const int st = 2 * m + jj;
          const int sb = 16 * st + 4 * q;
          const float4 cf4 = *(const float4*)&cumF[hh * 128 + sb];
          const float4 df4 = *(const float4*)&dtF[hh * 128 + sb];
          const float4 cb4 = *(const float4*)&cumB[hh * 128 + sb];
          const float4 db4 = *(const float4*)&dtB[hh * 128 + sb];
          const float cfv[4] = {cf4.x, cf4.y, cf4.z, cf4.w}, dfv[4] = {df4.x, df4.y, df4.z, df4.w};
          const float cbv[4] = {cb4.x, cb4.y, cb4.z, cb4.w}, dbv[4] = {db4.x, db4.y, db4.z, db4.w};
#pragma unroll
          for (int i = 0; i < 4; ++i) {
            const int s = sb + i;
            const float ef = (s <= t) ? __expf(cF_t - cfv[i]) * dfv[i] : 0.f;
            const float eb = (s >= t) ? __expf(cB_t - cbv[i]) * dbv[i] : 0.f;
            mv[4 * jj + i] = G[st][i] * (ef + eb) + ((s == t) ? Dh : 0.f);
          }
        }
        uint4 mu;
        mu.x = pk(mv[0], mv[1]); mu.y = pk(mv[2], mv[3]); mu.z = pk(mv[4], mv[5]); mu.w = pk(mv[6], mv[7]);
        const bf16x8 Mf = __builtin_bit_cast(bf16x8, mu);
#pragma unroll
        for (int pt = 0; pt < 4; ++pt) {
          const u16* xp = xT + (16 * pt + c16) * S_LD + 32 * m + 4 * q;
          s16x4 lo = *(const s16x4*)xp;
          s16x4 hi = *(const s16x4*)(xp + 16);
          const bf16x8 af = __builtin_shufflevector(lo, hi, 0, 1, 2, 3, 4, 5, 6, 7);
          Y[pt] = MFMA16(af, Mf, Y[pt]);
        }
      }
#pragma unroll
      for (int pt = 0; pt < 4; ++pt) {
        uint2 o;
        o.x = pk(Y[pt][0], Y[pt][1]); o.y = pk(Y[pt][2], Y[pt][3]);
        *(uint2*)(W.Ycat + (Rc0 + t) * 1024 + hg * 64 + 16 * pt + 4 * q) = o;
      }
    }
#pragma unroll
    for (int dir = 0; dir < 2; ++dir) {
      const u16* xs = dir ? xsB : xsF;
      f32x4 acc[4];
#pragma unroll
      for (int pt = 0; pt < 4; ++pt) acc[pt] = (f32x4){0.f, 0.f, 0.f, 0.f};
#pragma unroll
      for (int ks = 0; ks < 4; ++ks) {
        const bf16x8 af = *(const bf16x8*)&BsT[(16 * w + c16) * S_LD + 32 * ks + 8 * q];
#pragma unroll
        for (int pt = 0; pt < 4; ++pt) {
          const bf16x8 bfr = *(const bf16x8*)&xs[(16 * pt + c16) * S_LD + 32 * ks + 8 * q];
          acc[pt] = MFMA16(af, bfr, acc[pt]);
        }
      }
      u16* dst = W.Sloc + ((((size_t)dir * 8 + b) * 18 + c) * 8 + hg) * 8192;
#pragma unroll
      for (int pt = 0; pt < 4; ++pt) {
        uint2 o;
        o.x = pk(acc[pt][0], acc[pt][1]); o.y = pk(acc[pt][2], acc[pt][3]);
        *(uint2*)(dst + (16 * pt + c16) * 128 + 16 * w + 4 * q) = o;
      }
    }
    __syncthreads();
  }
}

DI void ws_init(WS& W, unsigned char* ws) {
        W.WinT = (u16*)(ws + OFF_WIN); W.WoutT = (u16*)(ws + OFF_WOUT); W.mod = (float*)(ws + OFF_MOD);
    W.ropeG = (float2*)(ws + OFF_ROPE); W.ropeD = (float2*)(ws + OFF_ROPE + 8192);
    W.U = (u16*)(ws + OFF_U); W.Ycat = (u16*)(ws + OFF_U); W.XBC = (u16*)(ws + OFF_XBC); W.Obuf = (u16*)(ws + OFF_XBC);
    W.Z = (u16*)(ws + OFF_Z); W.DT = (float*)(ws + OFF_DT);
    W.Q = (u16*)(ws + OFF_Q); W.K = (u16*)(ws + OFF_K); W.Vt = (u16*)(ws + OFF_VT);
    W.DQ = (u16*)(ws + OFF_DQ); W.DK = (u16*)(ws + OFF_DK); W.DVt = (u16*)(ws + OFF_DVT); W.Stin = (u16*)(ws + OFF_Q);
    W.GG = (u16*)(ws + OFF_GG); W.DG = (u16*)(ws + OFF_DG); W.Cc = (u16*)(ws + OFF_CC);
    W.cumF = (float*)(ws + OFF_CUMF); W.cumB = (float*)(ws + OFF_CUMB); W.Sloc = (u16*)(ws + OFF_SLOC);
    W.Opart = (float*)(ws + OFF_OPART);
}

#define XCD_LOOP(UPX, xcd, idx) \
  const bool sw_ = (nb & 7) == 0; \
  for (int t_ = sw_ ? (bid >> 3) : bid; t_ < (sw_ ? (UPX) : 8 * (UPX)); t_ += (sw_ ? (nb >> 3) : nb)) { \
    const int xcd = sw_ ? (bid & 7) : t_ / (UPX); const int idx = sw_ ? t_ : t_ % (UPX);
#define XCD_END }

typedef const Params __attribute__((address_space(4)))* KArgP;
DI Params load_params(KArgP kp) {
  asm volatile("" : "+s"(kp));
  Params P;
#pragma unroll
  for (int i = 0; i < 22; ++i) P.in[i] = kp->in[i];
  P.out = kp->out; P.ws = kp->ws;
  return P;
}

DI void ph0_prologue(KArgP kp, unsigned char* lds) {
  const Params P = load_params(kp); WS W; ws_init(W, P.ws);
  const int tid = fresh_tid(), lane = tid & 63, w = tid >> 6;
  const int nb = gridDim.x, bid = blockIdx.x;
  (void)lane; (void)w; (void)tid;
  {
    float* S = (float*)(lds + 69632);
    for (int i = tid; i < 9 * 1024; i += NT) {
      const float x = (i < 8192) ? P.in[1][i] : P.in[3][i - 8192];
      S[i] = silu(x);
    }
    __syncthreads();
    constexpr int U_WIN = 2 * 14 * 16, U_WOUT = 2 * 4 * 16, U_MOD = 384;
    for (int u = bid; u < U_WIN + U_WOUT + U_MOD + 1; u += nb) {
      if (u < U_WIN + U_WOUT) {
        const float* src; u16* dst; int ldn, n0, k0, nrows; bool inproj;
        if (u < U_WIN) {
          const int l = u / (14 * 16), rem = u % (14 * 16);
          n0 = (rem >> 4) * 256; k0 = (rem & 15) * 64; ldn = 3344; inproj = true; nrows = NPAD;
          src = P.in[8] + (size_t)l * 1024 * 3344; dst = W.WinT + (size_t)l * NPAD * 1024;
        } else {
          const int v = u - U_WIN; const int l = v >> 6, rem = v & 63;
          n0 = (rem >> 4) * 256; k0 = (rem & 15) * 64; ldn = 1024; inproj = false; nrows = 1024;
          src = P.in[21] + (size_t)l * 1024 * 1024; dst = W.WoutT + (size_t)l * 1024 * 1024;
        }
        float* tile = (float*)lds;
        {
          const int n = tid & 63, kq = tid >> 6;
#pragma unroll
          for (int sub = 0; sub < 4; ++sub) {
            const int nd = n0 + sub * 64 + n;
            int ns = nd;
            if (inproj) { ns = (nd < 1536) ? nd : (nd < 3328 ? nd + 16 : (nd < 3344 ? nd - 3328 + 1536 : -1)); }
#pragma unroll
            for (int i = 0; i < 8; ++i) {
              const int k = kq * 8 + i;
              tile[sub * 4160 + k * 65 + n] = (ns >= 0) ? src[(size_t)(k0 + k) * ldn + ns] : 0.f;
            }
          }
        }
        __syncthreads();
        {
          const int n = tid >> 3, kc = tid & 7;
#pragma unroll
          for (int sub = 0; sub < 4; ++sub) {
            float f[8];
#pragma unroll
            for (int i = 0; i < 8; ++i) f[i] = tile[sub * 4160 + (kc * 8 + i) * 65 + n];
            uint4 o;
            o.x = pk(f[0], f[1]); o.y = pk(f[2], f[3]); o.z = pk(f[4], f[5]); o.w = pk(f[6], f[7]);
            if (n0 + sub * 64 + n < nrows) *(uint4*)(dst + (size_t)(n0 + sub * 64 + n) * 1024 + k0 + kc * 8) = o;
          }
        }
        __syncthreads();
      } else if (u < U_WIN + U_WOUT + U_MOD) {
        const int v = u - U_WIN - U_WOUT;
        const int l = v / 192, n0 = (v % 192) * 16;
        const int c16 = tid & 15, kg = tid >> 4;
        const float* wm = P.in[4] + (size_t)l * 1024 * 3072 + n0 + c16;
        float acc[9];
#pragma unroll
        for (int rr = 0; rr < 9; ++rr) acc[rr] = 0.f;
#pragma unroll 8
        for (int kk = 0; kk < 32; ++kk) {
          const int k = kg * 32 + kk;
          const float wv = wm[(size_t)k * 3072];
#pragma unroll
          for (int rr = 0; rr < 9; ++rr) acc[rr] += S[rr * 1024 + k] * wv;
        }
        float* red = (float*)lds;
#pragma unroll
        for (int rr = 0; rr < 9; ++rr) red[(kg * 16 + c16) * 9 + rr] = acc[rr];
        __syncthreads();
        if (tid < 144) {
          const int cc = tid / 9, rr = tid % 9;
          float s = 0.f;
          for (int k2 = 0; k2 < 32; ++k2) s += red[(k2 * 16 + cc) * 9 + rr];
          W.mod[((size_t)l * 9 + rr) * 3072 + n0 + cc] = s + P.in[5][l * 3072 + n0 + cc];
        }
        __syncthreads();
      } else {
        for (int i = tid; i < 64 * 16; i += NT) {
          const int idx = i >> 4, k = i & 15;
          const float inv = powf(10000.f, -(float)k / 16.f);
          float sn, cs; sincosf((float)idx * inv, &sn, &cs);
          W.ropeG[i] = make_float2(cs, sn);
        }
        for (int i = tid; i < 64 * 8; i += NT) {
          const int idx = i >> 3, k = i & 7;
          const float inv = powf(10000.f, -(float)k / 8.f);
          float sn, cs; sincosf((float)idx * inv, &sn, &cs);
          W.ropeD[i] = make_float2(cs, sn);
        }
      }
    }
  }
}

DI void ph1_prep(KArgP kp) {
  const Params P = load_params(kp); WS W; ws_init(W, P.ws);
  const int tid = fresh_tid(), lane = tid & 63, w = tid >> 6;
  const int nb = gridDim.x, bid = blockIdx.x;
  (void)lane; (void)w; (void)tid;
  XCD_LOOP(288, xcd, idx)
    const int R = xcd * TT + idx * 8 + w;
    const int b = xcd, t = idx * 8 + w;
    const float* src = (t < 256) ? (P.in[2] + ((size_t)b * 256 + t) * 1024) : (P.in[0] + ((size_t)b * 2048 + (t - 256)) * 1024);
    const float* md = W.mod + (size_t)((t < 256) ? 8 : b) * 3072;
    const float* gp = P.in[6];
    float4 x[4];
    float ss = 0.f;
#pragma unroll
    for (int i = 0; i < 4; ++i) {
      x[i] = *(const float4*)(src + i * 256 + lane * 4);
      ss += x[i].x * x[i].x + x[i].y * x[i].y + x[i].z * x[i].z + x[i].w * x[i].w;
    }
#pragma unroll
    for (int d = 32; d >= 1; d >>= 1) ss += __shfl_xor(ss, d);
    const float rn = rsqrtf(ss * (1.f / 1024.f) + EPS);
#pragma unroll
    for (int i = 0; i < 4; ++i) {
      const int k = i * 256 + lane * 4;
      const float4 g4 = *(const float4*)(gp + k);
      const float4 sh = *(const float4*)(md + k);
      const float4 sc = *(const float4*)(md + 1024 + k);
      uint2 o;
      o.x = pk(x[i].x * rn * g4.x * (1.f + sc.x) + sh.x, x[i].y * rn * g4.y * (1.f + sc.y) + sh.y);
      o.y = pk(x[i].z * rn * g4.z * (1.f + sc.z) + sh.z, x[i].w * rn * g4.w * (1.f + sc.w) + sh.w);
      *(uint2*)(W.U + (size_t)R * 1024 + k) = o;
    }
  XCD_END
}

DI void ph2_inproj(KArgP kp, int l, unsigned char* lds) {
  const Params P = load_params(kp); WS W; ws_init(W, P.ws);
  const int tid = fresh_tid();
  const int nb = gridDim.x, bid = blockIdx.x;
  XCD_LOOP(243, xcd, idx)
    const int nt = idx / 9, mt = xcd * 9 + idx % 9;
    gemm_tile_to_lds(W.U, W.WinT + (size_t)l * NPAD * 1024, mt * 256, nt * 128, lds);
    if (nt == 15 || nt == 22 || nt == 23) {
      const int b = mt / 9, t0 = (mt - b * 9) * 256;
      u16* vt = (nt == 15) ? (W.Vt + (size_t)(b * 2) * 64 * TT) : (W.DVt + (size_t)(b * 4 + (nt - 22) * 2) * 64 * TT);
      store_tile_transposed(lds, vt, t0);
    } else {
      float v[64];
      load_row64(lds, v);
      inproj_epi(P, W, l, mt * 256 + (tid >> 1), nt, tid & 1, v);
    }
    __syncthreads();
  XCD_END
}

DI void ph3_mix(KArgP kp, int l, unsigned char* lds) {
  const Params P = load_params(kp); WS W; ws_init(W, P.ws);
  const int nb = gridDim.x, bid = blockIdx.x;
  const int upx = (l == 0) ? 120 : 112;
  XCD_LOOP(upx, xcd, idx)
    const int b = xcd;
    if (idx < 32) {
      diff_unit(P, W, l, b, idx >> 3, 1 + (idx & 7), lds);
    } else if (idx < 64) {
      gqa_unit(W, P.in[17] + l * 64, P.in[18] + l * 64, b, (idx - 32) >> 3, 1 + (idx & 7), lds);
    } else if (idx < 96) {
      const int v = idx - 64;
      ssd_local_unit(P, W, l, b, v >> 1, v & 1, 0, 4, lds);
    } else if (idx < 112) {
      const int v = idx - 96, u = 32 + (v >> 2), hq = v & 3;
      ssd_local_unit(P, W, l, b, u >> 1, u & 1, hq, hq + 1, lds);
    } else if (idx < 116) {
      diff_unit(P, W, l, b, idx - 112, 0, lds);
    } else {
      gqa_unit(W, P.in[17] + l * 64, P.in[18] + l * 64, b, idx - 116, 0, lds);
    }
    __syncthreads();
  XCD_END
}

DI void ph4a_states(KArgP kp) {
  const Params P = load_params(kp); WS W; ws_init(W, P.ws);
  const int tid = fresh_tid(), lane = tid & 63, w = tid >> 6;
  const int nb = gridDim.x, bid = blockIdx.x;
  (void)lane; (void)w; (void)tid;
    XCD_LOOP(64, xcd, idx)
      const int gid = idx * NT + tid;
      const int e4 = gid & 2047, hg = (gid >> 11) & 7, b = xcd, dir = gid >> 14;
      float s0 = 0.f, s1 = 0.f, s2 = 0.f, s3 = 0.f;
      for (int step = 0; step < 18; ++step) {
        const int c = dir ? (step == 0 ? 1 : (step == 1 ? 0 : 19 - step)) : step;
        const size_t idx = ((((size_t)dir * 8 + b) * 18 + c) * 8 + hg) * 8192 + (size_t)e4 * 4;
        uint2 o;
        o.x = pk(s0, s1); o.y = pk(s2, s3);
        *(uint2*)(W.Stin + idx) = o;
        const float tot = W.cumF[(size_t)dir * ((size_t)RR * 8) + ((size_t)b * TT + c * 128 + (dir ? 0 : 127)) * 8 + hg];
        const float dec = __expf(tot);
        const uint2 sv = *(const uint2*)(W.Sloc + idx);
        s0 = s0 * dec + bflo(sv.x); s1 = s1 * dec + bfhi(sv.x);
        s2 = s2 * dec + bflo(sv.y); s3 = s3 * dec + bfhi(sv.y);
      }
    XCD_END
}

DI void ph4b_yoff(KArgP kp, int l, unsigned char* lds) {
  const Params P = load_params(kp); WS W; ws_init(W, P.ws);
  const int tid = fresh_tid(), lane = tid & 63, w = tid >> 6;
  const int nb = gridDim.x, bid = blockIdx.x;
  (void)lane; (void)w; (void)tid;
    XCD_LOOP((l == 0 ? 72 : 64), xcd, idx)
      const int b = xcd, c = (idx >> 2) + (l == 0 ? 0 : 2), tb = idx & 3;
      const int r = lane & 31, h2 = lane >> 5;
      const int hg = w, g = w >> 2;
      const size_t Rr = (size_t)b * TT + c * 128 + 32 * tb + r;
      f32x16 acc[2][2];
#pragma unroll
      for (int d = 0; d < 2; ++d)
#pragma unroll
        for (int pt = 0; pt < 2; ++pt)
#pragma unroll
          for (int e = 0; e < 16; ++e) acc[d][pt][e] = 0.f;
      const u16* cp = W.Cc + Rr * 256 + g * 128 + 8 * h2;
      bf16x8 bfr[8];
#pragma unroll
      for (int ks = 0; ks < 8; ++ks) bfr[ks] = *(const bf16x8*)(cp + 16 * ks);
      u16* myl = (u16*)lds + w * (64 * 136);
#pragma unroll
      for (int d = 0; d < 2; ++d) {
        const u16* sp = W.Stin + ((((size_t)d * 8 + b) * 18 + c) * 8 + hg) * 8192 + lane * 8;
        u32x4 sv[16];
#pragma unroll
        for (int i = 0; i < 16; ++i) sv[i] = *(const u32x4*)(sp + i * 512);
#pragma unroll
        for (int i = 0; i < 16; ++i) *(u32x4*)(myl + (4 * i + (lane >> 4)) * 136 + (lane & 15) * 8) = sv[i];
        __builtin_amdgcn_wave_barrier();
#pragma unroll
        for (int ks = 0; ks < 8; ++ks) {
          const bf16x8 f0 = *(const bf16x8*)(myl + r * 136 + 16 * ks + 8 * h2);
          const bf16x8 f1 = *(const bf16x8*)(myl + (32 + r) * 136 + 16 * ks + 8 * h2);
          acc[d][0] = MFMA32(f0, bfr[ks], acc[d][0]);
          acc[d][1] = MFMA32(f1, bfr[ks], acc[d][1]);
        }
        __builtin_amdgcn_wave_barrier();
      }
      const float eF = __expf(W.cumF[Rr * 8 + hg]), eB = __expf(W.cumB[Rr * 8 + hg]);
      float ss = 0.f;
#pragma unroll
      for (int pt = 0; pt < 2; ++pt)
#pragma unroll
        for (int i4 = 0; i4 < 4; ++i4) {
          const int p = 32 * pt + 8 * i4 + 4 * h2;
          const uint2 yd = *(const uint2*)(W.Ycat + Rr * 1024 + hg * 64 + p);
          const uint2 zz = *(const uint2*)(W.Z + Rr * 512 + hg * 64 + p);
          float y0 = bflo(yd.x) + eF * acc[0][pt][4 * i4] + eB * acc[1][pt][4 * i4];
          float y1 = bfhi(yd.x) + eF * acc[0][pt][4 * i4 + 1] + eB * acc[1][pt][4 * i4 + 1];
          float y2 = bflo(yd.y) + eF * acc[0][pt][4 * i4 + 2] + eB * acc[1][pt][4 * i4 + 2];
          float y3 = bfhi(yd.y) + eF * acc[0][pt][4 * i4 + 3] + eB * acc[1][pt][4 * i4 + 3];
          y0 *= silu(bflo(zz.x)); y1 *= silu(bfhi(zz.x)); y2 *= silu(bflo(zz.y)); y3 *= silu(bfhi(zz.y));
          acc[0][pt][4 * i4] = y0; acc[0][pt][4 * i4 + 1] = y1; acc[0][pt][4 * i4 + 2] = y2; acc[0][pt][4 * i4 + 3] = y3;
          ss += y0 * y0 + y1 * y1 + y2 * y2 + y3 * y3;
        }
      ss += __shfl_xor(ss, 32);
      float* red = (float*)(lds + 8 * 64 * 136 * 2);
      if (h2 == 0) red[w * 32 + r] = ss;
      __syncthreads();
      float tot = 0.f;
#pragma unroll
      for (int k = 0; k < 8; ++k) tot += red[k * 32 + r];
      const float rn = rsqrtf(tot * (1.f / 512.f) + EPS);
      const float* ng = P.in[16] + l * 512 + hg * 64;
#pragma unroll
      for (int pt = 0; pt < 2; ++pt)
#pragma unroll
        for (int i4 = 0; i4 < 4; ++i4) {
          const int p = 32 * pt + 8 * i4 + 4 * h2;
          const float4 n4 = *(const float4*)(ng + p);
          uint2 o;
          o.x = pk(acc[0][pt][4 * i4] * rn * n4.x, acc[0][pt][4 * i4 + 1] * rn * n4.y);
          o.y = pk(acc[0][pt][4 * i4 + 2] * rn * n4.z, acc[0][pt][4 * i4 + 3] * rn * n4.w);
          *(uint2*)(W.Ycat + Rr * 1024 + hg * 64 + p) = o;
        }
      __syncthreads();
    XCD_END
}

DI void ph5_outproj(KArgP kp, int l, unsigned char* lds) {
  const Params P = load_params(kp); WS W; ws_init(W, P.ws);
  const int tid = fresh_tid();
  const int nb = gridDim.x, bid = blockIdx.x;
  const int upx = (l == 0) ? 72 : 64;
  XCD_LOOP(upx, xcd, idx)
    const int mt = xcd * 9 + (idx >> 3) + (l == 0 ? 0 : 1), nt = idx & 7;
    gemm_tile_to_lds(W.Ycat, W.WoutT + (size_t)l * 1024 * 1024, mt * 256, nt * 128, lds);
    float v[64];
    load_row64(lds, v);
    const size_t R = (size_t)mt * 256 + (tid >> 1);
    float ss = 0.f;
#pragma unroll
    for (int j = 0; j < 64; ++j) ss += v[j] * v[j];
    W.Opart[R * 16 + nt * 2 + (tid & 1)] = ss;
    store64(W.Obuf + R * 1024 + nt * 128 + (tid & 1) * 64, v);
    __syncthreads();
  XCD_END
}

DI void ph6_post(KArgP kp, int l) {
  const Params P = load_params(kp); WS W; ws_init(W, P.ws);
  const int tid = fresh_tid(), lane = tid & 63, w = tid >> 6;
  const int nb = gridDim.x, bid = blockIdx.x;
  (void)lane; (void)w; (void)tid;
    XCD_LOOP(288, xcd, idx)
      const int R = xcd * TT + idx * 8 + w;
      const int b = xcd, t = idx * 8 + w;
      const bool isctx = t < 256;
      if (l == 1 && isctx) continue;
      const float* md = W.mod + ((size_t)l * 9 + (isctx ? 8 : b)) * 3072;
      const float* hsrc = isctx ? (P.in[2] + ((size_t)b * 256 + t) * 1024) : (P.in[0] + ((size_t)b * 2048 + (t - 256)) * 1024);
      u16* hb = (u16*)(P.ws + OFF_HB) + ((size_t)b * 2048 + (t - 256)) * 1024;
      float pss = (lane < 16) ? W.Opart[(size_t)R * 16 + lane] : 0.f;
#pragma unroll
      for (int d = 8; d >= 1; d >>= 1) pss += __shfl_xor(pss, d);
      pss = __shfl(pss, 0);
      const float rn = rsqrtf(pss * (1.f / 1024.f) + EPS);
      const float* gpost = P.in[7] + l * 1024;
      float4 hn[4];
      float ss = 0.f;
#pragma unroll
      for (int i = 0; i < 4; ++i) {
        const int k = i * 256 + lane * 4;
        float4 hv;
        if (l == 0) hv = *(const float4*)(hsrc + k);
        else { const uint2 hu = *(const uint2*)(hb + k); hv = make_float4(bflo(hu.x), bfhi(hu.x), bflo(hu.y), bfhi(hu.y)); }
        const uint2 ov = *(const uint2*)(W.Obuf + (size_t)R * 1024 + k);
        const float4 g4 = *(const float4*)(gpost + k);
        const float4 gt = *(const float4*)(md + 2048 + k);
        hn[i].x = hv.x + gt.x * (bflo(ov.x) * rn * g4.x);
        hn[i].y = hv.y + gt.y * (bfhi(ov.x) * rn * g4.y);
        hn[i].z = hv.z + gt.z * (bflo(ov.y) * rn * g4.z);
        hn[i].w = hv.w + gt.w * (bfhi(ov.y) * rn * g4.w);
        ss += hn[i].x * hn[i].x + hn[i].y * hn[i].y + hn[i].z * hn[i].z + hn[i].w * hn[i].w;
      }
      if (!isctx) {
        if (l == 0) {
#pragma unroll
          for (int i = 0; i < 4; ++i) {
            uint2 o; o.x = pk(hn[i].x, hn[i].y); o.y = pk(hn[i].z, hn[i].w);
            *(uint2*)(hb + i * 256 + lane * 4) = o;
          }
        } else {
          float* dst = P.out + ((size_t)b * 2048 + (t - 256)) * 1024;
#pragma unroll
          for (int i = 0; i < 4; ++i) *(float4*)(dst + i * 256 + lane * 4) = hn[i];
        }
      }
      if (l == 0) {
#pragma unroll
        for (int d = 32; d >= 1; d >>= 1) ss += __shfl_xor(ss, d);
        const float r2 = rsqrtf(ss * (1.f / 1024.f) + EPS);
        const float* md1 = W.mod + ((size_t)9 + (isctx ? 8 : b)) * 3072;
        const float* gp = P.in[6] + 1024;
#pragma unroll
        for (int i = 0; i < 4; ++i) {
          const int k = i * 256 + lane * 4;
          const float4 g4 = *(const float4*)(gp + k);
          const float4 sh = *(const float4*)(md1 + k);
          const float4 sc = *(const float4*)(md1 + 1024 + k);
          uint2 o;
          o.x = pk(hn[i].x * r2 * g4.x * (1.f + sc.x) + sh.x, hn[i].y * r2 * g4.y * (1.f + sc.y) + sh.y);
          o.y = pk(hn[i].z * r2 * g4.z * (1.f + sc.z) + sh.z, hn[i].w * r2 * g4.w * (1.f + sc.w) + sh.w);
          *(uint2*)(W.U + (size_t)R * 1024 + k) = o;
        }
      }
    XCD_END
}


#define XB_TMO      128
#define XB_XCNT(j)  (256  + 64 * (j))
#define XB_XSUB(j)  (1280 + 64 * (j))
#define XB_XGEN(j)  (2304 + 64 * (j))
#define XB_TOP      3328
#define XB_TOPGEN   3392
#define XCD_BAR_WORDS 3456
#define XB_SPIN_CAP (1u << 18)
#define LAS __attribute__((address_space(3)))

__device__ __forceinline__ unsigned xb_ld(unsigned* p)              { return __hip_atomic_load(p, __ATOMIC_RELAXED, __HIP_MEMORY_SCOPE_AGENT); }
__device__ __forceinline__ unsigned xb_add(unsigned* p, unsigned v) { return __hip_atomic_fetch_add(p, v, __ATOMIC_RELAXED, __HIP_MEMORY_SCOPE_AGENT); }
__device__ __forceinline__ unsigned xb_xcc_id() { return (unsigned)__builtin_amdgcn_s_getreg((3 << 11) | 20) & 0xFu; }
#define XB_SPIN(cond, bar) do { unsigned _sp = 0; while (cond) { __builtin_amdgcn_s_sleep(1); \
    if ((++_sp & 255u) == 0u) { if (xb_ld(&(bar)[XB_TMO])) break; if (_sp > XB_SPIN_CAP) { atomicAdd(&(bar)[XB_TMO], 1u); break; } } } } while (0)

struct XcdBarrier {
    unsigned* bar; unsigned x;
    volatile LAS unsigned* st;
};

__device__ __forceinline__ XcdBarrier xcd_barrier_post(unsigned* bar, volatile LAS unsigned* st) {
    XcdBarrier b; b.bar = bar; b.x = xb_xcc_id(); b.st = st;
    if (threadIdx.x == 0) (void)xb_add(&bar[XB_XCNT(b.x)], 1u);
    return b;
}
__device__ __forceinline__ void xcd_barrier_complete(unsigned* bar, unsigned x, unsigned& nloc, unsigned& nx) {
    const unsigned G = gridDim.x * gridDim.y * gridDim.z;
    unsigned sum, cnt, mine, sp = 0u;
    for (;;) {
        sum = 0u; cnt = 0u; mine = 0u;
#pragma unroll
        for (unsigned j = 0; j < 16; ++j) { const unsigned c = xb_ld(&bar[XB_XCNT(j)]); sum += c; cnt += (c > 0u) ? 1u : 0u; mine = (j == x) ? c : mine; }
        if (sum == G) break;
        __builtin_amdgcn_s_sleep(1);
        if ((++sp & 255u) == 0u) { if (xb_ld(&bar[XB_TMO])) break; if (sp > XB_SPIN_CAP) { atomicAdd(&bar[XB_TMO], 1u); break; } }
    }
    nloc = mine > 0u ? mine : 1u; nx = cnt > 0u ? cnt : 1u;
}

__device__ __forceinline__ void xcd_barrier(const XcdBarrier& b) {
    asm volatile("s_waitcnt vmcnt(0)" ::: "memory");
    __syncthreads();
    if (threadIdx.x == 0) {
        unsigned* bar = b.bar;
        __builtin_amdgcn_s_waitcnt(0);
        unsigned nloc = b.st[0], nx = b.st[1];
        if (nloc == 0u) { xcd_barrier_complete(bar, b.x, nloc, nx); b.st[0] = nloc; b.st[1] = nx; }
        const unsigned old = xb_add(&bar[XB_XSUB(b.x)], 1u);
        const unsigned gen = old / nloc;
        if (old + 1u == (gen + 1u) * nloc) {
            __builtin_amdgcn_fence(__ATOMIC_RELEASE, "agent");
            asm volatile("s_waitcnt vmcnt(0)" ::: "memory");
            const unsigned og = xb_add(&bar[XB_TOP], 1u);
            const unsigned tg = og / nx;
            if (og + 1u == (tg + 1u) * nx) xb_add(&bar[XB_TOPGEN], 1u);
            else XB_SPIN(xb_ld(&bar[XB_TOPGEN]) == tg, bar);
            __builtin_amdgcn_fence(__ATOMIC_ACQUIRE, "agent");
            xb_add(&bar[XB_XGEN(b.x)], 1u);
            asm volatile("s_waitcnt vmcnt(0)" ::: "memory");
        } else {
            XB_SPIN(xb_ld(&bar[XB_XGEN(b.x)]) == gen, bar);
            __builtin_amdgcn_fence(__ATOMIC_ACQUIRE, "agent");
            asm volatile("s_waitcnt vmcnt(0)" ::: "memory");
        }
    }
    __syncthreads();
}

DI void grid_barrier(unsigned* bar, unsigned& epoch) {
  asm volatile("s_waitcnt vmcnt(0)" ::: "memory");
  __syncthreads();
  ++epoch;
  if (threadIdx.x == 0) {
    __builtin_amdgcn_fence(__ATOMIC_RELEASE, "agent");
    asm volatile("s_waitcnt vmcnt(0)" ::: "memory");
    const unsigned nb = gridDim.x, bid = blockIdx.x;
    const bool hier = (nb & 7u) == 0u;
    const unsigned ng = hier ? 8u : 1u, per = hier ? (nb >> 3) : nb;
    unsigned* grp = bar + 64 * (1 + (hier ? (bid & 7u) : 0u));
    const unsigned old = __hip_atomic_fetch_add(grp, 1u, __ATOMIC_RELAXED, __HIP_MEMORY_SCOPE_AGENT);
    if (old + 1u == epoch * per) __hip_atomic_fetch_add(bar, 1u, __ATOMIC_RELAXED, __HIP_MEMORY_SCOPE_AGENT);
    const unsigned target = epoch * ng;
    while (__hip_atomic_load(bar, __ATOMIC_RELAXED, __HIP_MEMORY_SCOPE_AGENT) < target) __builtin_amdgcn_s_sleep(1);
    __builtin_amdgcn_fence(__ATOMIC_ACQUIRE, "agent");
    asm volatile("s_waitcnt vmcnt(0)" ::: "memory");
  }
  __syncthreads();
}

__global__ void __launch_bounds__(NT) fwd_mega(Params Parg) {
  extern __shared__ __attribute__((aligned(16))) unsigned char lds[];
  cg::grid_group grid = cg::this_grid();
  KArgP kp = (KArgP)__builtin_amdgcn_kernarg_segment_ptr();
  unsigned* bar = (unsigned*)(Parg.ws + OFF_BAR);
  if (gridDim.x == 0x7fffffffu) grid.sync();
  volatile LAS unsigned* xst = (volatile LAS unsigned*)((LAS unsigned char*)lds + (LDS_BYTES - 64));
  if (threadIdx.x == 0) { xst[0] = 0u; xst[1] = 0u; }
  __syncthreads();
  const XcdBarrier xb = xcd_barrier_post(bar, xst);

  ph0_prologue(kp, lds);
  xcd_barrier(xb);

  ph1_prep(kp);
  xcd_barrier(xb);

  for (int l = 0; l < 2; ++l) {
    ph2_inproj(kp, l, lds);
    xcd_barrier(xb);

    ph3_mix(kp, l, lds);
    xcd_barrier(xb);

    ph4a_states(kp);
    xcd_barrier(xb);

    ph4b_yoff(kp, l, lds);
    xcd_barrier(xb);

    ph5_outproj(kp, l, lds);
    xcd_barrier(xb);

    ph6_post(kp, l);
    if (l == 0) xcd_barrier(xb);
  }
}

extern "C" void kernel_launch(void* const* d_in, const int* in_sizes, int n_in,
                              void* d_out, int out_size, void* d_ws, size_t ws_size,
                              hipStream_t stream) {
  static int grid_blocks = 0;
  if (!grid_blocks) {
    int dev = 0, cus = 0, per_cu = 0;
    (void)hipGetDevice(&dev);
    (void)hipDeviceGetAttribute(&cus, hipDeviceAttributeMultiprocessorCount, dev);
    (void)hipFuncSetAttribute((const void*)fwd_mega, hipFuncAttributeMaxDynamicSharedMemorySize, LDS_BYTES);
    (void)hipOccupancyMaxActiveBlocksPerMultiprocessor(&per_cu, (const void*)fwd_mega, NT, LDS_BYTES);
    if (per_cu < 1) per_cu = 1;
    grid_blocks = cus * per_cu;
    if (ws_size < WS_END) fprintf(stderr, "workspace too small: %zu < %zu\n", ws_size, (size_t)WS_END);
  }
  Params p{};
  for (int i = 0; i < 22; ++i) p.in[i] = (const float*)d_in[i];
  p.out = (float*)d_out;
  p.ws = (unsigned char*)d_ws;
  (void)hipMemsetAsync((unsigned char*)d_ws + OFF_BAR, 0, 16384, stream);
  void* args[] = {&p};
  hipError_t e = hipLaunchCooperativeKernel((const void*)fwd_mega, dim3(grid_blocks), dim3(NT), args, LDS_BYTES, stream);
  if (e != hipSuccess) fprintf(stderr, "cooperative launch failed: %s (grid %d)\n", hipGetErrorString(e), grid_blocks);
}
```

```cpp
#include <hip/hip_runtime.h>
#include <hip/hip_cooperative_groups.h>
#include <cstdio>
namespace cg = cooperative_groups;

#define DI __device__ __forceinline__
#define NT 512
static __device__ __forceinline__ int fresh_tid() { int t = threadIdx.x; asm volatile("" : "+v"(t)); return t; }
typedef unsigned short u16;
typedef __attribute__((ext_vector_type(8))) short bf16x8;
typedef __attribute__((ext_vector_type(4))) short s16x4;
typedef __attribute__((ext_vector_type(16))) float f32x16;
typedef __attribute__((ext_vector_type(4))) float f32x4;
typedef __attribute__((ext_vector_type(2))) __bf16 bf2v;
typedef __attribute__((ext_vector_type(2))) float f2v;
typedef unsigned __attribute__((ext_vector_type(4))) u32x4;

#define MFMA32(a, b, c) __builtin_amdgcn_mfma_f32_32x32x16_bf16((a), (b), (c), 0, 0, 0)
#define MFMA16(a, b, c) __builtin_amdgcn_mfma_f32_16x16x32_bf16((a), (b), (c), 0, 0, 0)

constexpr int LDS_BYTES = 140 * 1024;
constexpr int TT = 2304;
constexpr int RR = 18432;
constexpr int NPAD = 3456;
constexpr float EPS = 1e-6f;
constexpr float LOG2E = 1.4426950408889634f;

constexpr size_t SZ_WIN = (size_t)2 * NPAD * 1024 * 2;
constexpr size_t SZ_WOUT = (size_t)2 * 1024 * 1024 * 2;
constexpr size_t SZ_MOD = (size_t)2 * 9 * 3072 * 4;
constexpr size_t SZ_ROPE = 16384;
constexpr size_t SZ_R1024 = (size_t)RR * 1024 * 2;
constexpr size_t SZ_R512 = (size_t)RR * 512 * 2;
constexpr size_t SZ_R256 = (size_t)RR * 256 * 2;
constexpr size_t OFF_WIN = 0;
constexpr size_t OFF_WOUT = OFF_WIN + SZ_WIN;
constexpr size_t OFF_MOD = OFF_WOUT + SZ_WOUT;
constexpr size_t OFF_ROPE = OFF_MOD + SZ_MOD;
constexpr size_t OFF_U = OFF_ROPE + SZ_ROPE;
constexpr size_t OFF_XBC = OFF_U + SZ_R1024;
constexpr size_t OFF_Z = OFF_XBC + SZ_R1024;
constexpr size_t OFF_DT = OFF_Z + SZ_R512;
constexpr size_t SZ_DT = (size_t)RR * 16 * 4;
constexpr size_t OFF_Q = OFF_DT + SZ_DT;
constexpr size_t SZ_Q = (size_t)8 * 4 * TT * 64 * 2;
constexpr size_t OFF_K = OFF_Q + SZ_Q;
constexpr size_t SZ_K = (size_t)8 * 2 * TT * 64 * 2;
constexpr size_t OFF_VT = OFF_K + SZ_K;
constexpr size_t OFF_DQ = OFF_VT + SZ_K;
constexpr size_t SZ_DQ = (size_t)8 * 8 * TT * 32 * 2;
constexpr size_t OFF_DK = OFF_DQ + SZ_DQ;
constexpr size_t OFF_DVT = OFF_DK + SZ_DQ;
constexpr size_t SZ_DVT = (size_t)8 * 4 * 64 * TT * 2;
constexpr size_t OFF_GG = OFF_DVT + SZ_DVT;
constexpr size_t OFF_DG = OFF_GG + SZ_R256;
constexpr size_t OFF_CC = OFF_DG + SZ_R256;
constexpr size_t OFF_CUMF = OFF_CC + SZ_R256;
constexpr size_t SZ_CUM = (size_t)RR * 8 * 4;
constexpr size_t OFF_CUMB = OFF_CUMF + SZ_CUM;
constexpr size_t OFF_SLOC = OFF_CUMB + SZ_CUM;
constexpr size_t SZ_ST = (size_t)2 * 8 * 18 * 8 * 8192 * 2;
constexpr size_t OFF_OPART = OFF_SLOC + SZ_ST;
constexpr size_t OFF_HB = OFF_OPART + SZ_DT;
constexpr size_t SZ_HB = (size_t)8 * 2048 * 1024 * 2;
constexpr size_t OFF_BAR = OFF_HB + SZ_HB;
constexpr size_t WS_END = OFF_BAR + 16384;
static_assert(SZ_ST <= (OFF_GG - OFF_Q), "Stin must fit in the q/k/v region");
static_assert(WS_END <= (size_t)256 * 1024 * 1024, "workspace");

struct Params {
  const float* in[22];
  float* out;
  unsigned char* ws;
};

struct WS {
  u16 *WinT, *WoutT, *U, *Ycat, *XBC, *Obuf, *Z, *Q, *K, *Vt, *DQ, *DK, *DVt, *GG, *DG, *Cc, *Sloc, *Stin;
  float *mod, *DT, *cumF, *cumB, *Opart;
  float2 *ropeG, *ropeD;
};

DI unsigned pk(float a, float b) { f2v v = {a, b}; return __builtin_bit_cast(unsigned, __builtin_convertvector(v, bf2v)); }
DI u16 f2bf(float a) { return (u16)(pk(a, 0.f) & 0xffffu); }
DI float bf2f(u16 b) { return __uint_as_float(((unsigned)b) << 16); }
DI float bflo(unsigned u) { return __uint_as_float(u << 16); }
DI float bfhi(unsigned u) { return __uint_as_float(u & 0xffff0000u); }
DI float silu(float x) { return x / (1.f + __expf(-x)); }
DI float softplus(float x) { return fmaxf(x, 0.f) + log1pf(__expf(-fabsf(x))); }
DI float fexp2(float x) { return __builtin_amdgcn_exp2f(x); }

DI void store64(u16* dst, const float (&v)[64]) {
#pragma unroll
  for (int i = 0; i < 8; ++i) {
    uint4 u;
    u.x = pk(v[8 * i], v[8 * i + 1]); u.y = pk(v[8 * i + 2], v[8 * i + 3]);
    u.z = pk(v[8 * i + 4], v[8 * i + 5]); u.w = pk(v[8 * i + 6], v[8 * i + 7]);
    ((uint4*)dst)[i] = u;
  }
}

struct GRegs { u32x4 a0, a1, a2, a3, b0, b1; };
DI void g_load(GRegs& R, const u16* ag, const u16* bg, int k0) {
  constexpr size_t K = 1024;
  R.a0 = *(const u32x4*)(ag + k0);
  R.a1 = *(const u32x4*)(ag + 64 * K + k0);
  R.a2 = *(const u32x4*)(ag + 128 * K + k0);
  R.a3 = *(const u32x4*)(ag + 192 * K + k0);
  R.b0 = *(const u32x4*)(bg + k0);
  R.b1 = *(const u32x4*)(bg + 64 * K + k0);
}
DI void g_store(const GRegs& R, u16* as, u16* bs) {
  *(u32x4*)(as) = R.a0;
  *(u32x4*)(as + 64 * 72) = R.a1;
  *(u32x4*)(as + 128 * 72) = R.a2;
  *(u32x4*)(as + 192 * 72) = R.a3;
  *(u32x4*)(bs) = R.b0;
  *(u32x4*)(bs + 64 * 72) = R.b1;
}
DI void g_compute(const u16* as, const u16* bs, f32x16 (&acc)[2][2]) {
#pragma unroll
  for (int ks = 0; ks < 4; ++ks) {
    bf16x8 a0 = *(const bf16x8*)(as + 16 * ks);
    bf16x8 a1 = *(const bf16x8*)(as + 32 * 72 + 16 * ks);
    bf16x8 b0 = *(const bf16x8*)(bs + 16 * ks);
    bf16x8 b1 = *(const bf16x8*)(bs + 32 * 72 + 16 * ks);
    acc[0][0] = MFMA32(a0, b0, acc[0][0]);
    acc[0][1] = MFMA32(a0, b1, acc[0][1]);
    acc[1][0] = MFMA32(a1, b0, acc[1][0]);
    acc[1][1] = MFMA32(a1, b1, acc[1][1]);
  }
}
constexpr int G_LDK = 72;
constexpr int G_CST = 132;
DI void gemm_tile_to_lds(const u16* __restrict__ A, const u16* __restrict__ Bt, int m0, int n0, unsigned char* lds) {
  constexpr int K = 1024;
  u16* As = (u16*)lds;
  u16* Bs = (u16*)(lds + 2 * 256 * G_LDK * 2);
  const int tid = fresh_tid(), lane = tid & 63, w = tid >> 6;
  const int r = lane & 31, h = lane >> 5;
  const int wm = w >> 1, wn = w & 1;
  const int arow = tid >> 3, akc = tid & 7;
  const u16* ag = A + (size_t)(m0 + arow) * K + akc * 8;
  const u16* bg = Bt + (size_t)(n0 + arow) * K + akc * 8;
  f32x16 acc[2][2];
#pragma unroll
  for (int i = 0; i < 2; ++i)
#pragma unroll
    for (int j = 0; j < 2; ++j)
#pragma unroll
      for (int e = 0; e < 16; ++e) acc[i][j][e] = 0.f;
  GRegs R0, R1;
  g_load(R0, ag, bg, 0);
  g_load(R1, ag, bg, 64);
  g_store(R0, As + arow * G_LDK + akc * 8, Bs + arow * G_LDK + akc * 8);
  __syncthreads();
  const u16* as0 = As + (64 * wm + r) * G_LDK + 8 * h;
  const u16* bs0 = Bs + (64 * wn + r) * G_LDK + 8 * h;
  for (int kt2 = 0; kt2 < 16; kt2 += 2) {
    if (kt2 + 2 < 16) g_load(R0, ag, bg, (kt2 + 2) * 64);
    g_compute(as0, bs0, acc);
    g_store(R1, As + 256 * G_LDK + arow * G_LDK + akc * 8, Bs + 128 * G_LDK + arow * G_LDK + akc * 8);
    __syncthreads();
    if (kt2 + 3 < 16) g_load(R1, ag, bg, (kt2 + 3) * 64);
    g_compute(as0 + 256 * G_LDK, bs0 + 128 * G_LDK, acc);
    if (kt2 + 2 < 16) g_store(R0, As + arow * G_LDK + akc * 8, Bs + arow * G_LDK + akc * 8);
    __syncthreads();
  }
  float* Cst = (float*)lds;
#pragma unroll
  for (int i = 0; i < 2; ++i)
#pragma unroll
    for (int j = 0; j < 2; ++j)
#pragma unroll
      for (int e = 0; e < 16; ++e) {
        const int row = 64 * wm + 32 * i + (e & 3) + 8 * (e >> 2) + 4 * h;
        Cst[row * G_CST + 64 * wn + 32 * j + r] = acc[i][j][e];
      }
  __syncthreads();
}

DI void load_row64(const unsigned char* lds, float (&v)[64]) {
  const int tid = fresh_tid();
  const float* src = (const float*)lds + (tid >> 1) * G_CST + (tid & 1) * 64;
#pragma unroll
  for (int i = 0; i < 16; ++i) {
    float4 f = ((const float4*)src)[i];
    v[4 * i] = f.x; v[4 * i + 1] = f.y; v[4 * i + 2] = f.z; v[4 * i + 3] = f.w;
  }
}

DI void store_tile_transposed(const unsigned char* lds, u16* vt, int t0) {
  const int tid = fresh_tid();
  const int col = tid & 127, rg = tid >> 7;
  const float* src = (const float*)lds + (rg * 64) * G_CST + col;
  u16* dst = vt + (size_t)col * TT + t0 + rg * 64;
#pragma unroll
  for (int i = 0; i < 8; ++i) {
    float f[8];
#pragma unroll
    for (int k = 0; k < 8; ++k) f[k] = src[(8 * i + k) * G_CST];
    uint4 u;
    u.x = pk(f[0], f[1]); u.y = pk(f[2], f[3]); u.z = pk(f[4], f[5]); u.w = pk(f[6], f[7]);
    ((uint4*)dst)[i] = u;
  }
}

DI void inproj_epi(const Params& P, const WS& W, int l, int R, int nt, int half, float (&v)[64]) {
  const int b = R / TT;
  const int t = R - b * TT;
  if (nt < 8) {
    store64(W.XBC + (size_t)R * 1024 + nt * 128 + half * 64, v);
  } else if (nt < 12) {
    store64(W.Z + (size_t)R * 512 + (nt - 8) * 128 + half * 64, v);
  } else if (nt < 15) {
    const bool isq = nt < 14;
    const float* g = (isq ? P.in[17] : P.in[18]) + l * 64;
    float ss = 0.f;
#pragma unroll
    for (int j = 0; j < 64; ++j) ss += v[j] * v[j];
    const float rn = rsqrtf(ss * (1.f / 64.f) + EPS);
#pragma unroll
    for (int j = 0; j < 64; ++j) { if ((j & 15) == 0) __builtin_amdgcn_sched_barrier(0); v[j] = v[j] * rn * g[j]; }
    if (t >= 256) {
      const int pos = t - 256, ri = pos >> 6, ci = pos & 63;
#pragma unroll
      for (int i = 0; i < 32; ++i) {
        if ((i & 7) == 0) __builtin_amdgcn_sched_barrier(0);
        const float2 cs = (i < 16) ? W.ropeG[ri * 16 + i] : W.ropeG[ci * 16 + (i - 16)];
        const float x1 = v[i], x2 = v[i + 32];
        v[i] = x1 * cs.x - x2 * cs.y;
        v[i + 32] = x2 * cs.x + x1 * cs.y;
      }
    }
    if (isq) {
      const float sc = 0.125f * LOG2E;
#pragma unroll
      for (int j = 0; j < 64; ++j) v[j] *= sc;
      const int head = (nt - 12) * 2 + half;
      store64(W.Q + ((size_t)(b * 4 + head) * TT + t) * 64, v);
    } else {
      store64(W.K + ((size_t)(b * 2 + half) * TT + t) * 64, v);
    }
  } else if (nt == 15) {
    u16* dst = W.Vt + ((size_t)(b * 2 + half) * 64) * TT + t;
#pragma unroll
    for (int j = 0; j < 64; ++j) { if ((j & 7) == 0) __builtin_amdgcn_sched_barrier(0); dst[(size_t)j * TT] = f2bf(v[j]); }
  } else if (nt < 18) {
#pragma unroll
    for (int j = 0; j < 64; ++j) v[j] = silu(v[j]);
    store64(W.GG + (size_t)R * 256 + (nt - 16) * 128 + half * 64, v);
  } else if (nt < 22) {
    const bool isq = nt < 20;
    const int mbase = (nt - (isq ? 18 : 20)) * 4 + half * 2;
    if (t >= 256) {
      const int pos = t - 256, ri = pos >> 6, ci = pos & 63;
#pragma unroll
      for (int mm = 0; mm < 2; ++mm)
#pragma unroll
        for (int i = 0; i < 16; ++i) {
          if ((i & 7) == 0) __builtin_amdgcn_sched_barrier(0);
          const float2 cs = (i < 8) ? W.ropeD[ri * 8 + i] : W.ropeD[ci * 8 + (i - 8)];
          const float x1 = v[32 * mm + i], x2 = v[32 * mm + i + 16];
          v[32 * mm + i] = x1 * cs.x - x2 * cs.y;
          v[32 * mm + i + 16] = x2 * cs.x + x1 * cs.y;
        }
    }
    if (isq) {
      const float sc = 0.17677669529663687f * LOG2E;
#pragma unroll
      for (int j = 0; j < 64; ++j) v[j] *= sc;
    }
    u16* base = isq ? W.DQ : W.DK;
#pragma unroll
    for (int mm = 0; mm < 2; ++mm) {
      u16* dst = base + ((size_t)(b * 8 + mbase + mm) * TT + t) * 32;
#pragma unroll
      for (int i = 0; i < 4; ++i) {
        uint4 u;
        u.x = pk(v[32 * mm + 8 * i], v[32 * mm + 8 * i + 1]); u.y = pk(v[32 * mm + 8 * i + 2], v[32 * mm + 8 * i + 3]);
        u.z = pk(v[32 * mm + 8 * i + 4], v[32 * mm + 8 * i + 5]); u.w = pk(v[32 * mm + 8 * i + 6], v[32 * mm + 8 * i + 7]);
        ((uint4*)dst)[i] = u;
      }
    }
  } else if (nt < 24) {
    const int head = (nt - 22) * 2 + half;
    u16* dst = W.DVt + ((size_t)(b * 4 + head) * 64) * TT + t;
#pragma unroll
    for (int j = 0; j < 64; ++j) { if ((j & 7) == 0) __builtin_amdgcn_sched_barrier(0); dst[(size_t)j * TT] = f2bf(v[j]); }
  } else if (nt < 26) {
#pragma unroll
    for (int j = 0; j < 64; ++j) v[j] = silu(v[j]);
    store64(W.DG + (size_t)R * 256 + (nt - 24) * 128 + half * 64, v);
  } else if (nt == 26) {
    if (half == 0) {
      const float* bf = P.in[13] + l * 8;
      const float* bb = P.in[14] + l * 8;
#pragma unroll
      for (int j = 0; j < 16; ++j) {
        const float x = v[j] + (j < 8 ? bf[j] : bb[j - 8]);
        W.DT[(size_t)R * 16 + j] = softplus(x);
      }
    }
  }
}

template <int D, bool BOUNDED>
DI void attn_core(const u16* __restrict__ Qh, const u16* __restrict__ Kh, const u16* __restrict__ Vth, int q0, int nkeys,
                  float bound, unsigned char* lds, f32x16 (&O)[2], float& lout) {
  constexpr int KP = D + 8;
  constexpr int KS = D / 16;
  u16* Ks = (u16*)lds;
  constexpr int VP = 68;
  u16* Vs = (u16*)(lds + 2 * 64 * 72 * 2);
  const int tid = fresh_tid(), lane = tid & 63, w = tid >> 6;
  const int r = lane & 31, h = lane >> 5;
  bf16x8 qf[KS];
  {
    const u16* qp = Qh + (size_t)(q0 + 32 * w + r) * D + 8 * h;
#pragma unroll
    for (int ks = 0; ks < KS; ++ks) qf[ks] = *(const bf16x8*)(qp + 16 * ks);
  }
#pragma unroll
  for (int e = 0; e < 16; ++e) { O[0][e] = 0.f; O[1][e] = 0.f; }
  float m = BOUNDED ? bound : 0.f, lsum = 0.f;
  const int krow = (D == 64) ? (tid >> 3) : (tid >> 2);
  const int kc = (D == 64) ? (tid & 7) : (tid & 3);
  const bool kact = (D == 64) ? true : (tid < 256);
  const int vrow = tid >> 3, vc = tid & 7;
  const u16* kg = Kh + (size_t)krow * D + kc * 8;
  const u16* vg = Vth + (size_t)vrow * TT + vc * 8;
  u32x4 rk0 = (u32x4){0u, 0u, 0u, 0u}, rk1 = rk0, rv0, rv1;
  const int nk = nkeys >> 6;
  if (kact) rk0 = *(const u32x4*)kg;
  rv0 = *(const u32x4*)vg;
  __builtin_amdgcn_s_waitcnt(0x0F70);
  if (kact) *(u32x4*)&Ks[krow * KP + kc * 8] = rk0;
  { const u32x4 t_ = rv0; *(uint2*)&Vs[vrow * VP + vc * 8] = make_uint2(t_.x, t_.y); *(uint2*)&Vs[vrow * VP + vc * 8 + 4] = make_uint2(t_.z, t_.w); }
  if (kact) rk1 = *(const u32x4*)(kg + (size_t)64 * D);
  rv1 = *(const u32x4*)(vg + 64);
  __syncthreads();
  for (int kt2 = 0; kt2 < nk; kt2 += 2) {
#pragma unroll
  for (int ph = 0; ph < 2; ++ph) {
    const int kt = kt2 + ph;
    const int cur = ph;
    {
      const int tx = min(kt + 2, nk - 1);
      if (ph == 0) {
        if (kact) rk0 = *(const u32x4*)(kg + (size_t)tx * 64 * D);
        rv0 = *(const u32x4*)(vg + tx * 64);
      } else {
        if (kact) rk1 = *(const u32x4*)(kg + (size_t)tx * 64 * D);
        rv1 = *(const u32x4*)(vg + tx * 64);
      }
    }
    __builtin_amdgcn_sched_barrier(0);
    const u16* ks_ = Ks + cur * 64 * KP + r * KP + 8 * h;
    bf16x8 kf0[KS], kf1[KS];
#pragma unroll
    for (int ks = 0; ks < KS; ++ks) {
      kf0[ks] = *(const bf16x8*)(ks_ + 16 * ks);
      kf1[ks] = *(const bf16x8*)(ks_ + 32 * KP + 16 * ks);
    }
    const u16* vs_ = Vs + cur * 64 * VP + r * VP + 4 * h;
    bf16x8 vf[8];
#pragma unroll
    for (int s = 0; s < 2; ++s)
#pragma unroll
      for (int dt = 0; dt < 2; ++dt) {
        const u16* vp = vs_ + dt * 32 * VP + 16 * s;
        s16x4 lo = *(const s16x4*)vp;
        s16x4 hi = *(const s16x4*)(vp + 8);
        vf[s * 2 + dt] = __builtin_shufflevector(lo, hi, 0, 1, 2, 3, 4, 5, 6, 7);
      }
    __builtin_amdgcn_sched_barrier(0);
    f32x16 S[2];
    {
      const float nm = -m;
#pragma unroll
      for (int e = 0; e < 16; ++e) { S[0][e] = nm; S[1][e] = nm; }
    }
#pragma unroll
    for (int ks = 0; ks < KS; ++ks) {
      S[0] = MFMA32(kf0[ks], qf[ks], S[0]);
      S[1] = MFMA32(kf1[ks], qf[ks], S[1]);
    }
    __builtin_amdgcn_sched_barrier(0);
#pragma unroll
    for (int s = 0; s < 2; ++s)
#pragma unroll
      for (int dt = 0; dt < 2; ++dt) {
        const u16* vp = vs_ + dt * 32 * VP + 32 + 16 * s;
        s16x4 lo = *(const s16x4*)vp;
        s16x4 hi = *(const s16x4*)(vp + 8);
        vf[(2 + s) * 2 + dt] = __builtin_shufflevector(lo, hi, 0, 1, 2, 3, 4, 5, 6, 7);
      }
    __builtin_amdgcn_sched_barrier(0);
    if (!BOUNDED) {
      float t0 = fmaxf(fmaxf(S[0][0], S[0][1]), S[0][2]);
      float t1 = fmaxf(fmaxf(S[1][0], S[1][1]), S[1][2]);
#pragma unroll
      for (int e = 3; e < 15; e += 2) { t0 = fmaxf(fmaxf(t0, S[0][e]), S[0][e + 1]); t1 = fmaxf(fmaxf(t1, S[1][e]), S[1][e + 1]); }
      float tm = fmaxf(fmaxf(t0, t1), fmaxf(S[0][15], S[1][15]));
      tm = fmaxf(tm, __shfl_xor(tm, 32));
      const bool first = (kt == 0);
      if (first || __any(tm > 0.f)) {
        const float adj = first ? tm : fmaxf(tm, 0.f);
        const float alpha = first ? 1.f : fexp2(-adj);
        m += adj;
        lsum *= alpha;
#pragma unroll
        for (int e = 0; e < 16; ++e) { O[0][e] *= alpha; O[1][e] *= alpha; S[0][e] -= adj; S[1][e] -= adj; }
      }
    }
    float rs = 0.f;
#pragma unroll
    for (int e = 0; e < 16; ++e) { S[0][e] = fexp2(S[0][e]); rs += S[0][e]; }
#pragma unroll
    for (int e = 0; e < 16; ++e) { S[1][e] = fexp2(S[1][e]); rs += S[1][e]; }
    lsum += rs;
#pragma unroll
    for (int t2 = 0; t2 < 2; ++t2)
#pragma unroll
      for (int s = 0; s < 2; ++s) {
        uint4 pu;
        pu.x = pk(S[t2][8 * s], S[t2][8 * s + 1]); pu.y = pk(S[t2][8 * s + 2], S[t2][8 * s + 3]);
        pu.z = pk(S[t2][8 * s + 4], S[t2][8 * s + 5]); pu.w = pk(S[t2][8 * s + 6], S[t2][8 * s + 7]);
        const bf16x8 pb = __builtin_bit_cast(bf16x8, pu);
        O[0] = MFMA32(vf[(t2 * 2 + s) * 2 + 0], pb, O[0]);
        O[1] = MFMA32(vf[(t2 * 2 + s) * 2 + 1], pb, O[1]);
      }
    if (kt + 1 < nk) {
      const int nx = cur ^ 1;
      if (kact) *(u32x4*)&Ks[nx * 64 * KP + krow * KP + kc * 8] = (ph == 0) ? rk1 : rk0;
      { const u32x4 t_ = (ph == 0) ? rv1 : rv0; *(uint2*)&Vs[nx * 64 * VP + vrow * VP + vc * 8] = make_uint2(t_.x, t_.y); *(uint2*)&Vs[nx * 64 * VP + vrow * VP + vc * 8 + 4] = make_uint2(t_.z, t_.w); }
    }
    __syncthreads();
  }
  }
  lout = lsum + __shfl_xor(lsum, 32);
}

DI void gqa_unit(const WS& W, const float* qg, const float* kg_, int b, int head, int qb, unsigned char* lds) {
  const int tid = fresh_tid(), lane = tid & 63, w = tid >> 6, r = lane & 31, h = lane >> 5;
  const int q0 = qb * 256;
  const int nkeys = (qb == 0) ? 256 : TT;
  f32x16 O[2];
  float l;
  float bound;
  {
    float gq = fabsf(qg[lane]), gk = fabsf(kg_[lane]);
#pragma unroll
    for (int d = 32; d >= 1; d >>= 1) { gq = fmaxf(gq, __shfl_xor(gq, d)); gk = fmaxf(gk, __shfl_xor(gk, d)); }
    bound = 8.f * LOG2E * gq * gk * 1.02f + 0.25f;
  }
  attn_core<64, true>(W.Q + (size_t)(b * 4 + head) * TT * 64, W.K + (size_t)(b * 2 + (head >> 1)) * TT * 64,
                      W.Vt + (size_t)(b * 2 + (head >> 1)) * 64 * TT, q0, nkeys, bound, lds, O, l);
  const float il = 1.f / l;
  const size_t Rr = (size_t)b * TT + q0 + 32 * w + r;
#pragma unroll
  for (int dt = 0; dt < 2; ++dt)
#pragma unroll
    for (int i4 = 0; i4 < 4; ++i4) {
      const int dv = 32 * dt + 8 * i4 + 4 * h;
      const uint2 g = *(const uint2*)(W.GG + Rr * 256 + head * 64 + dv);
      uint2 o;
      o.x = pk(O[dt][4 * i4] * il * bflo(g.x), O[dt][4 * i4 + 1] * il * bfhi(g.x));
      o.y = pk(O[dt][4 * i4 + 2] * il * bflo(g.y), O[dt][4 * i4 + 3] * il * bfhi(g.y));
      *(uint2*)(W.Ycat + Rr * 1024 + 512 + head * 64 + dv) = o;
    }
}

DI void diff_unit(const Params& P, const WS& W, int l, int b, int hh, int qb, unsigned char* lds) {
  const int tid = fresh_tid(), lane = tid & 63, w = tid >> 6, r = lane & 31, h = lane >> 5;
  const int q0 = qb * 256;
  const int nkeys = (qb == 0) ? 256 : TT;
  const float lam_init = (l == 0) ? 0.2f : 0.35550906759f;
  float lam;
  {
    const float* lp = P.in[19] + l * 128;
    float s1 = (lane < 32) ? lp[lane] * lp[32 + lane] : 0.f;
    float s2 = (lane < 32) ? lp[64 + lane] * lp[96 + lane] : 0.f;
#pragma unroll
    for (int d = 32; d >= 1; d >>= 1) { s1 += __shfl_xor(s1, d); s2 += __shfl_xor(s2, d); }
    lam = __expf(s1) - __expf(s2) + lam_init;
  }
  f32x16 O1[2], O2[2];
  float l1, l2;
  const u16* vt = W.DVt + (size_t)(b * 4 + hh) * 64 * TT;
  attn_core<32, false>(W.DQ + (size_t)(b * 8 + 2 * hh) * TT * 32, W.DK + (size_t)(b * 8 + 2 * hh) * TT * 32, vt, q0, nkeys, 0.f, lds, O1, l1);
  attn_core<32, false>(W.DQ + (size_t)(b * 8 + 2 * hh + 1) * TT * 32, W.DK + (size_t)(b * 8 + 2 * hh + 1) * TT * 32, vt, q0, nkeys, 0.f, lds, O2, l2);
  const float i1 = 1.f / l1, i2 = lam / l2;
  float ss = 0.f;
#pragma unroll
  for (int dt = 0; dt < 2; ++dt)
#pragma unroll
    for (int e = 0; e < 16; ++e) {
      const float o = O1[dt][e] * i1 - O2[dt][e] * i2;
      O1[dt][e] = o;
      ss += o * o;
    }
  ss += __shfl_xor(ss, 32);
  const float rn = rsqrtf(ss * (1.f / 64.f) + EPS) * (1.f - lam_init);
  const float* ng = P.in[20] + l * 64;
  const size_t Rr = (size_t)b * TT + q0 + 32 * w + r;
#pragma unroll
  for (int dt = 0; dt < 2; ++dt)
#pragma unroll
    for (int i4 = 0; i4 < 4; ++i4) {
      const int dv = 32 * dt + 8 * i4 + 4 * h;
      const uint2 g = *(const uint2*)(W.DG + Rr * 256 + hh * 64 + dv);
      const float4 n4 = *(const float4*)(ng + dv);
      uint2 o;
      o.x = pk(O1[dt][4 * i4] * rn * n4.x * bflo(g.x), O1[dt][4 * i4 + 1] * rn * n4.y * bfhi(g.x));
      o.y = pk(O1[dt][4 * i4 + 2] * rn * n4.z * bflo(g.y), O1[dt][4 * i4 + 3] * rn * n4.w * bfhi(g.y));
      *(uint2*)(W.Ycat + Rr * 1024 + 768 + hh * 64 + dv) = o;
    }
}

DI void ssd_xload(uint2 (&raw)[8], const u16* src, int tb, int seg_lo, int seg_hi) {
#pragma unroll
  for (int i = 0; i < 8; ++i) {
    const int t = tb - 2 + i;
    const int tc = min(max(t, seg_lo), seg_hi - 1);
    uint2 v = *(const uint2*)(src + (size_t)tc * 1024);
    if (t < seg_lo || t >= seg_hi) v = make_uint2(0u, 0u);
    raw[i] = v;
  }
}
constexpr int S_LD = 136;
DI void ssd_local_unit(const Params& P, const WS& W, int l, int b, int c, int g, int h_lo, int h_hi, unsigned char* lds) {
  const int tid = fresh_tid(), lane = tid & 63, w = tid >> 6;
  u16* BsT = (u16*)lds;
  u16* Bs = (u16*)(lds + 34816);
  u16* Cs = (u16*)(lds + 69632);
  u16* xT = (u16*)(lds + 34816);
  u16* xsF = (u16*)(lds + 52224);
  u16* xsB = (u16*)(lds + 69632);
  float* cumF = (float*)(lds + 104448);
  float* cumB = cumF + 512;
  float* dtF = cumB + 512;
  float* dtB = dtF + 512;
  const size_t Rc0 = (size_t)b * TT + c * 128;
  const int seg_lo = (c < 2) ? 0 : 256;
  const int seg_hi = (c < 2) ? 256 : TT;
  const float* conv_w = P.in[9] + (size_t)l * 5 * 1024;
  const float* conv_b = P.in[10] + (size_t)l * 1024;
  const int cqB = lane;
  const bool isB = cqB < 32;
  const int ch0 = isB ? 4 * cqB : 4 * (cqB - 32);
  float4 wjB[5];
  float4 biasB;
  uint2 rawB[20];
  {
    const int col = (isB ? 512 : 768) + g * 128 + ch0;
#pragma unroll
    for (int j = 0; j < 5; ++j) wjB[j] = *(const float4*)(conv_w + j * 1024 + col);
    biasB = *(const float4*)(conv_b + col);
    const u16* src = W.XBC + (size_t)b * TT * 1024 + col;
    const int tb = c * 128 + 16 * w;
#pragma unroll
    for (int i = 0; i < 20; ++i) {
      const int t = tb - 2 + i;
      const int tc = min(max(t, seg_lo), seg_hi - 1);
      uint2 v = *(const uint2*)(src + (size_t)tc * 1024);
      if (t < seg_lo || t >= seg_hi) v = make_uint2(0u, 0u);
      rawB[i] = v;
    }
  }
  uint2 xraw[8];
  ssd_xload(xraw, W.XBC + (size_t)b * TT * 1024 + (g * 4 + h_lo) * 64 + 4 * (tid & 15), c * 128 + 4 * (tid >> 4), seg_lo, seg_hi);
  float4 xw[5], xbias;
  {
    const int col = (g * 4 + h_lo) * 64 + 4 * (tid & 15);
#pragma unroll
    for (int j = 0; j < 5; ++j) xw[j] = *(const float4*)(conv_w + j * 1024 + col);
    xbias = *(const float4*)(conv_b + col);
  }
  {
    const int hh = w & 3, dir = w >> 2, hg = g * 4 + hh;
    const float a = -__expf((dir ? P.in[12] : P.in[11])[l * 8 + hg]);
    const float d0 = W.DT[(Rc0 + 2 * lane) * 16 + dir * 8 + hg];
    const float d1 = W.DT[(Rc0 + 2 * lane + 1) * 16 + dir * 8 + hg];
    const float a0 = d0 * a, a1 = d1 * a;
    float v = a0 + a1;
    float c0, c1;
    if (dir == 0) {
#pragma unroll
      for (int d = 1; d < 64; d <<= 1) { const float t = __shfl_up(v, d); if (lane >= d) v += t; }
      c0 = v - a1; c1 = v;
    } else {
#pragma unroll
      for (int d = 1; d < 64; d <<= 1) { const float t = __shfl_down(v, d); if (lane + d < 64) v += t; }
      c0 = v; c1 = v - a0;
    }
    float* lc = cumF + dir * 512 + hh * 128 + 2 * lane;
    lc[0] = c0; lc[1] = c1;
    lc[1024] = d0; lc[1025] = d1;
    float* gc = W.cumF + (size_t)dir * ((size_t)RR * 8) + (Rc0 + 2 * lane) * 8 + hg;
    gc[0] = c0; gc[8] = c1;
  }
  {
    float y[4][16];
#pragma unroll
    for (int s2 = 0; s2 < 16; ++s2) {
      float a0 = biasB.x, a1 = biasB.y, a2 = biasB.z, a3 = biasB.w;
#pragma unroll
      for (int j = 0; j < 5; ++j) {
        const uint2 v = rawB[s2 + j];
        a0 += wjB[j].x * bflo(v.x); a1 += wjB[j].y * bfhi(v.x); a2 += wjB[j].z * bflo(v.y); a3 += wjB[j].w * bfhi(v.y);
      }
      y[0][s2] = silu(a0); y[1][s2] = silu(a1); y[2][s2] = silu(a2); y[3][s2] = silu(a3);
    }
    const int s0 = 16 * w;
    if (isB) {
#pragma unroll
      for (int s2 = 0; s2 < 16; ++s2) {
        uint2 o; o.x = pk(y[0][s2], y[1][s2]); o.y = pk(y[2][s2], y[3][s2]);
        *(uint2*)&Bs[(s0 + s2) * S_LD + ch0] = o;
      }
#pragma unroll
      for (int ch = 0; ch < 4; ++ch) {
        uint4 u0, u1;
        u0.x = pk(y[ch][0], y[ch][1]); u0.y = pk(y[ch][2], y[ch][3]); u0.z = pk(y[ch][4], y[ch][5]); u0.w = pk(y[ch][6], y[ch][7]);
        u1.x = pk(y[ch][8], y[ch][9]); u1.y = pk(y[ch][10], y[ch][11]); u1.z = pk(y[ch][12], y[ch][13]); u1.w = pk(y[ch][14], y[ch][15]);
        *(uint4*)&BsT[(ch0 + ch) * S_LD + s0] = u0;
        *(uint4*)&BsT[(ch0 + ch) * S_LD + s0 + 8] = u1;
      }
    } else {
#pragma unroll
      for (int s2 = 0; s2 < 16; ++s2) {
        uint2 o; o.x = pk(y[0][s2], y[1][s2]); o.y = pk(y[2][s2], y[3][s2]);
        *(uint2*)&Cs[(s0 + s2) * S_LD + ch0] = o;
        *(uint2*)(W.Cc + (Rc0 + s0 + s2) * 256 + g * 128 + ch0) = o;
      }
    }
  }
  __syncthreads();
  const int c16 = lane & 15, q = lane >> 4;
  f32x4 G[8];
#pragma unroll
  for (int st = 0; st < 8; ++st) G[st] = (f32x4){0.f, 0.f, 0.f, 0.f};
#pragma unroll
  for (int ks = 0; ks < 4; ++ks) {
    const bf16x8 bfrag = *(const bf16x8*)&Cs[(16 * w + c16) * S_LD + 32 * ks + 8 * q];
#pragma unroll
    for (int st = 0; st < 8; ++st) {
      const bf16x8 afrag = *(const bf16x8*)&Bs[(16 * st + c16) * S_LD + 32 * ks + 8 * q];
      G[st] = MFMA16(afrag, bfrag, G[st]);
    }
  }
  __syncthreads();
  for (int hh = h_lo; hh < h_hi; ++hh) {
    const int hg = g * 4 + hh;
    {
      const int cq = tid & 15, tg = tid >> 4;
      const int col = hg * 64 + 4 * cq;
      float4 wj[5];
#pragma unroll
      for (int j = 0; j < 5; ++j) wj[j] = xw[j];
      const float4 bias = xbias;
      (void)col;
      const float cF_end = cumF[hh * 128 + 127], cB_end = cumB[hh * 128];
      float y[4][4], ff[4], fb[4];
#pragma unroll
      for (int s2 = 0; s2 < 4; ++s2) {
        float a0 = bias.x, a1 = bias.y, a2 = bias.z, a3 = bias.w;
#pragma unroll
        for (int j = 0; j < 5; ++j) {
          const uint2 v = xraw[s2 + j];
          a0 += wj[j].x * bflo(v.x); a1 += wj[j].y * bfhi(v.x); a2 += wj[j].z * bflo(v.y); a3 += wj[j].w * bfhi(v.y);
        }
        y[0][s2] = silu(a0); y[1][s2] = silu(a1); y[2][s2] = silu(a2); y[3][s2] = silu(a3);
        const int sI = 4 * tg + s2;
        ff[s2] = dtF[hh * 128 + sI] * __expf(cF_end - cumF[hh * 128 + sI]);
        fb[s2] = dtB[hh * 128 + sI] * __expf(cB_end - cumB[hh * 128 + sI]);
      }
#pragma unroll
      for (int ch = 0; ch < 4; ++ch) {
        const int p = 4 * cq + ch;
        uint2 o;
        o.x = pk(y[ch][0], y[ch][1]); o.y = pk(y[ch][2], y[ch][3]);
        *(uint2*)&xT[p * S_LD + 4 * tg] = o;
        o.x = pk(y[ch][0] * ff[0], y[ch][1] * ff[1]); o.y = pk(y[ch][2] * ff[2], y[ch][3] * ff[3]);
        *(uint2*)&xsF[p * S_LD + 4 * tg] = o;
        o.x = pk(y[ch][0] * fb[0], y[ch][1] * fb[1]); o.y = pk(y[ch][2] * fb[2], y[ch][3] * fb[3]);
        *(uint2*)&xsB[p * S_LD + 4 * tg] = o;
      }
      if (hh + 1 < h_hi) {
        ssd_xload(xraw, W.XBC + (size_t)b * TT * 1024 + (hg + 1) * 64 + 4 * cq, c * 128 + 4 * tg, seg_lo, seg_hi);
        const int coln = (hg + 1) * 64 + 4 * cq;
#pragma unroll
        for (int j = 0; j < 5; ++j) xw[j] = *(const float4*)(conv_w + j * 1024 + coln);
        xbias = *(const float4*)(conv_b + coln);
      }
    }
    __syncthreads();
    {
      const int t = 16 * w + c16;
      const float cF_t = cumF[hh * 128 + t], cB_t = cumB[hh * 128 + t];
      const float Dh = P.in[15][l * 8 + hg];
      f32x4 Y[4];
#pragma unroll
      for (int pt = 0; pt < 4; ++pt) Y[pt] = (f32x4){0.f, 0.f, 0.f, 0.f};
#pragma unroll
      for (int m = 0; m < 4; ++m) {
        __builtin_amdgcn_sched_barrier(0);
        float mv[8];
#pragma unroll
        for (int jj = 0; jj < 2; ++jj) {
          const int st = 2 * m + jj;
          const int sb = 16 * st + 4 * q;
          const float4 cf4 = *(const float4*)&cumF[hh * 128 + sb];
          const float4 df4 = *(const float4*)&dtF[hh * 128 + sb];
          const float4 cb4 = *(const float4*)&cumB[hh * 128 + sb];
          const float4 db4 = *(const float4*)&dtB[hh * 128 + sb];
          const float cfv[4] = {cf4.x, cf4.y, cf4.z, cf4.w}, dfv[4] = {df4.x, df4.y, df4.z, df4.w};
          const float cbv[4] = {cb4.x, cb4.y, cb4.z, cb4.w}, dbv[4] = {db4.x, db4.y, db4.z, db4.w};
#pragma unroll
          for (int i = 0; i < 4; ++i) {
            const int s = sb + i;
            const float ef = (s <= t) ? __expf(cF_t - cfv[i]) * dfv[i] : 0.f;
            const float eb = (s >= t) ? __expf(cB_t - cbv[i]) * dbv[i] : 0.f;
            mv[4 * jj + i] = G[st][i] * (ef + eb) + ((s == t) ? Dh : 0.f);
          }
        }
        uint4 mu;
        mu.x = pk(mv[0], mv[1]); mu.y = pk(mv[2], mv[3]); mu.z = pk(mv[4], mv[5]); mu.w = pk(mv[6], mv[7]);
        const bf16x8 Mf = __builtin_bit_cast(bf16x8, mu);
#pragma unroll
        for (int pt = 0; pt < 4; ++pt) {
          const u16* xp = xT + (16 * pt + c16) * S_LD + 32 * m + 4 * q;
          s16x4 lo = *(const s16x4*)xp;
          s16x4 hi = *(const s16x4*)(xp + 16);
          const bf16x8 af = __builtin_shufflevector(lo, hi, 0, 1, 2, 3, 4, 5, 6, 7);
          Y[pt] = MFMA16(af, Mf, Y[pt]);
        }
      }
#pragma unroll
      for (int pt = 0; pt < 4; ++pt) {
        uint2 o;
        o.x = pk(Y[pt][0], Y[pt][1]); o.y = pk(Y[pt][2], Y[pt][3]);
        *(uint2*)(W.Ycat + (Rc0 + t) * 1024 + hg * 64 + 16 * pt + 4 * q) = o;
      }
    }
#pragma unroll
    for (int dir = 0; dir < 2; ++dir) {
      const u16* xs = dir ? xsB : xsF;
      f32x4 acc[4];
#pragma unroll
      for (int pt = 0; pt < 4; ++pt) acc[pt] = (f32x4){0.f, 0.f, 0.f, 0.f};
#pragma unroll
      for (int ks = 0; ks < 4; ++ks) {
        const bf16x8 af = *(const bf16x8*)&BsT[(16 * w + c16) * S_LD + 32 * ks + 8 * q];
#pragma unroll
        for (int pt = 0; pt < 4; ++pt) {
          const bf16x8 bfr = *(const bf16x8*)&xs[(16 * pt + c16) * S_LD + 32 * ks + 8 * q];
          acc[pt] = MFMA16(af, bfr, acc[pt]);
        }
      }
      u16* dst = W.Sloc + ((((size_t)dir * 8 + b) * 18 + c) * 8 + hg) * 8192;
#pragma unroll
      for (int pt = 0; pt < 4; ++pt) {
        uint2 o;
        o.x = pk(acc[pt][0], acc[pt][1]); o.y = pk(acc[pt][2], acc[pt][3]);
        *(uint2*)(dst + (16 * pt + c16) * 128 + 16 * w + 4 * q) = o;
      }
    }
    __syncthreads();
  }
}

DI void ws_init(WS& W, unsigned char* ws) {
        W.WinT = (u16*)(ws + OFF_WIN); W.WoutT = (u16*)(ws + OFF_WOUT); W.mod = (float*)(ws + OFF_MOD);
    W.ropeG = (float2*)(ws + OFF_ROPE); W.ropeD = (float2*)(ws + OFF_ROPE + 8192);
    W.U = (u16*)(ws + OFF_U); W.Ycat = (u16*)(ws + OFF_U); W.XBC = (u16*)(ws + OFF_XBC); W.Obuf = (u16*)(ws + OFF_XBC);
    W.Z = (u16*)(ws + OFF_Z); W.DT = (float*)(ws + OFF_DT);
    W.Q = (u16*)(ws + OFF_Q); W.K = (u16*)(ws + OFF_K); W.Vt = (u16*)(ws + OFF_VT);
    W.DQ = (u16*)(ws + OFF_DQ); W.DK = (u16*)(ws + OFF_DK); W.DVt = (u16*)(ws + OFF_DVT); W.Stin = (u16*)(ws + OFF_Q);
    W.GG = (u16*)(ws + OFF_GG); W.DG = (u16*)(ws + OFF_DG); W.Cc = (u16*)(ws + OFF_CC);
    W.cumF = (float*)(ws + OFF_CUMF); W.cumB = (float*)(ws + OFF_CUMB); W.Sloc = (u16*)(ws + OFF_SLOC);
    W.Opart = (float*)(ws + OFF_OPART);
}

#define XCD_LOOP(UPX, xcd, idx) \
  const bool sw_ = (nb & 7) == 0; \
  for (int t_ = sw_ ? (bid >> 3) : bid; t_ < (sw_ ? (UPX) : 8 * (UPX)); t_ += (sw_ ? (nb >> 3) : nb)) { \
    const int xcd = sw_ ? (bid & 7) : t_ / (UPX); const int idx = sw_ ? t_ : t_ % (UPX);
#define XCD_END }

typedef const Params __attribute__((address_space(4)))* KArgP;
DI Params load_params(KArgP kp) {
  asm volatile("" : "+s"(kp));
  Params P;
#pragma unroll
  for (int i = 0; i < 22; ++i) P.in[i] = kp->in[i];
  P.out = kp->out; P.ws = kp->ws;
  return P;
}

DI void w_transpose_unit(const Params& P, const WS& W, unsigned char* lds, int u) {
  const int tid = fresh_tid();
  constexpr int U_WIN = 2 * 14 * 16;
        const float* src; u16* dst; int ldn, n0, k0, nrows; bool inproj;
        if (u < U_WIN) {
          const int l = u / (14 * 16), rem = u % (14 * 16);
          n0 = (rem >> 4) * 256; k0 = (rem & 15) * 64; ldn = 3344; inproj = true; nrows = NPAD;
          src = P.in[8] + (size_t)l * 1024 * 3344; dst = W.WinT + (size_t)l * NPAD * 1024;
        } else {
          const int v = u - U_WIN; const int l = v >> 6, rem = v & 63;
          n0 = (rem >> 4) * 256; k0 = (rem & 15) * 64; ldn = 1024; inproj = false; nrows = 1024;
          src = P.in[21] + (size_t)l * 1024 * 1024; dst = W.WoutT + (size_t)l * 1024 * 1024;
        }
        float* tile = (float*)lds;
        {
          const int n = tid & 63, kq = tid >> 6;
#pragma unroll
          for (int sub = 0; sub < 4; ++sub) {
            const int nd = n0 + sub * 64 + n;
            int ns = nd;
            if (inproj) { ns = (nd < 1536) ? nd : (nd < 3328 ? nd + 16 : (nd < 3344 ? nd - 3328 + 1536 : -1)); }
#pragma unroll
            for (int i = 0; i < 8; ++i) {
              const int k = kq * 8 + i;
              tile[sub * 4160 + k * 65 + n] = (ns >= 0) ? src[(size_t)(k0 + k) * ldn + ns] : 0.f;
            }
          }
        }
        __syncthreads();
        {
          const int n = tid >> 3, kc = tid & 7;
#pragma unroll
          for (int sub = 0; sub < 4; ++sub) {
            float f[8];
#pragma unroll
            for (int i = 0; i < 8; ++i) f[i] = tile[sub * 4160 + (kc * 8 + i) * 65 + n];
            uint4 o;
            o.x = pk(f[0], f[1]); o.y = pk(f[2], f[3]); o.z = pk(f[4], f[5]); o.w = pk(f[6], f[7]);
            if (n0 + sub * 64 + n < nrows) *(uint4*)(dst + (size_t)(n0 + sub * 64 + n) * 1024 + k0 + kc * 8) = o;
          }
        }
        __syncthreads();
}

DI void ph0_prologue(KArgP kp, unsigned char* lds) {
  const Params P = load_params(kp); WS W; ws_init(W, P.ws);
  const int tid = fresh_tid(), lane = tid & 63, w = tid >> 6;
  const int nb = gridDim.x, bid = blockIdx.x;
  (void)lane; (void)w; (void)tid;
  {
    float* S = (float*)(lds + 69632);
    for (int i = tid; i < 9 * 1024; i += NT) {
      const float x = (i < 8192) ? P.in[1][i] : P.in[3][i - 8192];
      S[i] = silu(x);
    }
    __syncthreads();
    constexpr int U_WIN = 2 * 14 * 16, U_WOUT = 2 * 4 * 16, U_MOD = 384;
    for (int u = U_WIN + U_WOUT + bid; u < U_WIN + U_WOUT + U_MOD + 1; u += nb) {
      if (u < U_WIN + U_WOUT) {
      } else if (u < U_WIN + U_WOUT + U_MOD) {
        const int v = u - U_WIN - U_WOUT;
        const int l = v / 192, n0 = (v % 192) * 16;
        const int c16 = tid & 15, kg = tid >> 4;
        const float* wm = P.in[4] + (size_t)l * 1024 * 3072 + n0 + c16;
        float acc[9];
#pragma unroll
        for (int rr = 0; rr < 9; ++rr) acc[rr] = 0.f;
#pragma unroll 8
        for (int kk = 0; kk < 32; ++kk) {
          const int k = kg * 32 + kk;
          const float wv = wm[(size_t)k * 3072];
#pragma unroll
          for (int rr = 0; rr < 9; ++rr) acc[rr] += S[rr * 1024 + k] * wv;
        }
        float* red = (float*)lds;
#pragma unroll
        for (int rr = 0; rr < 9; ++rr) red[(kg * 16 + c16) * 9 + rr] = acc[rr];
        __syncthreads();
        if (tid < 144) {
          const int cc = tid / 9, rr = tid % 9;
          float s = 0.f;
          for (int k2 = 0; k2 < 32; ++k2) s += red[(k2 * 16 + cc) * 9 + rr];
          W.mod[((size_t)l * 9 + rr) * 3072 + n0 + cc] = s + P.in[5][l * 3072 + n0 + cc];
        }
        __syncthreads();
      } else {
        for (int i = tid; i < 64 * 16; i += NT) {
          const int idx = i >> 4, k = i & 15;
          const float inv = powf(10000.f, -(float)k / 16.f);
          float sn, cs; sincosf((float)idx * inv, &sn, &cs);
          W.ropeG[i] = make_float2(cs, sn);
        }
        for (int i = tid; i < 64 * 8; i += NT) {
          const int idx = i >> 3, k = i & 7;
          const float inv = powf(10000.f, -(float)k / 8.f);
          float sn, cs; sincosf((float)idx * inv, &sn, &cs);
          W.ropeD[i] = make_float2(cs, sn);
        }
      }
    }
  }
}

DI void ph1_prep(KArgP kp, unsigned char* lds) {
  const Params P = load_params(kp); WS W; ws_init(W, P.ws);
  const int tid = fresh_tid(), lane = tid & 63, w = tid >> 6;
  const int nb = gridDim.x, bid = blockIdx.x;
  (void)lane; (void)w; (void)tid;
  XCD_LOOP(288, xcd, idx)
    const int R = xcd * TT + idx * 8 + w;
    const int b = xcd, t = idx * 8 + w;
    const float* src = (t < 256) ? (P.in[2] + ((size_t)b * 256 + t) * 1024) : (P.in[0] + ((size_t)b * 2048 + (t - 256)) * 1024);
    const float* md = W.mod + (size_t)((t < 256) ? 8 : b) * 3072;
    const float* gp = P.in[6];
    float4 x[4];
    float ss = 0.f;
#pragma unroll
    for (int i = 0; i < 4; ++i) {
      x[i] = *(const float4*)(src + i * 256 + lane * 4);
      ss += x[i].x * x[i].x + x[i].y * x[i].y + x[i].z * x[i].z + x[i].w * x[i].w;
    }
#pragma unroll
    for (int d = 32; d >= 1; d >>= 1) ss += __shfl_xor(ss, d);
    const float rn = rsqrtf(ss * (1.f / 1024.f) + EPS);
#pragma unroll
    for (int i = 0; i < 4; ++i) {
      const int k = i * 256 + lane * 4;
      const float4 g4 = *(const float4*)(gp + k);
      const float4 sh = *(const float4*)(md + k);
      const float4 sc = *(const float4*)(md + 1024 + k);
      uint2 o;
      o.x = pk(x[i].x * rn * g4.x * (1.f + sc.x) + sh.x, x[i].y * rn * g4.y * (1.f + sc.y) + sh.y);
      o.y = pk(x[i].z * rn * g4.z * (1.f + sc.z) + sh.z, x[i].w * rn * g4.w * (1.f + sc.w) + sh.w);
      *(uint2*)(W.U + (size_t)R * 1024 + k) = o;
    }
  XCD_END
  for (int u = bid; u < 2 * 14 * 16 + 2 * 4 * 16; u += nb) w_transpose_unit(P, W, lds, u);
}

DI void ph2_inproj(KArgP kp, int l, unsigned char* lds) {
  const Params P = load_params(kp); WS W; ws_init(W, P.ws);
  const int tid = fresh_tid();
  const int nb = gridDim.x, bid = blockIdx.x;
  XCD_LOOP(243, xcd, idx)
    const int nt = idx / 9, mt = xcd * 9 + idx % 9;
    gemm_tile_to_lds(W.U, W.WinT + (size_t)l * NPAD * 1024, mt * 256, nt * 128, lds);
    if (nt == 15 || nt == 22 || nt == 23) {
      const int b = mt / 9, t0 = (mt - b * 9) * 256;
      u16* vt = (nt == 15) ? (W.Vt + (size_t)(b * 2) * 64 * TT) : (W.DVt + (size_t)(b * 4 + (nt - 22) * 2) * 64 * TT);
      store_tile_transposed(lds, vt, t0);
    } else {
      float v[64];
      load_row64(lds, v);
      inproj_epi(P, W, l, mt * 256 + (tid >> 1), nt, tid & 1, v);
    }
    __syncthreads();
  XCD_END
}

DI void ph3_mix(KArgP kp, int l, unsigned char* lds) {
  const Params P = load_params(kp); WS W; ws_init(W, P.ws);
  const int nb = gridDim.x, bid = blockIdx.x;
  const int upx = (l == 0) ? 120 : 112;
  XCD_LOOP(upx, xcd, idx)
    const int b = xcd;
    if (idx < 32) {
      diff_unit(P, W, l, b, idx >> 3, 1 + (idx & 7), lds);
    } else if (idx < 64) {
      gqa_unit(W, P.in[17] + l * 64, P.in[18] + l * 64, b, (idx - 32) >> 3, 1 + (idx & 7), lds);
    } else if (idx < 96) {
      const int v = idx - 64;
      ssd_local_unit(P, W, l, b, v >> 1, v & 1, 0, 4, lds);
    } else if (idx < 112) {
      const int v = idx - 96, u = 32 + (v >> 2), hq = v & 3;
      ssd_local_unit(P, W, l, b, u >> 1, u & 1, hq, hq + 1, lds);
    } else if (idx < 116) {
      diff_unit(P, W, l, b, idx - 112, 0, lds);
    } else {
      gqa_unit(W, P.in[17] + l * 64, P.in[18] + l * 64, b, idx - 116, 0, lds);
    }
    __syncthreads();
  XCD_END
}

DI void ph4a_states(KArgP kp) {
  const Params P = load_params(kp); WS W; ws_init(W, P.ws);
  const int tid = fresh_tid(), lane = tid & 63, w = tid >> 6;
  const int nb = gridDim.x, bid = blockIdx.x;
  (void)lane; (void)w; (void)tid;
    XCD_LOOP(64, xcd, idx)
      const int gid = idx * NT + tid;
      const int e4 = gid & 2047, hg = (gid >> 11) & 7, b = xcd, dir = gid >> 14;
      float s0 = 0.f, s1 = 0.f, s2 = 0.f, s3 = 0.f;
      for (int step = 0; step < 18; ++step) {
        const int c = dir ? (step == 0 ? 1 : (step == 1 ? 0 : 19 - step)) : step;
        const size_t idx = ((((size_t)dir * 8 + b) * 18 + c) * 8 + hg) * 8192 + (size_t)e4 * 4;
        uint2 o;
        o.x = pk(s0, s1); o.y = pk(s2, s3);
        *(uint2*)(W.Stin + idx) = o;
        const float tot = W.cumF[(size_t)dir * ((size_t)RR * 8) + ((size_t)b * TT + c * 128 + (dir ? 0 : 127)) * 8 + hg];
        const float dec = __expf(tot);
        const uint2 sv = *(const uint2*)(W.Sloc + idx);
        s0 = s0 * dec + bflo(sv.x); s1 = s1 * dec + bfhi(sv.x);
        s2 = s2 * dec + bflo(sv.y); s3 = s3 * dec + bfhi(sv.y);
      }
    XCD_END
}

DI void ph4b_yoff(KArgP kp, int l, unsigned char* lds) {
  const Params P = load_params(kp); WS W; ws_init(W, P.ws);
  const int tid = fresh_tid(), lane = tid & 63, w = tid >> 6;
  const int nb = gridDim.x, bid = blockIdx.x;
  (void)lane; (void)w; (void)tid;
    XCD_LOOP((l == 0 ? 72 : 64), xcd, idx)
      const int b = xcd, c = (idx >> 2) + (l == 0 ? 0 : 2), tb = idx & 3;
      const int r = lane & 31, h2 = lane >> 5;
      const int hg = w, g = w >> 2;
      const size_t Rr = (size_t)b * TT + c * 128 + 32 * tb + r;
      f32x16 acc[2][2];
#pragma unroll
      for (int d = 0; d < 2; ++d)
#pragma unroll
        for (int pt = 0; pt < 2; ++pt)
#pragma unroll
          for (int e = 0; e < 16; ++e) acc[d][pt][e] = 0.f;
      const u16* cp = W.Cc + Rr * 256 + g * 128 + 8 * h2;
      bf16x8 bfr[8];
#pragma unroll
      for (int ks = 0; ks < 8; ++ks) bfr[ks] = *(const bf16x8*)(cp + 16 * ks);
      u16* myl = (u16*)lds + w * (64 * 136);
#pragma unroll
      for (int d = 0; d < 2; ++d) {
        const u16* sp = W.Stin + ((((size_t)d * 8 + b) * 18 + c) * 8 + hg) * 8192 + lane * 8;
        u32x4 sv[16];
#pragma unroll
        for (int i = 0; i < 16; ++i) sv[i] = *(const u32x4*)(sp + i * 512);
#pragma unroll
        for (int i = 0; i < 16; ++i) *(u32x4*)(myl + (4 * i + (lane >> 4)) * 136 + (lane & 15) * 8) = sv[i];
        __builtin_amdgcn_wave_barrier();
#pragma unroll
        for (int ks = 0; ks < 8; ++ks) {
          const bf16x8 f0 = *(const bf16x8*)(myl + r * 136 + 16 * ks + 8 * h2);
          const bf16x8 f1 = *(const bf16x8*)(myl + (32 + r) * 136 + 16 * ks + 8 * h2);
          acc[d][0] = MFMA32(f0, bfr[ks], acc[d][0]);
          acc[d][1] = MFMA32(f1, bfr[ks], acc[d][1]);
        }
        __builtin_amdgcn_wave_barrier();
      }
      const float eF = __expf(W.cumF[Rr * 8 + hg]), eB = __expf(W.cumB[Rr * 8 + hg]);
      float ss = 0.f;
#pragma unroll
      for (int pt = 0; pt < 2; ++pt)
#pragma unroll
        for (int i4 = 0; i4 < 4; ++i4) {
          const int p = 32 * pt + 8 * i4 + 4 * h2;
          const uint2 yd = *(const uint2*)(W.Ycat + Rr * 1024 + hg * 64 + p);
          const uint2 zz = *(const uint2*)(W.Z + Rr * 512 + hg * 64 + p);
          float y0 = bflo(yd.x) + eF * acc[0][pt][4 * i4] + eB * acc[1][pt][4 * i4];
          float y1 = bfhi(yd.x) + eF * acc[0][pt][4 * i4 + 1] + eB * acc[1][pt][4 * i4 + 1];
          float y2 = bflo(yd.y) + eF * acc[0][pt][4 * i4 + 2] + eB * acc[1][pt][4 * i4 + 2];
          float y3 = bfhi(yd.y) + eF * acc[0][pt][4 * i4 + 3] + eB * acc[1][pt][4 * i4 + 3];
          y0 *= silu(bflo(zz.x)); y1 *= silu(bfhi(zz.x)); y2 *= silu(bflo(zz.y)); y3 *= silu(bfhi(zz.y));
          acc[0][pt][4 * i4] = y0; acc[0][pt][4 * i4 + 1] = y1; acc[0][pt][4 * i4 + 2] = y2; acc[0][pt][4 * i4 + 3] = y3;
          ss += y0 * y0 + y1 * y1 + y2 * y2 + y3 * y3;
        }
      ss += __shfl_xor(ss, 32);
      float* red = (float*)(lds + 8 * 64 * 136 * 2);
      if (h2 == 0) red[w * 32 + r] = ss;
      __syncthreads();
      float tot = 0.f;
#pragma unroll
      for (int k = 0; k < 8; ++k) tot += red[k * 32 + r];
      const float rn = rsqrtf(tot * (1.f / 512.f) + EPS);
      const float* ng = P.in[16] + l * 512 + hg * 64;
#pragma unroll
      for (int pt = 0; pt < 2; ++pt)
#pragma unroll
        for (int i4 = 0; i4 < 4; ++i4) {
          const int p = 32 * pt + 8 * i4 + 4 * h2;
          const float4 n4 = *(const float4*)(ng + p);
          uint2 o;
          o.x = pk(acc[0][pt][4 * i4] * rn * n4.x, acc[0][pt][4 * i4 + 1] * rn * n4.y);
          o.y = pk(acc[0][pt][4 * i4 + 2] * rn * n4.z, acc[0][pt][4 * i4 + 3] * rn * n4.w);
          *(uint2*)(W.Ycat + Rr * 1024 + hg * 64 + p) = o;
        }
      __syncthreads();
    XCD_END
}

DI void ph5_outproj(KArgP kp, int l, unsigned char* lds) {
  const Params P = load_params(kp); WS W; ws_init(W, P.ws);
  const int tid = fresh_tid();
  const int nb = gridDim.x, bid = blockIdx.x;
  const int upx = (l == 0) ? 72 : 64;
  XCD_LOOP(upx, xcd, idx)
    const int mt = xcd * 9 + (idx >> 3) + (l == 0 ? 0 : 1), nt = idx & 7;
    gemm_tile_to_lds(W.Ycat, W.WoutT + (size_t)l * 1024 * 1024, mt * 256, nt * 128, lds);
    float v[64];
    load_row64(lds, v);
    const size_t R = (size_t)mt * 256 + (tid >> 1);
    float ss = 0.f;
#pragma unroll
    for (int j = 0; j < 64; ++j) ss += v[j] * v[j];
    W.Opart[R * 16 + nt * 2 + (tid & 1)] = ss;
    store64(W.Obuf + R * 1024 + nt * 128 + (tid & 1) * 64, v);
    __syncthreads();
  XCD_END
}

DI void ph6_post(KArgP kp, int l) {
  const Params P = load_params(kp); WS W; ws_init(W, P.ws);
  const int tid = fresh_tid(), lane = tid & 63, w = tid >> 6;
  const int nb = gridDim.x, bid = blockIdx.x;
  (void)lane; (void)w; (void)tid;
    XCD_LOOP(288, xcd, idx)
      const int R = xcd * TT + idx * 8 + w;
      const int b = xcd, t = idx * 8 + w;
      const bool isctx = t < 256;
      if (l == 1 && isctx) continue;
      const float* md = W.mod + ((size_t)l * 9 + (isctx ? 8 : b)) * 3072;
      const float* hsrc = isctx ? (P.in[2] + ((size_t)b * 256 + t) * 1024) : (P.in[0] + ((size_t)b * 2048 + (t - 256)) * 1024);
      u16* hb = (u16*)(P.ws + OFF_HB) + ((size_t)b * 2048 + (t - 256)) * 1024;
      float pss = (lane < 16) ? W.Opart[(size_t)R * 16 + lane] : 0.f;
#pragma unroll
      for (int d = 8; d >= 1; d >>= 1) pss += __shfl_xor(pss, d);
      pss = __shfl(pss, 0);
      const float rn = rsqrtf(pss * (1.f / 1024.f) + EPS);
      const float* gpost = P.in[7] + l * 1024;
      float4 hn[4];
      float ss = 0.f;
#pragma unroll
      for (int i = 0; i < 4; ++i) {
        const int k = i * 256 + lane * 4;
        float4 hv;
        if (l == 0) hv = *(const float4*)(hsrc + k);
        else { const uint2 hu = *(const uint2*)(hb + k); hv = make_float4(bflo(hu.x), bfhi(hu.x), bflo(hu.y), bfhi(hu.y)); }
        const uint2 ov = *(const uint2*)(W.Obuf + (size_t)R * 1024 + k);
        const float4 g4 = *(const float4*)(gpost + k);
        const float4 gt = *(const float4*)(md + 2048 + k);
        hn[i].x = hv.x + gt.x * (bflo(ov.x) * rn * g4.x);
        hn[i].y = hv.y + gt.y * (bfhi(ov.x) * rn * g4.y);
        hn[i].z = hv.z + gt.z * (bflo(ov.y) * rn * g4.z);
        hn[i].w = hv.w + gt.w * (bfhi(ov.y) * rn * g4.w);
        ss += hn[i].x * hn[i].x + hn[i].y * hn[i].y + hn[i].z * hn[i].z + hn[i].w * hn[i].w;
      }
      if (!isctx) {
        if (l == 0) {
#pragma unroll
          for (int i = 0; i < 4; ++i) {
            uint2 o; o.x = pk(hn[i].x, hn[i].y); o.y = pk(hn[i].z, hn[i].w);
            *(uint2*)(hb + i * 256 + lane * 4) = o;
          }
        } else {
          float* dst = P.out + ((size_t)b * 2048 + (t - 256)) * 1024;
#pragma unroll
          for (int i = 0; i < 4; ++i) *(float4*)(dst + i * 256 + lane * 4) = hn[i];
        }
      }
      if (l == 0) {
#pragma unroll
        for (int d = 32; d >= 1; d >>= 1) ss += __shfl_xor(ss, d);
        const float r2 = rsqrtf(ss * (1.f / 1024.f) + EPS);
        const float* md1 = W.mod + ((size_t)9 + (isctx ? 8 : b)) * 3072;
        const float* gp = P.in[6] + 1024;
#pragma unroll
        for (int i = 0; i < 4; ++i) {
          const int k = i * 256 + lane * 4;
          const float4 g4 = *(const float4*)(gp + k);
          const float4 sh = *(const float4*)(md1 + k);
          const float4 sc = *(const float4*)(md1 + 1024 + k);
          uint2 o;
          o.x = pk(hn[i].x * r2 * g4.x * (1.f + sc.x) + sh.x, hn[i].y * r2 * g4.y * (1.f + sc.y) + sh.y);
          o.y = pk(hn[i].z * r2 * g4.z * (1.f + sc.z) + sh.z, hn[i].w * r2 * g4.w * (1.f + sc.w) + sh.w);
          *(uint2*)(W.U + (size_t)R * 1024 + k) = o;
        }
      }
    XCD_END
}


#define XB_TMO      128
#define XB_XCNT(j)  (256  + 64 * (j))
#define XB_XSUB(j)  (1280 + 64 * (j))
#define XB_XGEN(j)  (2304 + 64 * (j))
#define XB_TOP      3328
#define XB_TOPGEN   3392
#define XCD_BAR_WORDS 3456
#define XB_SPIN_CAP (1u << 18)
#define LAS __attribute__((address_space(3)))

__device__ __forceinline__ unsigned xb_ld(unsigned* p)              { return __hip_atomic_load(p, __ATOMIC_RELAXED, __HIP_MEMORY_SCOPE_AGENT); }
__device__ __forceinline__ unsigned xb_add(unsigned* p, unsigned v) { return __hip_atomic_fetch_add(p, v, __ATOMIC_RELAXED, __HIP_MEMORY_SCOPE_AGENT); }
__device__ __forceinline__ unsigned xb_xcc_id() { return (unsigned)__builtin_amdgcn_s_getreg((3 << 11) | 20) & 0xFu; }
#define XB_SPIN(cond, bar) do { unsigned _sp = 0; while (cond) { __builtin_amdgcn_s_sleep(1); \
    if ((++_sp & 255u) == 0u) { if (xb_ld(&(bar)[XB_TMO])) break; if (_sp > XB_SPIN_CAP) { atomicAdd(&(bar)[XB_TMO], 1u); break; } } } } while (0)

struct XcdBarrier {
    unsigned* bar; unsigned x;
    volatile LAS unsigned* st;
};

__device__ __forceinline__ XcdBarrier xcd_barrier_post(unsigned* bar, volatile LAS unsigned* st) {
    XcdBarrier b; b.bar = bar; b.x = xb_xcc_id(); b.st = st;
    if (threadIdx.x == 0) (void)xb_add(&bar[XB_XCNT(b.x)], 1u);
    return b;
}
__device__ __forceinline__ void xcd_barrier_complete(unsigned* bar, unsigned x, unsigned& nloc, unsigned& nx) {
    const unsigned G = gridDim.x * gridDim.y * gridDim.z;
    unsigned sum, cnt, mine, sp = 0u;
    for (;;) {
        sum = 0u; cnt = 0u; mine = 0u;
#pragma unroll
        for (unsigned j = 0; j < 16; ++j) { const unsigned c = xb_ld(&bar[XB_XCNT(j)]); sum += c; cnt += (c > 0u) ? 1u : 0u; mine = (j == x) ? c : mine; }
        if (sum == G) break;
        __builtin_amdgcn_s_sleep(1);
        if ((++sp & 255u) == 0u) { if (xb_ld(&bar[XB_TMO])) break; if (sp > XB_SPIN_CAP) { atomicAdd(&bar[XB_TMO], 1u); break; } }
    }
    nloc = mine > 0u ? mine : 1u; nx = cnt > 0u ? cnt : 1u;
}

__device__ __forceinline__ void xcd_barrier(const XcdBarrier& b) {
    asm volatile("s_waitcnt vmcnt(0)" ::: "memory");
    __syncthreads();
    if (threadIdx.x == 0) {
        unsigned* bar = b.bar;
        __builtin_amdgcn_s_waitcnt(0);
        unsigned nloc = b.st[0], nx = b.st[1];
        if (nloc == 0u) { xcd_barrier_complete(bar, b.x, nloc, nx); b.st[0] = nloc; b.st[1] = nx; }
        const unsigned old = xb_add(&bar[XB_XSUB(b.x)], 1u);
        const unsigned gen = old / nloc;
        if (old + 1u == (gen + 1u) * nloc) {
            __builtin_amdgcn_fence(__ATOMIC_RELEASE, "agent");
            asm volatile("s_waitcnt vmcnt(0)" ::: "memory");
            const unsigned og = xb_add(&bar[XB_TOP], 1u);
            const unsigned tg = og / nx;
            if (og + 1u == (tg + 1u) * nx) xb_add(&bar[XB_TOPGEN], 1u);
            else XB_SPIN(xb_ld(&bar[XB_TOPGEN]) == tg, bar);
            __builtin_amdgcn_fence(__ATOMIC_ACQUIRE, "agent");
            xb_add(&bar[XB_XGEN(b.x)], 1u);
            asm volatile("s_waitcnt vmcnt(0)" ::: "memory");
        } else {
            XB_SPIN(xb_ld(&bar[XB_XGEN(b.x)]) == gen, bar);
            __builtin_amdgcn_fence(__ATOMIC_ACQUIRE, "agent");
            asm volatile("s_waitcnt vmcnt(0)" ::: "memory");
        }
    }
    __syncthreads();
}

DI void grid_barrier(unsigned* bar, unsigned& epoch) {
  asm volatile("s_waitcnt vmcnt(0)" ::: "memory");
  __syncthreads();
  ++epoch;
  if (threadIdx.x == 0) {
    __builtin_amdgcn_fence(__ATOMIC_RELEASE, "agent");
    asm volatile("s_waitcnt vmcnt(0)" ::: "memory");
    const unsigned nb = gridDim.x, bid = blockIdx.x;
    const bool hier = (nb & 7u) == 0u;
    const unsigned ng = hier ? 8u : 1u, per = hier ? (nb >> 3) : nb;
    unsigned* grp = bar + 64 * (1 + (hier ? (bid & 7u) : 0u));
    const unsigned old = __hip_atomic_fetch_add(grp, 1u, __ATOMIC_RELAXED, __HIP_MEMORY_SCOPE_AGENT);
    if (old + 1u == epoch * per) __hip_atomic_fetch_add(bar, 1u, __ATOMIC_RELAXED, __HIP_MEMORY_SCOPE_AGENT);
    const unsigned target = epoch * ng;
    while (__hip_atomic_load(bar, __ATOMIC_RELAXED, __HIP_MEMORY_SCOPE_AGENT) < target) __builtin_amdgcn_s_sleep(1);
    __builtin_amdgcn_fence(__ATOMIC_ACQUIRE, "agent");
    asm volatile("s_waitcnt vmcnt(0)" ::: "memory");
  }
  __syncthreads();
}

__global__ void __launch_bounds__(NT) fwd_mega(Params Parg) {
  extern __shared__ __attribute__((aligned(16))) unsigned char lds[];
  cg::grid_group grid = cg::this_grid();
  KArgP kp = (KArgP)__builtin_amdgcn_kernarg_segment_ptr();
  unsigned* bar = (unsigned*)(Parg.ws + OFF_BAR);
  if (gridDim.x == 0x7fffffffu) grid.sync();
  volatile LAS unsigned* xst = (volatile LAS unsigned*)((LAS unsigned char*)lds + (LDS_BYTES - 64));
  if (threadIdx.x == 0) { xst[0] = 0u; xst[1] = 0u; }
  __syncthreads();
  const XcdBarrier xb = xcd_barrier_post(bar, xst);

  ph0_prologue(kp, lds);
  xcd_barrier(xb);

  ph1_prep(kp, lds);
  xcd_barrier(xb);

  for (int l = 0; l < 2; ++l) {
    ph2_inproj(kp, l, lds);
    xcd_barrier(xb);

    ph3_mix(kp, l, lds);
    xcd_barrier(xb);

    ph4a_states(kp);
    xcd_barrier(xb);

    ph4b_yoff(kp, l, lds);
    xcd_barrier(xb);

    ph5_outproj(kp, l, lds);
    xcd_barrier(xb);

    ph6_post(kp, l);
    if (l == 0) xcd_barrier(xb);
  }
}

extern "C" void kernel_launch(void* const* d_in, const int* in_sizes, int n_in,
                              void* d_out, int out_size, void* d_ws, size_t ws_size,
                              hipStream_t stream) {
  static int grid_blocks = 0;
  if (!grid_blocks) {
    int dev = 0, cus = 0, per_cu = 0;
    (void)hipGetDevice(&dev);
    (void)hipDeviceGetAttribute(&cus, hipDeviceAttributeMultiprocessorCount, dev);
    (void)hipFuncSetAttribute((const void*)fwd_mega, hipFuncAttributeMaxDynamicSharedMemorySize, LDS_BYTES);
    (void)hipOccupancyMaxActiveBlocksPerMultiprocessor(&per_cu, (const void*)fwd_mega, NT, LDS_BYTES);
    if (per_cu < 1) per_cu = 1;
    grid_blocks = cus * per_cu;
    if (ws_size < WS_END) fprintf(stderr, "workspace too small: %zu < %zu\n", ws_size, (size_t)WS_END);
  }
  Params p{};
  for (int i = 0; i < 22; ++i) p.in[i] = (const float*)d_in[i];
  p.out = (float*)d_out;
  p.ws = (unsigned char*)d_ws;
  (void)hipMemsetAsync((unsigned char*)d_ws + OFF_BAR, 0, 16384, stream);
  void* args[] = {&p};
  hipError_t e = hipLaunchCooperativeKernel((const void*)fwd_mega, dim3(grid_blocks), dim3(NT), args, LDS_BYTES, stream);
  if (e != hipSuccess) fprintf(stderr, "cooperative launch failed: %s (grid %d)\n", hipGetErrorString(e), grid_blocks);
}
```

```cpp
#include <hip/hip_runtime.h>
#include <hip/hip_cooperative_groups.h>
#include <cstdio>
namespace cg = cooperative_groups;

#define DI __device__ __forceinline__
#define NT 512
static __device__ __forceinline__ int fresh_tid() { int t = threadIdx.x; asm volatile("" : "+v"(t)); return t; }
typedef unsigned short u16;
typedef __attribute__((ext_vector_type(8))) short bf16x8;
typedef __attribute__((ext_vector_type(4))) short s16x4;
typedef __attribute__((ext_vector_type(16))) float f32x16;
typedef __attribute__((ext_vector_type(4))) float f32x4;
typedef __attribute__((ext_vector_type(2))) __bf16 bf2v;
typedef __attribute__((ext_vector_type(2))) float f2v;
typedef unsigned __attribute__((ext_vector_type(4))) u32x4;

#define MFMA32(a, b, c) __builtin_amdgcn_mfma_f32_32x32x16_bf16((a), (b), (c), 0, 0, 0)
#define MFMA16(a, b, c) __builtin_amdgcn_mfma_f32_16x16x32_bf16((a), (b), (c), 0, 0, 0)

constexpr int LDS_BYTES = 140 * 1024;
constexpr int TT = 2304;
constexpr int RR = 18432;
constexpr int NPAD = 3456;
constexpr float EPS = 1e-6f;
constexpr float LOG2E = 1.4426950408889634f;

constexpr size_t SZ_WIN = (size_t)2 * NPAD * 1024 * 2;
constexpr size_t SZ_WOUT = (size_t)2 * 1024 * 1024 * 2;
constexpr size_t SZ_MOD = (size_t)2 * 9 * 3072 * 4;
constexpr size_t SZ_ROPE = 16384;
constexpr size_t SZ_R1024 = (size_t)RR * 1024 * 2;
constexpr size_t SZ_R512 = (size_t)RR * 512 * 2;
constexpr size_t SZ_R256 = (size_t)RR * 256 * 2;
constexpr size_t OFF_WIN = 0;
constexpr size_t OFF_WOUT = OFF_WIN + SZ_WIN;
constexpr size_t OFF_MOD = OFF_WOUT + SZ_WOUT;
constexpr size_t OFF_ROPE = OFF_MOD + SZ_MOD;
constexpr size_t OFF_U = OFF_ROPE + SZ_ROPE;
constexpr size_t OFF_XBC = OFF_U + SZ_R1024;
constexpr size_t OFF_Z = OFF_XBC + SZ_R1024;
constexpr size_t OFF_DT = OFF_Z + SZ_R512;
constexpr size_t SZ_DT = (size_t)RR * 16 * 4;
constexpr size_t OFF_Q = OFF_DT + SZ_DT;
constexpr size_t SZ_Q = (size_t)8 * 4 * TT * 64 * 2;
constexpr size_t OFF_K = OFF_Q + SZ_Q;
constexpr size_t SZ_K = (size_t)8 * 2 * TT * 64 * 2;
constexpr size_t OFF_VT = OFF_K + SZ_K;
constexpr size_t OFF_DQ = OFF_VT + SZ_K;
constexpr size_t SZ_DQ = (size_t)8 * 8 * TT * 32 * 2;
constexpr size_t OFF_DK = OFF_DQ + SZ_DQ;
constexpr size_t OFF_DVT = OFF_DK + SZ_DQ;
constexpr size_t SZ_DVT = (size_t)8 * 4 * 64 * TT * 2;
constexpr size_t OFF_GG = OFF_DVT + SZ_DVT;
constexpr size_t OFF_DG = OFF_GG + SZ_R256;
constexpr size_t OFF_CC = OFF_DG + SZ_R256;
constexpr size_t OFF_CUMF = OFF_CC + SZ_R256;
constexpr size_t SZ_CUM = (size_t)RR * 8 * 4;
constexpr size_t OFF_CUMB = OFF_CUMF + SZ_CUM;
constexpr size_t OFF_SLOC = OFF_CUMB + SZ_CUM;
constexpr size_t SZ_ST = (size_t)2 * 8 * 18 * 8 * 8192 * 2;
constexpr size_t OFF_OPART = OFF_SLOC + SZ_ST;
constexpr size_t OFF_HB = OFF_OPART + SZ_DT;
constexpr size_t SZ_HB = (size_t)8 * 2048 * 1024 * 2;
constexpr size_t OFF_BAR = OFF_HB + SZ_HB;
constexpr size_t WS_END = OFF_BAR + 16384;
static_assert(SZ_ST <= (OFF_GG - OFF_Q), "Stin must fit in the q/k/v region");
static_assert(WS_END <= (size_t)256 * 1024 * 1024, "workspace");

struct Params {
  const float* in[22];
  float* out;
  unsigned char* ws;
};

struct WS {
  u16 *WinT, *WoutT, *U, *Ycat, *XBC, *Obuf, *Z, *Q, *K, *Vt, *DQ, *DK, *DVt, *GG, *DG, *Cc, *Sloc, *Stin;
  float *mod, *DT, *cumF, *cumB, *Opart;
  float2 *ropeG, *ropeD;
};

DI unsigned pk(float a, float b) { f2v v = {a, b}; return __builtin_bit_cast(unsigned, __builtin_convertvector(v, bf2v)); }
DI u16 f2bf(float a) { return (u16)(pk(a, 0.f) & 0xffffu); }
DI float bf2f(u16 b) { return __uint_as_float(((unsigned)b) << 16); }
DI float bflo(unsigned u) { return __uint_as_float(u << 16); }
DI float bfhi(unsigned u) { return __uint_as_float(u & 0xffff0000u); }
DI float silu(float x) { return x / (1.f + __expf(-x)); }
DI float softplus(float x) { return fmaxf(x, 0.f) + log1pf(__expf(-fabsf(x))); }
DI float fexp2(float x) { return __builtin_amdgcn_exp2f(x); }

DI void store64(u16* dst, const float (&v)[64]) {
#pragma unroll
  for (int i = 0; i < 8; ++i) {
    uint4 u;
    u.x = pk(v[8 * i], v[8 * i + 1]); u.y = pk(v[8 * i + 2], v[8 * i + 3]);
    u.z = pk(v[8 * i + 4], v[8 * i + 5]); u.w = pk(v[8 * i + 6], v[8 * i + 7]);
    ((uint4*)dst)[i] = u;
  }
}

struct GRegs { u32x4 a0, a1, a2, a3, b0, b1; };
DI void g_load(GRegs& R, const u16* ag, const u16* bg, int k0) {
  constexpr size_t K = 1024;
  R.a0 = *(const u32x4*)(ag + k0);
  R.a1 = *(const u32x4*)(ag + 64 * K + k0);
  R.a2 = *(const u32x4*)(ag + 128 * K + k0);
  R.a3 = *(const u32x4*)(ag + 192 * K + k0);
  R.b0 = *(const u32x4*)(bg + k0);
  R.b1 = *(const u32x4*)(bg + 64 * K + k0);
}
DI void g_store(const GRegs& R, u16* as, u16* bs) {
  *(u32x4*)(as) = R.a0;
  *(u32x4*)(as + 64 * 72) = R.a1;
  *(u32x4*)(as + 128 * 72) = R.a2;
  *(u32x4*)(as + 192 * 72) = R.a3;
  *(u32x4*)(bs) = R.b0;
  *(u32x4*)(bs + 64 * 72) = R.b1;
}
DI void g_compute(const u16* as, const u16* bs, f32x16 (&acc)[2][2]) {
#pragma unroll
  for (int ks = 0; ks < 4; ++ks) {
    bf16x8 a0 = *(const bf16x8*)(as + 16 * ks);
    bf16x8 a1 = *(const bf16x8*)(as + 32 * 72 + 16 * ks);
    bf16x8 b0 = *(const bf16x8*)(bs + 16 * ks);
    bf16x8 b1 = *(const bf16x8*)(bs + 32 * 72 + 16 * ks);
    acc[0][0] = MFMA32(a0, b0, acc[0][0]);
    acc[0][1] = MFMA32(a0, b1, acc[0][1]);
    acc[1][0] = MFMA32(a1, b0, acc[1][0]);
    acc[1][1] = MFMA32(a1, b1, acc[1][1]);
  }
}
constexpr int G_LDK = 72;
constexpr int G_CST = 132;
DI void gemm_tile_to_lds(const u16* __restrict__ A, const u16* __restrict__ Bt, int m0, int n0, unsigned char* lds) {
  constexpr int K = 1024;
  u16* As = (u16*)lds;
  u16* Bs = (u16*)(lds + 2 * 256 * G_LDK * 2);
  const int tid = fresh_tid(), lane = tid & 63, w = tid >> 6;
  const int r = lane & 31, h = lane >> 5;
  const int wm = w >> 1, wn = w & 1;
  const int arow = tid >> 3, akc = tid & 7;
  const u16* ag = A + (size_t)(m0 + arow) * K + akc * 8;
  const u16* bg = Bt + (size_t)(n0 + arow) * K + akc * 8;
  f32x16 acc[2][2];
#pragma unroll
  for (int i = 0; i < 2; ++i)
#pragma unroll
    for (int j = 0; j < 2; ++j)
#pragma unroll
      for (int e = 0; e < 16; ++e) acc[i][j][e] = 0.f;
  GRegs R0, R1;
  g_load(R0, ag, bg, 0);
  g_load(R1, ag, bg, 64);
  g_store(R0, As + arow * G_LDK + akc * 8, Bs + arow * G_LDK + akc * 8);
  __syncthreads();
  const u16* as0 = As + (64 * wm + r) * G_LDK + 8 * h;
  const u16* bs0 = Bs + (64 * wn + r) * G_LDK + 8 * h;
  for (int kt2 = 0; kt2 < 16; kt2 += 2) {
    if (kt2 + 2 < 16) g_load(R0, ag, bg, (kt2 + 2) * 64);
    g_compute(as0, bs0, acc);
    g_store(R1, As + 256 * G_LDK + arow * G_LDK + akc * 8, Bs + 128 * G_LDK + arow * G_LDK + akc * 8);
    __syncthreads();
    if (kt2 + 3 < 16) g_load(R1, ag, bg, (kt2 + 3) * 64);
    g_compute(as0 + 256 * G_LDK, bs0 + 128 * G_LDK, acc);
    if (kt2 + 2 < 16) g_store(R0, As + arow * G_LDK + akc * 8, Bs + arow * G_LDK + akc * 8);
    __syncthreads();
  }
  float* Cst = (float*)lds;
#pragma unroll
  for (int i = 0; i < 2; ++i)
#pragma unroll
    for (int j = 0; j < 2; ++j)
#pragma unroll
      for (int e = 0; e < 16; ++e) {
        const int row = 64 * wm + 32 * i + (e & 3) + 8 * (e >> 2) + 4 * h;
        Cst[row * G_CST + 64 * wn + 32 * j + r] = acc[i][j][e];
      }
  __syncthreads();
}

DI void load_row64(const unsigned char* lds, float (&v)[64]) {
  const int tid = fresh_tid();
  const float* src = (const float*)lds + (tid >> 1) * G_CST + (tid & 1) * 64;
#pragma unroll
  for (int i = 0; i < 16; ++i) {
    float4 f = ((const float4*)src)[i];
    v[4 * i] = f.x; v[4 * i + 1] = f.y; v[4 * i + 2] = f.z; v[4 * i + 3] = f.w;
  }
}

DI void store_tile_transposed(const unsigned char* lds, u16* vt, int t0) {
  const int tid = fresh_tid();
  const int col = tid & 127, rg = tid >> 7;
  const float* src = (const float*)lds + (rg * 64) * G_CST + col;
  u16* dst = vt + (size_t)col * TT + t0 + rg * 64;
#pragma unroll
  for (int i = 0; i < 8; ++i) {
    float f[8];
#pragma unroll
    for (int k = 0; k < 8; ++k) f[k] = src[(8 * i + k) * G_CST];
    uint4 u;
    u.x = pk(f[0], f[1]); u.y = pk(f[2], f[3]); u.z = pk(f[4], f[5]); u.w = pk(f[6], f[7]);
    ((uint4*)dst)[i] = u;
  }
}

DI void inproj_epi(const Params& P, const WS& W, int l, int R, int nt, int half, float (&v)[64]) {
  const int b = R / TT;
  const int t = R - b * TT;
  if (nt < 8) {
    store64(W.XBC + (size_t)R * 1024 + nt * 128 + half * 64, v);
  } else if (nt < 12) {
    store64(W.Z + (size_t)R * 512 + (nt - 8) * 128 + half * 64, v);
  } else if (nt < 15) {
    const bool isq = nt < 14;
    const float* g = (isq ? P.in[17] : P.in[18]) + l * 64;
    float ss = 0.f;
#pragma unroll
    for (int j = 0; j < 64; ++j) ss += v[j] * v[j];
    const float rn = rsqrtf(ss * (1.f / 64.f) + EPS);
#pragma unroll
    for (int j = 0; j < 64; ++j) { if ((j & 15) == 0) __builtin_amdgcn_sched_barrier(0); v[j] = v[j] * rn * g[j]; }
    if (t >= 256) {
      const int pos = t - 256, ri = pos >> 6, ci = pos & 63;
#pragma unroll
      for (int i = 0; i < 32; ++i) {
        if ((i & 7) == 0) __builtin_amdgcn_sched_barrier(0);
        const float2 cs = (i < 16) ? W.ropeG[ri * 16 + i] : W.ropeG[ci * 16 + (i - 16)];
        const float x1 = v[i], x2 = v[i + 32];
        v[i] = x1 * cs.x - x2 * cs.y;
        v[i + 32] = x2 * cs.x + x1 * cs.y;
      }
    }
    if (isq) {
      const float sc = 0.125f * LOG2E;
#pragma unroll
      for (int j = 0; j < 64; ++j) v[j] *= sc;
      const int head = (nt - 12) * 2 + half;
      store64(W.Q + ((size_t)(b * 4 + head) * TT + t) * 64, v);
    } else {
      store64(W.K + ((size_t)(b * 2 + half) * TT + t) * 64, v);
    }
  } else if (nt == 15) {
    u16* dst = W.Vt + ((size_t)(b * 2 + half) * 64) * TT + t;
#pragma unroll
    for (int j = 0; j < 64; ++j) { if ((j & 7) == 0) __builtin_amdgcn_sched_barrier(0); dst[(size_t)j * TT] = f2bf(v[j]); }
  } else if (nt < 18) {
#pragma unroll
    for (int j = 0; j < 64; ++j) v[j] = silu(v[j]);
    store64(W.GG + (size_t)R * 256 + (nt - 16) * 128 + half * 64, v);
  } else if (nt < 22) {
    const bool isq = nt < 20;
    const int mbase = (nt - (isq ? 18 : 20)) * 4 + half * 2;
    if (t >= 256) {
      const int pos = t - 256, ri = pos >> 6, ci = pos & 63;
#pragma unroll
      for (int mm = 0; mm < 2; ++mm)
#pragma unroll
        for (int i = 0; i < 16; ++i) {
          if ((i & 7) == 0) __builtin_amdgcn_sched_barrier(0);
          const float2 cs = (i < 8) ? W.ropeD[ri * 8 + i] : W.ropeD[ci * 8 + (i - 8)];
          const float x1 = v[32 * mm + i], x2 = v[32 * mm + i + 16];
          v[32 * mm + i] = x1 * cs.x - x2 * cs.y;
          v[32 * mm + i + 16] = x2 * cs.x + x1 * cs.y;
        }
    }
    if (isq) {
      const float sc = 0.17677669529663687f * LOG2E;
#pragma unroll
      for (int j = 0; j < 64; ++j) v[j] *= sc;
    }
    u16* base = isq ? W.DQ : W.DK;
#pragma unroll
    for (int mm = 0; mm < 2; ++mm) {
      u16* dst = base + ((size_t)(b * 8 + mbase + mm) * TT + t) * 32;
#pragma unroll
      for (int i = 0; i < 4; ++i) {
        uint4 u;
        u.x = pk(v[32 * mm + 8 * i], v[32 * mm + 8 * i + 1]); u.y = pk(v[32 * mm + 8 * i + 2], v[32 * mm + 8 * i + 3]);
        u.z = pk(v[32 * mm + 8 * i + 4], v[32 * mm + 8 * i + 5]); u.w = pk(v[32 * mm + 8 * i + 6], v[32 * mm + 8 * i + 7]);
        ((uint4*)dst)[i] = u;
      }
    }
  } else if (nt < 24) {
    const int head = (nt - 22) * 2 + half;
    u16* dst = W.DVt + ((size_t)(b * 4 + head) * 64) * TT + t;
#pragma unroll
    for (int j = 0; j < 64; ++j) { if ((j & 7) == 0) __builtin_amdgcn_sched_barrier(0); dst[(size_t)j * TT] = f2bf(v[j]); }
  } else if (nt < 26) {
#pragma unroll
    for (int j = 0; j < 64; ++j) v[j] = silu(v[j]);
    store64(W.DG + (size_t)R * 256 + (nt - 24) * 128 + half * 64, v);
  } else if (nt == 26) {
    if (half == 0) {
      const float* bf = P.in[13] + l * 8;
      const float* bb = P.in[14] + l * 8;
#pragma unroll
      for (int j = 0; j < 16; ++j) {
        const float x = v[j] + (j < 8 ? bf[j] : bb[j - 8]);
        W.DT[(size_t)R * 16 + j] = softplus(x);
      }
    }
  }
}

template <int D, bool BOUNDED>
DI void attn_core(const u16* __restrict__ Qh, const u16* __restrict__ Kh, const u16* __restrict__ Vth, int q0, int nkeys,
                  float bound, unsigned char* lds, f32x16 (&O)[2], float& lout) {
  constexpr int KP = D + 8;
  constexpr int KS = D / 16;
  constexpr int VP = 132;
  constexpr int KST = 128 * KP;
  constexpr int VST = 64 * VP;
  u16* Ks = (u16*)lds;
  u16* Vs = (u16*)(lds + 2 * 128 * 72 * 2);
  const int tid = fresh_tid(), lane = tid & 63, w = tid >> 6;
  const int r = lane & 31, h = lane >> 5;
  bf16x8 qf[KS];
  {
    const u16* qp = Qh + (size_t)(q0 + 32 * w + r) * D + 8 * h;
#pragma unroll
    for (int ks = 0; ks < KS; ++ks) qf[ks] = *(const bf16x8*)(qp + 16 * ks);
  }
#pragma unroll
  for (int e = 0; e < 16; ++e) { O[0][e] = 0.f; O[1][e] = 0.f; }
  float m = BOUNDED ? bound : 0.f, lsum = 0.f;
  const int krow = (D == 64) ? (tid >> 3) : (tid >> 2);
  const int kc = (D == 64) ? (tid & 7) : (tid & 3);
  const int vrow = tid >> 3, vc = tid & 7;
  const u16* kg = Kh + (size_t)krow * D + kc * 8;
  const u16* vg = Vth + (size_t)vrow * TT + vc * 8;
  u16* kl = Ks + krow * KP + kc * 8;
  u16* vl = Vs + vrow * VP + vc * 8;
  u32x4 rk0a, rk0b, rv0a, rv0b, rk1a, rk1b, rv1a, rv1b;
  rk0b = (u32x4){0u, 0u, 0u, 0u}; rk1b = rk0b;
#define A_LOAD(KA, KB, VA, VB, T) { KA = *(const u32x4*)(kg + (size_t)(T) * 128 * D); if (D == 64) KB = *(const u32x4*)(kg + (size_t)(T) * 128 * D + 64 * D); \
                                    VA = *(const u32x4*)(vg + (T) * 128); VB = *(const u32x4*)(vg + (T) * 128 + 64); }
#define A_ST8(P, V) { const u32x4 t_ = (V); *(uint2*)(P) = make_uint2(t_.x, t_.y); *(uint2*)((P) + 4) = make_uint2(t_.z, t_.w); }
#define A_STORE(KA, KB, VA, VB, ST) { *(u32x4*)(kl + (ST) * KST) = KA; if (D == 64) *(u32x4*)(kl + (ST) * KST + 64 * KP) = KB; \
                                      A_ST8(vl + (ST) * VST, VA) A_ST8(vl + (ST) * VST + 64, VB) }
  const int nk = nkeys >> 7;
  A_LOAD(rk0a, rk0b, rv0a, rv0b, 0)
  __builtin_amdgcn_s_waitcnt(0x0F70);
  A_STORE(rk0a, rk0b, rv0a, rv0b, 0)
  A_LOAD(rk1a, rk1b, rv1a, rv1b, 1)
  __syncthreads();
  for (int kt2 = 0; kt2 < nk; kt2 += 2) {
#pragma unroll
  for (int ph = 0; ph < 2; ++ph) {
    const int kt = kt2 + ph;
    const int cur = ph;
    {
      const int tx = min(kt + 2, nk - 1);
      if (ph == 0) A_LOAD(rk0a, rk0b, rv0a, rv0b, tx)
      else A_LOAD(rk1a, rk1b, rv1a, rv1b, tx)
    }
    __builtin_amdgcn_sched_barrier(0);
#pragma unroll 1
    for (int sub = 0; sub < 2; ++sub) {
    const u16* ks_ = Ks + cur * KST + (64 * sub + r) * KP + 8 * h;
    bf16x8 kf0[KS], kf1[KS];
#pragma unroll
    for (int ks = 0; ks < KS; ++ks) {
      kf0[ks] = *(const bf16x8*)(ks_ + 16 * ks);
      kf1[ks] = *(const bf16x8*)(ks_ + 32 * KP + 16 * ks);
    }
    const u16* vs_ = Vs + cur * VST + r * VP + 64 * sub + 4 * h;
    bf16x8 vf[8];
#pragma unroll
    for (int s = 0; s < 2; ++s)
#pragma unroll
      for (int dt = 0; dt < 2; ++dt) {
        const u16* vp = vs_ + dt * 32 * VP + 16 * s;
        s16x4 lo = *(const s16x4*)vp;
        s16x4 hi = *(const s16x4*)(vp + 8);
        vf[s * 2 + dt] = __builtin_shufflevector(lo, hi, 0, 1, 2, 3, 4, 5, 6, 7);
      }
    __builtin_amdgcn_sched_barrier(0);
    f32x16 S[2];
    {
      const float nm = -m;
#pragma unroll
      for (int e = 0; e < 16; ++e) { S[0][e] = nm; S[1][e] = nm; }
    }
#pragma unroll
    for (int ks = 0; ks < KS; ++ks) {
      S[0] = MFMA32(kf0[ks], qf[ks], S[0]);
      S[1] = MFMA32(kf1[ks], qf[ks], S[1]);
    }
    __builtin_amdgcn_sched_barrier(0);
#pragma unroll
    for (int s = 0; s < 2; ++s)
#pragma unroll
      for (int dt = 0; dt < 2; ++dt) {
        const u16* vp = vs_ + dt * 32 * VP + 32 + 16 * s;
        s16x4 lo = *(const s16x4*)vp;
        s16x4 hi = *(const s16x4*)(vp + 8);
        vf[(2 + s) * 2 + dt] = __builtin_shufflevector(lo, hi, 0, 1, 2, 3, 4, 5, 6, 7);
      }
    __builtin_amdgcn_sched_barrier(0);
    if (!BOUNDED) {
      float t0 = fmaxf(fmaxf(S[0][0], S[0][1]), S[0][2]);
      float t1 = fmaxf(fmaxf(S[1][0], S[1][1]), S[1][2]);
#pragma unroll
      for (int e = 3; e < 15; e += 2) { t0 = fmaxf(fmaxf(t0, S[0][e]), S[0][e + 1]); t1 = fmaxf(fmaxf(t1, S[1][e]), S[1][e + 1]); }
      float tm = fmaxf(fmaxf(t0, t1), fmaxf(S[0][15], S[1][15]));
      tm = fmaxf(tm, __shfl_xor(tm, 32));
      const bool first = (kt == 0) && (sub == 0);
      if (first || __any(tm > 0.f)) {
        const float adj = first ? tm : fmaxf(tm, 0.f);
        const float alpha = first ? 1.f : fexp2(-adj);
        m += adj;
        lsum *= alpha;
#pragma unroll
        for (int e = 0; e < 16; ++e) { O[0][e] *= alpha; O[1][e] *= alpha; S[0][e] -= adj; S[1][e] -= adj; }
      }
    }
    float rs = 0.f;
#pragma unroll
    for (int e = 0; e < 16; ++e) { S[0][e] = fexp2(S[0][e]); rs += S[0][e]; }
#pragma unroll
    for (int e = 0; e < 16; ++e) { S[1][e] = fexp2(S[1][e]); rs += S[1][e]; }
    lsum += rs;
#pragma unroll
    for (int t2 = 0; t2 < 2; ++t2)
#pragma unroll
      for (int s = 0; s < 2; ++s) {
        uint4 pu;
        pu.x = pk(S[t2][8 * s], S[t2][8 * s + 1]); pu.y = pk(S[t2][8 * s + 2], S[t2][8 * s + 3]);
        pu.z = pk(S[t2][8 * s + 4], S[t2][8 * s + 5]); pu.w = pk(S[t2][8 * s + 6], S[t2][8 * s + 7]);
        const bf16x8 pb = __builtin_bit_cast(bf16x8, pu);
        O[0] = MFMA32(vf[(t2 * 2 + s) * 2 + 0], pb, O[0]);
        O[1] = MFMA32(vf[(t2 * 2 + s) * 2 + 1], pb, O[1]);
      }
    }
    if (kt + 1 < nk) {
      if (ph == 0) A_STORE(rk1a, rk1b, rv1a, rv1b, 1)
      else A_STORE(rk0a, rk0b, rv0a, rv0b, 0)
    }
    __syncthreads();
  }
  }
#undef A_LOAD
#undef A_ST8
#undef A_STORE
  lout = lsum + __shfl_xor(lsum, 32);
}

DI void gqa_unit(const WS& W, const float* qg, const float* kg_, int b, int head, int qb, unsigned char* lds) {
  const int tid = fresh_tid(), lane = tid & 63, w = tid >> 6, r = lane & 31, h = lane >> 5;
  const int q0 = qb * 256;
  const int nkeys = (qb == 0) ? 256 : TT;
  f32x16 O[2];
  float l;
  float bound;
  {
    float gq = fabsf(qg[lane]), gk = fabsf(kg_[lane]);
#pragma unroll
    for (int d = 32; d >= 1; d >>= 1) { gq = fmaxf(gq, __shfl_xor(gq, d)); gk = fmaxf(gk, __shfl_xor(gk, d)); }
    bound = 8.f * LOG2E * gq * gk * 1.02f + 0.25f;
  }
  attn_core<64, true>(W.Q + (size_t)(b * 4 + head) * TT * 64, W.K + (size_t)(b * 2 + (head >> 1)) * TT * 64,
                      W.Vt + (size_t)(b * 2 + (head >> 1)) * 64 * TT, q0, nkeys, bound, lds, O, l);
  const float il = 1.f / l;
  const size_t Rr = (size_t)b * TT + q0 + 32 * w + r;
#pragma unroll
  for (int dt = 0; dt < 2; ++dt)
#pragma unroll
    for (int i4 = 0; i4 < 4; ++i4) {
      const int dv = 32 * dt + 8 * i4 + 4 * h;
      const uint2 g = *(const uint2*)(W.GG + Rr * 256 + head * 64 + dv);
      uint2 o;
      o.x = pk(O[dt][4 * i4] * il * bflo(g.x), O[dt][4 * i4 + 1] * il * bfhi(g.x));
      o.y = pk(O[dt][4 * i4 + 2] * il * bflo(g.y), O[dt][4 * i4 + 3] * il * bfhi(g.y));
      *(uint2*)(W.Ycat + Rr * 1024 + 512 + head * 64 + dv) = o;
    }
}

DI void diff_unit(const Params& P, const WS& W, int l, int b, int hh, int qb, unsigned char* lds) {
  const int tid = fresh_tid(), lane = tid & 63, w = tid >> 6, r = lane & 31, h = lane >> 5;
  const int q0 = qb * 256;
  const int nkeys = (qb == 0) ? 256 : TT;
  const float lam_init = (l == 0) ? 0.2f : 0.35550906759f;
  float lam;
  {
    const float* lp = P.in[19] + l * 128;
    float s1 = (lane < 32) ? lp[lane] * lp[32 + lane] : 0.f;
    float s2 = (lane < 32) ? lp[64 + lane] * lp[96 + lane] : 0.f;
#pragma unroll
    for (int d = 32; d >= 1; d >>= 1) { s1 += __shfl_xor(s1, d); s2 += __shfl_xor(s2, d); }
    lam = __expf(s1) - __expf(s2) + lam_init;
  }
  f32x16 O1[2], O2[2];
  float l1, l2;
  const u16* vt = W.DVt + (size_t)(b * 4 + hh) * 64 * TT;
  attn_core<32, false>(W.DQ + (size_t)(b * 8 + 2 * hh) * TT * 32, W.DK + (size_t)(b * 8 + 2 * hh) * TT * 32, vt, q0, nkeys, 0.f, lds, O1, l1);
  attn_core<32, false>(W.DQ + (size_t)(b * 8 + 2 * hh + 1) * TT * 32, W.DK + (size_t)(b * 8 + 2 * hh + 1) * TT * 32, vt, q0, nkeys, 0.f, lds, O2, l2);
  const float i1 = 1.f / l1, i2 = lam / l2;
  float ss = 0.f;
#pragma unroll
  for (int dt = 0; dt < 2; ++dt)
#pragma unroll
    for (int e = 0; e < 16; ++e) {
      const float o = O1[dt][e] * i1 - O2[dt][e] * i2;
      O1[dt][e] = o;
      ss += o * o;
    }
  ss += __shfl_xor(ss, 32);
  const float rn = rsqrtf(ss * (1.f / 64.f) + EPS) * (1.f - lam_init);
  const float* ng = P.in[20] + l * 64;
  const size_t Rr = (size_t)b * TT + q0 + 32 * w + r;
#pragma unroll
  for (int dt = 0; dt < 2; ++dt)
#pragma unroll
    for (int i4 = 0; i4 < 4; ++i4) {
      const int dv = 32 * dt + 8 * i4 + 4 * h;
      const uint2 g = *(const uint2*)(W.DG + Rr * 256 + hh * 64 + dv);
      const float4 n4 = *(const float4*)(ng + dv);
      uint2 o;
      o.x = pk(O1[dt][4 * i4] * rn * n4.x * bflo(g.x), O1[dt][4 * i4 + 1] * rn * n4.y * bfhi(g.x));
      o.y = pk(O1[dt][4 * i4 + 2] * rn * n4.z * bflo(g.y), O1[dt][4 * i4 + 3] * rn * n4.w * bfhi(g.y));
      *(uint2*)(W.Ycat + Rr * 1024 + 768 + hh * 64 + dv) = o;
    }
}

DI void ssd_xload(uint2 (&raw)[8], const u16* src, int tb, int seg_lo, int seg_hi) {
#pragma unroll
  for (int i = 0; i < 8; ++i) {
    const int t = tb - 2 + i;
    const int tc = min(max(t, seg_lo), seg_hi - 1);
    uint2 v = *(const uint2*)(src + (size_t)tc * 1024);
    if (t < seg_lo || t >= seg_hi) v = make_uint2(0u, 0u);
    raw[i] = v;
  }
}
constexpr int S_LD = 136;
DI void ssd_local_unit(const Params& P, const WS& W, int l, int b, int c, int g, int h_lo, int h_hi, unsigned char* lds) {
  const int tid = fresh_tid(), lane = tid & 63, w = tid >> 6;
  u16* BsT = (u16*)lds;
  u16* Bs = (u16*)(lds + 34816);
  u16* Cs = (u16*)(lds + 69632);
  u16* xT = (u16*)(lds + 34816);
  u16* xsF = (u16*)(lds + 52224);
  u16* xsB = (u16*)(lds + 69632);
  float* cumF = (float*)(lds + 104448);
  float* cumB = cumF + 512;
  float* dtF = cumB + 512;
  float* dtB = dtF + 512;
  const size_t Rc0 = (size_t)b * TT + c * 128;
  const int seg_lo = (c < 2) ? 0 : 256;
  const int seg_hi = (c < 2) ? 256 : TT;
  const float* conv_w = P.in[9] + (size_t)l * 5 * 1024;
  const float* conv_b = P.in[10] + (size_t)l * 1024;
  const int cqB = lane;
  const bool isB = cqB < 32;
  const int ch0 = isB ? 4 * cqB : 4 * (cqB - 32);
  float4 wjB[5];
  float4 biasB;
  uint2 rawB[20];
  {
    const int col = (isB ? 512 : 768) + g * 128 + ch0;
#pragma unroll
    for (int j = 0; j < 5; ++j) wjB[j] = *(const float4*)(conv_w + j * 1024 + col);
    biasB = *(const float4*)(conv_b + col);
    const u16* src = W.XBC + (size_t)b * TT * 1024 + col;
    const int tb = c * 128 + 16 * w;
#pragma unroll
    for (int i = 0; i < 20; ++i) {
      const int t = tb - 2 + i;
      const int tc = min(max(t, seg_lo), seg_hi - 1);
      uint2 v = *(const uint2*)(src + (size_t)tc * 1024);
      if (t < seg_lo || t >= seg_hi) v = make_uint2(0u, 0u);
      rawB[i] = v;
    }
  }
  uint2 xraw[8];
  ssd_xload(xraw, W.XBC + (size_t)b * TT * 1024 + (g * 4 + h_lo) * 64 + 4 * (tid & 15), c * 128 + 4 * (tid >> 4), seg_lo, seg_hi);
  float4 xw[5], xbias;
  {
    const int col = (g * 4 + h_lo) * 64 + 4 * (tid & 15);
#pragma unroll
    for (int j = 0; j < 5; ++j) xw[j] = *(const float4*)(conv_w + j * 1024 + col);
    xbias = *(const float4*)(conv_b + col);
  }
  {
    const int hh = w & 3, dir = w >> 2, hg = g * 4 + hh;
    const float a = -__expf((dir ? P.in[12] : P.in[11])[l * 8 + hg]);
    const float d0 = W.DT[(Rc0 + 2 * lane) * 16 + dir * 8 + hg];
    const float d1 = W.DT[(Rc0 + 2 * lane + 1) * 16 + dir * 8 + hg];
    const float a0 = d0 * a, a1 = d1 * a;
    float v = a0 + a1;
    float c0, c1;
    if (dir == 0) {
#pragma unroll
      for (int d = 1; d < 64; d <<= 1) { const float t = __shfl_up(v, d); if (lane >= d) v += t; }
      c0 = v - a1; c1 = v;
    } else {
#pragma unroll
      for (int d = 1; d < 64; d <<= 1) { const float t = __shfl_down(v, d); if (lane + d < 64) v += t; }
      c0 = v; c1 = v - a0;
    }
    float* lc = cumF + dir * 512 + hh * 128 + 2 * lane;
    lc[0] = c0; lc[1] = c1;
    lc[1024] = d0; lc[1025] = d1;
    float* gc = W.cumF + (size_t)dir * ((size_t)RR * 8) + (Rc0 + 2 * lane) * 8 + hg;
    gc[0] = c0; gc[8] = c1;
  }
  {
    float y[4][16];
#pragma unroll
    for (int s2 = 0; s2 < 16; ++s2) {
      float a0 = biasB.x, a1 = biasB.y, a2 = biasB.z, a3 = biasB.w;
#pragma unroll
      for (int j = 0; j < 5; ++j) {
        const uint2 v = rawB[s2 + j];
        a0 += wjB[j].x * bflo(v.x); a1 += wjB[j].y * bfhi(v.x); a2 += wjB[j].z * bflo(v.y); a3 += wjB[j].w * bfhi(v.y);
      }
      y[0][s2] = silu(a0); y[1][s2] = silu(a1); y[2][s2] = silu(a2); y[3][s2] = silu(a3);
    }
    const int s0 = 16 * w;
    if (isB) {
#pragma unroll
      for (int s2 = 0; s2 < 16; ++s2) {
        uint2 o; o.x = pk(y[0][s2], y[1][s2]); o.y = pk(y[2][s2], y[3][s2]);
        *(uint2*)&Bs[(s0 + s2) * S_LD + ch0] = o;
      }
#pragma unroll
      for (int ch = 0; ch < 4; ++ch) {
        uint4 u0, u1;
        u0.x = pk(y[ch][0], y[ch][1]); u0.y = pk(y[ch][2], y[ch][3]); u0.z = pk(y[ch][4], y[ch][5]); u0.w = pk(y[ch][6], y[ch][7]);
        u1.x = pk(y[ch][8], y[ch][9]); u1.y = pk(y[ch][10], y[ch][11]); u1.z = pk(y[ch][12], y[ch][13]); u1.w = pk(y[ch][14], y[ch][15]);
        *(uint4*)&BsT[(ch0 + ch) * S_LD + s0] = u0;
        *(uint4*)&BsT[(ch0 + ch) * S_LD + s0 + 8] = u1;
      }
    } else {
#pragma unroll
      for (int s2 = 0; s2 < 16; ++s2) {
        uint2 o; o.x = pk(y[0][s2], y[1][s2]); o.y = pk(y[2][s2], y[3][s2]);
        *(uint2*)&Cs[(s0 + s2) * S_LD + ch0] = o;
        *(uint2*)(W.Cc + (Rc0 + s0 + s2) * 256 + g * 128 + ch0) = o;
      }
    }
  }
  __syncthreads();
  const int c16 = lane & 15, q = lane >> 4;
  f32x4 G[8];
#pragma unroll
  for (int st = 0; st < 8; ++st) G[st] = (f32x4){0.f, 0.f, 0.f, 0.f};
#pragma unroll
  for (int ks = 0; ks < 4; ++ks) {
    const bf16x8 bfrag = *(const bf16x8*)&Cs[(16 * w + c16) * S_LD + 32 * ks + 8 * q];
#pragma unroll
    for (int st = 0; st < 8; ++st) {
      const bf16x8 afrag = *(const bf16x8*)&Bs[(16 * st + c16) * S_LD + 32 * ks + 8 * q];
      G[st] = MFMA16(afrag, bfrag, G[st]);
    }
  }
  __syncthreads();
  for (int hh = h_lo; hh < h_hi; ++hh) {
    const int hg = g * 4 + hh;
    {
      const int cq = tid & 15, tg = tid >> 4;
      const int col = hg * 64 + 4 * cq;
      float4 wj[5];
#pragma unroll
      for (int j = 0; j < 5; ++j) wj[j] = xw[j];
      const float4 bias = xbias;
      (void)col;
      const float cF_end = cumF[hh * 128 + 127], cB_end = cumB[hh * 128];
      float y[4][4], ff[4], fb[4];
#pragma unroll
      for (int s2 = 0; s2 < 4; ++s2) {
        float a0 = bias.x, a1 = bias.y, a2 = bias.z, a3 = bias.w;
#pragma unroll
        for (int j = 0; j < 5; ++j) {
          const uint2 v = xraw[s2 + j];
          a0 += wj[j].x * bflo(v.x); a1 += wj[j].y * bfhi(v.x); a2 += wj[j].z * bflo(v.y); a3 += wj[j].w * bfhi(v.y);
        }
        y[0][s2] = silu(a0); y[1][s2] = silu(a1); y[2][s2] = silu(a2); y[3][s2] = silu(a3);
        const int sI = 4 * tg + s2;
        ff[s2] = dtF[hh * 128 + sI] * __expf(cF_end - cumF[hh * 128 + sI]);
        fb[s2] = dtB[hh * 128 + sI] * __expf(cB_end - cumB[hh * 128 + sI]);
      }
#pragma unroll
      for (int ch = 0; ch < 4; ++ch) {
        const int p = 4 * cq + ch;
        uint2 o;
        o.x = pk(y[ch][0], y[ch][1]); o.y = pk(y[ch][2], y[ch][3]);
        *(uint2*)&xT[p * S_LD + 4 * tg] = o;
        o.x = pk(y[ch][0] * ff[0], y[ch][1] * ff[1]); o.y = pk(y[ch][2] * ff[2], y[ch][3] * ff[3]);
        *(uint2*)&xsF[p * S_LD + 4 * tg] = o;
        o.x = pk(y[ch][0] * fb[0], y[ch][1] * fb[1]); o.y = pk(y[ch][2] * fb[2], y[ch][3] * fb[3]);
        *(uint2*)&xsB[p * S_LD + 4 * tg] = o;
      }
      if (hh + 1 < h_hi) {
        ssd_xload(xraw, W.XBC + (size_t)b * TT * 1024 + (hg + 1) * 64 + 4 * cq, c * 128 + 4 * tg, seg_lo, seg_hi);
        const int coln = (hg + 1) * 64 + 4 * cq;
#pragma unroll
        for (int j = 0; j < 5; ++j) xw[j] = *(const float4*)(conv_w + j * 1024 + coln);
        xbias = *(const float4*)(conv_b + coln);
      }
    }
    __syncthreads();
    {
      const int t = 16 * w + c16;
      const float cF_t = cumF[hh * 128 + t], cB_t = cumB[hh * 128 + t];
      const float Dh = P.in[15][l * 8 + hg];
      f32x4 Y[4];
#pragma unroll
      for (int pt = 0; pt < 4; ++pt) Y[pt] = (f32x4){0.f, 0.f, 0.f, 0.f};
#pragma unroll
      for (int m = 0; m < 4; ++m) {
        __builtin_amdgcn_sched_barrier(0);
        float mv[8];
#pragma unroll
        for (int jj = 0; jj < 2; ++jj) {
          const int st = 2 * m + jj;
          const int sb = 16 * st + 4 * q;
          const float4 cf4 = *(const float4*)&cumF[hh * 128 + sb];
          const float4 df4 = *(const float4*)&dtF[hh * 128 + sb];
          const float4 cb4 = *(const float4*)&cumB[hh * 128 + sb];
          const float4 db4 = *(const float4*)&dtB[hh * 128 + sb];
          const float cfv[4] = {cf4.x, cf4.y, cf4.z, cf4.w}, dfv[4] = {df4.x, df4.y, df4.z, df4.w};
          const float cbv[4] = {cb4.x, cb4.y, cb4.z, cb4.w}, dbv[4] = {db4.x, db4.y, db4.z, db4.w};
#pragma unroll
          for (int i = 0; i < 4; ++i) {
            const int s = sb + i;
            const float ef = (s <= t) ? __expf(cF_t - cfv[i]) * dfv[i] : 0.f;
            const float eb = (s >= t) ? __expf(cB_t - cbv[i]) * dbv[i] : 0.f;
            mv[4 * jj + i] = G[st][i] * (ef + eb) + ((s == t) ? Dh : 0.f);
          }
        }
        uint4 mu;
        mu.x = pk(mv[0], mv[1]); mu.y = pk(mv[2], mv[3]); mu.z = pk(mv[4], mv[5]); mu.w = pk(mv[6], mv[7]);
        const bf16x8 Mf = __builtin_bit_cast(bf16x8, mu);
#pragma unroll
        for (int pt = 0; pt < 4; ++pt) {
          const u16* xp = xT + (16 * pt + c16) * S_LD + 32 * m + 4 * q;
          s16x4 lo = *(const s16x4*)xp;
          s16x4 hi = *(const s16x4*)(xp + 16);
          const bf16x8 af = __builtin_shufflevector(lo, hi, 0, 1, 2, 3, 4, 5, 6, 7);
          Y[pt] = MFMA16(af, Mf, Y[pt]);
        }
      }
#pragma unroll
      for (int pt = 0; pt < 4; ++pt) {
        uint2 o;
        o.x = pk(Y[pt][0], Y[pt][1]); o.y = pk(Y[pt][2], Y[pt][3]);
        *(uint2*)(W.Ycat + (Rc0 + t) * 1024 + hg * 64 + 16 * pt + 4 * q) = o;
      }
    }
#pragma unroll
    for (int dir = 0; dir < 2; ++dir) {
      const u16* xs = dir ? xsB : xsF;
      f32x4 acc[4];
#pragma unroll
      for (int pt = 0; pt < 4; ++pt) acc[pt] = (f32x4){0.f, 0.f, 0.f, 0.f};
#pragma unroll
      for (int ks = 0; ks < 4; ++ks) {
        const bf16x8 af = *(const bf16x8*)&BsT[(16 * w + c16) * S_LD + 32 * ks + 8 * q];
#pragma unroll
        for (int pt = 0; pt < 4; ++pt) {
          const bf16x8 bfr = *(const bf16x8*)&xs[(16 * pt + c16) * S_LD + 32 * ks + 8 * q];
          acc[pt] = MFMA16(af, bfr, acc[pt]);
        }
      }
      u16* dst = W.Sloc + ((((size_t)dir * 8 + b) * 18 + c) * 8 + hg) * 8192;
#pragma unroll
      for (int pt = 0; pt < 4; ++pt) {
        uint2 o;
        o.x = pk(acc[pt][0], acc[pt][1]); o.y = pk(acc[pt][2], acc[pt][3]);
        *(uint2*)(dst + (16 * pt + c16) * 128 + 16 * w + 4 * q) = o;
      }
    }
    __syncthreads();
  }
}

DI void ws_init(WS& W, unsigned char* ws) {
        W.WinT = (u16*)(ws + OFF_WIN); W.WoutT = (u16*)(ws + OFF_WOUT); W.mod = (float*)(ws + OFF_MOD);
    W.ropeG = (float2*)(ws + OFF_ROPE); W.ropeD = (float2*)(ws + OFF_ROPE + 8192);
    W.U = (u16*)(ws + OFF_U); W.Ycat = (u16*)(ws + OFF_U); W.XBC = (u16*)(ws + OFF_XBC); W.Obuf = (u16*)(ws + OFF_XBC);
    W.Z = (u16*)(ws + OFF_Z); W.DT = (float*)(ws + OFF_DT);
    W.Q = (u16*)(ws + OFF_Q); W.K = (u16*)(ws + OFF_K); W.Vt = (u16*)(ws + OFF_VT);
    W.DQ = (u16*)(ws + OFF_DQ); W.DK = (u16*)(ws + OFF_DK); W.DVt = (u16*)(ws + OFF_DVT); W.Stin = (u16*)(ws + OFF_Q);
    W.GG = (u16*)(ws + OFF_GG); W.DG = (u16*)(ws + OFF_DG); W.Cc = (u16*)(ws + OFF_CC);
    W.cumF = (float*)(ws + OFF_CUMF); W.cumB = (float*)(ws + OFF_CUMB); W.Sloc = (u16*)(ws + OFF_SLOC);
    W.Opart = (float*)(ws + OFF_OPART);
}

#define XCD_LOOP(UPX, xcd, idx) \
  const bool sw_ = (nb & 7) == 0; \
  for (int t_ = sw_ ? (bid >> 3) : bid; t_ < (sw_ ? (UPX) : 8 * (UPX)); t_ += (sw_ ? (nb >> 3) : nb)) { \
    const int xcd = sw_ ? (bid & 7) : t_ / (UPX); const int idx = sw_ ? t_ : t_ % (UPX);
#define XCD_END }

typedef const Params __attribute__((address_space(4)))* KArgP;
DI Params load_params(KArgP kp) {
  asm volatile("" : "+s"(kp));
  Params P;
#pragma unroll
  for (int i = 0; i < 22; ++i) P.in[i] = kp->in[i];
  P.out = kp->out; P.ws = kp->ws;
  return P;
}

DI void w_transpose_unit(const Params& P, const WS& W, unsigned char* lds, int u) {
  const int tid = fresh_tid();
  constexpr int U_WIN = 2 * 14 * 16;
        const float* src; u16* dst; int ldn, n0, k0, nrows; bool inproj;
        if (u < U_WIN) {
          const int l = u / (14 * 16), rem = u % (14 * 16);
          n0 = (rem >> 4) * 256; k0 = (rem & 15) * 64; ldn = 3344; inproj = true; nrows = NPAD;
          src = P.in[8] + (size_t)l * 1024 * 3344; dst = W.WinT + (size_t)l * NPAD * 1024;
        } else {
          const int v = u - U_WIN; const int l = v >> 6, rem = v & 63;
          n0 = (rem >> 4) * 256; k0 = (rem & 15) * 64; ldn = 1024; inproj = false; nrows = 1024;
          src = P.in[21] + (size_t)l * 1024 * 1024; dst = W.WoutT + (size_t)l * 1024 * 1024;
        }
        float* tile = (float*)lds;
        {
          const int n = tid & 63, kq = tid >> 6;
#pragma unroll
          for (int sub = 0; sub < 4; ++sub) {
            const int nd = n0 + sub * 64 + n;
            int ns = nd;
            if (inproj) { ns = (nd < 1536) ? nd : (nd < 3328 ? nd + 16 : (nd < 3344 ? nd - 3328 + 1536 : -1)); }
#pragma unroll
            for (int i = 0; i < 8; ++i) {
              const int k = kq * 8 + i;
              tile[sub * 4160 + k * 65 + n] = (ns >= 0) ? src[(size_t)(k0 + k) * ldn + ns] : 0.f;
            }
          }
        }
        __syncthreads();
        {
          const int n = tid >> 3, kc = tid & 7;
#pragma unroll
          for (int sub = 0; sub < 4; ++sub) {
            float f[8];
#pragma unroll
            for (int i = 0; i < 8; ++i) f[i] = tile[sub * 4160 + (kc * 8 + i) * 65 + n];
            uint4 o;
            o.x = pk(f[0], f[1]); o.y = pk(f[2], f[3]); o.z = pk(f[4], f[5]); o.w = pk(f[6], f[7]);
            if (n0 + sub * 64 + n < nrows) *(uint4*)(dst + (size_t)(n0 + sub * 64 + n) * 1024 + k0 + kc * 8) = o;
          }
        }
        __syncthreads();
}

DI void ph0_prologue(KArgP kp, unsigned char* lds) {
  const Params P = load_params(kp); WS W; ws_init(W, P.ws);
  const int tid = fresh_tid(), lane = tid & 63, w = tid >> 6;
  const int nb = gridDim.x, bid = blockIdx.x;
  (void)lane; (void)w; (void)tid;
  {
    float* S = (float*)(lds + 69632);
    for (int i = tid; i < 9 * 1024; i += NT) {
      const float x = (i < 8192) ? P.in[1][i] : P.in[3][i - 8192];
      S[i] = silu(x);
    }
    __syncthreads();
    constexpr int U_WIN = 2 * 14 * 16, U_WOUT = 2 * 4 * 16, U_MOD = 384;
    for (int u = U_WIN + U_WOUT + bid; u < U_WIN + U_WOUT + U_MOD + 1; u += nb) {
      if (u < U_WIN + U_WOUT) {
      } else if (u < U_WIN + U_WOUT + U_MOD) {
        const int v = u - U_WIN - U_WOUT;
        const int l = v / 192, n0 = (v % 192) * 16;
        const int c16 = tid & 15, kg = tid >> 4;
        const float* wm = P.in[4] + (size_t)l * 1024 * 3072 + n0 + c16;
        float acc[9];
#pragma unroll
        for (int rr = 0; rr < 9; ++rr) acc[rr] = 0.f;
#pragma unroll 8
        for (int kk = 0; kk < 32; ++kk) {
          const int k = kg * 32 + kk;
          const float wv = wm[(size_t)k * 3072];
#pragma unroll
          for (int rr = 0; rr < 9; ++rr) acc[rr] += S[rr * 1024 + k] * wv;
        }
        float* red = (float*)lds;
#pragma unroll
        for (int rr = 0; rr < 9; ++rr) red[(kg * 16 + c16) * 9 + rr] = acc[rr];
        __syncthreads();
        if (tid < 144) {
          const int cc = tid / 9, rr = tid % 9;
          float s = 0.f;
          for (int k2 = 0; k2 < 32; ++k2) s += red[(k2 * 16 + cc) * 9 + rr];
          W.mod[((size_t)l * 9 + rr) * 3072 + n0 + cc] = s + P.in[5][l * 3072 + n0 + cc];
        }
        __syncthreads();
      } else {
        for (int i = tid; i < 64 * 16; i += NT) {
          const int idx = i >> 4, k = i & 15;
          const float inv = powf(10000.f, -(float)k / 16.f);
          float sn, cs; sincosf((float)idx * inv, &sn, &cs);
          W.ropeG[i] = make_float2(cs, sn);
        }
        for (int i = tid; i < 64 * 8; i += NT) {
          const int idx = i >> 3, k = i & 7;
          const float inv = powf(10000.f, -(float)k / 8.f);
          float sn, cs; sincosf((float)idx * inv, &sn, &cs);
          W.ropeD[i] = make_float2(cs, sn);
        }
      }
    }
  }
}

DI void ph1_prep(KArgP kp, unsigned char* lds) {
  const Params P = load_params(kp); WS W; ws_init(W, P.ws);
  const int tid = fresh_tid(), lane = tid & 63, w = tid >> 6;
  const int nb = gridDim.x, bid = blockIdx.x;
  (void)lane; (void)w; (void)tid;
  XCD_LOOP(288, xcd, idx)
    const int R = xcd * TT + idx * 8 + w;
    const int b = xcd, t = idx * 8 + w;
    const float* src = (t < 256) ? (P.in[2] + ((size_t)b * 256 + t) * 1024) : (P.in[0] + ((size_t)b * 2048 + (t - 256)) * 1024);
    const float* md = W.mod + (size_t)((t < 256) ? 8 : b) * 3072;
    const float* gp = P.in[6];
    float4 x[4];
    float ss = 0.f;
#pragma unroll
    for (int i = 0; i < 4; ++i) {
      x[i] = *(const float4*)(src + i * 256 + lane * 4);
      ss += x[i].x * x[i].x + x[i].y * x[i].y + x[i].z * x[i].z + x[i].w * x[i].w;
    }
#pragma unroll
    for (int d = 32; d >= 1; d >>= 1) ss += __shfl_xor(ss, d);
    const float rn = rsqrtf(ss * (1.f / 1024.f) + EPS);
#pragma unroll
    for (int i = 0; i < 4; ++i) {
      const int k = i * 256 + lane * 4;
      const float4 g4 = *(const float4*)(gp + k);
      const float4 sh = *(const float4*)(md + k);
      const float4 sc = *(const float4*)(md + 1024 + k);
      uint2 o;
      o.x = pk(x[i].x * rn * g4.x * (1.f + sc.x) + sh.x, x[i].y * rn * g4.y * (1.f + sc.y) + sh.y);
      o.y = pk(x[i].z * rn * g4.z * (1.f + sc.z) + sh.z, x[i].w * rn * g4.w * (1.f + sc.w) + sh.w);
      *(uint2*)(W.U + (size_t)R * 1024 + k) = o;
    }
  XCD_END
  for (int u = bid; u < 2 * 14 * 16 + 2 * 4 * 16; u += nb) w_transpose_unit(P, W, lds, u);
}

DI void ph2_inproj(KArgP kp, int l, unsigned char* lds) {
  const Params P = load_params(kp); WS W; ws_init(W, P.ws);
  const int tid = fresh_tid();
  const int nb = gridDim.x, bid = blockIdx.x;
  XCD_LOOP(243, xcd, idx)
    const int nt = idx / 9, mt = xcd * 9 + idx % 9;
    gemm_tile_to_lds(W.U, W.WinT + (size_t)l * NPAD * 1024, mt * 256, nt * 128, lds);
    if (nt == 15 || nt == 22 || nt == 23) {
      const int b = mt / 9, t0 = (mt - b * 9) * 256;
      u16* vt = (nt == 15) ? (W.Vt + (size_t)(b * 2) * 64 * TT) : (W.DVt + (size_t)(b * 4 + (nt - 22) * 2) * 64 * TT);
      store_tile_transposed(lds, vt, t0);
    } else {
      float v[64];
      load_row64(lds, v);
      inproj_epi(P, W, l, mt * 256 + (tid >> 1), nt, tid & 1, v);
    }
    __syncthreads();
  XCD_END
}

DI void ph3_mix(KArgP kp, int l, unsigned char* lds) {
  const Params P = load_params(kp); WS W; ws_init(W, P.ws);
  const int nb = gridDim.x, bid = blockIdx.x;
  const int upx = (l == 0) ? 120 : 112;
  XCD_LOOP(upx, xcd, idx)
    const int b = xcd;
    if (idx < 32) {
      diff_unit(P, W, l, b, idx >> 3, 1 + (idx & 7), lds);
    } else if (idx < 64) {
      gqa_unit(W, P.in[17] + l * 64, P.in[18] + l * 64, b, (idx - 32) >> 3, 1 + (idx & 7), lds);
    } else if (idx < 96) {
      const int v = idx - 64;
      ssd_local_unit(P, W, l, b, v >> 1, v & 1, 0, 4, lds);
    } else if (idx < 112) {
      const int v = idx - 96, u = 32 + (v >> 2), hq = v & 3;
      ssd_local_unit(P, W, l, b, u >> 1, u & 1, hq, hq + 1, lds);
    } else if (idx < 116) {
      diff_unit(P, W, l, b, idx - 112, 0, lds);
    } else {
      gqa_unit(W, P.in[17] + l * 64, P.in[18] + l * 64, b, idx - 116, 0, lds);
    }
    __syncthreads();
  XCD_END
}

DI void ph4a_states(KArgP kp) {
  const Params P = load_params(kp); WS W; ws_init(W, P.ws);
  const int tid = fresh_tid(), lane = tid & 63, w = tid >> 6;
  const int nb = gridDim.x, bid = blockIdx.x;
  (void)lane; (void)w; (void)tid;
    XCD_LOOP(64, xcd, idx)
      const int gid = idx * NT + tid;
      const int e4 = gid & 2047, hg = (gid >> 11) & 7, b = xcd, dir = gid >> 14;
      float s0 = 0.f, s1 = 0.f, s2 = 0.f, s3 = 0.f;
      for (int step = 0; step < 18; ++step) {
        const int c = dir ? (step == 0 ? 1 : (step == 1 ? 0 : 19 - step)) : step;
        const size_t idx = ((((size_t)dir * 8 + b) * 18 + c) * 8 + hg) * 8192 + (size_t)e4 * 4;
        uint2 o;
        o.x = pk(s0, s1); o.y = pk(s2, s3);
        *(uint2*)(W.Stin + idx) = o;
        const float tot = W.cumF[(size_t)dir * ((size_t)RR * 8) + ((size_t)b * TT + c * 128 + (dir ? 0 : 127)) * 8 + hg];
        const float dec = __expf(tot);
        const uint2 sv = *(const uint2*)(W.Sloc + idx);
        s0 = s0 * dec + bflo(sv.x); s1 = s1 * dec + bfhi(sv.x);
        s2 = s2 * dec + bflo(sv.y); s3 = s3 * dec + bfhi(sv.y);
      }
    XCD_END
}

DI void ph4b_yoff(KArgP kp, int l, unsigned char* lds) {
  const Params P = load_params(kp); WS W; ws_init(W, P.ws);
  const int tid = fresh_tid(), lane = tid & 63, w = tid >> 6;
  const int nb = gridDim.x, bid = blockIdx.x;
  (void)lane; (void)w; (void)tid;
    XCD_LOOP((l == 0 ? 72 : 64), xcd, idx)
      const int b = xcd, c = (idx >> 2) + (l == 0 ? 0 : 2), tb = idx & 3;
      const int r = lane & 31, h2 = lane >> 5;
      const int hg = w, g = w >> 2;
      const size_t Rr = (size_t)b * TT + c * 128 + 32 * tb + r;
      f32x16 acc[2][2];
#pragma unroll
      for (int d = 0; d < 2; ++d)
#pragma unroll
        for (int pt = 0; pt < 2; ++pt)
#pragma unroll
          for (int e = 0; e < 16; ++e) acc[d][pt][e] = 0.f;
      const u16* cp = W.Cc + Rr * 256 + g * 128 + 8 * h2;
      bf16x8 bfr[8];
#pragma unroll
      for (int ks = 0; ks < 8; ++ks) bfr[ks] = *(const bf16x8*)(cp + 16 * ks);
      u16* myl = (u16*)lds + w * (64 * 136);
#pragma unroll
      for (int d = 0; d < 2; ++d) {
        const u16* sp = W.Stin + ((((size_t)d * 8 + b) * 18 + c) * 8 + hg) * 8192 + lane * 8;
        u32x4 sv[16];
#pragma unroll
        for (int i = 0; i < 16; ++i) sv[i] = *(const u32x4*)(sp + i * 512);
#pragma unroll
        for (int i = 0; i < 16; ++i) *(u32x4*)(myl + (4 * i + (lane >> 4)) * 136 + (lane & 15) * 8) = sv[i];
        __builtin_amdgcn_wave_barrier();
#pragma unroll
        for (int ks = 0; ks < 8; ++ks) {
          const bf16x8 f0 = *(const bf16x8*)(myl + r * 136 + 16 * ks + 8 * h2);
          const bf16x8 f1 = *(const bf16x8*)(myl + (32 + r) * 136 + 16 * ks + 8 * h2);
          acc[d][0] = MFMA32(f0, bfr[ks], acc[d][0]);
          acc[d][1] = MFMA32(f1, bfr[ks], acc[d][1]);
        }
        __builtin_amdgcn_wave_barrier();
      }
      const float eF = __expf(W.cumF[Rr * 8 + hg]), eB = __expf(W.cumB[Rr * 8 + hg]);
      float ss = 0.f;
#pragma unroll
      for (int pt = 0; pt < 2; ++pt)
#pragma unroll
        for (int i4 = 0; i4 < 4; ++i4) {
          const int p = 32 * pt + 8 * i4 + 4 * h2;
          const uint2 yd = *(const uint2*)(W.Ycat + Rr * 1024 + hg * 64 + p);
          const uint2 zz = *(const uint2*)(W.Z + Rr * 512 + hg * 64 + p);
          float y0 = bflo(yd.x) + eF * acc[0][pt][4 * i4] + eB * acc[1][pt][4 * i4];
          float y1 = bfhi(yd.x) + eF * acc[0][pt][4 * i4 + 1] + eB * acc[1][pt][4 * i4 + 1];
          float y2 = bflo(yd.y) + eF * acc[0][pt][4 * i4 + 2] + eB * acc[1][pt][4 * i4 + 2];
          float y3 = bfhi(yd.y) + eF * acc[0][pt][4 * i4 + 3] + eB * acc[1][pt][4 * i4 + 3];
          y0 *= silu(bflo(zz.x)); y1 *= silu(bfhi(zz.x)); y2 *= silu(bflo(zz.y)); y3 *= silu(bfhi(zz.y));
          acc[0][pt][4 * i4] = y0; acc[0][pt][4 * i4 + 1] = y1; acc[0][pt][4 * i4 + 2] = y2; acc[0][pt][4 * i4 + 3] = y3;
          ss += y0 * y0 + y1 * y1 + y2 * y2 + y3 * y3;
        }
      ss += __shfl_xor(ss, 32);
      float* red = (float*)(lds + 8 * 64 * 136 * 2);
      if (h2 == 0) red[w * 32 + r] = ss;
      __syncthreads();
      float tot = 0.f;
#pragma unroll
      for (int k = 0; k < 8; ++k) tot += red[k * 32 + r];
      const float rn = rsqrtf(tot * (1.f / 512.f) + EPS);
      const float* ng = P.in[16] + l * 512 + hg * 64;
#pragma unroll
      for (int pt = 0; pt < 2; ++pt)
#pragma unroll
        for (int i4 = 0; i4 < 4; ++i4) {
          const int p = 32 * pt + 8 * i4 + 4 * h2;
          const float4 n4 = *(const float4*)(ng + p);
          uint2 o;
          o.x = pk(acc[0][pt][4 * i4] * rn * n4.x, acc[0][pt][4 * i4 + 1] * rn * n4.y);
          o.y = pk(acc[0][pt][4 * i4 + 2] * rn * n4.z, acc[0][pt][4 * i4 + 3] * rn * n4.w);
          *(uint2*)(W.Ycat + Rr * 1024 + hg * 64 + p) = o;
        }
      __syncthreads();
    XCD_END
}

DI void ph5_outproj(KArgP kp, int l, unsigned char* lds) {
  const Params P = load_params(kp); WS W; ws_init(W, P.ws);
  const int tid = fresh_tid();
  const int nb = gridDim.x, bid = blockIdx.x;
  const int upx = (l == 0) ? 72 : 64;
  XCD_LOOP(upx, xcd, idx)
    const int mt = xcd * 9 + (idx >> 3) + (l == 0 ? 0 : 1), nt = idx & 7;
    gemm_tile_to_lds(W.Ycat, W.WoutT + (size_t)l * 1024 * 1024, mt * 256, nt * 128, lds);
    float v[64];
    load_row64(lds, v);
    const size_t R = (size_t)mt * 256 + (tid >> 1);
    float ss = 0.f;
#pragma unroll
    for (int j = 0; j < 64; ++j) ss += v[j] * v[j];
    W.Opart[R * 16 + nt * 2 + (tid & 1)] = ss;
    store64(W.Obuf + R * 1024 + nt * 128 + (tid & 1) * 64, v);
    __syncthreads();
  XCD_END
}

DI void ph6_post(KArgP kp, int l) {
  const Params P = load_params(kp); WS W; ws_init(W, P.ws);
  const int tid = fresh_tid(), lane = tid & 63, w = tid >> 6;
  const int nb = gridDim.x, bid = blockIdx.x;
  (void)lane; (void)w; (void)tid;
    XCD_LOOP(288, xcd, idx)
      const int R = xcd * TT + idx * 8 + w;
      const int b = xcd, t = idx * 8 + w;
      const bool isctx = t < 256;
      if (l == 1 && isctx) continue;
      const float* md = W.mod + ((size_t)l * 9 + (isctx ? 8 : b)) * 3072;
      const float* hsrc = isctx ? (P.in[2] + ((size_t)b * 256 + t) * 1024) : (P.in[0] + ((size_t)b * 2048 + (t - 256)) * 1024);
      u16* hb = (u16*)(P.ws + OFF_HB) + ((size_t)b * 2048 + (t - 256)) * 1024;
      float pss = (lane < 16) ? W.Opart[(size_t)R * 16 + lane] : 0.f;
#pragma unroll
      for (int d = 8; d >= 1; d >>= 1) pss += __shfl_xor(pss, d);
      pss = __shfl(pss, 0);
      const float rn = rsqrtf(pss * (1.f / 1024.f) + EPS);
      const float* gpost = P.in[7] + l * 1024;
      float4 hn[4];
      float ss = 0.f;
#pragma unroll
      for (int i = 0; i < 4; ++i) {
        const int k = i * 256 + lane * 4;
        float4 hv;
        if (l == 0) hv = *(const float4*)(hsrc + k);
        else { const uint2 hu = *(const uint2*)(hb + k); hv = make_float4(bflo(hu.x), bfhi(hu.x), bflo(hu.y), bfhi(hu.y)); }
        const uint2 ov = *(const uint2*)(W.Obuf + (size_t)R * 1024 + k);
        const float4 g4 = *(const float4*)(gpost + k);
        const float4 gt = *(const float4*)(md + 2048 + k);
        hn[i].x = hv.x + gt.x * (bflo(ov.x) * rn * g4.x);
        hn[i].y = hv.y + gt.y * (bfhi(ov.x) * rn * g4.y);
        hn[i].z = hv.z + gt.z * (bflo(ov.y) * rn * g4.z);
        hn[i].w = hv.w + gt.w * (bfhi(ov.y) * rn * g4.w);
        ss += hn[i].x * hn[i].x + hn[i].y * hn[i].y + hn[i].z * hn[i].z + hn[i].w * hn[i].w;
      }
      if (!isctx) {
        if (l == 0) {
#pragma unroll
          for (int i = 0; i < 4; ++i) {
            uint2 o; o.x = pk(hn[i].x, hn[i].y); o.y = pk(hn[i].z, hn[i].w);
            *(uint2*)(hb + i * 256 + lane * 4) = o;
          }
        } else {
          float* dst = P.out + ((size_t)b * 2048 + (t - 256)) * 1024;
#pragma unroll
          for (int i = 0; i < 4; ++i) *(float4*)(dst + i * 256 + lane * 4) = hn[i];
        }
      }
      if (l == 0) {
#pragma unroll
        for (int d = 32; d >= 1; d >>= 1) ss += __shfl_xor(ss, d);
        const float r2 = rsqrtf(ss * (1.f / 1024.f) + EPS);
        const float* md1 = W.mod + ((size_t)9 + (isctx ? 8 : b)) * 3072;
        const float* gp = P.in[6] + 1024;
#pragma unroll
        for (int i = 0; i < 4; ++i) {
          const int k = i * 256 + lane * 4;
          const float4 g4 = *(const float4*)(gp + k);
          const float4 sh = *(const float4*)(md1 + k);
          const float4 sc = *(const float4*)(md1 + 1024 + k);
          uint2 o;
          o.x = pk(hn[i].x * r2 * g4.x * (1.f + sc.x) + sh.x, hn[i].y * r2 * g4.y * (1.f + sc.y) + sh.y);
          o.y = pk(hn[i].z * r2 * g4.z * (1.f + sc.z) + sh.z, hn[i].w * r2 * g4.w * (1.f + sc.w) + sh.w);
          *(uint2*)(W.U + (size_t)R * 1024 + k) = o;
        }
      }
    XCD_END
}


#define XB_TMO      128
#define XB_XCNT(j)  (256  + 64 * (j))
#define XB_XSUB(j)  (1280 + 64 * (j))
#define XB_XGEN(j)  (2304 + 64 * (j))
#define XB_TOP      3328
#define XB_TOPGEN   3392
#define XCD_BAR_WORDS 3456
#define XB_SPIN_CAP (1u << 18)
#define LAS __attribute__((address_space(3)))

__device__ __forceinline__ unsigned xb_ld(unsigned* p)              { return __hip_atomic_load(p, __ATOMIC_RELAXED, __HIP_MEMORY_SCOPE_AGENT); }
__device__ __forceinline__ unsigned xb_add(unsigned* p, unsigned v) { return __hip_atomic_fetch_add(p, v, __ATOMIC_RELAXED, __HIP_MEMORY_SCOPE_AGENT); }
__device__ __forceinline__ unsigned xb_xcc_id() { return (unsigned)__builtin_amdgcn_s_getreg((3 << 11) | 20) & 0xFu; }
#define XB_SPIN(cond, bar) do { unsigned _sp = 0; while (cond) { __builtin_amdgcn_s_sleep(1); \
    if ((++_sp & 255u) == 0u) { if (xb_ld(&(bar)[XB_TMO])) break; if (_sp > XB_SPIN_CAP) { atomicAdd(&(bar)[XB_TMO], 1u); break; } } } } while (0)

struct XcdBarrier {
    unsigned* bar; unsigned x;
    volatile LAS unsigned* st;
};

__device__ __forceinline__ XcdBarrier xcd_barrier_post(unsigned* bar, volatile LAS unsigned* st) {
    XcdBarrier b; b.bar = bar; b.x = xb_xcc_id(); b.st = st;
    if (threadIdx.x == 0) (void)xb_add(&bar[XB_XCNT(b.x)], 1u);
    return b;
}
__device__ __forceinline__ void xcd_barrier_complete(unsigned* bar, unsigned x, unsigned& nloc, unsigned& nx) {
    const unsigned G = gridDim.x * gridDim.y * gridDim.z;
    unsigned sum, cnt, mine, sp = 0u;
    for (;;) {
        sum = 0u; cnt = 0u; mine = 0u;
#pragma unroll
        for (unsigned j = 0; j < 16; ++j) { const unsigned c = xb_ld(&bar[XB_XCNT(j)]); sum += c; cnt += (c > 0u) ? 1u : 0u; mine = (j == x) ? c : mine; }
        if (sum == G) break;
        __builtin_amdgcn_s_sleep(1);
        if ((++sp & 255u) == 0u) { if (xb_ld(&bar[XB_TMO])) break; if (sp > XB_SPIN_CAP) { atomicAdd(&bar[XB_TMO], 1u); break; } }
    }
    nloc = mine > 0u ? mine : 1u; nx = cnt > 0u ? cnt : 1u;
}

__device__ __forceinline__ void xcd_barrier(const XcdBarrier& b) {
    asm volatile("s_waitcnt vmcnt(0)" ::: "memory");
    __syncthreads();
    if (threadIdx.x == 0) {
        unsigned* bar = b.bar;
        __builtin_amdgcn_s_waitcnt(0);
        unsigned nloc = b.st[0], nx = b.st[1];
        if (nloc == 0u) { xcd_barrier_complete(bar, b.x, nloc, nx); b.st[0] = nloc; b.st[1] = nx; }
        const unsigned old = xb_add(&bar[XB_XSUB(b.x)], 1u);
        const unsigned gen = old / nloc;
        if (old + 1u == (gen + 1u) * nloc) {
            __builtin_amdgcn_fence(__ATOMIC_RELEASE, "agent");
            asm volatile("s_waitcnt vmcnt(0)" ::: "memory");
            const unsigned og = xb_add(&bar[XB_TOP], 1u);
            const unsigned tg = og / nx;
            if (og + 1u == (tg + 1u) * nx) xb_add(&bar[XB_TOPGEN], 1u);
            else XB_SPIN(xb_ld(&bar[XB_TOPGEN]) == tg, bar);
            __builtin_amdgcn_fence(__ATOMIC_ACQUIRE, "agent");
            xb_add(&bar[XB_XGEN(b.x)], 1u);
            asm volatile("s_waitcnt vmcnt(0)" ::: "memory");
        } else {
            XB_SPIN(xb_ld(&bar[XB_XGEN(b.x)]) == gen, bar);
            __builtin_amdgcn_fence(__ATOMIC_ACQUIRE, "agent");
            asm volatile("s_waitcnt vmcnt(0)" ::: "memory");
        }
    }
    __syncthreads();
}

DI void grid_barrier(unsigned* bar, unsigned& epoch) {
  asm volatile("s_waitcnt vmcnt(0)" ::: "memory");
  __syncthreads();
  ++epoch;
  if (threadIdx.x == 0) {
    __builtin_amdgcn_fence(__ATOMIC_RELEASE, "agent");
    asm volatile("s_waitcnt vmcnt(0)" ::: "memory");
    const unsigned nb = gridDim.x, bid = blockIdx.x;
    const bool hier = (nb & 7u) == 0u;
    const unsigned ng = hier ? 8u : 1u, per = hier ? (nb >> 3) : nb;
    unsigned* grp = bar + 64 * (1 + (hier ? (bid & 7u) : 0u));
    const unsigned old = __hip_atomic_fetch_add(grp, 1u, __ATOMIC_RELAXED, __HIP_MEMORY_SCOPE_AGENT);
    if (old + 1u == epoch * per) __hip_atomic_fetch_add(bar, 1u, __ATOMIC_RELAXED, __HIP_MEMORY_SCOPE_AGENT);
    const unsigned target = epoch * ng;
    while (__hip_atomic_load(bar, __ATOMIC_RELAXED, __HIP_MEMORY_SCOPE_AGENT) < target) __builtin_amdgcn_s_sleep(1);
    __builtin_amdgcn_fence(__ATOMIC_ACQUIRE, "agent");
    asm volatile("s_waitcnt vmcnt(0)" ::: "memory");
  }
  __syncthreads();
}

__global__ void __launch_bounds__(NT) fwd_mega(Params Parg) {
  extern __shared__ __attribute__((aligned(16))) unsigned char lds[];
  cg::grid_group grid = cg::this_grid();
  KArgP kp = (KArgP)__builtin_amdgcn_kernarg_segment_ptr();
  unsigned* bar = (unsigned*)(Parg.ws + OFF_BAR);
  if (gridDim.x == 0x7fffffffu) grid.sync();
  volatile LAS unsigned* xst = (volatile LAS unsigned*)((LAS unsigned char*)lds + (LDS_BYTES - 64));
  if (threadIdx.x == 0) { xst[0] = 0u; xst[1] = 0u; }
  __syncthreads();
  const XcdBarrier xb = xcd_barrier_post(bar, xst);

  ph0_prologue(kp, lds);
  xcd_barrier(xb);

  ph1_prep(kp, lds);
  xcd_barrier(xb);

  for (int l = 0; l < 2; ++l) {
    ph2_inproj(kp, l, lds);
    xcd_barrier(xb);

    ph3_mix(kp, l, lds);
    xcd_barrier(xb);

    ph4a_states(kp);
    xcd_barrier(xb);

    ph4b_yoff(kp, l, lds);
    xcd_barrier(xb);

    ph5_outproj(kp, l, lds);
    xcd_barrier(xb);

    ph6_post(kp, l);
    if (l == 0) xcd_barrier(xb);
  }
}

extern "C" void kernel_launch(void* const* d_in, const int* in_sizes, int n_in,
                              void* d_out, int out_size, void* d_ws, size_t ws_size,
                              hipStream_t stream) {
  static int grid_blocks = 0;
  if (!grid_blocks) {
    int dev = 0, cus = 0, per_cu = 0;
    (void)hipGetDevice(&dev);
    (void)hipDeviceGetAttribute(&cus, hipDeviceAttributeMultiprocessorCount, dev);
    (void)hipFuncSetAttribute((const void*)fwd_mega, hipFuncAttributeMaxDynamicSharedMemorySize, LDS_BYTES);
    (void)hipOccupancyMaxActiveBlocksPerMultiprocessor(&per_cu, (const void*)fwd_mega, NT, LDS_BYTES);
    if (per_cu < 1) per_cu = 1;
    grid_blocks = cus * per_cu;
    if (ws_size < WS_END) fprintf(stderr, "workspace too small: %zu < %zu\n", ws_size, (size_t)WS_END);
  }
  Params p{};
  for (int i = 0; i < 22; ++i) p.in[i] = (const float*)d_in[i];
  p.out = (float*)d_out;
  p.ws = (unsigned char*)d_ws;
  (void)hipMemsetAsync((unsigned char*)d_ws + OFF_BAR, 0, 16384, stream);
  void* args[] = {&p};
  hipError_t e = hipLaunchCooperativeKernel((const void*)fwd_mega, dim3(grid_blocks), dim3(NT), args, LDS_BYTES, stream);
  if (e != hipSuccess) fprintf(stderr, "cooperative launch failed: %s (grid %d)\n", hipGetErrorString(e), grid_blocks);
}
```

```cpp
#include <hip/hip_runtime.h>
#include <hip/hip_cooperative_groups.h>
#include <cstdio>
namespace cg = cooperative_groups;

#define DI __device__ __forceinline__
#define NT 512
static __device__ __forceinline__ int fresh_tid() { int t = threadIdx.x; asm volatile("" : "+v"(t)); return t; }
typedef unsigned short u16;
typedef __attribute__((ext_vector_type(8))) short bf16x8;
typedef __attribute__((ext_vector_type(4))) short s16x4;
typedef __attribute__((ext_vector_type(16))) float f32x16;
typedef __attribute__((ext_vector_type(4))) float f32x4;
typedef __attribute__((ext_vector_type(2))) __bf16 bf2v;
typedef __attribute__((ext_vector_type(2))) float f2v;
typedef unsigned __attribute__((ext_vector_type(4))) u32x4;

#define MFMA32(a, b, c) __builtin_amdgcn_mfma_f32_32x32x16_bf16((a), (b), (c), 0, 0, 0)
#define MFMA16(a, b, c) __builtin_amdgcn_mfma_f32_16x16x32_bf16((a), (b), (c), 0, 0, 0)

constexpr int LDS_BYTES = 140 * 1024;
constexpr int TT = 2304;
constexpr int RR = 18432;
constexpr int NPAD = 3456;
constexpr float EPS = 1e-6f;
constexpr float LOG2E = 1.4426950408889634f;

constexpr size_t SZ_WIN = (size_t)2 * NPAD * 1024 * 2;
constexpr size_t SZ_WOUT = (size_t)2 * 1024 * 1024 * 2;
constexpr size_t SZ_MOD = (size_t)2 * 9 * 3072 * 4;
constexpr size_t SZ_ROPE = 16384;
constexpr size_t SZ_R1024 = (size_t)RR * 1024 * 2;
constexpr size_t SZ_R512 = (size_t)RR * 512 * 2;
constexpr size_t SZ_R256 = (size_t)RR * 256 * 2;
constexpr size_t OFF_WIN = 0;
constexpr size_t OFF_WOUT = OFF_WIN + SZ_WIN;
constexpr size_t OFF_MOD = OFF_WOUT + SZ_WOUT;
constexpr size_t OFF_ROPE = OFF_MOD + SZ_MOD;
constexpr size_t OFF_U = OFF_ROPE + SZ_ROPE;
constexpr size_t OFF_XBC = OFF_U + SZ_R1024;
constexpr size_t OFF_Z = OFF_XBC + SZ_R1024;
constexpr size_t OFF_DT = OFF_Z + SZ_R512;
constexpr size_t SZ_DT = (size_t)RR * 16 * 4;
constexpr size_t OFF_Q = OFF_DT + SZ_DT;
constexpr size_t SZ_Q = (size_t)8 * 4 * TT * 64 * 2;
constexpr size_t OFF_K = OFF_Q + SZ_Q;
constexpr size_t SZ_K = (size_t)8 * 2 * TT * 64 * 2;
constexpr size_t OFF_VT = OFF_K + SZ_K;
constexpr size_t OFF_DQ = OFF_VT + SZ_K;
constexpr size_t SZ_DQ = (size_t)8 * 8 * TT * 32 * 2;
constexpr size_t OFF_DK = OFF_DQ + SZ_DQ;
constexpr size_t OFF_DVT = OFF_DK + SZ_DQ;
constexpr size_t SZ_DVT = (size_t)8 * 4 * 64 * TT * 2;
constexpr size_t OFF_GG = OFF_DVT + SZ_DVT;
constexpr size_t OFF_DG = OFF_GG + SZ_R256;
constexpr size_t OFF_CC = OFF_DG + SZ_R256;
constexpr size_t OFF_CUMF = OFF_CC + SZ_R256;
constexpr size_t SZ_CUM = (size_t)RR * 8 * 4;
constexpr size_t OFF_CUMB = OFF_CUMF + SZ_CUM;
constexpr size_t OFF_SLOC = OFF_CUMB + SZ_CUM;
constexpr size_t SZ_ST = (size_t)2 * 8 * 18 * 8 * 8192 * 2;
constexpr size_t OFF_OPART = OFF_SLOC + SZ_ST;
constexpr size_t OFF_HB = OFF_OPART + SZ_DT;
constexpr size_t SZ_HB = (size_t)8 * 2048 * 1024 * 2;
constexpr size_t OFF_BAR = OFF_HB + SZ_HB;
constexpr size_t WS_END = OFF_BAR + 16384;
static_assert(SZ_ST <= (OFF_GG - OFF_Q), "Stin must fit in the q/k/v region");
static_assert(WS_END <= (size_t)256 * 1024 * 1024, "workspace");

struct Params {
  const float* in[22];
  float* out;
  unsigned char* ws;
};

struct WS {
  u16 *WinT, *WoutT, *U, *Ycat, *XBC, *Obuf, *Z, *Q, *K, *Vt, *DQ, *DK, *DVt, *GG, *DG, *Cc, *Sloc, *Stin;
  float *mod, *DT, *cumF, *cumB, *Opart;
  float2 *ropeG, *ropeD;
};

DI unsigned pk(float a, float b) { f2v v = {a, b}; return __builtin_bit_cast(unsigned, __builtin_convertvector(v, bf2v)); }
DI u16 f2bf(float a) { return (u16)(pk(a, 0.f) & 0xffffu); }
DI float bf2f(u16 b) { return __uint_as_float(((unsigned)b) << 16); }
DI float bflo(unsigned u) { return __uint_as_float(u << 16); }
DI float bfhi(unsigned u) { return __uint_as_float(u & 0xffff0000u); }
DI float silu(float x) { return x / (1.f + __expf(-x)); }
DI float softplus(float x) { return fmaxf(x, 0.f) + log1pf(__expf(-fabsf(x))); }
DI float fexp2(float x) { return __builtin_amdgcn_exp2f(x); }

DI void store64(u16* dst, const float (&v)[64]) {
#pragma unroll
  for (int i = 0; i < 8; ++i) {
    uint4 u;
    u.x = pk(v[8 * i], v[8 * i + 1]); u.y = pk(v[8 * i + 2], v[8 * i + 3]);
    u.z = pk(v[8 * i + 4], v[8 * i + 5]); u.w = pk(v[8 * i + 6], v[8 * i + 7]);
    ((uint4*)dst)[i] = u;
  }
}

struct GRegs { u32x4 a0, a1, a2, a3, b0, b1; };
DI void g_load(GRegs& R, const u16* ag, const u16* bg, int k0) {
  constexpr size_t K = 1024;
  R.a0 = *(const u32x4*)(ag + k0);
  R.a1 = *(const u32x4*)(ag + 64 * K + k0);
  R.a2 = *(const u32x4*)(ag + 128 * K + k0);
  R.a3 = *(const u32x4*)(ag + 192 * K + k0);
  R.b0 = *(const u32x4*)(bg + k0);
  R.b1 = *(const u32x4*)(bg + 64 * K + k0);
}
DI void g_store(const GRegs& R, u16* as, u16* bs) {
  *(u32x4*)(as) = R.a0;
  *(u32x4*)(as + 64 * 72) = R.a1;
  *(u32x4*)(as + 128 * 72) = R.a2;
  *(u32x4*)(as + 192 * 72) = R.a3;
  *(u32x4*)(bs) = R.b0;
  *(u32x4*)(bs + 64 * 72) = R.b1;
}
DI void g_compute(const u16* as, const u16* bs, f32x16 (&acc)[2][2]) {
  __builtin_amdgcn_iglp_opt(0);
#pragma unroll
  for (int ks = 0; ks < 4; ++ks) {
    bf16x8 a0 = *(const bf16x8*)(as + 16 * ks);
    bf16x8 a1 = *(const bf16x8*)(as + 32 * 72 + 16 * ks);
    bf16x8 b0 = *(const bf16x8*)(bs + 16 * ks);
    bf16x8 b1 = *(const bf16x8*)(bs + 32 * 72 + 16 * ks);
    acc[0][0] = MFMA32(a0, b0, acc[0][0]);
    acc[0][1] = MFMA32(a0, b1, acc[0][1]);
    acc[1][0] = MFMA32(a1, b0, acc[1][0]);
    acc[1][1] = MFMA32(a1, b1, acc[1][1]);
  }
}
constexpr int G_LDK = 72;
constexpr int G_CST = 132;
DI void gemm_tile_to_lds(const u16* __restrict__ A, const u16* __restrict__ Bt, int m0, int n0, unsigned char* lds) {
  constexpr int K = 1024;
  u16* As = (u16*)lds;
  u16* Bs = (u16*)(lds + 2 * 256 * G_LDK * 2);
  const int tid = fresh_tid(), lane = tid & 63, w = tid >> 6;
  const int r = lane & 31, h = lane >> 5;
  const int wm = w >> 1, wn = w & 1;
  const int arow = tid >> 3, akc = tid & 7;
  const u16* ag = A + (size_t)(m0 + arow) * K + akc * 8;
  const u16* bg = Bt + (size_t)(n0 + arow) * K + akc * 8;
  f32x16 acc[2][2];
#pragma unroll
  for (int i = 0; i < 2; ++i)
#pragma unroll
    for (int j = 0; j < 2; ++j)
#pragma unroll
      for (int e = 0; e < 16; ++e) acc[i][j][e] = 0.f;
  GRegs R0, R1;
  g_load(R0, ag, bg, 0);
  g_load(R1, ag, bg, 64);
  g_store(R0, As + arow * G_LDK + akc * 8, Bs + arow * G_LDK + akc * 8);
  __syncthreads();
  const u16* as0 = As + (64 * wm + r) * G_LDK + 8 * h;
  const u16* bs0 = Bs + (64 * wn + r) * G_LDK + 8 * h;
  for (int kt2 = 0; kt2 < 16; kt2 += 2) {
    if (kt2 + 2 < 16) g_load(R0, ag, bg, (kt2 + 2) * 64);
    g_compute(as0, bs0, acc);
    g_store(R1, As + 256 * G_LDK + arow * G_LDK + akc * 8, Bs + 128 * G_LDK + arow * G_LDK + akc * 8);
    __syncthreads();
    if (kt2 + 3 < 16) g_load(R1, ag, bg, (kt2 + 3) * 64);
    g_compute(as0 + 256 * G_LDK, bs0 + 128 * G_LDK, acc);
    if (kt2 + 2 < 16) g_store(R0, As + arow * G_LDK + akc * 8, Bs + arow * G_LDK + akc * 8);
    __syncthreads();
  }
  float* Cst = (float*)lds;
#pragma unroll
  for (int i = 0; i < 2; ++i)
#pragma unroll
    for (int j = 0; j < 2; ++j)
#pragma unroll
      for (int e = 0; e < 16; ++e) {
        const int row = 64 * wm + 32 * i + (e & 3) + 8 * (e >> 2) + 4 * h;
        Cst[row * G_CST + 64 * wn + 32 * j + r] = acc[i][j][e];
      }
  __syncthreads();
}

DI void load_row64(const unsigned char* lds, float (&v)[64]) {
  const int tid = fresh_tid();
  const float* src = (const float*)lds + (tid >> 1) * G_CST + (tid & 1) * 64;
#pragma unroll
  for (int i = 0; i < 16; ++i) {
    float4 f = ((const float4*)src)[i];
    v[4 * i] = f.x; v[4 * i + 1] = f.y; v[4 * i + 2] = f.z; v[4 * i + 3] = f.w;
  }
}

DI void store_tile_transposed(const unsigned char* lds, u16* vt, int t0) {
  const int tid = fresh_tid();
  const int col = tid & 127, rg = tid >> 7;
  const float* src = (const float*)lds + (rg * 64) * G_CST + col;
  u16* dst = vt + (size_t)col * TT + t0 + rg * 64;
#pragma unroll
  for (int i = 0; i < 8; ++i) {
    float f[8];
#pragma unroll
    for (int k = 0; k < 8; ++k) f[k] = src[(8 * i + k) * G_CST];
    uint4 u;
    u.x = pk(f[0], f[1]); u.y = pk(f[2], f[3]); u.z = pk(f[4], f[5]); u.w = pk(f[6], f[7]);
    ((uint4*)dst)[i] = u;
  }
}

DI void inproj_epi(const Params& P, const WS& W, int l, int R, int nt, int half, float (&v)[64]) {
  const int b = R / TT;
  const int t = R - b * TT;
  if (nt < 8) {
    store64(W.XBC + (size_t)R * 1024 + nt * 128 + half * 64, v);
  } else if (nt < 12) {
    store64(W.Z + (size_t)R * 512 + (nt - 8) * 128 + half * 64, v);
  } else if (nt < 15) {
    const bool isq = nt < 14;
    const float* g = (isq ? P.in[17] : P.in[18]) + l * 64;
    float ss = 0.f;
#pragma unroll
    for (int j = 0; j < 64; ++j) ss += v[j] * v[j];
    const float rn = rsqrtf(ss * (1.f / 64.f) + EPS);
#pragma unroll
    for (int j = 0; j < 64; ++j) { if ((j & 15) == 0) __builtin_amdgcn_sched_barrier(0); v[j] = v[j] * rn * g[j]; }
    if (t >= 256) {
      const int pos = t - 256, ri = pos >> 6, ci = pos & 63;
#pragma unroll
      for (int i = 0; i < 32; ++i) {
        if ((i & 7) == 0) __builtin_amdgcn_sched_barrier(0);
        const float2 cs = (i < 16) ? W.ropeG[ri * 16 + i] : W.ropeG[ci * 16 + (i - 16)];
        const float x1 = v[i], x2 = v[i + 32];
        v[i] = x1 * cs.x - x2 * cs.y;
        v[i + 32] = x2 * cs.x + x1 * cs.y;
      }
    }
    if (isq) {
      const float sc = 0.125f * LOG2E;
#pragma unroll
      for (int j = 0; j < 64; ++j) v[j] *= sc;
      const int head = (nt - 12) * 2 + half;
      store64(W.Q + ((size_t)(b * 4 + head) * TT + t) * 64, v);
    } else {
      store64(W.K + ((size_t)(b * 2 + half) * TT + t) * 64, v);
    }
  } else if (nt == 15) {
    u16* dst = W.Vt + ((size_t)(b * 2 + half) * 64) * TT + t;
#pragma unroll
    for (int j = 0; j < 64; ++j) { if ((j & 7) == 0) __builtin_amdgcn_sched_barrier(0); dst[(size_t)j * TT] = f2bf(v[j]); }
  } else if (nt < 18) {
#pragma unroll
    for (int j = 0; j < 64; ++j) v[j] = silu(v[j]);
    store64(W.GG + (size_t)R * 256 + (nt - 16) * 128 + half * 64, v);
  } else if (nt < 22) {
    const bool isq = nt < 20;
    const int mbase = (nt - (isq ? 18 : 20)) * 4 + half * 2;
    if (t >= 256) {
      const int pos = t - 256, ri = pos >> 6, ci = pos & 63;
#pragma unroll
      for (int mm = 0; mm < 2; ++mm)
#pragma unroll
        for (int i = 0; i < 16; ++i) {
          if ((i & 7) == 0) __builtin_amdgcn_sched_barrier(0);
          const float2 cs = (i < 8) ? W.ropeD[ri * 8 + i] : W.ropeD[ci * 8 + (i - 8)];
          const float x1 = v[32 * mm + i], x2 = v[32 * mm + i + 16];
          v[32 * mm + i] = x1 * cs.x - x2 * cs.y;
          v[32 * mm + i + 16] = x2 * cs.x + x1 * cs.y;
        }
    }
    if (isq) {
      const float sc = 0.17677669529663687f * LOG2E;
#pragma unroll
      for (int j = 0; j < 64; ++j) v[j] *= sc;
    }
    u16* base = isq ? W.DQ : W.DK;
#pragma unroll
    for (int mm = 0; mm < 2; ++mm) {
      u16* dst = base + ((size_t)(b * 8 + mbase + mm) * TT + t) * 32;
#pragma unroll
      for (int i = 0; i < 4; ++i) {
        uint4 u;
        u.x = pk(v[32 * mm + 8 * i], v[32 * mm + 8 * i + 1]); u.y = pk(v[32 * mm + 8 * i + 2], v[32 * mm + 8 * i + 3]);
        u.z = pk(v[32 * mm + 8 * i + 4], v[32 * mm + 8 * i + 5]); u.w = pk(v[32 * mm + 8 * i + 6], v[32 * mm + 8 * i + 7]);
        ((uint4*)dst)[i] = u;
      }
    }
  } else if (nt < 24) {
    const int head = (nt - 22) * 2 + half;
    u16* dst = W.DVt + ((size_t)(b * 4 + head) * 64) * TT + t;
#pragma unroll
    for (int j = 0; j < 64; ++j) { if ((j & 7) == 0) __builtin_amdgcn_sched_barrier(0); dst[(size_t)j * TT] = f2bf(v[j]); }
  } else if (nt < 26) {
#pragma unroll
    for (int j = 0; j < 64; ++j) v[j] = silu(v[j]);
    store64(W.DG + (size_t)R * 256 + (nt - 24) * 128 + half * 64, v);
  } else if (nt == 26) {
    if (half == 0) {
      const float* bf = P.in[13] + l * 8;
      const float* bb = P.in[14] + l * 8;
#pragma unroll
      for (int j = 0; j < 16; ++j) {
        const float x = v[j] + (j < 8 ? bf[j] : bb[j - 8]);
        W.DT[(size_t)R * 16 + j] = softplus(x);
      }
    }
  }
}

template <int D, bool BOUNDED>
DI void attn_core(const u16* __restrict__ Qh, const u16* __restrict__ Kh, const u16* __restrict__ Vth, int q0, int nkeys,
                  float bound, unsigned char* lds, f32x16 (&O)[2], float& lout) {
  constexpr int KP = D + 8;
  constexpr int KS = D / 16;
  constexpr int VP = 132;
  constexpr int KST = 128 * KP;
  constexpr int VST = 64 * VP;
  u16* Ks = (u16*)lds;
  u16* Vs = (u16*)(lds + 2 * 128 * 72 * 2);
  const int tid = fresh_tid(), lane = tid & 63, w = tid >> 6;
  const int r = lane & 31, h = lane >> 5;
  bf16x8 qf[KS];
  {
    const u16* qp = Qh + (size_t)(q0 + 32 * w + r) * D + 8 * h;
#pragma unroll
    for (int ks = 0; ks < KS; ++ks) qf[ks] = *(const bf16x8*)(qp + 16 * ks);
  }
#pragma unroll
  for (int e = 0; e < 16; ++e) { O[0][e] = 0.f; O[1][e] = 0.f; }
  float m = BOUNDED ? bound : 0.f, lsum = 0.f;
  const int krow = (D == 64) ? (tid >> 3) : (tid >> 2);
  const int kc = (D == 64) ? (tid & 7) : (tid & 3);
  const int vrow = tid >> 3, vc = tid & 7;
  const u16* kg = Kh + (size_t)krow * D + kc * 8;
  const u16* vg = Vth + (size_t)vrow * TT + vc * 8;
  u16* kl = Ks + krow * KP + kc * 8;
  u16* vl = Vs + vrow * VP + vc * 8;
  u32x4 rk0a, rk0b, rv0a, rv0b, rk1a, rk1b, rv1a, rv1b;
  rk0b = (u32x4){0u, 0u, 0u, 0u}; rk1b = rk0b;
#define A_LOAD(KA, KB, VA, VB, T) { KA = *(const u32x4*)(kg + (size_t)(T) * 128 * D); if (D == 64) KB = *(const u32x4*)(kg + (size_t)(T) * 128 * D + 64 * D); \
                                    VA = *(const u32x4*)(vg + (T) * 128); VB = *(const u32x4*)(vg + (T) * 128 + 64); }
#define A_ST8(P, V) { const u32x4 t_ = (V); *(uint2*)(P) = make_uint2(t_.x, t_.y); *(uint2*)((P) + 4) = make_uint2(t_.z, t_.w); }
#define A_STORE(KA, KB, VA, VB, ST) { *(u32x4*)(kl + (ST) * KST) = KA; if (D == 64) *(u32x4*)(kl + (ST) * KST + 64 * KP) = KB; \
                                      A_ST8(vl + (ST) * VST, VA) A_ST8(vl + (ST) * VST + 64, VB) }
  const int nk = nkeys >> 7;
  A_LOAD(rk0a, rk0b, rv0a, rv0b, 0)
  __builtin_amdgcn_s_waitcnt(0x0F70);
  A_STORE(rk0a, rk0b, rv0a, rv0b, 0)
  A_LOAD(rk1a, rk1b, rv1a, rv1b, 1)
  __syncthreads();
  for (int kt2 = 0; kt2 < nk; kt2 += 2) {
#pragma unroll
  for (int ph = 0; ph < 2; ++ph) {
    const int kt = kt2 + ph;
    const int cur = ph;
    {
      const int tx = min(kt + 2, nk - 1);
      if (ph == 0) A_LOAD(rk0a, rk0b, rv0a, rv0b, tx)
      else A_LOAD(rk1a, rk1b, rv1a, rv1b, tx)
    }
    __builtin_amdgcn_sched_barrier(0);
#pragma unroll 1
    for (int sub = 0; sub < 2; ++sub) {
    const u16* ks_ = Ks + cur * KST + (64 * sub + r) * KP + 8 * h;
    bf16x8 kf0[KS], kf1[KS];
#pragma unroll
    for (int ks = 0; ks < KS; ++ks) {
      kf0[ks] = *(const bf16x8*)(ks_ + 16 * ks);
      kf1[ks] = *(const bf16x8*)(ks_ + 32 * KP + 16 * ks);
    }
    const u16* vs_ = Vs + cur * VST + r * VP + 64 * sub + 4 * h;
    bf16x8 vf[8];
#pragma unroll
    for (int s = 0; s < 2; ++s)
#pragma unroll
      for (int dt = 0; dt < 2; ++dt) {
        const u16* vp = vs_ + dt * 32 * VP + 16 * s;
        s16x4 lo = *(const s16x4*)vp;
        s16x4 hi = *(const s16x4*)(vp + 8);
        vf[s * 2 + dt] = __builtin_shufflevector(lo, hi, 0, 1, 2, 3, 4, 5, 6, 7);
      }
    __builtin_amdgcn_sched_barrier(0);
    f32x16 S[2];
    {
      const float nm = -m;
#pragma unroll
      for (int e = 0; e < 16; ++e) { S[0][e] = nm; S[1][e] = nm; }
    }
#pragma unroll
    for (int ks = 0; ks < KS; ++ks) {
      S[0] = MFMA32(kf0[ks], qf[ks], S[0]);
      S[1] = MFMA32(kf1[ks], qf[ks], S[1]);
    }
    __builtin_amdgcn_sched_barrier(0);
#pragma unroll
    for (int s = 0; s < 2; ++s)
#pragma unroll
      for (int dt = 0; dt < 2; ++dt) {
        const u16* vp = vs_ + dt * 32 * VP + 32 + 16 * s;
        s16x4 lo = *(const s16x4*)vp;
        s16x4 hi = *(const s16x4*)(vp + 8);
        vf[(2 + s) * 2 + dt] = __builtin_shufflevector(lo, hi, 0, 1, 2, 3, 4, 5, 6, 7);
      }
    __builtin_amdgcn_sched_barrier(0);
    if (!BOUNDED) {
      float t0 = fmaxf(fmaxf(S[0][0], S[0][1]), S[0][2]);
      float t1 = fmaxf(fmaxf(S[1][0], S[1][1]), S[1][2]);
#pragma unroll
      for (int e = 3; e < 15; e += 2) { t0 = fmaxf(fmaxf(t0, S[0][e]), S[0][e + 1]); t1 = fmaxf(fmaxf(t1, S[1][e]), S[1][e + 1]); }
      float tm = fmaxf(fmaxf(t0, t1), fmaxf(S[0][15], S[1][15]));
      tm = fmaxf(tm, __shfl_xor(tm, 32));
      const bool first = (kt == 0) && (sub == 0);
      if (first || __any(tm > 0.f)) {
        const float adj = first ? tm : fmaxf(tm, 0.f);
        const float alpha = first ? 1.f : fexp2(-adj);
        m += adj;
        lsum *= alpha;
#pragma unroll
        for (int e = 0; e < 16; ++e) { O[0][e] *= alpha; O[1][e] *= alpha; S[0][e] -= adj; S[1][e] -= adj; }
      }
    }
    float rs = 0.f;
#pragma unroll
    for (int e = 0; e < 16; ++e) { S[0][e] = fexp2(S[0][e]); rs += S[0][e]; }
#pragma unroll
    for (int e = 0; e < 16; ++e) { S[1][e] = fexp2(S[1][e]); rs += S[1][e]; }
    lsum += rs;
#pragma unroll
    for (int t2 = 0; t2 < 2; ++t2)
#pragma unroll
      for (int s = 0; s < 2; ++s) {
        uint4 pu;
        pu.x = pk(S[t2][8 * s], S[t2][8 * s + 1]); pu.y = pk(S[t2][8 * s + 2], S[t2][8 * s + 3]);
        pu.z = pk(S[t2][8 * s + 4], S[t2][8 * s + 5]); pu.w = pk(S[t2][8 * s + 6], S[t2][8 * s + 7]);
        const bf16x8 pb = __builtin_bit_cast(bf16x8, pu);
        O[0] = MFMA32(vf[(t2 * 2 + s) * 2 + 0], pb, O[0]);
        O[1] = MFMA32(vf[(t2 * 2 + s) * 2 + 1], pb, O[1]);
      }
    }
    if (kt + 1 < nk) {
      if (ph == 0) A_STORE(rk1a, rk1b, rv1a, rv1b, 1)
      else A_STORE(rk0a, rk0b, rv0a, rv0b, 0)
    }
    __syncthreads();
  }
  }
#undef A_LOAD
#undef A_ST8
#undef A_STORE
  lout = lsum + __shfl_xor(lsum, 32);
}

DI void gqa_unit(const WS& W, const float* qg, const float* kg_, int b, int head, int qb, unsigned char* lds) {
  const int tid = fresh_tid(), lane = tid & 63, w = tid >> 6, r = lane & 31, h = lane >> 5;
  const int q0 = qb * 256;
  const int nkeys = (qb == 0) ? 256 : TT;
  f32x16 O[2];
  float l;
  float bound;
  {
    float gq = fabsf(qg[lane]), gk = fabsf(kg_[lane]);
#pragma unroll
    for (int d = 32; d >= 1; d >>= 1) { gq = fmaxf(gq, __shfl_xor(gq, d)); gk = fmaxf(gk, __shfl_xor(gk, d)); }
    bound = 8.f * LOG2E * gq * gk * 1.02f + 0.25f;
  }
  attn_core<64, true>(W.Q + (size_t)(b * 4 + head) * TT * 64, W.K + (size_t)(b * 2 + (head >> 1)) * TT * 64,
                      W.Vt + (size_t)(b * 2 + (head >> 1)) * 64 * TT, q0, nkeys, bound, lds, O, l);
  const float il = 1.f / l;
  const size_t Rr = (size_t)b * TT + q0 + 32 * w + r;
#pragma unroll
  for (int dt = 0; dt < 2; ++dt)
#pragma unroll
    for (int i4 = 0; i4 < 4; ++i4) {
      const int dv = 32 * dt + 8 * i4 + 4 * h;
      const uint2 g = *(const uint2*)(W.GG + Rr * 256 + head * 64 + dv);
      uint2 o;
      o.x = pk(O[dt][4 * i4] * il * bflo(g.x), O[dt][4 * i4 + 1] * il * bfhi(g.x));
      o.y = pk(O[dt][4 * i4 + 2] * il * bflo(g.y), O[dt][4 * i4 + 3] * il * bfhi(g.y));
      *(uint2*)(W.Ycat + Rr * 1024 + 512 + head * 64 + dv) = o;
    }
}

DI void diff_unit(const Params& P, const WS& W, int l, int b, int hh, int qb, unsigned char* lds) {
  const int tid = fresh_tid(), lane = tid & 63, w = tid >> 6, r = lane & 31, h = lane >> 5;
  const int q0 = qb * 256;
  const int nkeys = (qb == 0) ? 256 : TT;
  const float lam_init = (l == 0) ? 0.2f : 0.35550906759f;
  float lam;
  {
    const float* lp = P.in[19] + l * 128;
    float s1 = (lane < 32) ? lp[lane] * lp[32 + lane] : 0.f;
    float s2 = (lane < 32) ? lp[64 + lane] * lp[96 + lane] : 0.f;
#pragma unroll
    for (int d = 32; d >= 1; d >>= 1) { s1 += __shfl_xor(s1, d); s2 += __shfl_xor(s2, d); }
    lam = __expf(s1) - __expf(s2) + lam_init;
  }
  f32x16 O1[2], O2[2];
  float l1, l2;
  const u16* vt = W.DVt + (size_t)(b * 4 + hh) * 64 * TT;
  attn_core<32, false>(W.DQ + (size_t)(b * 8 + 2 * hh) * TT * 32, W.DK + (size_t)(b * 8 + 2 * hh) * TT * 32, vt, q0, nkeys, 0.f, lds, O1, l1);
  attn_core<32, false>(W.DQ + (size_t)(b * 8 + 2 * hh + 1) * TT * 32, W.DK + (size_t)(b * 8 + 2 * hh + 1) * TT * 32, vt, q0, nkeys, 0.f, lds, O2, l2);
  const float i1 = 1.f / l1, i2 = lam / l2;
  float ss = 0.f;
#pragma unroll
  for (int dt = 0; dt < 2; ++dt)
#pragma unroll
    for (int e = 0; e < 16; ++e) {
      const float o = O1[dt][e] * i1 - O2[dt][e] * i2;
      O1[dt][e] = o;
      ss += o * o;
    }
  ss += __shfl_xor(ss, 32);
  const float rn = rsqrtf(ss * (1.f / 64.f) + EPS) * (1.f - lam_init);
  const float* ng = P.in[20] + l * 64;
  const size_t Rr = (size_t)b * TT + q0 + 32 * w + r;
#pragma unroll
  for (int dt = 0; dt < 2; ++dt)
#pragma unroll
    for (int i4 = 0; i4 < 4; ++i4) {
      const int dv = 32 * dt + 8 * i4 + 4 * h;
      const uint2 g = *(const uint2*)(W.DG + Rr * 256 + hh * 64 + dv);
      const float4 n4 = *(const float4*)(ng + dv);
      uint2 o;
      o.x = pk(O1[dt][4 * i4] * rn * n4.x * bflo(g.x), O1[dt][4 * i4 + 1] * rn * n4.y * bfhi(g.x));
      o.y = pk(O1[dt][4 * i4 + 2] * rn * n4.z * bflo(g.y), O1[dt][4 * i4 + 3] * rn * n4.w * bfhi(g.y));
      *(uint2*)(W.Ycat + Rr * 1024 + 768 + hh * 64 + dv) = o;
    }
}

DI void ssd_xload(uint2 (&raw)[8], const u16* src, int tb, int seg_lo, int seg_hi) {
#pragma unroll
  for (int i = 0; i < 8; ++i) {
    const int t = tb - 2 + i;
    const int tc = min(max(t, seg_lo), seg_hi - 1);
    uint2 v = *(const uint2*)(src + (size_t)tc * 1024);
    if (t < seg_lo || t >= seg_hi) v = make_uint2(0u, 0u);
    raw[i] = v;
  }
}
constexpr int S_LD = 136;
DI void ssd_local_unit(const Params& P, const WS& W, int l, int b, int c, int g, int h_lo, int h_hi, unsigned char* lds) {
  const int tid = fresh_tid(), lane = tid & 63, w = tid >> 6;
  u16* BsT = (u16*)lds;
  u16* Bs = (u16*)(lds + 34816);
  u16* Cs = (u16*)(lds + 69632);
  u16* xT = (u16*)(lds + 34816);
  u16* xsF = (u16*)(lds + 52224);
  u16* xsB = (u16*)(lds + 69632);
  float* cumF = (float*)(lds + 104448);
  float* cumB = cumF + 512;
  float* dtF = cumB + 512;
  float* dtB = dtF + 512;
  const size_t Rc0 = (size_t)b * TT + c * 128;
  const int seg_lo = (c < 2) ? 0 : 256;
  const int seg_hi = (c < 2) ? 256 : TT;
  const float* conv_w = P.in[9] + (size_t)l * 5 * 1024;
  const float* conv_b = P.in[10] + (size_t)l * 1024;
  const int cqB = lane;
  const bool isB = cqB < 32;
  const int ch0 = isB ? 4 * cqB : 4 * (cqB - 32);
  float4 wjB[5];
  float4 biasB;
  uint2 rawB[20];
  {
    const int col = (isB ? 512 : 768) + g * 128 + ch0;
#pragma unroll
    for (int j = 0; j < 5; ++j) wjB[j] = *(const float4*)(conv_w + j * 1024 + col);
    biasB = *(const float4*)(conv_b + col);
    const u16* src = W.XBC + (size_t)b * TT * 1024 + col;
    const int tb = c * 128 + 16 * w;
#pragma unroll
    for (int i = 0; i < 20; ++i) {
      const int t = tb - 2 + i;
      const int tc = min(max(t, seg_lo), seg_hi - 1);
      uint2 v = *(const uint2*)(src + (size_t)tc * 1024);
      if (t < seg_lo || t >= seg_hi) v = make_uint2(0u, 0u);
      rawB[i] = v;
    }
  }
  uint2 xraw[8];
  ssd_xload(xraw, W.XBC + (size_t)b * TT * 1024 + (g * 4 + h_lo) * 64 + 4 * (tid & 15), c * 128 + 4 * (tid >> 4), seg_lo, seg_hi);
  float4 xw[5], xbias;
  {
    const int col = (g * 4 + h_lo) * 64 + 4 * (tid & 15);
#pragma unroll
    for (int j = 0; j < 5; ++j) xw[j] = *(const float4*)(conv_w + j * 1024 + col);
    xbias = *(const float4*)(conv_b + col);
  }
  {
    const int hh = w & 3, dir = w >> 2, hg = g * 4 + hh;
    const float a = -__expf((dir ? P.in[12] : P.in[11])[l * 8 + hg]);
    const float d0 = W.DT[(Rc0 + 2 * lane) * 16 + dir * 8 + hg];
    const float d1 = W.DT[(Rc0 + 2 * lane + 1) * 16 + dir * 8 + hg];
    const float a0 = d0 * a, a1 = d1 * a;
    float v = a0 + a1;
    float c0, c1;
    if (dir == 0) {
#pragma unroll
      for (int d = 1; d < 64; d <<= 1) { const float t = __shfl_up(v, d); if (lane >= d) v += t; }
      c0 = v - a1; c1 = v;
    } else {
#pragma unroll
      for (int d = 1; d < 64; d <<= 1) { const float t = __shfl_down(v, d); if (lane + d < 64) v += t; }
      c0 = v; c1 = v - a0;
    }
    float* lc = cumF + dir * 512 + hh * 128 + 2 * lane;
    lc[0] = c0; lc[1] = c1;
    lc[1024] = d0; lc[1025] = d1;
    float* gc = W.cumF + (size_t)dir * ((size_t)RR * 8) + (Rc0 + 2 * lane) * 8 + hg;
    gc[0] = c0; gc[8] = c1;
  }
  {
    float y[4][16];
#pragma unroll
    for (int s2 = 0; s2 < 16; ++s2) {
      float a0 = biasB.x, a1 = biasB.y, a2 = biasB.z, a3 = biasB.w;
#pragma unroll
      for (int j = 0; j < 5; ++j) {
        const uint2 v = rawB[s2 + j];
        a0 += wjB[j].x * bflo(v.x); a1 += wjB[j].y * bfhi(v.x); a2 += wjB[j].z * bflo(v.y); a3 += wjB[j].w * bfhi(v.y);
      }
      y[0][s2] = silu(a0); y[1][s2] = silu(a1); y[2][s2] = silu(a2); y[3][s2] = silu(a3);
    }
    const int s0 = 16 * w;
    if (isB) {
#pragma unroll
      for (int s2 = 0; s2 < 16; ++s2) {
        uint2 o; o.x = pk(y[0][s2], y[1][s2]); o.y = pk(y[2][s2], y[3][s2]);
        *(uint2*)&Bs[(s0 + s2) * S_LD + ch0] = o;
      }
#pragma unroll
      for (int ch = 0; ch < 4; ++ch) {
        uint4 u0, u1;
        u0.x = pk(y[ch][0], y[ch][1]); u0.y = pk(y[ch][2], y[ch][3]); u0.z = pk(y[ch][4], y[ch][5]); u0.w = pk(y[ch][6], y[ch][7]);
        u1.x = pk(y[ch][8], y[ch][9]); u1.y = pk(y[ch][10], y[ch][11]); u1.z = pk(y[ch][12], y[ch][13]); u1.w = pk(y[ch][14], y[ch][15]);
        *(uint4*)&BsT[(ch0 + ch) * S_LD + s0] = u0;
        *(uint4*)&BsT[(ch0 + ch) * S_LD + s0 + 8] = u1;
      }
    } else {
#pragma unroll
      for (int s2 = 0; s2 < 16; ++s2) {
        uint2 o; o.x = pk(y[0][s2], y[1][s2]); o.y = pk(y[2][s2], y[3][s2]);
        *(uint2*)&Cs[(s0 + s2) * S_LD + ch0] = o;
        *(uint2*)(W.Cc + (Rc0 + s0 + s2) * 256 + g * 128 + ch0) = o;
      }
    }
  }
  __syncthreads();
  const int c16 = lane & 15, q = lane >> 4;
  f32x4 G[8];
#pragma unroll
  for (int st = 0; st < 8; ++st) G[st] = (f32x4){0.f, 0.f, 0.f, 0.f};
#pragma unroll
  for (int ks = 0; ks < 4; ++ks) {
    const bf16x8 bfrag = *(const bf16x8*)&Cs[(16 * w + c16) * S_LD + 32 * ks + 8 * q];
#pragma unroll
    for (int st = 0; st < 8; ++st) {
      const bf16x8 afrag = *(const bf16x8*)&Bs[(16 * st + c16) * S_LD + 32 * ks + 8 * q];
      G[st] = MFMA16(afrag, bfrag, G[st]);
    }
  }
  __syncthreads();
  for (int hh = h_lo; hh < h_hi; ++hh) {
    const int hg = g * 4 + hh;
    {
      const int cq = tid & 15, tg = tid >> 4;
      const int col = hg * 64 + 4 * cq;
      float4 wj[5];
#pragma unroll
      for (int j = 0; j < 5; ++j) wj[j] = xw[j];
      const float4 bias = xbias;
      (void)col;
      const float cF_end = cumF[hh * 128 + 127], cB_end = cumB[hh * 128];
      float y[4][4], ff[4], fb[4];
#pragma unroll
      for (int s2 = 0; s2 < 4; ++s2) {
        float a0 = bias.x, a1 = bias.y, a2 = bias.z, a3 = bias.w;
#pragma unroll
        for (int j = 0; j < 5; ++j) {
          const uint2 v = xraw[s2 + j];
          a0 += wj[j].x * bflo(v.x); a1 += wj[j].y * bfhi(v.x); a2 += wj[j].z * bflo(v.y); a3 += wj[j].w * bfhi(v.y);
        }
        y[0][s2] = silu(a0); y[1][s2] = silu(a1); y[2][s2] = silu(a2); y[3][s2] = silu(a3);
        const int sI = 4 * tg + s2;
        ff[s2] = dtF[hh * 128 + sI] * __expf(cF_end - cumF[hh * 128 + sI]);
        fb[s2] = dtB[hh * 128 + sI] * __expf(cB_end - cumB[hh * 128 + sI]);
      }
#pragma unroll
      for (int ch = 0; ch < 4; ++ch) {
        const int p = 4 * cq + ch;
        uint2 o;
        o.x = pk(y[ch][0], y[ch][1]); o.y = pk(y[ch][2], y[ch][3]);
        *(uint2*)&xT[p * S_LD + 4 * tg] = o;
        o.x = pk(y[ch][0] * ff[0], y[ch][1] * ff[1]); o.y = pk(y[ch][2] * ff[2], y[ch][3] * ff[3]);
        *(uint2*)&xsF[p * S_LD + 4 * tg] = o;
        o.x = pk(y[ch][0] * fb[0], y[ch][1] * fb[1]); o.y = pk(y[ch][2] * fb[2], y[ch][3] * fb[3]);
        *(uint2*)&xsB[p * S_LD + 4 * tg] = o;
      }
      if (hh + 1 < h_hi) {
        ssd_xload(xraw, W.XBC + (size_t)b * TT * 1024 + (hg + 1) * 64 + 4 * cq, c * 128 + 4 * tg, seg_lo, seg_hi);
        const int coln = (hg + 1) * 64 + 4 * cq;
#pragma unroll
        for (int j = 0; j < 5; ++j) xw[j] = *(const float4*)(conv_w + j * 1024 + coln);
        xbias = *(const float4*)(conv_b + coln);
      }
    }
    __syncthreads();
    {
      const int t = 16 * w + c16;
      const float cF_t = cumF[hh * 128 + t], cB_t = cumB[hh * 128 + t];
      const float Dh = P.in[15][l * 8 + hg];
      f32x4 Y[4];
#pragma unroll
      for (int pt = 0; pt < 4; ++pt) Y[pt] = (f32x4){0.f, 0.f, 0.f, 0.f};
#pragma unroll
      for (int m = 0; m < 4; ++m) {
        __builtin_amdgcn_sched_barrier(0);
        float mv[8];
#pragma unroll
        for (int jj = 0; jj < 2; ++jj) {
          const int st = 2 * m + jj;
          const int sb = 16 * st + 4 * q;
          const float4 cf4 = *(const float4*)&cumF[hh * 128 + sb];
          const float4 df4 = *(const float4*)&dtF[hh * 128 + sb];
          const float4 cb4 = *(const float4*)&cumB[hh * 128 + sb];
          const float4 db4 = *(const float4*)&dtB[hh * 128 + sb];
          const float cfv[4] = {cf4.x, cf4.y, cf4.z, cf4.w}, dfv[4] = {df4.x, df4.y, df4.z, df4.w};
          const float cbv[4] = {cb4.x, cb4.y, cb4.z, cb4.w}, dbv[4] = {db4.x, db4.y, db4.z, db4.w};
#pragma unroll
          for (int i = 0; i < 4; ++i) {
            const int s = sb + i;
            const float ef = (s <= t) ? __expf(cF_t - cfv[i]) * dfv[i] : 0.f;
            const float eb = (s >= t) ? __expf(cB_t - cbv[i]) * dbv[i] : 0.f;
            mv[4 * jj + i] = G[st][i] * (ef + eb) + ((s == t) ? Dh : 0.f);
          }
        }
        uint4 mu;
        mu.x = pk(mv[0], mv[1]); mu.y = pk(mv[2], mv[3]); mu.z = pk(mv[4], mv[5]); mu.w = pk(mv[6], mv[7]);
        const bf16x8 Mf = __builtin_bit_cast(bf16x8, mu);
#pragma unroll
        for (int pt = 0; pt < 4; ++pt) {
          const u16* xp = xT + (16 * pt + c16) * S_LD + 32 * m + 4 * q;
          s16x4 lo = *(const s16x4*)xp;
          s16x4 hi = *(const s16x4*)(xp + 16);
          const bf16x8 af = __builtin_shufflevector(lo, hi, 0, 1, 2, 3, 4, 5, 6, 7);
          Y[pt] = MFMA16(af, Mf, Y[pt]);
        }
      }
#pragma unroll
      for (int pt = 0; pt < 4; ++pt) {
        uint2 o;
        o.x = pk(Y[pt][0], Y[pt][1]); o.y = pk(Y[pt][2], Y[pt][3]);
        *(uint2*)(W.Ycat + (Rc0 + t) * 1024 + hg * 64 + 16 * pt + 4 * q) = o;
      }
    }
#pragma unroll
    for (int dir = 0; dir < 2; ++dir) {
      const u16* xs = dir ? xsB : xsF;
      f32x4 acc[4];
#pragma unroll
      for (int pt = 0; pt < 4; ++pt) acc[pt] = (f32x4){0.f, 0.f, 0.f, 0.f};
#pragma unroll
      for (int ks = 0; ks < 4; ++ks) {
        const bf16x8 af = *(const bf16x8*)&BsT[(16 * w + c16) * S_LD + 32 * ks + 8 * q];
#pragma unroll
        for (int pt = 0; pt < 4; ++pt) {
          const bf16x8 bfr = *(const bf16x8*)&xs[(16 * pt + c16) * S_LD + 32 * ks + 8 * q];
          acc[pt] = MFMA16(af, bfr, acc[pt]);
        }
      }
      u16* dst = W.Sloc + ((((size_t)dir * 8 + b) * 18 + c) * 8 + hg) * 8192;
#pragma unroll
      for (int pt = 0; pt < 4; ++pt) {
        uint2 o;
        o.x = pk(acc[pt][0], acc[pt][1]); o.y = pk(acc[pt][2], acc[pt][3]);
        *(uint2*)(dst + (16 * pt + c16) * 128 + 16 * w + 4 * q) = o;
      }
    }
    __syncthreads();
  }
}

DI void ws_init(WS& W, unsigned char* ws) {
        W.WinT = (u16*)(ws + OFF_WIN); W.WoutT = (u16*)(ws + OFF_WOUT); W.mod = (float*)(ws + OFF_MOD);
    W.ropeG = (float2*)(ws + OFF_ROPE); W.ropeD = (float2*)(ws + OFF_ROPE + 8192);
    W.U = (u16*)(ws + OFF_U); W.Ycat = (u16*)(ws + OFF_U); W.XBC = (u16*)(ws + OFF_XBC); W.Obuf = (u16*)(ws + OFF_XBC);
    W.Z = (u16*)(ws + OFF_Z); W.DT = (float*)(ws + OFF_DT);
    W.Q = (u16*)(ws + OFF_Q); W.K = (u16*)(ws + OFF_K); W.Vt = (u16*)(ws + OFF_VT);
    W.DQ = (u16*)(ws + OFF_DQ); W.DK = (u16*)(ws + OFF_DK); W.DVt = (u16*)(ws + OFF_DVT); W.Stin = (u16*)(ws + OFF_Q);
    W.GG = (u16*)(ws + OFF_GG); W.DG = (u16*)(ws + OFF_DG); W.Cc = (u16*)(ws + OFF_CC);
    W.cumF = (float*)(ws + OFF_CUMF); W.cumB = (float*)(ws + OFF_CUMB); W.Sloc = (u16*)(ws + OFF_SLOC);
    W.Opart = (float*)(ws + OFF_OPART);
}

#define XCD_LOOP(UPX, xcd, idx) \
  const bool sw_ = (nb & 7) == 0; \
  for (int t_ = sw_ ? (bid >> 3) : bid; t_ < (sw_ ? (UPX) : 8 * (UPX)); t_ += (sw_ ? (nb >> 3) : nb)) { \
    const int xcd = sw_ ? (bid & 7) : t_ / (UPX); const int idx = sw_ ? t_ : t_ % (UPX);
#define XCD_END }

typedef const Params __attribute__((address_space(4)))* KArgP;
DI Params load_params(KArgP kp) {
  asm volatile("" : "+s"(kp));
  Params P;
#pragma unroll
  for (int i = 0; i < 22; ++i) P.in[i] = kp->in[i];
  P.out = kp->out; P.ws = kp->ws;
  return P;
}

DI void w_transpose_unit(const Params& P, const WS& W, unsigned char* lds, int u) {
  const int tid = fresh_tid();
  constexpr int U_WIN = 2 * 14 * 16;
        const float* src; u16* dst; int ldn, n0, k0, nrows; bool inproj;
        if (u < U_WIN) {
          const int l = u / (14 * 16), rem = u % (14 * 16);
          n0 = (rem >> 4) * 256; k0 = (rem & 15) * 64; ldn = 3344; inproj = true; nrows = NPAD;
          src = P.in[8] + (size_t)l * 1024 * 3344; dst = W.WinT + (size_t)l * NPAD * 1024;
        } else {
          const int v = u - U_WIN; const int l = v >> 6, rem = v & 63;
          n0 = (rem >> 4) * 256; k0 = (rem & 15) * 64; ldn = 1024; inproj = false; nrows = 1024;
          src = P.in[21] + (size_t)l * 1024 * 1024; dst = W.WoutT + (size_t)l * 1024 * 1024;
        }
        float* tile = (float*)lds;
        {
          const int n = tid & 63, kq = tid >> 6;
#pragma unroll
          for (int sub = 0; sub < 4; ++sub) {
            const int nd = n0 + sub * 64 + n;
            int ns = nd;
            if (inproj) { ns = (nd < 1536) ? nd : (nd < 3328 ? nd + 16 : (nd < 3344 ? nd - 3328 + 1536 : -1)); }
#pragma unroll
            for (int i = 0; i < 8; ++i) {
              const int k = kq * 8 + i;
              tile[sub * 4160 + k * 65 + n] = (ns >= 0) ? src[(size_t)(k0 + k) * ldn + ns] : 0.f;
            }
          }
        }
        __syncthreads();
        {
          const int n = tid >> 3, kc = tid & 7;
#pragma unroll
          for (int sub = 0; sub < 4; ++sub) {
            float f[8];
#pragma unroll
            for (int i = 0; i < 8; ++i) f[i] = tile[sub * 4160 + (kc * 8 + i) * 65 + n];
            uint4 o;
            o.x = pk(f[0], f[1]); o.y = pk(f[2], f[3]); o.z = pk(f[4], f[5]); o.w = pk(f[6], f[7]);
            if (n0 + sub * 64 + n < nrows) *(uint4*)(dst + (size_t)(n0 + sub * 64 + n) * 1024 + k0 + kc * 8) = o;
          }
        }
        __syncthreads();
}

DI void ph0_prologue(KArgP kp, unsigned char* lds) {
  const Params P = load_params(kp); WS W; ws_init(W, P.ws);
  const int tid = fresh_tid(), lane = tid & 63, w = tid >> 6;
  const int nb = gridDim.x, bid = blockIdx.x;
  (void)lane; (void)w; (void)tid;
  {
    float* S = (float*)(lds + 69632);
    for (int i = tid; i < 9 * 1024; i += NT) {
      const float x = (i < 8192) ? P.in[1][i] : P.in[3][i - 8192];
      S[i] = silu(x);
    }
    __syncthreads();
    constexpr int U_WIN = 2 * 14 * 16, U_WOUT = 2 * 4 * 16, U_MOD = 384;
    for (int u = U_WIN + U_WOUT + bid; u < U_WIN + U_WOUT + U_MOD + 1; u += nb) {
      if (u < U_WIN + U_WOUT) {
      } else if (u < U_WIN + U_WOUT + U_MOD) {
        const int v = u - U_WIN - U_WOUT;
        const int l = v / 192, n0 = (v % 192) * 16;
        const int c16 = tid & 15, kg = tid >> 4;
        const float* wm = P.in[4] + (size_t)l * 1024 * 3072 + n0 + c16;
        float acc[9];
#pragma unroll
        for (int rr = 0; rr < 9; ++rr) acc[rr] = 0.f;
#pragma unroll 8
        for (int kk = 0; kk < 32; ++kk) {
          const int k = kg * 32 + kk;
          const float wv = wm[(size_t)k * 3072];
#pragma unroll
          for (int rr = 0; rr < 9; ++rr) acc[rr] += S[rr * 1024 + k] * wv;
        }
        float* red = (float*)lds;
#pragma unroll
        for (int rr = 0; rr < 9; ++rr) red[(kg * 16 + c16) * 9 + rr] = acc[rr];
        __syncthreads();
        if (tid < 144) {
          const int cc = tid / 9, rr = tid % 9;
          float s = 0.f;
          for (int k2 = 0; k2 < 32; ++k2) s += red[(k2 * 16 + cc) * 9 + rr];
          W.mod[((size_t)l * 9 + rr) * 3072 + n0 + cc] = s + P.in[5][l * 3072 + n0 + cc];
        }
        __syncthreads();
      } else {
        for (int i = tid; i < 64 * 16; i += NT) {
          const int idx = i >> 4, k = i & 15;
          const float inv = powf(10000.f, -(float)k / 16.f);
          float sn, cs; sincosf((float)idx * inv, &sn, &cs);
          W.ropeG[i] = make_float2(cs, sn);
        }
        for (int i = tid; i < 64 * 8; i += NT) {
          const int idx = i >> 3, k = i & 7;
          const float inv = powf(10000.f, -(float)k / 8.f);
          float sn, cs; sincosf((float)idx * inv, &sn, &cs);
          W.ropeD[i] = make_float2(cs, sn);
        }
      }
    }
  }
}

DI void ph1_prep(KArgP kp, unsigned char* lds) {
  const Params P = load_params(kp); WS W; ws_init(W, P.ws);
  const int tid = fresh_tid(), lane = tid & 63, w = tid >> 6;
  const int nb = gridDim.x, bid = blockIdx.x;
  (void)lane; (void)w; (void)tid;
  XCD_LOOP(288, xcd, idx)
    const int R = xcd * TT + idx * 8 + w;
    const int b = xcd, t = idx * 8 + w;
    const float* src = (t < 256) ? (P.in[2] + ((size_t)b * 256 + t) * 1024) : (P.in[0] + ((size_t)b * 2048 + (t - 256)) * 1024);
    const float* md = W.mod + (size_t)((t < 256) ? 8 : b) * 3072;
    const float* gp = P.in[6];
    float4 x[4];
    float ss = 0.f;
#pragma unroll
    for (int i = 0; i < 4; ++i) {
      x[i] = *(const float4*)(src + i * 256 + lane * 4);
      ss += x[i].x * x[i].x + x[i].y * x[i].y + x[i].z * x[i].z + x[i].w * x[i].w;
    }
#pragma unroll
    for (int d = 32; d >= 1; d >>= 1) ss += __shfl_xor(ss, d);
    const float rn = rsqrtf(ss * (1.f / 1024.f) + EPS);
#pragma unroll
    for (int i = 0; i < 4; ++i) {
      const int k = i * 256 + lane * 4;
      const float4 g4 = *(const float4*)(gp + k);
      const float4 sh = *(const float4*)(md + k);
      const float4 sc = *(const float4*)(md + 1024 + k);
      uint2 o;
      o.x = pk(x[i].x * rn * g4.x * (1.f + sc.x) + sh.x, x[i].y * rn * g4.y * (1.f + sc.y) + sh.y);
      o.y = pk(x[i].z * rn * g4.z * (1.f + sc.z) + sh.z, x[i].w * rn * g4.w * (1.f + sc.w) + sh.w);
      *(uint2*)(W.U + (size_t)R * 1024 + k) = o;
    }
  XCD_END
  for (int u = bid; u < 2 * 14 * 16 + 2 * 4 * 16; u += nb) w_transpose_unit(P, W, lds, u);
}

DI void ph2_inproj(KArgP kp, int l, unsigned char* lds) {
  const Params P = load_params(kp); WS W; ws_init(W, P.ws);
  const int tid = fresh_tid();
  const int nb = gridDim.x, bid = blockIdx.x;
  XCD_LOOP(243, xcd, idx)
    const int nt = idx / 9, mt = xcd * 9 + idx % 9;
    gemm_tile_to_lds(W.U, W.WinT + (size_t)l * NPAD * 1024, mt * 256, nt * 128, lds);
    if (nt == 15 || nt == 22 || nt == 23) {
      const int b = mt / 9, t0 = (mt - b * 9) * 256;
      u16* vt = (nt == 15) ? (W.Vt + (size_t)(b * 2) * 64 * TT) : (W.DVt + (size_t)(b * 4 + (nt - 22) * 2) * 64 * TT);
      store_tile_transposed(lds, vt, t0);
    } else {
      float v[64];
      load_row64(lds, v);
      inproj_epi(P, W, l, mt * 256 + (tid >> 1), nt, tid & 1, v);
    }
    __syncthreads();
  XCD_END
}

DI void ph3_mix(KArgP kp, int l, unsigned char* lds) {
  const Params P = load_params(kp); WS W; ws_init(W, P.ws);
  const int nb = gridDim.x, bid = blockIdx.x;
  const int upx = (l == 0) ? 120 : 112;
  XCD_LOOP(upx, xcd, idx)
    const int b = xcd;
    if (idx < 32) {
      diff_unit(P, W, l, b, idx >> 3, 1 + (idx & 7), lds);
    } else if (idx < 64) {
      gqa_unit(W, P.in[17] + l * 64, P.in[18] + l * 64, b, (idx - 32) >> 3, 1 + (idx & 7), lds);
    } else if (idx < 96) {
      const int v = idx - 64;
      ssd_local_unit(P, W, l, b, v >> 1, v & 1, 0, 4, lds);
    } else if (idx < 112) {
      const int v = idx - 96, u = 32 + (v >> 2), hq = v & 3;
      ssd_local_unit(P, W, l, b, u >> 1, u & 1, hq, hq + 1, lds);
    } else if (idx < 116) {
      diff_unit(P, W, l, b, idx - 112, 0, lds);
    } else {
      gqa_unit(W, P.in[17] + l * 64, P.in[18] + l * 64, b, idx - 116, 0, lds);
    }
    __syncthreads();
  XCD_END
}

DI void ph4a_states(KArgP kp) {
  const Params P = load_params(kp); WS W; ws_init(W, P.ws);
  const int tid = fresh_tid(), lane = tid & 63, w = tid >> 6;
  const int nb = gridDim.x, bid = blockIdx.x;
  (void)lane; (void)w; (void)tid;
    XCD_LOOP(64, xcd, idx)
      const int gid = idx * NT + tid;
      const int e4 = gid & 2047, hg = (gid >> 11) & 7, b = xcd, dir = gid >> 14;
      float s0 = 0.f, s1 = 0.f, s2 = 0.f, s3 = 0.f;
      for (int step = 0; step < 18; ++step) {
        const int c = dir ? (step == 0 ? 1 : (step == 1 ? 0 : 19 - step)) : step;
        const size_t idx = ((((size_t)dir * 8 + b) * 18 + c) * 8 + hg) * 8192 + (size_t)e4 * 4;
        uint2 o;
        o.x = pk(s0, s1); o.y = pk(s2, s3);
        *(uint2*)(W.Stin + idx) = o;
        const float tot = W.cumF[(size_t)dir * ((size_t)RR * 8) + ((size_t)b * TT + c * 128 + (dir ? 0 : 127)) * 8 + hg];
        const float dec = __expf(tot);
        const uint2 sv = *(const uint2*)(W.Sloc + idx);
        s0 = s0 * dec + bflo(sv.x); s1 = s1 * dec + bfhi(sv.x);
        s2 = s2 * dec + bflo(sv.y); s3 = s3 * dec + bfhi(sv.y);
      }
    XCD_END
}

DI void ph4b_yoff(KArgP kp, int l, unsigned char* lds) {
  const Params P = load_params(kp); WS W; ws_init(W, P.ws);
  const int tid = fresh_tid(), lane = tid & 63, w = tid >> 6;
  const int nb = gridDim.x, bid = blockIdx.x;
  (void)lane; (void)w; (void)tid;
    XCD_LOOP((l == 0 ? 72 : 64), xcd, idx)
      const int b = xcd, c = (idx >> 2) + (l == 0 ? 0 : 2), tb = idx & 3;
      const int r = lane & 31, h2 = lane >> 5;
      const int hg = w, g = w >> 2;
      const size_t Rr = (size_t)b * TT + c * 128 + 32 * tb + r;
      f32x16 acc[2][2];
#pragma unroll
      for (int d = 0; d < 2; ++d)
#pragma unroll
        for (int pt = 0; pt < 2; ++pt)
#pragma unroll
          for (int e = 0; e < 16; ++e) acc[d][pt][e] = 0.f;
      const u16* cp = W.Cc + Rr * 256 + g * 128 + 8 * h2;
      bf16x8 bfr[8];
#pragma unroll
      for (int ks = 0; ks < 8; ++ks) bfr[ks] = *(const bf16x8*)(cp + 16 * ks);
      u16* myl = (u16*)lds + w * (64 * 136);
#pragma unroll
      for (int d = 0; d < 2; ++d) {
        const u16* sp = W.Stin + ((((size_t)d * 8 + b) * 18 + c) * 8 + hg) * 8192 + lane * 8;
        u32x4 sv[16];
#pragma unroll
        for (int i = 0; i < 16; ++i) sv[i] = *(const u32x4*)(sp + i * 512);
#pragma unroll
        for (int i = 0; i < 16; ++i) *(u32x4*)(myl + (4 * i + (lane >> 4)) * 136 + (lane & 15) * 8) = sv[i];
        __builtin_amdgcn_wave_barrier();
#pragma unroll
        for (int ks = 0; ks < 8; ++ks) {
          const bf16x8 f0 = *(const bf16x8*)(myl + r * 136 + 16 * ks + 8 * h2);
          const bf16x8 f1 = *(const bf16x8*)(myl + (32 + r) * 136 + 16 * ks + 8 * h2);
          acc[d][0] = MFMA32(f0, bfr[ks], acc[d][0]);
          acc[d][1] = MFMA32(f1, bfr[ks], acc[d][1]);
        }
        __builtin_amdgcn_wave_barrier();
      }
      const float eF = __expf(W.cumF[Rr * 8 + hg]), eB = __expf(W.cumB[Rr * 8 + hg]);
      float ss = 0.f;
#pragma unroll
      for (int pt = 0; pt < 2; ++pt)
#pragma unroll
        for (int i4 = 0; i4 < 4; ++i4) {
          const int p = 32 * pt + 8 * i4 + 4 * h2;
          const uint2 yd = *(const uint2*)(W.Ycat + Rr * 1024 + hg * 64 + p);
          const uint2 zz = *(const uint2*)(W.Z + Rr * 512 + hg * 64 + p);
          float y0 = bflo(yd.x) + eF * acc[0][pt][4 * i4] + eB * acc[1][pt][4 * i4];
          float y1 = bfhi(yd.x) + eF * acc[0][pt][4 * i4 + 1] + eB * acc[1][pt][4 * i4 + 1];
          float y2 = bflo(yd.y) + eF * acc[0][pt][4 * i4 + 2] + eB * acc[1][pt][4 * i4 + 2];
          float y3 = bfhi(yd.y) + eF * acc[0][pt][4 * i4 + 3] + eB * acc[1][pt][4 * i4 + 3];
          y0 *= silu(bflo(zz.x)); y1 *= silu(bfhi(zz.x)); y2 *= silu(bflo(zz.y)); y3 *= silu(bfhi(zz.y));
          acc[0][pt][4 * i4] = y0; acc[0][pt][4 * i4 + 1] = y1; acc[0][pt][4 * i4 + 2] = y2; acc[0][pt][4 * i4 + 3] = y3;
          ss += y0 * y0 + y1 * y1 + y2 * y2 + y3 * y3;
        }
      ss += __shfl_xor(ss, 32);
      float* red = (float*)(lds + 8 * 64 * 136 * 2);
      if (h2 == 0) red[w * 32 + r] = ss;
      __syncthreads();
      float tot = 0.f;
#pragma unroll
      for (int k = 0; k < 8; ++k) tot += red[k * 32 + r];
      const float rn = rsqrtf(tot * (1.f / 512.f) + EPS);
      const float* ng = P.in[16] + l * 512 + hg * 64;
#pragma unroll
      for (int pt = 0; pt < 2; ++pt)
#pragma unroll
        for (int i4 = 0; i4 < 4; ++i4) {
          const int p = 32 * pt + 8 * i4 + 4 * h2;
          const float4 n4 = *(const float4*)(ng + p);
          uint2 o;
          o.x = pk(acc[0][pt][4 * i4] * rn * n4.x, acc[0][pt][4 * i4 + 1] * rn * n4.y);
          o.y = pk(acc[0][pt][4 * i4 + 2] * rn * n4.z, acc[0][pt][4 * i4 + 3] * rn * n4.w);
          *(uint2*)(W.Ycat + Rr * 1024 + hg * 64 + p) = o;
        }
      __syncthreads();
    XCD_END
}

DI void ph5_outproj(KArgP kp, int l, unsigned char* lds) {
  const Params P = load_params(kp); WS W; ws_init(W, P.ws);
  const int tid = fresh_tid();
  const int nb = gridDim.x, bid = blockIdx.x;
  const int upx = (l == 0) ? 72 : 64;
  XCD_LOOP(upx, xcd, idx)
    const int mt = xcd * 9 + (idx >> 3) + (l == 0 ? 0 : 1), nt = idx & 7;
    gemm_tile_to_lds(W.Ycat, W.WoutT + (size_t)l * 1024 * 1024, mt * 256, nt * 128, lds);
    float v[64];
    load_row64(lds, v);
    const size_t R = (size_t)mt * 256 + (tid >> 1);
    float ss = 0.f;
#pragma unroll
    for (int j = 0; j < 64; ++j) ss += v[j] * v[j];
    W.Opart[R * 16 + nt * 2 + (tid & 1)] = ss;
    store64(W.Obuf + R * 1024 + nt * 128 + (tid & 1) * 64, v);
    __syncthreads();
  XCD_END
}

DI void ph6_post(KArgP kp, int l) {
  const Params P = load_params(kp); WS W; ws_init(W, P.ws);
  const int tid = fresh_tid(), lane = tid & 63, w = tid >> 6;
  const int nb = gridDim.x, bid = blockIdx.x;
  (void)lane; (void)w; (void)tid;
    XCD_LOOP(288, xcd, idx)
      const int R = xcd * TT + idx * 8 + w;
      const int b = xcd, t = idx * 8 + w;
      const bool isctx = t < 256;
      if (l == 1 && isctx) continue;
      const float* md = W.mod + ((size_t)l * 9 + (isctx ? 8 : b)) * 3072;
      const float* hsrc = isctx ? (P.in[2] + ((size_t)b * 256 + t) * 1024) : (P.in[0] + ((size_t)b * 2048 + (t - 256)) * 1024);
      u16* hb = (u16*)(P.ws + OFF_HB) + ((size_t)b * 2048 + (t - 256)) * 1024;
      float pss = (lane < 16) ? W.Opart[(size_t)R * 16 + lane] : 0.f;
#pragma unroll
      for (int d = 8; d >= 1; d >>= 1) pss += __shfl_xor(pss, d);
      pss = __shfl(pss, 0);
      const float rn = rsqrtf(pss * (1.f / 1024.f) + EPS);
      const float* gpost = P.in[7] + l * 1024;
      float4 hn[4];
      float ss = 0.f;
#pragma unroll
      for (int i = 0; i < 4; ++i) {
        const int k = i * 256 + lane * 4;
        float4 hv;
        if (l == 0) hv = *(const float4*)(hsrc + k);
        else { const uint2 hu = *(const uint2*)(hb + k); hv = make_float4(bflo(hu.x), bfhi(hu.x), bflo(hu.y), bfhi(hu.y)); }
        const uint2 ov = *(const uint2*)(W.Obuf + (size_t)R * 1024 + k);
        const float4 g4 = *(const float4*)(gpost + k);
        const float4 gt = *(const float4*)(md + 2048 + k);
        hn[i].x = hv.x + gt.x * (bflo(ov.x) * rn * g4.x);
        hn[i].y = hv.y + gt.y * (bfhi(ov.x) * rn * g4.y);
        hn[i].z = hv.z + gt.z * (bflo(ov.y) * rn * g4.z);
        hn[i].w = hv.w + gt.w * (bfhi(ov.y) * rn * g4.w);
        ss += hn[i].x * hn[i].x + hn[i].y * hn[i].y + hn[i].z * hn[i].z + hn[i].w * hn[i].w;
      }
      if (!isctx) {
        if (l == 0) {
#pragma unroll
          for (int i = 0; i < 4; ++i) {
            uint2 o; o.x = pk(hn[i].x, hn[i].y); o.y = pk(hn[i].z, hn[i].w);
            *(uint2*)(hb + i * 256 + lane * 4) = o;
          }
        } else {
          float* dst = P.out + ((size_t)b * 2048 + (t - 256)) * 1024;
#pragma unroll
          for (int i = 0; i < 4; ++i) *(float4*)(dst + i * 256 + lane * 4) = hn[i];
        }
      }
      if (l == 0) {
#pragma unroll
        for (int d = 32; d >= 1; d >>= 1) ss += __shfl_xor(ss, d);
        const float r2 = rsqrtf(ss * (1.f / 1024.f) + EPS);
        const float* md1 = W.mod + ((size_t)9 + (isctx ? 8 : b)) * 3072;
        const float* gp = P.in[6] + 1024;
#pragma unroll
        for (int i = 0; i < 4; ++i) {
          const int k = i * 256 + lane * 4;
          const float4 g4 = *(const float4*)(gp + k);
          const float4 sh = *(const float4*)(md1 + k);
          const float4 sc = *(const float4*)(md1 + 1024 + k);
          uint2 o;
          o.x = pk(hn[i].x * r2 * g4.x * (1.f + sc.x) + sh.x, hn[i].y * r2 * g4.y * (1.f + sc.y) + sh.y);
          o.y = pk(hn[i].z * r2 * g4.z * (1.f + sc.z) + sh.z, hn[i].w * r2 * g4.w * (1.f + sc.w) + sh.w);
          *(uint2*)(W.U + (size_t)R * 1024 + k) = o;
        }
      }
    XCD_END
}


#define XB_TMO      128
#define XB_XCNT(j)  (256  + 64 * (j))
#define XB_XSUB(j)  (1280 + 64 * (j))
#define XB_XGEN(j)  (2304 + 64 * (j))
#define XB_TOP      3328
#define XB_TOPGEN   3392
#define XCD_BAR_WORDS 3456
#define XB_SPIN_CAP (1u << 18)
#define LAS __attribute__((address_space(3)))

__device__ __forceinline__ unsigned xb_ld(unsigned* p)              { return __hip_atomic_load(p, __ATOMIC_RELAXED, __HIP_MEMORY_SCOPE_AGENT); }
__device__ __forceinline__ unsigned xb_add(unsigned* p, unsigned v) { return __hip_atomic_fetch_add(p, v, __ATOMIC_RELAXED, __HIP_MEMORY_SCOPE_AGENT); }
__device__ __forceinline__ unsigned xb_xcc_id() { return (unsigned)__builtin_amdgcn_s_getreg((3 << 11) | 20) & 0xFu; }
#define XB_SPIN(cond, bar) do { unsigned _sp = 0; while (cond) { __builtin_amdgcn_s_sleep(1); \
    if ((++_sp & 255u) == 0u) { if (xb_ld(&(bar)[XB_TMO])) break; if (_sp > XB_SPIN_CAP) { atomicAdd(&(bar)[XB_TMO], 1u); break; } } } } while (0)

struct XcdBarrier {
    unsigned* bar; unsigned x;
    volatile LAS unsigned* st;
};

__device__ __forceinline__ XcdBarrier xcd_barrier_post(unsigned* bar, volatile LAS unsigned* st) {
    XcdBarrier b; b.bar = bar; b.x = xb_xcc_id(); b.st = st;
    if (threadIdx.x == 0) (void)xb_add(&bar[XB_XCNT(b.x)], 1u);
    return b;
}
__device__ __forceinline__ void xcd_barrier_complete(unsigned* bar, unsigned x, unsigned& nloc, unsigned& nx) {
    const unsigned G = gridDim.x * gridDim.y * gridDim.z;
    unsigned sum, cnt, mine, sp = 0u;
    for (;;) {
        sum = 0u; cnt = 0u; mine = 0u;
#pragma unroll
        for (unsigned j = 0; j < 16; ++j) { const unsigned c = xb_ld(&bar[XB_XCNT(j)]); sum += c; cnt += (c > 0u) ? 1u : 0u; mine = (j == x) ? c : mine; }
        if (sum == G) break;
        __builtin_amdgcn_s_sleep(1);
        if ((++sp & 255u) == 0u) { if (xb_ld(&bar[XB_TMO])) break; if (sp > XB_SPIN_CAP) { atomicAdd(&bar[XB_TMO], 1u); break; } }
    }
    nloc = mine > 0u ? mine : 1u; nx = cnt > 0u ? cnt : 1u;
}

__device__ __forceinline__ void xcd_barrier(const XcdBarrier& b) {
    asm volatile("s_waitcnt vmcnt(0)" ::: "memory");
    __syncthreads();
    if (threadIdx.x == 0) {
        unsigned* bar = b.bar;
        __builtin_amdgcn_s_waitcnt(0);
        unsigned nloc = b.st[0], nx = b.st[1];
        if (nloc == 0u) { xcd_barrier_complete(bar, b.x, nloc, nx); b.st[0] = nloc; b.st[1] = nx; }
        const unsigned old = xb_add(&bar[XB_XSUB(b.x)], 1u);
        const unsigned gen = old / nloc;
        if (old + 1u == (gen + 1u) * nloc) {
            __builtin_amdgcn_fence(__ATOMIC_RELEASE, "agent");
            asm volatile("s_waitcnt vmcnt(0)" ::: "memory");
            const unsigned og = xb_add(&bar[XB_TOP], 1u);
            const unsigned tg = og / nx;
            if (og + 1u == (tg + 1u) * nx) xb_add(&bar[XB_TOPGEN], 1u);
            else XB_SPIN(xb_ld(&bar[XB_TOPGEN]) == tg, bar);
            __builtin_amdgcn_fence(__ATOMIC_ACQUIRE, "agent");
            xb_add(&bar[XB_XGEN(b.x)], 1u);
            asm volatile("s_waitcnt vmcnt(0)" ::: "memory");
        } else {
            XB_SPIN(xb_ld(&bar[XB_XGEN(b.x)]) == gen, bar);
            __builtin_amdgcn_fence(__ATOMIC_ACQUIRE, "agent");
            asm volatile("s_waitcnt vmcnt(0)" ::: "memory");
        }
    }
    __syncthreads();
}

DI void grid_barrier(unsigned* bar, unsigned& epoch) {
  asm volatile("s_waitcnt vmcnt(0)" ::: "memory");
  __syncthreads();
  ++epoch;
  if (threadIdx.x == 0) {
    __builtin_amdgcn_fence(__ATOMIC_RELEASE, "agent");
    asm volatile("s_waitcnt vmcnt(0)" ::: "memory");
    const unsigned nb = gridDim.x, bid = blockIdx.x;
    const bool hier = (nb & 7u) == 0u;
    const unsigned ng = hier ? 8u : 1u, per = hier ? (nb >> 3) : nb;
    unsigned* grp = bar + 64 * (1 + (hier ? (bid & 7u) : 0u));
    const unsigned old = __hip_atomic_fetch_add(grp, 1u, __ATOMIC_RELAXED, __HIP_MEMORY_SCOPE_AGENT);
    if (old + 1u == epoch * per) __hip_atomic_fetch_add(bar, 1u, __ATOMIC_RELAXED, __HIP_MEMORY_SCOPE_AGENT);
    const unsigned target = epoch * ng;
    while (__hip_atomic_load(bar, __ATOMIC_RELAXED, __HIP_MEMORY_SCOPE_AGENT) < target) __builtin_amdgcn_s_sleep(1);
    __builtin_amdgcn_fence(__ATOMIC_ACQUIRE, "agent");
    asm volatile("s_waitcnt vmcnt(0)" ::: "memory");
  }
  __syncthreads();
}

__global__ void __launch_bounds__(NT) fwd_mega(Params Parg) {
  extern __shared__ __attribute__((aligned(16))) unsigned char lds[];
  cg::grid_group grid = cg::this_grid();
  KArgP kp = (KArgP)__builtin_amdgcn_kernarg_segment_ptr();
  unsigned* bar = (unsigned*)(Parg.ws + OFF_BAR);
  if (gridDim.x == 0x7fffffffu) grid.sync();
  volatile LAS unsigned* xst = (volatile LAS unsigned*)((LAS unsigned char*)lds + (LDS_BYTES - 64));
  if (threadIdx.x == 0) { xst[0] = 0u; xst[1] = 0u; }
  __syncthreads();
  const XcdBarrier xb = xcd_barrier_post(bar, xst);

  ph0_prologue(kp, lds);
  xcd_barrier(xb);

  ph1_prep(kp, lds);
  xcd_barrier(xb);

  for (int l = 0; l < 2; ++l) {
    ph2_inproj(kp, l, lds);
    xcd_barrier(xb);

    ph3_mix(kp, l, lds);
    xcd_barrier(xb);

    ph4a_states(kp);
    xcd_barrier(xb);

    ph4b_yoff(kp, l, lds);
    xcd_barrier(xb);

    ph5_outproj(kp, l, lds);
    xcd_barrier(xb);

    ph6_post(kp, l);
    if (l == 0) xcd_barrier(xb);
  }
}

extern "C" void kernel_launch(void* const* d_in, const int* in_sizes, int n_in,
                              void* d_out, int out_size, void* d_ws, size_t ws_size,
                              hipStream_t stream) {
  static int grid_blocks = 0;
  if (!grid_blocks) {
    int dev = 0, cus = 0, per_cu = 0;
    (void)hipGetDevice(&dev);
    (void)hipDeviceGetAttribute(&cus, hipDeviceAttributeMultiprocessorCount, dev);
    (void)hipFuncSetAttribute((const void*)fwd_mega, hipFuncAttributeMaxDynamicSharedMemorySize, LDS_BYTES);
    (void)hipOccupancyMaxActiveBlocksPerMultiprocessor(&per_cu, (const void*)fwd_mega, NT, LDS_BYTES);
    if (per_cu < 1) per_cu = 1;
    grid_blocks = cus * per_cu;
    if (ws_size < WS_END) fprintf(stderr, "workspace too small: %zu < %zu\n", ws_size, (size_t)WS_END);
  }
  Params p{};
  for (int i = 0; i < 22; ++i) p.in[i] = (const float*)d_in[i];
  p.out = (float*)d_out;
  p.ws = (unsigned char*)d_ws;
  (void)hipMemsetAsync((unsigned char*)d_ws + OFF_BAR, 0, 16384, stream);
  void* args[] = {&p};
  hipError_t e = hipLaunchCooperativeKernel((const void*)fwd_mega, dim3(grid_blocks), dim3(NT), args, LDS_BYTES, stream);
  if (e != hipSuccess) fprintf(stderr, "cooperative launch failed: %s (grid %d)\n", hipGetErrorString(e), grid_blocks);
}
```

```cpp
#include <hip/hip_runtime.h>
#include <hip/hip_cooperative_groups.h>
#include <cstdio>
namespace cg = cooperative_groups;

#define DI __device__ __forceinline__
#define NT 512
static __device__ __forceinline__ int fresh_tid() { int t = threadIdx.x; asm volatile("" : "+v"(t)); return t; }
typedef unsigned short u16;
typedef __attribute__((ext_vector_type(8))) short bf16x8;
typedef __attribute__((ext_vector_type(4))) short s16x4;
typedef __attribute__((ext_vector_type(16))) float f32x16;
typedef __attribute__((ext_vector_type(4))) float f32x4;
typedef __attribute__((ext_vector_type(2))) __bf16 bf2v;
typedef __attribute__((ext_vector_type(2))) float f2v;
typedef unsigned __attribute__((ext_vector_type(4))) u32x4;
typedef unsigned __attribute__((ext_vector_type(2))) u32x2;

#define MFMA32(a, b, c) __builtin_amdgcn_mfma_f32_32x32x16_bf16((a), (b), (c), 0, 0, 0)
#define MFMA16(a, b, c) __builtin_amdgcn_mfma_f32_16x16x32_bf16((a), (b), (c), 0, 0, 0)

constexpr int LDS_BYTES = 140 * 1024;
constexpr int TT = 2304;
constexpr int RR = 18432;
constexpr int NPAD = 3456;
constexpr float EPS = 1e-6f;
constexpr float LOG2E = 1.4426950408889634f;

constexpr size_t SZ_WIN = (size_t)2 * NPAD * 1024 * 2;
constexpr size_t SZ_WOUT = (size_t)2 * 1024 * 1024 * 2;
constexpr size_t SZ_MOD = (size_t)2 * 9 * 3072 * 4;
constexpr size_t SZ_ROPE = 16384;
constexpr size_t SZ_R1024 = (size_t)RR * 1024 * 2;
constexpr size_t SZ_R512 = (size_t)RR * 512 * 2;
constexpr size_t SZ_R256 = (size_t)RR * 256 * 2;
constexpr size_t OFF_WIN = 0;
constexpr size_t OFF_WOUT = OFF_WIN + SZ_WIN;
constexpr size_t OFF_MOD = OFF_WOUT + SZ_WOUT;
constexpr size_t OFF_ROPE = OFF_MOD + SZ_MOD;
constexpr size_t OFF_U = OFF_ROPE + SZ_ROPE;
constexpr size_t OFF_XBC = OFF_U + SZ_R1024;
constexpr size_t OFF_Z = OFF_XBC + SZ_R1024;
constexpr size_t OFF_DT = OFF_Z + SZ_R512;
constexpr size_t SZ_DT = (size_t)RR * 16 * 4;
constexpr size_t OFF_Q = OFF_DT + SZ_DT;
constexpr size_t SZ_Q = (size_t)8 * 4 * TT * 64 * 2;
constexpr size_t OFF_K = OFF_Q + SZ_Q;
constexpr size_t SZ_K = (size_t)8 * 2 * TT * 64 * 2;
constexpr size_t OFF_VT = OFF_K + SZ_K;
constexpr size_t OFF_DQ = OFF_VT + SZ_K;
constexpr size_t SZ_DQ = (size_t)8 * 8 * TT * 32 * 2;
constexpr size_t OFF_DK = OFF_DQ + SZ_DQ;
constexpr size_t OFF_DVT = OFF_DK + SZ_DQ;
constexpr size_t SZ_DVT = (size_t)8 * 4 * 64 * TT * 2;
constexpr size_t OFF_GG = OFF_DVT + SZ_DVT;
constexpr size_t OFF_DG = OFF_GG + SZ_R256;
constexpr size_t OFF_CC = OFF_DG + SZ_R256;
constexpr size_t OFF_CUMF = OFF_CC + SZ_R256;
constexpr size_t SZ_CUM = (size_t)RR * 8 * 4;
constexpr size_t OFF_CUMB = OFF_CUMF + SZ_CUM;
constexpr size_t OFF_SLOC = OFF_CUMB + SZ_CUM;
constexpr size_t SZ_ST = (size_t)2 * 8 * 18 * 8 * 8192 * 2;
constexpr size_t OFF_OPART = OFF_SLOC + SZ_ST;
constexpr size_t OFF_HB = OFF_OPART + SZ_DT;
constexpr size_t SZ_HB = (size_t)8 * 2048 * 1024 * 2;
constexpr size_t OFF_BAR = OFF_HB + SZ_HB;
constexpr size_t WS_END = OFF_BAR + 16384;
static_assert(SZ_ST <= (OFF_GG - OFF_Q), "Stin must fit in the q/k/v region");
static_assert(WS_END <= (size_t)256 * 1024 * 1024, "workspace");

struct Params {
  const float* in[22];
  float* out;
  unsigned char* ws;
};

struct WS {
  u16 *WinT, *WoutT, *U, *Ycat, *XBC, *Obuf, *Z, *Q, *K, *Vt, *DQ, *DK, *DVt, *GG, *DG, *Cc, *Sloc, *Stin;
  float *mod, *DT, *cumF, *cumB, *Opart;
  float2 *ropeG, *ropeD;
};

DI unsigned pk(float a, float b) { f2v v = {a, b}; return __builtin_bit_cast(unsigned, __builtin_convertvector(v, bf2v)); }
DI u16 f2bf(float a) { return (u16)(pk(a, 0.f) & 0xffffu); }
DI float bf2f(u16 b) { return __uint_as_float(((unsigned)b) << 16); }
DI float bflo(unsigned u) { return __uint_as_float(u << 16); }
DI float bfhi(unsigned u) { return __uint_as_float(u & 0xffff0000u); }
DI float silu(float x) { return x / (1.f + __expf(-x)); }
DI float softplus(float x) { return fmaxf(x, 0.f) + log1pf(__expf(-fabsf(x))); }
DI float fexp2(float x) { return __builtin_amdgcn_exp2f(x); }

DI void store64(u16* dst, const float (&v)[64]) {
#pragma unroll
  for (int i = 0; i < 8; ++i) {
    uint4 u;
    u.x = pk(v[8 * i], v[8 * i + 1]); u.y = pk(v[8 * i + 2], v[8 * i + 3]);
    u.z = pk(v[8 * i + 4], v[8 * i + 5]); u.w = pk(v[8 * i + 6], v[8 * i + 7]);
    ((uint4*)dst)[i] = u;
  }
}

struct GRegs { u32x4 a0, a1, a2, a3, b0, b1; };
DI void g_load(GRegs& R, const u16* ag, const u16* bg, int k0) {
  constexpr size_t K = 1024;
  R.a0 = *(const u32x4*)(ag + k0);
  R.a1 = *(const u32x4*)(ag + 64 * K + k0);
  R.a2 = *(const u32x4*)(ag + 128 * K + k0);
  R.a3 = *(const u32x4*)(ag + 192 * K + k0);
  R.b0 = *(const u32x4*)(bg + k0);
  R.b1 = *(const u32x4*)(bg + 64 * K + k0);
}
DI void g_store(const GRegs& R, u16* as, u16* bs) {
  *(u32x4*)(as) = R.a0;
  *(u32x4*)(as + 64 * 72) = R.a1;
  *(u32x4*)(as + 128 * 72) = R.a2;
  *(u32x4*)(as + 192 * 72) = R.a3;
  *(u32x4*)(bs) = R.b0;
  *(u32x4*)(bs + 64 * 72) = R.b1;
}
DI void g_compute(const u16* as, const u16* bs, f32x16 (&acc)[2][2]) {
  __builtin_amdgcn_iglp_opt(0);
#pragma unroll
  for (int ks = 0; ks < 4; ++ks) {
    bf16x8 a0 = *(const bf16x8*)(as + 16 * ks);
    bf16x8 a1 = *(const bf16x8*)(as + 32 * 72 + 16 * ks);
    bf16x8 b0 = *(const bf16x8*)(bs + 16 * ks);
    bf16x8 b1 = *(const bf16x8*)(bs + 32 * 72 + 16 * ks);
    acc[0][0] = MFMA32(a0, b0, acc[0][0]);
    acc[0][1] = MFMA32(a0, b1, acc[0][1]);
    acc[1][0] = MFMA32(a1, b0, acc[1][0]);
    acc[1][1] = MFMA32(a1, b1, acc[1][1]);
  }
}
constexpr int G_LDK = 72;
constexpr int G_CST = 132;
DI void gemm_tile_to_lds(const u16* __restrict__ A, const u16* __restrict__ Bt, int m0, int n0, unsigned char* lds) {
  constexpr int K = 1024;
  u16* As = (u16*)lds;
  u16* Bs = (u16*)(lds + 2 * 256 * G_LDK * 2);
  const int tid = fresh_tid(), lane = tid & 63, w = tid >> 6;
  const int r = lane & 31, h = lane >> 5;
  const int wm = w >> 1, wn = w & 1;
  const int arow = tid >> 3, akc = tid & 7;
  const u16* ag = A + (size_t)(m0 + arow) * K + akc * 8;
  const u16* bg = Bt + (size_t)(n0 + arow) * K + akc * 8;
  f32x16 acc[2][2];
#pragma unroll
  for (int i = 0; i < 2; ++i)
#pragma unroll
    for (int j = 0; j < 2; ++j)
#pragma unroll
      for (int e = 0; e < 16; ++e) acc[i][j][e] = 0.f;
  GRegs R0, R1;
  g_load(R0, ag, bg, 0);
  g_load(R1, ag, bg, 64);
  g_store(R0, As + arow * G_LDK + akc * 8, Bs + arow * G_LDK + akc * 8);
  __syncthreads();
  const u16* as0 = As + (64 * wm + r) * G_LDK + 8 * h;
  const u16* bs0 = Bs + (64 * wn + r) * G_LDK + 8 * h;
  for (int kt2 = 0; kt2 < 16; kt2 += 2) {
    if (kt2 + 2 < 16) g_load(R0, ag, bg, (kt2 + 2) * 64);
    g_compute(as0, bs0, acc);
    g_store(R1, As + 256 * G_LDK + arow * G_LDK + akc * 8, Bs + 128 * G_LDK + arow * G_LDK + akc * 8);
    __syncthreads();
    if (kt2 + 3 < 16) g_load(R1, ag, bg, (kt2 + 3) * 64);
    g_compute(as0 + 256 * G_LDK, bs0 + 128 * G_LDK, acc);
    if (kt2 + 2 < 16) g_store(R0, As + arow * G_LDK + akc * 8, Bs + arow * G_LDK + akc * 8);
    __syncthreads();
  }
  float* Cst = (float*)lds;
#pragma unroll
  for (int i = 0; i < 2; ++i)
#pragma unroll
    for (int j = 0; j < 2; ++j)
#pragma unroll
      for (int e = 0; e < 16; ++e) {
        const int row = 64 * wm + 32 * i + (e & 3) + 8 * (e >> 2) + 4 * h;
        Cst[row * G_CST + 64 * wn + 32 * j + r] = acc[i][j][e];
      }
  __syncthreads();
}

DI void load_row64(const unsigned char* lds, float (&v)[64]) {
  const int tid = fresh_tid();
  const float* src = (const float*)lds + (tid >> 1) * G_CST + (tid & 1) * 64;
#pragma unroll
  for (int i = 0; i < 16; ++i) {
    float4 f = ((const float4*)src)[i];
    v[4 * i] = f.x; v[4 * i + 1] = f.y; v[4 * i + 2] = f.z; v[4 * i + 3] = f.w;
  }
}

DI void store_tile_transposed(const unsigned char* lds, u16* vt, int t0) {
  const int tid = fresh_tid();
  const int col = tid & 127, rg = tid >> 7;
  const float* src = (const float*)lds + (rg * 64) * G_CST + col;
  u16* dst = vt + (size_t)col * TT + t0 + rg * 64;
#pragma unroll
  for (int i = 0; i < 8; ++i) {
    float f[8];
#pragma unroll
    for (int k = 0; k < 8; ++k) f[k] = src[(8 * i + k) * G_CST];
    uint4 u;
    u.x = pk(f[0], f[1]); u.y = pk(f[2], f[3]); u.z = pk(f[4], f[5]); u.w = pk(f[6], f[7]);
    ((uint4*)dst)[i] = u;
  }
}

DI void inproj_epi(const Params& P, const WS& W, int l, int R, int nt, int half, float (&v)[64]) {
  const int b = R / TT;
  const int t = R - b * TT;
  if (nt < 8) {
    store64(W.XBC + (size_t)R * 1024 + nt * 128 + half * 64, v);
  } else if (nt < 12) {
    store64(W.Z + (size_t)R * 512 + (nt - 8) * 128 + half * 64, v);
  } else if (nt < 15) {
    const bool isq = nt < 14;
    const float* g = (isq ? P.in[17] : P.in[18]) + l * 64;
    float ss = 0.f;
#pragma unroll
    for (int j = 0; j < 64; ++j) ss += v[j] * v[j];
    const float rn = rsqrtf(ss * (1.f / 64.f) + EPS);
#pragma unroll
    for (int j = 0; j < 64; ++j) { if ((j & 15) == 0) __builtin_amdgcn_sched_barrier(0); v[j] = v[j] * rn * g[j]; }
    if (t >= 256) {
      const int pos = t - 256, ri = pos >> 6, ci = pos & 63;
#pragma unroll
      for (int i = 0; i < 32; ++i) {
        if ((i & 7) == 0) __builtin_amdgcn_sched_barrier(0);
        const float2 cs = (i < 16) ? W.ropeG[ri * 16 + i] : W.ropeG[ci * 16 + (i - 16)];
        const float x1 = v[i], x2 = v[i + 32];
        v[i] = x1 * cs.x - x2 * cs.y;
        v[i + 32] = x2 * cs.x + x1 * cs.y;
      }
    }
    if (isq) {
      const float sc = 0.125f * LOG2E;
#pragma unroll
      for (int j = 0; j < 64; ++j) v[j] *= sc;
      const int head = (nt - 12) * 2 + half;
      store64(W.Q + ((size_t)(b * 4 + head) * TT + t) * 64, v);
    } else {
      store64(W.K + ((size_t)(b * 2 + half) * TT + t) * 64, v);
    }
  } else if (nt == 15) {
    u16* dst = W.Vt + ((size_t)(b * 2 + half) * 64) * TT + t;
#pragma unroll
    for (int j = 0; j < 64; ++j) { if ((j & 7) == 0) __builtin_amdgcn_sched_barrier(0); dst[(size_t)j * TT] = f2bf(v[j]); }
  } else if (nt < 18) {
#pragma unroll
    for (int j = 0; j < 64; ++j) v[j] = silu(v[j]);
    store64(W.GG + (size_t)R * 256 + (nt - 16) * 128 + half * 64, v);
  } else if (nt < 22) {
    const bool isq = nt < 20;
    const int mbase = (nt - (isq ? 18 : 20)) * 4 + half * 2;
    if (t >= 256) {
      const int pos = t - 256, ri = pos >> 6, ci = pos & 63;
#pragma unroll
      for (int mm = 0; mm < 2; ++mm)
#pragma unroll
        for (int i = 0; i < 16; ++i) {
          if ((i & 7) == 0) __builtin_amdgcn_sched_barrier(0);
          const float2 cs = (i < 8) ? W.ropeD[ri * 8 + i] : W.ropeD[ci * 8 + (i - 8)];
          const float x1 = v[32 * mm + i], x2 = v[32 * mm + i + 16];
          v[32 * mm + i] = x1 * cs.x - x2 * cs.y;
          v[32 * mm + i + 16] = x2 * cs.x + x1 * cs.y;
        }
    }
    if (isq) {
      const float sc = 0.17677669529663687f * LOG2E;
#pragma unroll
      for (int j = 0; j < 64; ++j) v[j] *= sc;
    }
    u16* base = isq ? W.DQ : W.DK;
#pragma unroll
    for (int mm = 0; mm < 2; ++mm) {
      u16* dst = base + ((size_t)(b * 8 + mbase + mm) * TT + t) * 32;
#pragma unroll
      for (int i = 0; i < 4; ++i) {
        uint4 u;
        u.x = pk(v[32 * mm + 8 * i], v[32 * mm + 8 * i + 1]); u.y = pk(v[32 * mm + 8 * i + 2], v[32 * mm + 8 * i + 3]);
        u.z = pk(v[32 * mm + 8 * i + 4], v[32 * mm + 8 * i + 5]); u.w = pk(v[32 * mm + 8 * i + 6], v[32 * mm + 8 * i + 7]);
        ((uint4*)dst)[i] = u;
      }
    }
  } else if (nt < 24) {
    const int head = (nt - 22) * 2 + half;
    u16* dst = W.DVt + ((size_t)(b * 4 + head) * 64) * TT + t;
#pragma unroll
    for (int j = 0; j < 64; ++j) { if ((j & 7) == 0) __builtin_amdgcn_sched_barrier(0); dst[(size_t)j * TT] = f2bf(v[j]); }
  } else if (nt < 26) {
#pragma unroll
    for (int j = 0; j < 64; ++j) v[j] = silu(v[j]);
    store64(W.DG + (size_t)R * 256 + (nt - 24) * 128 + half * 64, v);
  } else if (nt == 26) {
    if (half == 0) {
      const float* bf = P.in[13] + l * 8;
      const float* bb = P.in[14] + l * 8;
#pragma unroll
      for (int j = 0; j < 16; ++j) {
        const float x = v[j] + (j < 8 ? bf[j] : bb[j - 8]);
        W.DT[(size_t)R * 16 + j] = softplus(x);
      }
    }
  }
}

template <int D, bool BOUNDED>
DI void attn_core(const u16* __restrict__ Qh, const u16* __restrict__ Kh, const u16* __restrict__ Vth, int q0, int nkeys,
                  float bound, unsigned char* lds, f32x16 (&O)[2], float& lout) {
  constexpr int KP = D + 8;
  constexpr int KS = D / 16;
  constexpr int VP = 132;
  constexpr int KST = 128 * KP;
  constexpr int VST = 64 * VP;
  u16* Ks = (u16*)lds;
  u16* Vs = (u16*)(lds + 2 * 128 * 72 * 2);
  const int tid = fresh_tid(), lane = tid & 63, w = tid >> 6;
  const int r = lane & 31, h = lane >> 5;
  bf16x8 qf[KS];
  {
    const u16* qp = Qh + (size_t)(q0 + 32 * w + r) * D + 8 * h;
#pragma unroll
    for (int ks = 0; ks < KS; ++ks) qf[ks] = *(const bf16x8*)(qp + 16 * ks);
  }
#pragma unroll
  for (int e = 0; e < 16; ++e) { O[0][e] = 0.f; O[1][e] = 0.f; }
  float m = BOUNDED ? bound : 0.f, lsum = 0.f;
  const int krow = (D == 64) ? (tid >> 3) : (tid >> 2);
  const int kc = (D == 64) ? (tid & 7) : (tid & 3);
  const int vrow = tid >> 3, vc = tid & 7;
  const u16* kg = Kh + (size_t)krow * D + kc * 8;
  const u16* vg = Vth + (size_t)vrow * TT + vc * 8;
  u16* kl = Ks + krow * KP + kc * 8;
  u16* vl = Vs + vrow * VP + vc * 8;
  u32x4 rk0a, rk0b, rv0a, rv0b, rk1a, rk1b, rv1a, rv1b;
  rk0b = (u32x4){0u, 0u, 0u, 0u}; rk1b = rk0b;
#define A_LOAD(KA, KB, VA, VB, T) { KA = *(const u32x4*)(kg + (size_t)(T) * 128 * D); if (D == 64) KB = *(const u32x4*)(kg + (size_t)(T) * 128 * D + 64 * D); \
                                    VA = *(const u32x4*)(vg + (T) * 128); VB = *(const u32x4*)(vg + (T) * 128 + 64); }
#define A_ST8(P, V) { const u32x4 t_ = (V); *(uint2*)(P) = make_uint2(t_.x, t_.y); *(uint2*)((P) + 4) = make_uint2(t_.z, t_.w); }
#define A_STORE(KA, KB, VA, VB, ST) { *(u32x4*)(kl + (ST) * KST) = KA; if (D == 64) *(u32x4*)(kl + (ST) * KST + 64 * KP) = KB; \
                                      A_ST8(vl + (ST) * VST, VA) A_ST8(vl + (ST) * VST + 64, VB) }
  const int nk = nkeys >> 7;
  A_LOAD(rk0a, rk0b, rv0a, rv0b, 0)
  __builtin_amdgcn_s_waitcnt(0x0F70);
  A_STORE(rk0a, rk0b, rv0a, rv0b, 0)
  A_LOAD(rk1a, rk1b, rv1a, rv1b, 1)
  __syncthreads();
  for (int kt2 = 0; kt2 < nk; kt2 += 2) {
#pragma unroll
  for (int ph = 0; ph < 2; ++ph) {
    const int kt = kt2 + ph;
    const int cur = ph;
    {
      const int tx = min(kt + 2, nk - 1);
      if (ph == 0) A_LOAD(rk0a, rk0b, rv0a, rv0b, tx)
      else A_LOAD(rk1a, rk1b, rv1a, rv1b, tx)
    }
    __builtin_amdgcn_sched_barrier(0);
#pragma unroll 1
    for (int sub = 0; sub < 2; ++sub) {
    const u16* ks_ = Ks + cur * KST + (64 * sub + r) * KP + 8 * h;
    bf16x8 kf0[KS], kf1[KS];
#pragma unroll
    for (int ks = 0; ks < KS; ++ks) {
      kf0[ks] = *(const bf16x8*)(ks_ + 16 * ks);
      kf1[ks] = *(const bf16x8*)(ks_ + 32 * KP + 16 * ks);
    }
    const u16* vs_ = Vs + cur * VST + r * VP + 64 * sub + 4 * h;
    bf16x8 vf[8];
#pragma unroll
    for (int s = 0; s < 2; ++s)
#pragma unroll
      for (int dt = 0; dt < 2; ++dt) {
        const u16* vp = vs_ + dt * 32 * VP + 16 * s;
        s16x4 lo = *(const s16x4*)vp;
        s16x4 hi = *(const s16x4*)(vp + 8);
        vf[s * 2 + dt] = __builtin_shufflevector(lo, hi, 0, 1, 2, 3, 4, 5, 6, 7);
      }
    __builtin_amdgcn_sched_barrier(0);
    f32x16 S[2];
    {
      const float nm = -m;
#pragma unroll
      for (int e = 0; e < 16; ++e) { S[0][e] = nm; S[1][e] = nm; }
    }
#pragma unroll
    for (int ks = 0; ks < KS; ++ks) {
      S[0] = MFMA32(kf0[ks], qf[ks], S[0]);
      S[1] = MFMA32(kf1[ks], qf[ks], S[1]);
    }
    __builtin_amdgcn_sched_barrier(0);
#pragma unroll
    for (int s = 0; s < 2; ++s)
#pragma unroll
      for (int dt = 0; dt < 2; ++dt) {
        const u16* vp = vs_ + dt * 32 * VP + 32 + 16 * s;
        s16x4 lo = *(const s16x4*)vp;
        s16x4 hi = *(const s16x4*)(vp + 8);
        vf[(2 + s) * 2 + dt] = __builtin_shufflevector(lo, hi, 0, 1, 2, 3, 4, 5, 6, 7);
      }
    __builtin_amdgcn_sched_barrier(0);
    if (!BOUNDED) {
      float t0 = fmaxf(fmaxf(S[0][0], S[0][1]), S[0][2]);
      float t1 = fmaxf(fmaxf(S[1][0], S[1][1]), S[1][2]);
#pragma unroll
      for (int e = 3; e < 15; e += 2) { t0 = fmaxf(fmaxf(t0, S[0][e]), S[0][e + 1]); t1 = fmaxf(fmaxf(t1, S[1][e]), S[1][e + 1]); }
      float tm = fmaxf(fmaxf(t0, t1), fmaxf(S[0][15], S[1][15]));
      tm = fmaxf(tm, __shfl_xor(tm, 32));
      const bool first = (kt == 0) && (sub == 0);
      if (first || __any(tm > 0.f)) {
        const float adj = first ? tm : fmaxf(tm, 0.f);
        const float alpha = first ? 1.f : fexp2(-adj);
        m += adj;
        lsum *= alpha;
#pragma unroll
        for (int e = 0; e < 16; ++e) { O[0][e] *= alpha; O[1][e] *= alpha; S[0][e] -= adj; S[1][e] -= adj; }
      }
    }
    float rs = 0.f;
#pragma unroll
    for (int e = 0; e < 16; ++e) { S[0][e] = fexp2(S[0][e]); rs += S[0][e]; }
#pragma unroll
    for (int e = 0; e < 16; ++e) { S[1][e] = fexp2(S[1][e]); rs += S[1][e]; }
    lsum += rs;
#pragma unroll
    for (int t2 = 0; t2 < 2; ++t2)
#pragma unroll
      for (int s = 0; s < 2; ++s) {
        uint4 pu;
        pu.x = pk(S[t2][8 * s], S[t2][8 * s + 1]); pu.y = pk(S[t2][8 * s + 2], S[t2][8 * s + 3]);
        pu.z = pk(S[t2][8 * s + 4], S[t2][8 * s + 5]); pu.w = pk(S[t2][8 * s + 6], S[t2][8 * s + 7]);
        const bf16x8 pb = __builtin_bit_cast(bf16x8, pu);
        O[0] = MFMA32(vf[(t2 * 2 + s) * 2 + 0], pb, O[0]);
        O[1] = MFMA32(vf[(t2 * 2 + s) * 2 + 1], pb, O[1]);
      }
    }
    if (kt + 1 < nk) {
      if (ph == 0) A_STORE(rk1a, rk1b, rv1a, rv1b, 1)
      else A_STORE(rk0a, rk0b, rv0a, rv0b, 0)
    }
    __syncthreads();
  }
  }
#undef A_LOAD
#undef A_ST8
#undef A_STORE
  lout = lsum + __shfl_xor(lsum, 32);
}

DI void gqa_unit(const WS& W, const float* qg, const float* kg_, int b, int head, int qb, unsigned char* lds) {
  const int tid = fresh_tid(), lane = tid & 63, w = tid >> 6, r = lane & 31, h = lane >> 5;
  const int q0 = qb * 256;
  const int nkeys = (qb == 0) ? 256 : TT;
  f32x16 O[2];
  float l;
  float bound;
  {
    float gq = fabsf(qg[lane]), gk = fabsf(kg_[lane]);
#pragma unroll
    for (int d = 32; d >= 1; d >>= 1) { gq = fmaxf(gq, __shfl_xor(gq, d)); gk = fmaxf(gk, __shfl_xor(gk, d)); }
    bound = 8.f * LOG2E * gq * gk * 1.02f + 0.25f;
  }
  attn_core<64, true>(W.Q + (size_t)(b * 4 + head) * TT * 64, W.K + (size_t)(b * 2 + (head >> 1)) * TT * 64,
                      W.Vt + (size_t)(b * 2 + (head >> 1)) * 64 * TT, q0, nkeys, bound, lds, O, l);
  const float il = 1.f / l;
  const size_t Rr = (size_t)b * TT + q0 + 32 * w + r;
#pragma unroll
  for (int dt = 0; dt < 2; ++dt)
#pragma unroll
    for (int i4 = 0; i4 < 4; ++i4) {
      const int dv = 32 * dt + 8 * i4 + 4 * h;
      const uint2 g = *(const uint2*)(W.GG + Rr * 256 + head * 64 + dv);
      uint2 o;
      o.x = pk(O[dt][4 * i4] * il * bflo(g.x), O[dt][4 * i4 + 1] * il * bfhi(g.x));
      o.y = pk(O[dt][4 * i4 + 2] * il * bflo(g.y), O[dt][4 * i4 + 3] * il * bfhi(g.y));
      *(uint2*)(W.Ycat + Rr * 1024 + 512 + head * 64 + dv) = o;
    }
}

DI void diff_unit(const Params& P, const WS& W, int l, int b, int hh, int qb, unsigned char* lds) {
  const int tid = fresh_tid(), lane = tid & 63, w = tid >> 6, r = lane & 31, h = lane >> 5;
  const int q0 = qb * 256;
  const int nkeys = (qb == 0) ? 256 : TT;
  const float lam_init = (l == 0) ? 0.2f : 0.35550906759f;
  float lam;
  {
    const float* lp = P.in[19] + l * 128;
    float s1 = (lane < 32) ? lp[lane] * lp[32 + lane] : 0.f;
    float s2 = (lane < 32) ? lp[64 + lane] * lp[96 + lane] : 0.f;
#pragma unroll
    for (int d = 32; d >= 1; d >>= 1) { s1 += __shfl_xor(s1, d); s2 += __shfl_xor(s2, d); }
    lam = __expf(s1) - __expf(s2) + lam_init;
  }
  f32x16 O1[2], O2[2];
  float l1, l2;
  const u16* vt = W.DVt + (size_t)(b * 4 + hh) * 64 * TT;
  attn_core<32, false>(W.DQ + (size_t)(b * 8 + 2 * hh) * TT * 32, W.DK + (size_t)(b * 8 + 2 * hh) * TT * 32, vt, q0, nkeys, 0.f, lds, O1, l1);
  attn_core<32, false>(W.DQ + (size_t)(b * 8 + 2 * hh + 1) * TT * 32, W.DK + (size_t)(b * 8 + 2 * hh + 1) * TT * 32, vt, q0, nkeys, 0.f, lds, O2, l2);
  const float i1 = 1.f / l1, i2 = lam / l2;
  float ss = 0.f;
#pragma unroll
  for (int dt = 0; dt < 2; ++dt)
#pragma unroll
    for (int e = 0; e < 16; ++e) {
      const float o = O1[dt][e] * i1 - O2[dt][e] * i2;
      O1[dt][e] = o;
      ss += o * o;
    }
  ss += __shfl_xor(ss, 32);
  const float rn = rsqrtf(ss * (1.f / 64.f) + EPS) * (1.f - lam_init);
  const float* ng = P.in[20] + l * 64;
  const size_t Rr = (size_t)b * TT + q0 + 32 * w + r;
#pragma unroll
  for (int dt = 0; dt < 2; ++dt)
#pragma unroll
    for (int i4 = 0; i4 < 4; ++i4) {
      const int dv = 32 * dt + 8 * i4 + 4 * h;
      const uint2 g = *(const uint2*)(W.DG + Rr * 256 + hh * 64 + dv);
      const float4 n4 = *(const float4*)(ng + dv);
      uint2 o;
      o.x = pk(O1[dt][4 * i4] * rn * n4.x * bflo(g.x), O1[dt][4 * i4 + 1] * rn * n4.y * bfhi(g.x));
      o.y = pk(O1[dt][4 * i4 + 2] * rn * n4.z * bflo(g.y), O1[dt][4 * i4 + 3] * rn * n4.w * bfhi(g.y));
      *(uint2*)(W.Ycat + Rr * 1024 + 768 + hh * 64 + dv) = o;
    }
}

DI void ssd_xload(uint2 (&raw)[8], const u16* src, int tb, int seg_lo, int seg_hi) {
#pragma unroll
  for (int i = 0; i < 8; ++i) {
    const int t = tb - 2 + i;
    const int tc = min(max(t, seg_lo), seg_hi - 1);
    uint2 v = *(const uint2*)(src + (size_t)tc * 1024);
    if (t < seg_lo || t >= seg_hi) v = make_uint2(0u, 0u);
    raw[i] = v;
  }
}
constexpr int S_LD = 136;
DI void ssd_local_unit(const Params& P, const WS& W, int l, int b, int c, int g, int h_lo, int h_hi, unsigned char* lds) {
  const int tid = fresh_tid(), lane = tid & 63, w = tid >> 6;
  u16* BsT = (u16*)lds;
  u16* Bs = (u16*)(lds + 34816);
  u16* Cs = (u16*)(lds + 69632);
  u16* xT = (u16*)(lds + 34816);
  u16* xsF = (u16*)(lds + 52224);
  u16* xsB = (u16*)(lds + 69632);
  float* cumF = (float*)(lds + 104448);
  float* cumB = cumF + 512;
  float* dtF = cumB + 512;
  float* dtB = dtF + 512;
  const size_t Rc0 = (size_t)b * TT + c * 128;
  const int seg_lo = (c < 2) ? 0 : 256;
  const int seg_hi = (c < 2) ? 256 : TT;
  const float* conv_w = P.in[9] + (size_t)l * 5 * 1024;
  const float* conv_b = P.in[10] + (size_t)l * 1024;
  const int cqB = lane;
  const bool isB = cqB < 32;
  const int ch0 = isB ? 4 * cqB : 4 * (cqB - 32);
  float4 wjB[5];
  float4 biasB;
  uint2 rawB[20];
  {
    const int col = (isB ? 512 : 768) + g * 128 + ch0;
#pragma unroll
    for (int j = 0; j < 5; ++j) wjB[j] = *(const float4*)(conv_w + j * 1024 + col);
    biasB = *(const float4*)(conv_b + col);
    const u16* src = W.XBC + (size_t)b * TT * 1024 + col;
    const int tb = c * 128 + 16 * w;
#pragma unroll
    for (int i = 0; i < 20; ++i) {
      const int t = tb - 2 + i;
      const int tc = min(max(t, seg_lo), seg_hi - 1);
      uint2 v = *(const uint2*)(src + (size_t)tc * 1024);
      if (t < seg_lo || t >= seg_hi) v = make_uint2(0u, 0u);
      rawB[i] = v;
    }
  }
  uint2 xraw[8];
  ssd_xload(xraw, W.XBC + (size_t)b * TT * 1024 + (g * 4 + h_lo) * 64 + 4 * (tid & 15), c * 128 + 4 * (tid >> 4), seg_lo, seg_hi);
  float4 xw[5], xbias;
  {
    const int col = (g * 4 + h_lo) * 64 + 4 * (tid & 15);
#pragma unroll
    for (int j = 0; j < 5; ++j) xw[j] = *(const float4*)(conv_w + j * 1024 + col);
    xbias = *(const float4*)(conv_b + col);
  }
  {
    const int hh = w & 3, dir = w >> 2, hg = g * 4 + hh;
    const float a = -__expf((dir ? P.in[12] : P.in[11])[l * 8 + hg]);
    const float d0 = W.DT[(Rc0 + 2 * lane) * 16 + dir * 8 + hg];
    const float d1 = W.DT[(Rc0 + 2 * lane + 1) * 16 + dir * 8 + hg];
    const float a0 = d0 * a, a1 = d1 * a;
    float v = a0 + a1;
    float c0, c1;
    if (dir == 0) {
#pragma unroll
      for (int d = 1; d < 64; d <<= 1) { const float t = __shfl_up(v, d); if (lane >= d) v += t; }
      c0 = v - a1; c1 = v;
    } else {
#pragma unroll
      for (int d = 1; d < 64; d <<= 1) { const float t = __shfl_down(v, d); if (lane + d < 64) v += t; }
      c0 = v; c1 = v - a0;
    }
    float* lc = cumF + dir * 512 + hh * 128 + 2 * lane;
    lc[0] = c0; lc[1] = c1;
    lc[1024] = d0; lc[1025] = d1;
    float* gc = W.cumF + (size_t)dir * ((size_t)RR * 8) + (Rc0 + 2 * lane) * 8 + hg;
    gc[0] = c0; gc[8] = c1;
  }
  {
    float y[4][16];
#pragma unroll
    for (int s2 = 0; s2 < 16; ++s2) {
      float a0 = biasB.x, a1 = biasB.y, a2 = biasB.z, a3 = biasB.w;
#pragma unroll
      for (int j = 0; j < 5; ++j) {
        const uint2 v = rawB[s2 + j];
        a0 += wjB[j].x * bflo(v.x); a1 += wjB[j].y * bfhi(v.x); a2 += wjB[j].z * bflo(v.y); a3 += wjB[j].w * bfhi(v.y);
      }
      y[0][s2] = silu(a0); y[1][s2] = silu(a1); y[2][s2] = silu(a2); y[3][s2] = silu(a3);
    }
    const int s0 = 16 * w;
    if (isB) {
#pragma unroll
      for (int s2 = 0; s2 < 16; ++s2) {
        uint2 o; o.x = pk(y[0][s2], y[1][s2]); o.y = pk(y[2][s2], y[3][s2]);
        *(uint2*)&Bs[(s0 + s2) * S_LD + ch0] = o;
      }
#pragma unroll
      for (int ch = 0; ch < 4; ++ch) {
        uint4 u0, u1;
        u0.x = pk(y[ch][0], y[ch][1]); u0.y = pk(y[ch][2], y[ch][3]); u0.z = pk(y[ch][4], y[ch][5]); u0.w = pk(y[ch][6], y[ch][7]);
        u1.x = pk(y[ch][8], y[ch][9]); u1.y = pk(y[ch][10], y[ch][11]); u1.z = pk(y[ch][12], y[ch][13]); u1.w = pk(y[ch][14], y[ch][15]);
        *(uint4*)&BsT[(ch0 + ch) * S_LD + s0] = u0;
        *(uint4*)&BsT[(ch0 + ch) * S_LD + s0 + 8] = u1;
      }
    } else {
#pragma unroll
      for (int s2 = 0; s2 < 16; ++s2) {
        uint2 o; o.x = pk(y[0][s2], y[1][s2]); o.y = pk(y[2][s2], y[3][s2]);
        *(uint2*)&Cs[(s0 + s2) * S_LD + ch0] = o;
        *(uint2*)(W.Cc + (Rc0 + s0 + s2) * 256 + g * 128 + ch0) = o;
      }
    }
  }
  __syncthreads();
  const int c16 = lane & 15, q = lane >> 4;
  f32x4 G[8];
#pragma unroll
  for (int st = 0; st < 8; ++st) G[st] = (f32x4){0.f, 0.f, 0.f, 0.f};
#pragma unroll
  for (int ks = 0; ks < 4; ++ks) {
    const bf16x8 bfrag = *(const bf16x8*)&Cs[(16 * w + c16) * S_LD + 32 * ks + 8 * q];
#pragma unroll
    for (int st = 0; st < 8; ++st) {
      const bf16x8 afrag = *(const bf16x8*)&Bs[(16 * st + c16) * S_LD + 32 * ks + 8 * q];
      G[st] = MFMA16(afrag, bfrag, G[st]);
    }
  }
  __syncthreads();
  for (int hh = h_lo; hh < h_hi; ++hh) {
    const int hg = g * 4 + hh;
    {
      const int cq = tid & 15, tg = tid >> 4;
      const int col = hg * 64 + 4 * cq;
      float4 wj[5];
#pragma unroll
      for (int j = 0; j < 5; ++j) wj[j] = xw[j];
      const float4 bias = xbias;
      (void)col;
      const float cF_end = cumF[hh * 128 + 127], cB_end = cumB[hh * 128];
      float y[4][4], ff[4], fb[4];
#pragma unroll
      for (int s2 = 0; s2 < 4; ++s2) {
        float a0 = bias.x, a1 = bias.y, a2 = bias.z, a3 = bias.w;
#pragma unroll
        for (int j = 0; j < 5; ++j) {
          const uint2 v = xraw[s2 + j];
          a0 += wj[j].x * bflo(v.x); a1 += wj[j].y * bfhi(v.x); a2 += wj[j].z * bflo(v.y); a3 += wj[j].w * bfhi(v.y);
        }
        y[0][s2] = silu(a0); y[1][s2] = silu(a1); y[2][s2] = silu(a2); y[3][s2] = silu(a3);
        const int sI = 4 * tg + s2;
        ff[s2] = dtF[hh * 128 + sI] * __expf(cF_end - cumF[hh * 128 + sI]);
        fb[s2] = dtB[hh * 128 + sI] * __expf(cB_end - cumB[hh * 128 + sI]);
      }
#pragma unroll
      for (int ch = 0; ch < 4; ++ch) {
        const int p = 4 * cq + ch;
        uint2 o;
        o.x = pk(y[ch][0], y[ch][1]); o.y = pk(y[ch][2], y[ch][3]);
        *(uint2*)&xT[p * S_LD + 4 * tg] = o;
        o.x = pk(y[ch][0] * ff[0], y[ch][1] * ff[1]); o.y = pk(y[ch][2] * ff[2], y[ch][3] * ff[3]);
        *(uint2*)&xsF[p * S_LD + 4 * tg] = o;
        o.x = pk(y[ch][0] * fb[0], y[ch][1] * fb[1]); o.y = pk(y[ch][2] * fb[2], y[ch][3] * fb[3]);
        *(uint2*)&xsB[p * S_LD + 4 * tg] = o;
      }
      if (hh + 1 < h_hi) {
        ssd_xload(xraw, W.XBC + (size_t)b * TT * 1024 + (hg + 1) * 64 + 4 * cq, c * 128 + 4 * tg, seg_lo, seg_hi);
        const int coln = (hg + 1) * 64 + 4 * cq;
#pragma unroll
        for (int j = 0; j < 5; ++j) xw[j] = *(const float4*)(conv_w + j * 1024 + coln);
        xbias = *(const float4*)(conv_b + coln);
      }
    }
    __syncthreads();
    {
      const int t = 16 * w + c16;
      const float cF_t = cumF[hh * 128 + t], cB_t = cumB[hh * 128 + t];
      const float Dh = P.in[15][l * 8 + hg];
      f32x4 Y[4];
#pragma unroll
      for (int pt = 0; pt < 4; ++pt) Y[pt] = (f32x4){0.f, 0.f, 0.f, 0.f};
#pragma unroll
      for (int m = 0; m < 4; ++m) {
        __builtin_amdgcn_sched_barrier(0);
        float mv[8];
#pragma unroll
        for (int jj = 0; jj < 2; ++jj) {
          const int st = 2 * m + jj;
          const int sb = 16 * st + 4 * q;
          const float4 cf4 = *(const float4*)&cumF[hh * 128 + sb];
          const float4 df4 = *(const float4*)&dtF[hh * 128 + sb];
          const float4 cb4 = *(const float4*)&cumB[hh * 128 + sb];
          const float4 db4 = *(const float4*)&dtB[hh * 128 + sb];
          const float cfv[4] = {cf4.x, cf4.y, cf4.z, cf4.w}, dfv[4] = {df4.x, df4.y, df4.z, df4.w};
          const float cbv[4] = {cb4.x, cb4.y, cb4.z, cb4.w}, dbv[4] = {db4.x, db4.y, db4.z, db4.w};
#pragma unroll
          for (int i = 0; i < 4; ++i) {
            const int s = sb + i;
            const float ef = (s <= t) ? __expf(cF_t - cfv[i]) * dfv[i] : 0.f;
            const float eb = (s >= t) ? __expf(cB_t - cbv[i]) * dbv[i] : 0.f;
            mv[4 * jj + i] = G[st][i] * (ef + eb) + ((s == t) ? Dh : 0.f);
          }
        }
        uint4 mu;
        mu.x = pk(mv[0], mv[1]); mu.y = pk(mv[2], mv[3]); mu.z = pk(mv[4], mv[5]); mu.w = pk(mv[6], mv[7]);
        const bf16x8 Mf = __builtin_bit_cast(bf16x8, mu);
#pragma unroll
        for (int pt = 0; pt < 4; ++pt) {
          const u16* xp = xT + (16 * pt + c16) * S_LD + 32 * m + 4 * q;
          s16x4 lo = *(const s16x4*)xp;
          s16x4 hi = *(const s16x4*)(xp + 16);
          const bf16x8 af = __builtin_shufflevector(lo, hi, 0, 1, 2, 3, 4, 5, 6, 7);
          Y[pt] = MFMA16(af, Mf, Y[pt]);
        }
      }
#pragma unroll
      for (int pt = 0; pt < 4; ++pt) {
        uint2 o;
        o.x = pk(Y[pt][0], Y[pt][1]); o.y = pk(Y[pt][2], Y[pt][3]);
        *(uint2*)(W.Ycat + (Rc0 + t) * 1024 + hg * 64 + 16 * pt + 4 * q) = o;
      }
    }
#pragma unroll
    for (int dir = 0; dir < 2; ++dir) {
      const u16* xs = dir ? xsB : xsF;
      f32x4 acc[4];
#pragma unroll
      for (int pt = 0; pt < 4; ++pt) acc[pt] = (f32x4){0.f, 0.f, 0.f, 0.f};
#pragma unroll
      for (int ks = 0; ks < 4; ++ks) {
        const bf16x8 af = *(const bf16x8*)&BsT[(16 * w + c16) * S_LD + 32 * ks + 8 * q];
#pragma unroll
        for (int pt = 0; pt < 4; ++pt) {
          const bf16x8 bfr = *(const bf16x8*)&xs[(16 * pt + c16) * S_LD + 32 * ks + 8 * q];
          acc[pt] = MFMA16(af, bfr, acc[pt]);
        }
      }
      u16* dst = W.Sloc + ((((size_t)dir * 8 + b) * 18 + c) * 8 + hg) * 8192;
#pragma unroll
      for (int pt = 0; pt < 4; ++pt) {
        uint2 o;
        o.x = pk(acc[pt][0], acc[pt][1]); o.y = pk(acc[pt][2], acc[pt][3]);
        *(uint2*)(dst + (16 * pt + c16) * 128 + 16 * w + 4 * q) = o;
      }
    }
    __syncthreads();
  }
}

DI void ws_init(WS& W, unsigned char* ws) {
        W.WinT = (u16*)(ws + OFF_WIN); W.WoutT = (u16*)(ws + OFF_WOUT); W.mod = (float*)(ws + OFF_MOD);
    W.ropeG = (float2*)(ws + OFF_ROPE); W.ropeD = (float2*)(ws + OFF_ROPE + 8192);
    W.U = (u16*)(ws + OFF_U); W.Ycat = (u16*)(ws + OFF_U); W.XBC = (u16*)(ws + OFF_XBC); W.Obuf = (u16*)(ws + OFF_XBC);
    W.Z = (u16*)(ws + OFF_Z); W.DT = (float*)(ws + OFF_DT);
    W.Q = (u16*)(ws + OFF_Q); W.K = (u16*)(ws + OFF_K); W.Vt = (u16*)(ws + OFF_VT);
    W.DQ = (u16*)(ws + OFF_DQ); W.DK = (u16*)(ws + OFF_DK); W.DVt = (u16*)(ws + OFF_DVT); W.Stin = (u16*)(ws + OFF_Q);
    W.GG = (u16*)(ws + OFF_GG); W.DG = (u16*)(ws + OFF_DG); W.Cc = (u16*)(ws + OFF_CC);
    W.cumF = (float*)(ws + OFF_CUMF); W.cumB = (float*)(ws + OFF_CUMB); W.Sloc = (u16*)(ws + OFF_SLOC);
    W.Opart = (float*)(ws + OFF_OPART);
}

#define XCD_LOOP(UPX, xcd, idx) \
  const bool sw_ = (nb & 7) == 0; \
  for (int t_ = sw_ ? (bid >> 3) : bid; t_ < (sw_ ? (UPX) : 8 * (UPX)); t_ += (sw_ ? (nb >> 3) : nb)) { \
    const int xcd = sw_ ? (bid & 7) : t_ / (UPX); const int idx = sw_ ? t_ : t_ % (UPX);
#define XCD_END }

typedef const Params __attribute__((address_space(4)))* KArgP;
DI Params load_params(KArgP kp) {
  asm volatile("" : "+s"(kp));
  Params P;
#pragma unroll
  for (int i = 0; i < 22; ++i) P.in[i] = kp->in[i];
  P.out = kp->out; P.ws = kp->ws;
  return P;
}

DI void w_transpose_unit(const Params& P, const WS& W, unsigned char* lds, int u) {
  const int tid = fresh_tid();
  constexpr int U_WIN = 2 * 14 * 16;
        const float* src; u16* dst; int ldn, n0, k0, nrows; bool inproj;
        if (u < U_WIN) {
          const int l = u / (14 * 16), rem = u % (14 * 16);
          n0 = (rem >> 4) * 256; k0 = (rem & 15) * 64; ldn = 3344; inproj = true; nrows = NPAD;
          src = P.in[8] + (size_t)l * 1024 * 3344; dst = W.WinT + (size_t)l * NPAD * 1024;
        } else {
          const int v = u - U_WIN; const int l = v >> 6, rem = v & 63;
          n0 = (rem >> 4) * 256; k0 = (rem & 15) * 64; ldn = 1024; inproj = false; nrows = 1024;
          src = P.in[21] + (size_t)l * 1024 * 1024; dst = W.WoutT + (size_t)l * 1024 * 1024;
        }
        float* tile = (float*)lds;
        {
          const int n = tid & 63, kq = tid >> 6;
#pragma unroll
          for (int sub = 0; sub < 4; ++sub) {
            const int nd = n0 + sub * 64 + n;
            int ns = nd;
            if (inproj) { ns = (nd < 1536) ? nd : (nd < 3328 ? nd + 16 : (nd < 3344 ? nd - 3328 + 1536 : -1)); }
#pragma unroll
            for (int i = 0; i < 8; ++i) {
              const int k = kq * 8 + i;
              tile[sub * 4160 + k * 65 + n] = (ns >= 0) ? src[(size_t)(k0 + k) * ldn + ns] : 0.f;
            }
          }
        }
        __syncthreads();
        {
          const int n = tid >> 3, kc = tid & 7;
#pragma unroll
          for (int sub = 0; sub < 4; ++sub) {
            float f[8];
#pragma unroll
            for (int i = 0; i < 8; ++i) f[i] = tile[sub * 4160 + (kc * 8 + i) * 65 + n];
            uint4 o;
            o.x = pk(f[0], f[1]); o.y = pk(f[2], f[3]); o.z = pk(f[4], f[5]); o.w = pk(f[6], f[7]);
            if (n0 + sub * 64 + n < nrows) *(uint4*)(dst + (size_t)(n0 + sub * 64 + n) * 1024 + k0 + kc * 8) = o;
          }
        }
        __syncthreads();
}

DI void ph0_prologue(KArgP kp, unsigned char* lds) {
  const Params P = load_params(kp); WS W; ws_init(W, P.ws);
  const int tid = fresh_tid(), lane = tid & 63, w = tid >> 6;
  const int nb = gridDim.x, bid = blockIdx.x;
  (void)lane; (void)w; (void)tid;
  {
    float* S = (float*)(lds + 69632);
    for (int i = tid; i < 9 * 1024; i += NT) {
      const float x = (i < 8192) ? P.in[1][i] : P.in[3][i - 8192];
      S[i] = silu(x);
    }
    __syncthreads();
    constexpr int U_WIN = 2 * 14 * 16, U_WOUT = 2 * 4 * 16, U_MOD = 384;
    for (int u = U_WIN + U_WOUT + bid; u < U_WIN + U_WOUT + U_MOD + 1; u += nb) {
      if (u < U_WIN + U_WOUT) {
      } else if (u < U_WIN + U_WOUT + U_MOD) {
        const int v = u - U_WIN - U_WOUT;
        const int l = v / 192, n0 = (v % 192) * 16;
        const int c16 = tid & 15, kg = tid >> 4;
        const float* wm = P.in[4] + (size_t)l * 1024 * 3072 + n0 + c16;
        float acc[9];
#pragma unroll
        for (int rr = 0; rr < 9; ++rr) acc[rr] = 0.f;
#pragma unroll 8
        for (int kk = 0; kk < 32; ++kk) {
          const int k = kg * 32 + kk;
          const float wv = wm[(size_t)k * 3072];
#pragma unroll
          for (int rr = 0; rr < 9; ++rr) acc[rr] += S[rr * 1024 + k] * wv;
        }
        float* red = (float*)lds;
#pragma unroll
        for (int rr = 0; rr < 9; ++rr) red[(kg * 16 + c16) * 9 + rr] = acc[rr];
        __syncthreads();
        if (tid < 144) {
          const int cc = tid / 9, rr = tid % 9;
          float s = 0.f;
          for (int k2 = 0; k2 < 32; ++k2) s += red[(k2 * 16 + cc) * 9 + rr];
          W.mod[((size_t)l * 9 + rr) * 3072 + n0 + cc] = s + P.in[5][l * 3072 + n0 + cc];
        }
        __syncthreads();
      } else {
        for (int i = tid; i < 64 * 16; i += NT) {
          const int idx = i >> 4, k = i & 15;
          const float inv = powf(10000.f, -(float)k / 16.f);
          float sn, cs; sincosf((float)idx * inv, &sn, &cs);
          W.ropeG[i] = make_float2(cs, sn);
        }
        for (int i = tid; i < 64 * 8; i += NT) {
          const int idx = i >> 3, k = i & 7;
          const float inv = powf(10000.f, -(float)k / 8.f);
          float sn, cs; sincosf((float)idx * inv, &sn, &cs);
          W.ropeD[i] = make_float2(cs, sn);
        }
      }
    }
  }
}

DI void ph1_prep(KArgP kp, unsigned char* lds) {
  const Params P = load_params(kp); WS W; ws_init(W, P.ws);
  const int tid = fresh_tid(), lane = tid & 63, w = tid >> 6;
  const int nb = gridDim.x, bid = blockIdx.x;
  (void)lane; (void)w; (void)tid;
  XCD_LOOP(288, xcd, idx)
    const int R = xcd * TT + idx * 8 + w;
    const int b = xcd, t = idx * 8 + w;
    const float* src = (t < 256) ? (P.in[2] + ((size_t)b * 256 + t) * 1024) : (P.in[0] + ((size_t)b * 2048 + (t - 256)) * 1024);
    const float* md = W.mod + (size_t)((t < 256) ? 8 : b) * 3072;
    const float* gp = P.in[6];
    float4 x[4];
    float ss = 0.f;
#pragma unroll
    for (int i = 0; i < 4; ++i) {
      x[i] = *(const float4*)(src + i * 256 + lane * 4);
      ss += x[i].x * x[i].x + x[i].y * x[i].y + x[i].z * x[i].z + x[i].w * x[i].w;
    }
#pragma unroll
    for (int d = 32; d >= 1; d >>= 1) ss += __shfl_xor(ss, d);
    const float rn = rsqrtf(ss * (1.f / 1024.f) + EPS);
#pragma unroll
    for (int i = 0; i < 4; ++i) {
      const int k = i * 256 + lane * 4;
      const float4 g4 = *(const float4*)(gp + k);
      const float4 sh = *(const float4*)(md + k);
      const float4 sc = *(const float4*)(md + 1024 + k);
      uint2 o;
      o.x = pk(x[i].x * rn * g4.x * (1.f + sc.x) + sh.x, x[i].y * rn * g4.y * (1.f + sc.y) + sh.y);
      o.y = pk(x[i].z * rn * g4.z * (1.f + sc.z) + sh.z, x[i].w * rn * g4.w * (1.f + sc.w) + sh.w);
      *(uint2*)(W.U + (size_t)R * 1024 + k) = o;
    }
  XCD_END
  for (int u = bid; u < 2 * 14 * 16 + 2 * 4 * 16; u += nb) w_transpose_unit(P, W, lds, u);
}

DI void ph2_inproj(KArgP kp, int l, unsigned char* lds) {
  const Params P = load_params(kp); WS W; ws_init(W, P.ws);
  const int tid = fresh_tid();
  const int nb = gridDim.x, bid = blockIdx.x;
  XCD_LOOP(243, xcd, idx)
    const int nt = idx / 9, mt = xcd * 9 + idx % 9;
    gemm_tile_to_lds(W.U, W.WinT + (size_t)l * NPAD * 1024, mt * 256, nt * 128, lds);
    if (nt == 15 || nt == 22 || nt == 23) {
      const int b = mt / 9, t0 = (mt - b * 9) * 256;
      u16* vt = (nt == 15) ? (W.Vt + (size_t)(b * 2) * 64 * TT) : (W.DVt + (size_t)(b * 4 + (nt - 22) * 2) * 64 * TT);
      store_tile_transposed(lds, vt, t0);
    } else {
      float v[64];
      load_row64(lds, v);
      inproj_epi(P, W, l, mt * 256 + (tid >> 1), nt, tid & 1, v);
    }
    __syncthreads();
  XCD_END
}

DI void ph3_mix(KArgP kp, int l, unsigned char* lds) {
  const Params P = load_params(kp); WS W; ws_init(W, P.ws);
  const int nb = gridDim.x, bid = blockIdx.x;
  const int upx = (l == 0) ? 120 : 112;
  XCD_LOOP(upx, xcd, idx)
    const int b = xcd;
    if (idx < 32) {
      diff_unit(P, W, l, b, idx >> 3, 1 + (idx & 7), lds);
    } else if (idx < 64) {
      gqa_unit(W, P.in[17] + l * 64, P.in[18] + l * 64, b, (idx - 32) >> 3, 1 + (idx & 7), lds);
    } else if (idx < 96) {
      const int v = idx - 64;
      ssd_local_unit(P, W, l, b, v >> 1, v & 1, 0, 4, lds);
    } else if (idx < 112) {
      const int v = idx - 96, u = 32 + (v >> 2), hq = v & 3;
      ssd_local_unit(P, W, l, b, u >> 1, u & 1, hq, hq + 1, lds);
    } else if (idx < 116) {
      diff_unit(P, W, l, b, idx - 112, 0, lds);
    } else {
      gqa_unit(W, P.in[17] + l * 64, P.in[18] + l * 64, b, idx - 116, 0, lds);
    }
    __syncthreads();
  XCD_END
}

DI void ph4a_states(KArgP kp) {
  const Params P = load_params(kp); WS W; ws_init(W, P.ws);
  const int tid = fresh_tid(), lane = tid & 63, w = tid >> 6;
  const int nb = gridDim.x, bid = blockIdx.x;
  (void)lane; (void)w; (void)tid;
    XCD_LOOP(64, xcd, idx)
      const int gid = idx * NT + tid;
      const int e4 = gid & 2047, hg = (gid >> 11) & 7, b = xcd, dir = gid >> 14;
      float s0 = 0.f, s1 = 0.f, s2 = 0.f, s3 = 0.f;
      for (int step = 0; step < 18; ++step) {
        const int c = dir ? (step == 0 ? 1 : (step == 1 ? 0 : 19 - step)) : step;
        const size_t idx = ((((size_t)dir * 8 + b) * 18 + c) * 8 + hg) * 8192 + (size_t)e4 * 4;
        uint2 o;
        o.x = pk(s0, s1); o.y = pk(s2, s3);
        *(uint2*)(W.Stin + idx) = o;
        const float tot = W.cumF[(size_t)dir * ((size_t)RR * 8) + ((size_t)b * TT + c * 128 + (dir ? 0 : 127)) * 8 + hg];
        const float dec = __expf(tot);
        const uint2 sv = *(const uint2*)(W.Sloc + idx);
        s0 = s0 * dec + bflo(sv.x); s1 = s1 * dec + bfhi(sv.x);
        s2 = s2 * dec + bflo(sv.y); s3 = s3 * dec + bfhi(sv.y);
      }
    XCD_END
}

DI void ph4b_yoff(KArgP kp, int l, unsigned char* lds) {
  const Params P = load_params(kp); WS W; ws_init(W, P.ws);
  const int tid = fresh_tid(), lane = tid & 63, w = tid >> 6;
  const int nb = gridDim.x, bid = blockIdx.x;
  (void)lane; (void)w; (void)tid;
    XCD_LOOP((l == 0 ? 72 : 64), xcd, idx)
      const int b = xcd, c = (idx >> 2) + (l == 0 ? 0 : 2), tb = idx & 3;
      const int r = lane & 31, h2 = lane >> 5;
      const int hg = w, g = w >> 2;
      const size_t Rr = (size_t)b * TT + c * 128 + 32 * tb + r;
      f32x16 acc[2][2];
#pragma unroll
      for (int d = 0; d < 2; ++d)
#pragma unroll
        for (int pt = 0; pt < 2; ++pt)
#pragma unroll
          for (int e = 0; e < 16; ++e) acc[d][pt][e] = 0.f;
      const u16* cp = W.Cc + Rr * 256 + g * 128 + 8 * h2;
      bf16x8 bfr[8];
#pragma unroll
      for (int ks = 0; ks < 8; ++ks) bfr[ks] = *(const bf16x8*)(cp + 16 * ks);
      u16* myl = (u16*)lds + w * (64 * 136);
#pragma unroll
      for (int d = 0; d < 2; ++d) {
        const u16* sp = W.Stin + ((((size_t)d * 8 + b) * 18 + c) * 8 + hg) * 8192 + lane * 8;
        u32x4 sv[16];
#pragma unroll
        for (int i = 0; i < 16; ++i) sv[i] = *(const u32x4*)(sp + i * 512);
#pragma unroll
        for (int i = 0; i < 16; ++i) *(u32x4*)(myl + (4 * i + (lane >> 4)) * 136 + (lane & 15) * 8) = sv[i];
        __builtin_amdgcn_wave_barrier();
#pragma unroll
        for (int ks = 0; ks < 8; ++ks) {
          const bf16x8 f0 = *(const bf16x8*)(myl + r * 136 + 16 * ks + 8 * h2);
          const bf16x8 f1 = *(const bf16x8*)(myl + (32 + r) * 136 + 16 * ks + 8 * h2);
          acc[d][0] = MFMA32(f0, bfr[ks], acc[d][0]);
          acc[d][1] = MFMA32(f1, bfr[ks], acc[d][1]);
        }
        __builtin_amdgcn_wave_barrier();
      }
      const float eF = __expf(W.cumF[Rr * 8 + hg]), eB = __expf(W.cumB[Rr * 8 + hg]);
      float ss = 0.f;
#pragma unroll
      for (int pt = 0; pt < 2; ++pt)
#pragma unroll
        for (int i4 = 0; i4 < 4; ++i4) {
          const int p = 32 * pt + 8 * i4 + 4 * h2;
          const uint2 yd = *(const uint2*)(W.Ycat + Rr * 1024 + hg * 64 + p);
          const uint2 zz = *(const uint2*)(W.Z + Rr * 512 + hg * 64 + p);
          float y0 = bflo(yd.x) + eF * acc[0][pt][4 * i4] + eB * acc[1][pt][4 * i4];
          float y1 = bfhi(yd.x) + eF * acc[0][pt][4 * i4 + 1] + eB * acc[1][pt][4 * i4 + 1];
          float y2 = bflo(yd.y) + eF * acc[0][pt][4 * i4 + 2] + eB * acc[1][pt][4 * i4 + 2];
          float y3 = bfhi(yd.y) + eF * acc[0][pt][4 * i4 + 3] + eB * acc[1][pt][4 * i4 + 3];
          y0 *= silu(bflo(zz.x)); y1 *= silu(bfhi(zz.x)); y2 *= silu(bflo(zz.y)); y3 *= silu(bfhi(zz.y));
          acc[0][pt][4 * i4] = y0; acc[0][pt][4 * i4 + 1] = y1; acc[0][pt][4 * i4 + 2] = y2; acc[0][pt][4 * i4 + 3] = y3;
          ss += y0 * y0 + y1 * y1 + y2 * y2 + y3 * y3;
        }
      ss += __shfl_xor(ss, 32);
      float* red = (float*)(lds + 8 * 64 * 136 * 2);
      if (h2 == 0) red[w * 32 + r] = ss;
      __syncthreads();
      float tot = 0.f;
#pragma unroll
      for (int k = 0; k < 8; ++k) tot += red[k * 32 + r];
      const float rn = rsqrtf(tot * (1.f / 512.f) + EPS);
      const float* ng = P.in[16] + l * 512 + hg * 64;
#pragma unroll
      for (int pt = 0; pt < 2; ++pt)
#pragma unroll
        for (int i4 = 0; i4 < 4; ++i4) {
          const int p = 32 * pt + 8 * i4 + 4 * h2;
          const float4 n4 = *(const float4*)(ng + p);
          uint2 o;
          o.x = pk(acc[0][pt][4 * i4] * rn * n4.x, acc[0][pt][4 * i4 + 1] * rn * n4.y);
          o.y = pk(acc[0][pt][4 * i4 + 2] * rn * n4.z, acc[0][pt][4 * i4 + 3] * rn * n4.w);
          *(uint2*)(W.Ycat + Rr * 1024 + hg * 64 + p) = o;
        }
      __syncthreads();
    XCD_END
}

DI void ph5_outproj(KArgP kp, int l, unsigned char* lds) {
  const Params P = load_params(kp); WS W; ws_init(W, P.ws);
  const int tid = fresh_tid();
  const int nb = gridDim.x, bid = blockIdx.x;
  const int upx = (l == 0) ? 72 : 64;
  XCD_LOOP(upx, xcd, idx)
    const int mt = xcd * 9 + (idx >> 3) + (l == 0 ? 0 : 1), nt = idx & 7;
    gemm_tile_to_lds(W.Ycat, W.WoutT + (size_t)l * 1024 * 1024, mt * 256, nt * 128, lds);
    float v[64];
    load_row64(lds, v);
    const size_t R = (size_t)mt * 256 + (tid >> 1);
    float ss = 0.f;
#pragma unroll
    for (int j = 0; j < 64; ++j) ss += v[j] * v[j];
    W.Opart[R * 16 + nt * 2 + (tid & 1)] = ss;
    store64(W.Obuf + R * 1024 + nt * 128 + (tid & 1) * 64, v);
    __syncthreads();
  XCD_END
}

DI void ph6_post(KArgP kp, int l) {
  const Params P = load_params(kp); WS W; ws_init(W, P.ws);
  const int tid = fresh_tid(), lane = tid & 63, w = tid >> 6;
  const int nb = gridDim.x, bid = blockIdx.x;
  (void)lane; (void)w; (void)tid;
    XCD_LOOP(288, xcd, idx)
      const int R = xcd * TT + idx * 8 + w;
      const int b = xcd, t = idx * 8 + w;
      const bool isctx = t < 256;
      if (l == 1 && isctx) continue;
      const float* md = W.mod + ((size_t)l * 9 + (isctx ? 8 : b)) * 3072;
      const float* hsrc = isctx ? (P.in[2] + ((size_t)b * 256 + t) * 1024) : (P.in[0] + ((size_t)b * 2048 + (t - 256)) * 1024);
      u16* hb = (u16*)(P.ws + OFF_HB) + ((size_t)b * 2048 + (t - 256)) * 1024;
      float pss = (lane < 16) ? W.Opart[(size_t)R * 16 + lane] : 0.f;
#pragma unroll
      for (int d = 8; d >= 1; d >>= 1) pss += __shfl_xor(pss, d);
      pss = __shfl(pss, 0);
      const float rn = rsqrtf(pss * (1.f / 1024.f) + EPS);
      const float* gpost = P.in[7] + l * 1024;
      float4 hn[4];
      float ss = 0.f;
#pragma unroll
      for (int i = 0; i < 4; ++i) {
        const int k = i * 256 + lane * 4;
        float4 hv;
        if (l == 0) { const f32x4 t_ = __builtin_nontemporal_load((const f32x4*)(hsrc + k)); hv = make_float4(t_[0], t_[1], t_[2], t_[3]); }
        else { const u32x2 hu = __builtin_nontemporal_load((const u32x2*)(hb + k)); hv = make_float4(bflo(hu[0]), bfhi(hu[0]), bflo(hu[1]), bfhi(hu[1])); }
        const u32x2 ov_ = __builtin_nontemporal_load((const u32x2*)(W.Obuf + (size_t)R * 1024 + k));
        const uint2 ov = make_uint2(ov_[0], ov_[1]);
        const float4 g4 = *(const float4*)(gpost + k);
        const float4 gt = *(const float4*)(md + 2048 + k);
        hn[i].x = hv.x + gt.x * (bflo(ov.x) * rn * g4.x);
        hn[i].y = hv.y + gt.y * (bfhi(ov.x) * rn * g4.y);
        hn[i].z = hv.z + gt.z * (bflo(ov.y) * rn * g4.z);
        hn[i].w = hv.w + gt.w * (bfhi(ov.y) * rn * g4.w);
        ss += hn[i].x * hn[i].x + hn[i].y * hn[i].y + hn[i].z * hn[i].z + hn[i].w * hn[i].w;
      }
      if (!isctx) {
        if (l == 0) {
#pragma unroll
          for (int i = 0; i < 4; ++i) {
            uint2 o; o.x = pk(hn[i].x, hn[i].y); o.y = pk(hn[i].z, hn[i].w);
            *(uint2*)(hb + i * 256 + lane * 4) = o;
          }
        } else {
          float* dst = P.out + ((size_t)b * 2048 + (t - 256)) * 1024;
#pragma unroll
          for (int i = 0; i < 4; ++i) { const f32x4 t_ = {hn[i].x, hn[i].y, hn[i].z, hn[i].w}; __builtin_nontemporal_store(t_, (f32x4*)(dst + i * 256 + lane * 4)); }
        }
      }
      if (l == 0) {
#pragma unroll
        for (int d = 32; d >= 1; d >>= 1) ss += __shfl_xor(ss, d);
        const float r2 = rsqrtf(ss * (1.f / 1024.f) + EPS);
        const float* md1 = W.mod + ((size_t)9 + (isctx ? 8 : b)) * 3072;
        const float* gp = P.in[6] + 1024;
#pragma unroll
        for (int i = 0; i < 4; ++i) {
          const int k = i * 256 + lane * 4;
          const float4 g4 = *(const float4*)(gp + k);
          const float4 sh = *(const float4*)(md1 + k);
          const float4 sc = *(const float4*)(md1 + 1024 + k);
          uint2 o;
          o.x = pk(hn[i].x * r2 * g4.x * (1.f + sc.x) + sh.x, hn[i].y * r2 * g4.y * (1.f + sc.y) + sh.y);
          o.y = pk(hn[i].z * r2 * g4.z * (1.f + sc.z) + sh.z, hn[i].w * r2 * g4.w * (1.f + sc.w) + sh.w);
          *(uint2*)(W.U + (size_t)R * 1024 + k) = o;
        }
      }
    XCD_END
}


#define XB_TMO      128
#define XB_XCNT(j)  (256  + 64 * (j))
#define XB_XSUB(j)  (1280 + 64 * (j))
#define XB_XGEN(j)  (2304 + 64 * (j))
#define XB_TOP      3328
#define XB_TOPGEN   3392
#define XCD_BAR_WORDS 3456
#define XB_SPIN_CAP (1u << 18)
#define LAS __attribute__((address_space(3)))

__device__ __forceinline__ unsigned xb_ld(unsigned* p)              { return __hip_atomic_load(p, __ATOMIC_RELAXED, __HIP_MEMORY_SCOPE_AGENT); }
__device__ __forceinline__ unsigned xb_add(unsigned* p, unsigned v) { return __hip_atomic_fetch_add(p, v, __ATOMIC_RELAXED, __HIP_MEMORY_SCOPE_AGENT); }
__device__ __forceinline__ unsigned xb_xcc_id() { return (unsigned)__builtin_amdgcn_s_getreg((3 << 11) | 20) & 0xFu; }
#define XB_SPIN(cond, bar) do { unsigned _sp = 0; while (cond) { __builtin_amdgcn_s_sleep(1); \
    if ((++_sp & 255u) == 0u) { if (xb_ld(&(bar)[XB_TMO])) break; if (_sp > XB_SPIN_CAP) { atomicAdd(&(bar)[XB_TMO], 1u); break; } } } } while (0)

struct XcdBarrier {
    unsigned* bar; unsigned x;
    volatile LAS unsigned* st;
};

__device__ __forceinline__ XcdBarrier xcd_barrier_post(unsigned* bar, volatile LAS unsigned* st) {
    XcdBarrier b; b.bar = bar; b.x = xb_xcc_id(); b.st = st;
    if (threadIdx.x == 0) (void)xb_add(&bar[XB_XCNT(b.x)], 1u);
    return b;
}
__device__ __forceinline__ void xcd_barrier_complete(unsigned* bar, unsigned x, unsigned& nloc, unsigned& nx) {
    const unsigned G = gridDim.x * gridDim.y * gridDim.z;
    unsigned sum, cnt, mine, sp = 0u;
    for (;;) {
        sum = 0u; cnt = 0u; mine = 0u;
#pragma unroll
        for (unsigned j = 0; j < 16; ++j) { const unsigned c = xb_ld(&bar[XB_XCNT(j)]); sum += c; cnt += (c > 0u) ? 1u : 0u; mine = (j == x) ? c : mine; }
        if (sum == G) break;
        __builtin_amdgcn_s_sleep(1);
        if ((++sp & 255u) == 0u) { if (xb_ld(&bar[XB_TMO])) break; if (sp > XB_SPIN_CAP) { atomicAdd(&bar[XB_TMO], 1u); break; } }
    }
    nloc = mine > 0u ? mine : 1u; nx = cnt > 0u ? cnt : 1u;
}

__device__ __forceinline__ void xcd_barrier(const XcdBarrier& b) {
    asm volatile("s_waitcnt vmcnt(0)" ::: "memory");
    __syncthreads();
    if (threadIdx.x == 0) {
        unsigned* bar = b.bar;
        __builtin_amdgcn_s_waitcnt(0);
        unsigned nloc = b.st[0], nx = b.st[1];
        if (nloc == 0u) { xcd_barrier_complete(bar, b.x, nloc, nx); b.st[0] = nloc; b.st[1] = nx; }
        const unsigned old = xb_add(&bar[XB_XSUB(b.x)], 1u);
        const unsigned gen = old / nloc;
        if (old + 1u == (gen + 1u) * nloc) {
            __builtin_amdgcn_fence(__ATOMIC_RELEASE, "agent");
            asm volatile("s_waitcnt vmcnt(0)" ::: "memory");
            const unsigned og = xb_add(&bar[XB_TOP], 1u);
            const unsigned tg = og / nx;
            if (og + 1u == (tg + 1u) * nx) xb_add(&bar[XB_TOPGEN], 1u);
            else XB_SPIN(xb_ld(&bar[XB_TOPGEN]) == tg, bar);
            __builtin_amdgcn_fence(__ATOMIC_ACQUIRE, "agent");
            xb_add(&bar[XB_XGEN(b.x)], 1u);
            asm volatile("s_waitcnt vmcnt(0)" ::: "memory");
        } else {
            XB_SPIN(xb_ld(&bar[XB_XGEN(b.x)]) == gen, bar);
            __builtin_amdgcn_fence(__ATOMIC_ACQUIRE, "agent");
            asm volatile("s_waitcnt vmcnt(0)" ::: "memory");
        }
    }
    __syncthreads();
}

DI void grid_barrier(unsigned* bar, unsigned& epoch) {
  asm volatile("s_waitcnt vmcnt(0)" ::: "memory");
  __syncthreads();
  ++epoch;
  if (threadIdx.x == 0) {
    __builtin_amdgcn_fence(__ATOMIC_RELEASE, "agent");
    asm volatile("s_waitcnt vmcnt(0)" ::: "memory");
    const unsigned nb = gridDim.x, bid = blockIdx.x;
    const bool hier = (nb & 7u) == 0u;
    const unsigned ng = hier ? 8u : 1u, per = hier ? (nb >> 3) : nb;
    unsigned* grp = bar + 64 * (1 + (hier ? (bid & 7u) : 0u));
    const unsigned old = __hip_atomic_fetch_add(grp, 1u, __ATOMIC_RELAXED, __HIP_MEMORY_SCOPE_AGENT);
    if (old + 1u == epoch * per) __hip_atomic_fetch_add(bar, 1u, __ATOMIC_RELAXED, __HIP_MEMORY_SCOPE_AGENT);
    const unsigned target = epoch * ng;
    while (__hip_atomic_load(bar, __ATOMIC_RELAXED, __HIP_MEMORY_SCOPE_AGENT) < target) __builtin_amdgcn_s_sleep(1);
    __builtin_amdgcn_fence(__ATOMIC_ACQUIRE, "agent");
    asm volatile("s_waitcnt vmcnt(0)" ::: "memory");
  }
  __syncthreads();
}

__global__ void __launch_bounds__(NT) fwd_mega(Params Parg) {
  extern __shared__ __attribute__((aligned(16))) unsigned char lds[];
  cg::grid_group grid = cg::this_grid();
  KArgP kp = (KArgP)__builtin_amdgcn_kernarg_segment_ptr();
  unsigned* bar = (unsigned*)(Parg.ws + OFF_BAR);
  if (gridDim.x == 0x7fffffffu) grid.sync();
  volatile LAS unsigned* xst = (volatile LAS unsigned*)((LAS unsigned char*)lds + (LDS_BYTES - 64));
  if (threadIdx.x == 0) { xst[0] = 0u; xst[1] = 0u; }
  __syncthreads();
  const XcdBarrier xb = xcd_barrier_post(bar, xst);

  ph0_prologue(kp, lds);
  xcd_barrier(xb);

  ph1_prep(kp, lds);
  xcd_barrier(xb);

  for (int l = 0; l < 2; ++l) {
    ph2_inproj(kp, l, lds);
    xcd_barrier(xb);

    ph3_mix(kp, l, lds);
    xcd_barrier(xb);

    ph4a_states(kp);
    xcd_barrier(xb);

    ph4b_yoff(kp, l, lds);
    xcd_barrier(xb);

    ph5_outproj(kp, l, lds);
    xcd_barrier(xb);

    ph6_post(kp, l);
    if (l == 0) xcd_barrier(xb);
  }
}

extern "C" void kernel_launch(void* const* d_in, const int* in_sizes, int n_in,
                              void* d_out, int out_size, void* d_ws, size_t ws_size,
                              hipStream_t stream) {
  static int grid_blocks = 0;
  if (!grid_blocks) {
    int dev = 0, cus = 0, per_cu = 0;
    (void)hipGetDevice(&dev);
    (void)hipDeviceGetAttribute(&cus, hipDeviceAttributeMultiprocessorCount, dev);
    (void)hipFuncSetAttribute((const void*)fwd_mega, hipFuncAttributeMaxDynamicSharedMemorySize, LDS_BYTES);
    (void)hipOccupancyMaxActiveBlocksPerMultiprocessor(&per_cu, (const void*)fwd_mega, NT, LDS_BYTES);
    if (per_cu < 1) per_cu = 1;
    grid_blocks = cus * per_cu;
    if (ws_size < WS_END) fprintf(stderr, "workspace too small: %zu < %zu\n", ws_size, (size_t)WS_END);
  }
  Params p{};
  for (int i = 0; i < 22; ++i) p.in[i] = (const float*)d_in[i];
  p.out = (float*)d_out;
  p.ws = (unsigned char*)d_ws;
  (void)hipMemsetAsync((unsigned char*)d_ws + OFF_BAR, 0, 16384, stream);
  void* args[] = {&p};
  hipError_t e = hipLaunchCooperativeKernel((const void*)fwd_mega, dim3(grid_blocks), dim3(NT), args, LDS_BYTES, stream);
  if (e != hipSuccess) fprintf(stderr, "cooperative launch failed: %s (grid %d)\n", hipGetErrorString(e), grid_blocks);
}
```
